# Optimizing an MI355X kernel written in HIP

```python
import jax
import jax.numpy as jnp
from jax import lax
import numpy as np

D_MODEL = 1024
BATCH = 4
SEQ = 8192
DEPTH = 4

GRID_W = 64
CTX_LEN = 256
Q_BLOCK = 128
ROPE_THETA = 10000.0
HEAD_DIM = 64
A_HEADS = 8
A_KV_HEADS = 2
MLA_HEADS = 8
MLA_Q_RANK = 384
MLA_KV_RANK = 256
MLA_NOPE = 64
MLA_ROPE = 32
MLA_V = 64
NA_HEADS = 8
NBR_ROWS = 8
NBR_COLS = 16
HG_HEADS = 4
HG_EXPAND = 128
HG_WIDTH = HG_HEADS * HG_EXPAND
HG_CHUNK = 64
D_FF = 2816
N_EXPERTS = 8
TOP_K = 2
D_FF_EXPERT = 3584
ALPHA = (2 * DEPTH) ** 0.25
BETA = (8 * DEPTH) ** -0.25
N_EVEN = (DEPTH + 1) // 2
N_ODD = DEPTH // 2
EV_SIZES = (A_HEADS * HEAD_DIM, A_KV_HEADS * HEAD_DIM, A_KV_HEADS * HEAD_DIM, MLA_Q_RANK, MLA_KV_RANK, MLA_ROPE)
EV_IN = sum(EV_SIZES)
EV_OUT = A_HEADS * HEAD_DIM + MLA_HEADS * MLA_V
OD_SIZES = (NA_HEADS * HEAD_DIM,) * 3 + (HG_WIDTH,) * 5
OD_IN = sum(OD_SIZES)
OD_OUT = NA_HEADS * HEAD_DIM + HG_WIDTH
F32 = jnp.float32

kernel_name = 'hybrid_dit_gqa_mla_natten_hgrn2_moe'


def split_cols(p, sizes):
    out, start = [], 0
    for s in sizes:
        out.append(p[..., start:start + s])
        start += s
    return out


def rms_norm(x, g, eps=1e-6):
    xf = x.astype(F32)
    y = xf * lax.rsqrt(jnp.mean(xf * xf, axis=-1, keepdims=True) + eps)
    return (y * g.astype(F32)).astype(x.dtype)


def layer_norm(x, g, b, eps=1e-6):
    xf = x.astype(F32)
    mu = jnp.mean(xf, axis=-1, keepdims=True)
    var = jnp.mean(jnp.square(xf - mu), axis=-1, keepdims=True)
    return ((xf - mu) * lax.rsqrt(var + eps) * g.astype(F32) + b.astype(F32)).astype(x.dtype)


def modulate(x, shift, scale):
    return x * (1 + scale) + shift


def axial_rope_tables(n_tokens, rot_dim, dtype):
    axis_dim = rot_dim // 2
    inv_freq = ROPE_THETA ** (-jnp.arange(0, axis_dim, 2, dtype=F32) / axis_dim)
    t = jnp.arange(n_tokens, dtype=jnp.int32)
    pos = jnp.stack([t // GRID_W, t % GRID_W], axis=-1).astype(F32)
    ang = pos[:, :, None] * inv_freq
    ang = jnp.concatenate([ang, ang], axis=-1).reshape(n_tokens, rot_dim)
    return jnp.cos(ang).astype(dtype), jnp.sin(ang).astype(dtype)


def apply_axial_rope(x, cos, sin):
    rot_dim = x.shape[-1]
    axis_dim = rot_dim // 2
    half = axis_dim // 2
    xs = x.reshape(x.shape[:-1] + (2, axis_dim))
    rot = jnp.concatenate([-xs[..., half:], xs[..., :half]], axis=-1).reshape(x.shape)
    return x * cos[None, :, None, :] + rot * sin[None, :, None, :]


def blocked_attention(q, k, v):
    B, Sq, G, R, Dk = q.shape
    nb = Sq // Q_BLOCK
    scale = Dk ** -0.5
    qb = jnp.moveaxis(q.reshape(B, nb, Q_BLOCK, G, R, Dk), 1, 0)

    def one_block(qblk):
        s = jnp.einsum('bqgrd,bkgd->bgrqk', qblk, k).astype(F32) * scale
        p = jax.nn.softmax(s, axis=-1).astype(v.dtype)
        return jnp.einsum('bgrqk,bkgd->bqgrd', p, v)

    o = lax.map(one_block, qb)
    return jnp.moveaxis(o, 0, 1).reshape(B, Sq, G, R, v.shape[-1])


def neighbourhood_attention(q, k, v, k_ctx, v_ctx, rpb):
    B, S, H, Dh = q.shape
    rows = S // GRID_W
    kh = min(NBR_ROWS, rows)
    kw = NBR_COLS
    r = np.arange(rows)
    row_start = np.clip(r - kh // 2, 0, rows - kh)
    dr_idx = row_start[:, None] + np.arange(kh)[None, :] - r[:, None] + (NBR_ROWS - 1)
    cc = np.arange(GRID_W)
    col_start = np.clip(cc - kw // 2, 0, GRID_W - kw)
    col_idx = col_start[:, None] + np.arange(kw)[None, :]
    dc_idx = col_idx - cc[:, None] + (NBR_COLS - 1)
    rpb_c = rpb[:, :, dc_idx]
    scale = Dh ** -0.5
    q_rows = jnp.moveaxis(q.reshape(B, rows, GRID_W, H, Dh), 1, 0)
    kg = k.reshape(B, rows, GRID_W, H, Dh)
    vg = v.reshape(B, rows, GRID_W, H, Dh)
    n_win = kh * kw

    def one_row(args):
        q_r, r0, dr = args
        kb = lax.dynamic_slice_in_dim(kg, r0, kh, axis=1)
        vb = lax.dynamic_slice_in_dim(vg, r0, kh, axis=1)
        kwin = kb[:, :, col_idx]
        vwin = vb[:, :, col_idx]
        bias = jnp.take(rpb_c, dr, axis=1).transpose(0, 2, 1, 3).astype(F32)
        s_win = jnp.einsum('bchd,bicjhd->bhcij', q_r, kwin).astype(F32) * scale + bias[None]
        s_ctx = jnp.einsum('bchd,bkhd->bhck', q_r, k_ctx).astype(F32) * scale
        s = jnp.concatenate([s_win.reshape(B, H, GRID_W, n_win), s_ctx], axis=-1)
        p = jax.nn.softmax(s, axis=-1).astype(v.dtype)
        p_win = p[..., :n_win].reshape(B, H, GRID_W, kh, kw)
        p_ctx = p[..., n_win:]
        return (jnp.einsum('bhcij,bicjhd->bchd', p_win, vwin)
                + jnp.einsum('bhck,bkhd->bchd', p_ctx, v_ctx))

    o = lax.map(one_row, (q_rows, jnp.asarray(row_start, jnp.int32), jnp.asarray(dr_idx, jnp.int32)))
    return jnp.moveaxis(o, 0, 1).reshape(B, S, H, Dh)


def gla_chunk_scan(q, k, v, log_f, s0, with_outputs):
    B, L, H, E = q.shape
    n = L // HG_CHUNK

    def to_chunks(t):
        return t.reshape(B, n, HG_CHUNK, H, E).transpose(1, 0, 3, 2, 4)

    causal = jnp.tril(jnp.ones((HG_CHUNK, HG_CHUNK), dtype=bool))

    def step(state, blk):
        qc, kc, vc, gc = blk
        b = jnp.cumsum(gc, axis=2)
        b_end = b[:, :, -1, :]
        k_end = kc * jnp.exp(b_end[:, :, None, :] - b)
        new_state = jnp.exp(b_end)[..., None] * state + jnp.einsum('bhse,bhsf->bhef', k_end, vc)
        if not with_outputs:
            return new_state, None
        diff = b[:, :, :, None, :] - b[:, :, None, :, :]
        decay = jnp.exp(jnp.where(causal[:, :, None], diff, -jnp.inf))
        scores = jnp.einsum('bhte,bhtse,bhse->bhts', qc, decay, kc)
        out = (jnp.einsum('bhts,bhsf->bhtf', scores, vc)
               + jnp.einsum('bhte,bhef->bhtf', qc * jnp.exp(b), state))
        return new_state, out

    final, outs = lax.scan(step, s0, (to_chunks(q), to_chunks(k), to_chunks(v), to_chunks(log_f)))
    if not with_outputs:
        return final, None
    return final, outs.transpose(1, 0, 3, 2, 4).reshape(B, L, H, E)


def hgrn_forget(z, lb):
    zf = z.astype(F32)
    lb = lb.reshape(HG_HEADS, HG_EXPAND)
    f = lb + (1.0 - lb) * jax.nn.sigmoid(zf)
    return (1.0 - lb) * jax.nn.sigmoid(-zf), jnp.log(f)


def hgrn2_bidirectional(lat, ctx, need_ctx):
    ql, vl, kfl, gfl, kbl, gbl = lat
    qc, vc, kfc, gfc, kbc, gbc = ctx
    B = ql.shape[0]
    s0 = jnp.zeros((B, HG_HEADS, HG_EXPAND, HG_EXPAND), F32)
    flip = lambda t: jnp.flip(t, axis=1)
    s_cf, o_cf = gla_chunk_scan(qc, kfc, vc, gfc, s0, need_ctx)
    _, o_lf = gla_chunk_scan(ql, kfl, vl, gfl, s_cf, True)
    s_cb, o_cb = gla_chunk_scan(flip(qc), flip(kbc), flip(vc), flip(gbc), s0, need_ctx)
    _, o_lb = gla_chunk_scan(flip(ql), flip(kbl), flip(vl), flip(gbl), s_cb, True)
    o_l = o_lf + flip(o_lb)
    o_c = (o_cf + flip(o_cb)) if need_ctx else None
    return o_l, o_c


def hgrn_readout(o, g, onorm_g):
    B, L = g.shape[:2]
    y = rms_norm(o, onorm_g) * jax.nn.silu(g.astype(F32))
    return y.astype(g.dtype).reshape(B, L, HG_WIDTH)


def attn_mla_mixer(hl, hc, w_in, qn_g, kn_g, cq_g, ckv_g, w_uq, w_ukv, w_out, rope_a, rope_b, need_ctx):
    def project(h, with_rope):
        B, L, _ = h.shape
        qa, ka, va, cq, ckv, kr = split_cols(h @ w_in, EV_SIZES)
        qa = rms_norm(qa.reshape(B, L, A_HEADS, HEAD_DIM), qn_g)
        ka = rms_norm(ka.reshape(B, L, A_KV_HEADS, HEAD_DIM), kn_g)
        va = va.reshape(B, L, A_KV_HEADS, HEAD_DIM)
        qb = (rms_norm(cq, cq_g) @ w_uq).reshape(B, L, MLA_HEADS, MLA_NOPE + MLA_ROPE)
        kvb = (rms_norm(ckv, ckv_g) @ w_ukv).reshape(B, L, MLA_HEADS, MLA_NOPE + MLA_V)
        q_rope = qb[..., MLA_NOPE:]
        k_rope = kr.reshape(B, L, 1, MLA_ROPE)
        if with_rope:
            qa = apply_axial_rope(qa, *rope_a)
            ka = apply_axial_rope(ka, *rope_a)
            q_rope = apply_axial_rope(q_rope, *rope_b)
            k_rope = apply_axial_rope(k_rope, *rope_b)
        qb = jnp.concatenate([qb[..., :MLA_NOPE], q_rope], axis=-1)
        kb = jnp.concatenate([kvb[..., :MLA_NOPE], jnp.broadcast_to(k_rope, (B, L, MLA_HEADS, MLA_ROPE))], axis=-1)
        vb = kvb[..., MLA_NOPE:]
        qa = qa.reshape(B, L, A_KV_HEADS, A_HEADS // A_KV_HEADS, HEAD_DIM)
        return qa, ka, va, qb[:, :, :, None, :], kb, vb

    B, S, _ = hl.shape
    qa_l, ka_l, va_l, qb_l, kb_l, vb_l = project(hl, True)
    qa_c, ka_c, va_c, qb_c, kb_c, vb_c = project(hc, False)
    oa_l = blocked_attention(qa_l, jnp.concatenate([ka_l, ka_c], axis=1), jnp.concatenate([va_l, va_c], axis=1))
    ob_l = blocked_attention(qb_l, jnp.concatenate([kb_l, kb_c], axis=1), jnp.concatenate([vb_l, vb_c], axis=1))
    yl = jnp.concatenate([oa_l.reshape(B, S, A_HEADS * HEAD_DIM), ob_l.reshape(B, S, MLA_HEADS * MLA_V)], axis=-1) @ w_out
    if not need_ctx:
        return yl, None
    Lc = hc.shape[1]
    oa_c = blocked_attention(qa_c, ka_c, va_c)
    ob_c = blocked_attention(qb_c, kb_c, vb_c)
    yc = jnp.concatenate([oa_c.reshape(B, Lc, A_HEADS * HEAD_DIM), ob_c.reshape(B, Lc, MLA_HEADS * MLA_V)], axis=-1) @ w_out
    return yl, yc


def na_hgrn_mixer(hl, hc, w_in, rpb, lb_fwd, lb_bwd, onorm_g, w_out, need_ctx):
    def project(h):
        B, L, _ = h.shape
        parts = split_cols(h @ w_in, OD_SIZES)
        qn, kn, vn = [p.reshape(B, L, NA_HEADS, HEAD_DIM) for p in parts[:3]]
        qd, vd, zf, zb, gd = [p.reshape(B, L, HG_HEADS, HG_EXPAND) for p in parts[3:]]
        k_f, logf_f = hgrn_forget(zf, lb_fwd)
        k_b, logf_b = hgrn_forget(zb, lb_bwd)
        hg = (jax.nn.silu(qd).astype(F32), vd.astype(F32), k_f, logf_f, k_b, logf_b)
        return (qn, kn, vn), hg, gd

    B, S, _ = hl.shape
    (qn_l, kn_l, vn_l), hg_l, g_l = project(hl)
    (qn_c, kn_c, vn_c), hg_c, g_c = project(hc)
    on_l = neighbourhood_attention(qn_l, kn_l, vn_l, kn_c, vn_c, rpb)
    od_l, od_c = hgrn2_bidirectional(hg_l, hg_c, need_ctx)
    yl = jnp.concatenate([on_l.reshape(B, S, NA_HEADS * HEAD_DIM), hgrn_readout(od_l, g_l, onorm_g)], axis=-1) @ w_out
    if not need_ctx:
        return yl, None
    Lc = hc.shape[1]
    on_c = blocked_attention(qn_c[:, :, :, None, :], kn_c, vn_c)
    yc = jnp.concatenate([on_c.reshape(B, Lc, NA_HEADS * HEAD_DIM), hgrn_readout(od_c, g_c, onorm_g)], axis=-1) @ w_out
    return yl, yc


def swiglu(h, wg, wu, wd):
    return (jax.nn.silu(h @ wg) * (h @ wu)) @ wd


def moe_ffn(h, router, wg, wu, wd):
    logits = (h @ router).astype(F32)
    top_v, top_i = lax.top_k(logits, TOP_K)
    w = jax.nn.softmax(top_v, axis=-1)
    gates = jnp.sum(jax.nn.one_hot(top_i, N_EXPERTS, dtype=F32) * w[..., None], axis=-2).astype(h.dtype)
    y = jnp.zeros_like(h)
    for e in range(N_EXPERTS):
        y = y + gates[..., e:e + 1] * swiglu(h, wg[e], wu[e], wd[e])
    return y


def setup_inputs(seed: int = 0) -> dict:
    key = jax.random.key(seed)
    ks = iter(jax.random.split(key, 40))
    D = D_MODEL

    def nrm(shape, scale):
        return jax.random.normal(next(ks), shape, F32) * scale

    def gain(shape):
        return 1.0 + nrm(shape, 0.02)

    return {
        'x': nrm((BATCH, SEQ, D), 1.0),
        'c': nrm((BATCH, D), 1.0),
        'ctx': nrm((BATCH, CTX_LEN, D), 1.0),
        'c_ctx': nrm((D,), 1.0),
        'ada_w': nrm((DEPTH, D, 6 * D), 0.5 * D ** -0.5),
        'ada_b': nrm((DEPTH, 6 * D), 0.02),
        'ln1_g': gain((DEPTH, D)),
        'ln1_b': nrm((DEPTH, D), 0.02),
        'ln2_g': gain((DEPTH, D)),
        'ln2_b': nrm((DEPTH, D), 0.02),
        'ev_w_in': nrm((N_EVEN, D, EV_IN), D ** -0.5),
        'ev_qn_g': gain((N_EVEN, HEAD_DIM)),
        'ev_kn_g': gain((N_EVEN, HEAD_DIM)),
        'ev_cq_g': gain((N_EVEN, MLA_Q_RANK)),
        'ev_ckv_g': gain((N_EVEN, MLA_KV_RANK)),
        'ev_w_uq': nrm((N_EVEN, MLA_Q_RANK, MLA_HEADS * (MLA_NOPE + MLA_ROPE)), MLA_Q_RANK ** -0.5),
        'ev_w_ukv': nrm((N_EVEN, MLA_KV_RANK, MLA_HEADS * (MLA_NOPE + MLA_V)), MLA_KV_RANK ** -0.5),
        'ev_w_out': nrm((N_EVEN, EV_OUT, D), BETA * EV_OUT ** -0.5),
        'ff_w_gate': nrm((N_EVEN, D, D_FF), D ** -0.5),
        'ff_w_up': nrm((N_EVEN, D, D_FF), D ** -0.5),
        'ff_w_down': nrm((N_EVEN, D_FF, D), BETA * D_FF ** -0.5),
        'od_w_in': nrm((N_ODD, D, OD_IN), D ** -0.5),
        'od_rpb': nrm((N_ODD, NA_HEADS, 2 * NBR_ROWS - 1, 2 * NBR_COLS - 1), 0.02),
        'od_lb_logits': nrm((2, N_ODD, HG_WIDTH), 0.1),
        'od_onorm_g': gain((N_ODD, HG_EXPAND)),
        'od_w_out': nrm((N_ODD, OD_OUT, D), BETA * OD_OUT ** -0.5),
        'moe_router': nrm((N_ODD, D, N_EXPERTS), D ** -0.5),
        'moe_w_gate': nrm((N_ODD, N_EXPERTS, D, D_FF_EXPERT), D ** -0.5),
        'moe_w_up': nrm((N_ODD, N_EXPERTS, D, D_FF_EXPERT), D ** -0.5),
        'moe_w_down': nrm((N_ODD, N_EXPERTS, D_FF_EXPERT, D), BETA * D_FF_EXPERT ** -0.5),
    }


def reference(x, c, ctx, c_ctx, ada_w, ada_b, ln1_g, ln1_b, ln2_g, ln2_b,
              ev_w_in, ev_qn_g, ev_kn_g, ev_cq_g, ev_ckv_g, ev_w_uq, ev_w_ukv, ev_w_out,
              ff_w_gate, ff_w_up, ff_w_down,
              od_w_in, od_rpb, od_lb_logits, od_onorm_g, od_w_out,
              moe_router, moe_w_gate, moe_w_up, moe_w_down):
    B, S, _ = x.shape
    rope_a = axial_rope_tables(S, HEAD_DIM, x.dtype)
    rope_b = axial_rope_tables(S, MLA_ROPE, x.dtype)
    lb_p = jax.nn.softmax(od_lb_logits.astype(F32), axis=1)
    lb_tab = jnp.cumsum(lb_p, axis=1) - lb_p[:, :1]
    s_lat = jax.nn.silu(c)
    s_ctx = jax.nn.silu(c_ctx)
    xl, xc = x, ctx

    for layer in range(DEPTH):
        need_ctx = layer < DEPTH - 1
        j = layer // 2
        mod_l = jnp.split((s_lat @ ada_w[layer] + ada_b[layer])[:, None, :], 6, axis=-1)
        mod_c = jnp.split((s_ctx @ ada_w[layer] + ada_b[layer])[None, None, :], 6, axis=-1)
        hl = modulate(xl, mod_l[0], mod_l[1])
        hc = modulate(xc, mod_c[0], mod_c[1])
        if layer % 2 == 0:
            yl, yc = attn_mla_mixer(hl, hc, ev_w_in[j], ev_qn_g[j], ev_kn_g[j], ev_cq_g[j], ev_ckv_g[j],
                                    ev_w_uq[j], ev_w_ukv[j], ev_w_out[j], rope_a, rope_b, need_ctx)
        else:
            yl, yc = na_hgrn_mixer(hl, hc, od_w_in[j], od_rpb[j], lb_tab[0, j], lb_tab[1, j],
                                   od_onorm_g[j], od_w_out[j], need_ctx)

        def channel_mixer(h):
            if layer % 2 == 0:
                return swiglu(h, ff_w_gate[j], ff_w_up[j], ff_w_down[j])
            return moe_ffn(h, moe_router[j], moe_w_gate[j], moe_w_up[j], moe_w_down[j])

        xl = layer_norm(ALPHA * xl + mod_l[2] * yl, ln1_g[layer], ln1_b[layer])
        xl = layer_norm(ALPHA * xl + mod_l[5] * channel_mixer(modulate(xl, mod_l[3], mod_l[4])),
                        ln2_g[layer], ln2_b[layer])
        if need_ctx:
            xc = layer_norm(ALPHA * xc + mod_c[2] * yc, ln1_g[layer], ln1_b[layer])
            xc = layer_norm(ALPHA * xc + mod_c[5] * channel_mixer(modulate(xc, mod_c[3], mod_c[4])),
                            ln2_g[layer], ln2_b[layer])
    return xl
```

```cpp
#include <hip/hip_runtime.h>
#include <cstdio>
#include <cstdint>

#ifndef MK_MULTI
#define MK_MULTI 1
#endif

constexpr int DM = 1024, NB = 4, SEQ = 8192, CTXL = 256, GRIDW = 64;
constexpr int MLAT = NB * SEQ, MCTX = NB * CTXL, MROWS = MLAT + MCTX;
constexpr int DEPTH = 4;
constexpr int EV_IN = 1440, EV_INP = 1536;
constexpr int DFF = 2816, DFFE = 3584, NEXP = 8;
constexpr int MOE_ROWS = 2 * MROWS + NEXP * 256;
constexpr float ALPHA = 1.6817928305074290f;
constexpr float LOG2E = 1.4426950408889634f;
constexpr float C2_64 = 0.125f * LOG2E;
constexpr float C2_96 = 0.10206207261596577f * LOG2E;

constexpr size_t MiB = 1u << 20;
constexpr size_t WS_CTL = 0, CTL_ZERO_BYTES = 1 * MiB;
constexpr size_t WS_SMALL = 2 * MiB;
constexpr size_t WS_TOPK = 4 * MiB;
constexpr size_t WS_W = 6 * MiB;
constexpr size_t WS_WMOE = 72 * MiB;
constexpr size_t WS_X = 240 * MiB;
constexpr size_t WS_H = 372 * MiB;
constexpr size_t WS_S = 438 * MiB;
constexpr size_t WS_RAW = WS_S;
constexpr size_t WS_QG = 636 * MiB, WS_KG = 669 * MiB, WS_VG = 678 * MiB, WS_CQN = 687 * MiB, WS_CKVN = 712 * MiB;
constexpr size_t WS_QM = 729 * MiB, WS_KM = 779 * MiB, WS_VM = 829 * MiB, WS_OE = 862 * MiB;
constexpr size_t WS_FFH = WS_S;
constexpr size_t WS_QN = 438 * MiB, WS_KN = 471 * MiB, WS_VN = 504 * MiB, WS_QD = 537 * MiB, WS_VD = 570 * MiB, WS_SG = 603 * MiB;
constexpr size_t WS_ZF = 636 * MiB, WS_ZB = 702 * MiB, WS_OO = 768 * MiB, WS_HST = 834 * MiB, WS_HDM = 966 * MiB;
constexpr size_t WS_MH = 372 * MiB;
constexpr size_t WS_XG = 848 * MiB;
constexpr size_t WS_END = 984 * MiB;
static_assert(WS_QG >= WS_RAW + (size_t)MROWS * EV_INP * 4 && WS_OE + (size_t)MROWS * 2048 <= 984 * MiB, "even map");
static_assert(WS_HST + (size_t)32 * 66 * 65536 <= WS_HDM && WS_HDM + (size_t)32 * 66 * 512 <= WS_END, "odd map");
static_assert(WS_MH + (size_t)MOE_ROWS * DFFE * 2 <= WS_XG && WS_XG + (size_t)MOE_ROWS * 2048 <= WS_END, "moe map");
constexpr size_t SM_MODS = 0;
constexpr size_t SM_ROPEA = 512 * 1024;
constexpr size_t SM_ROPEB = SM_ROPEA + 16384;
constexpr size_t SM_LB = SM_ROPEB + 8192;
constexpr size_t W_EVIN = 0;
constexpr size_t W_UQ = W_EVIN + (size_t)2 * 1536 * 1024;
constexpr size_t W_UKV = W_UQ + (size_t)2 * 768 * 384;
constexpr size_t W_EVOUT = W_UKV + (size_t)2 * 1024 * 256;
constexpr size_t W_FFGU = W_EVOUT + (size_t)2 * 1024 * 1024;
constexpr size_t W_FFD = W_FFGU + (size_t)2 * 5632 * 1024;
constexpr size_t W_ODIN = W_FFD + (size_t)2 * 1024 * 2816;
constexpr size_t W_ODOUT = W_ODIN + (size_t)2 * 4096 * 1024;
constexpr size_t W_ENDE = W_ODOUT + (size_t)2 * 1024 * 1024;
static_assert(W_ENDE * 2 <= 66 * MiB, "weights map");
constexpr size_t WM_GU = 0;
constexpr size_t WM_D = (size_t)8 * 7168 * 1024;
constexpr int CW_BAR = 4096;
constexpr int CW_CNT = 8192;
constexpr int CW_CNT2 = 8192 + 256;
constexpr int LDS_BYTES = 160256;
constexpr int MISC_OFF = LDS_BYTES - 512;
constexpr int NWAVES = 8, NTHR = 512;

#define GAS __attribute__((address_space(1)))
#define LAS __attribute__((address_space(3)))
typedef unsigned short bf16;
typedef unsigned v4u __attribute__((ext_vector_type(4)));
typedef unsigned v2u __attribute__((ext_vector_type(2)));
typedef float f32x4 __attribute__((ext_vector_type(4)));
typedef float f32x16 __attribute__((ext_vector_type(16)));
typedef short bf16x8 __attribute__((ext_vector_type(8)));
typedef short s16x4 __attribute__((ext_vector_type(4)));
typedef GAS unsigned gu32;

__device__ __forceinline__ unsigned pkbf(float lo, float hi) { unsigned r; asm volatile("v_cvt_pk_bf16_f32 %0, %1, %2" : "=v"(r) : "v"(lo), "v"(hi)); return r; }
__device__ __forceinline__ float bf_lo(unsigned u) { return __uint_as_float(u << 16); }
__device__ __forceinline__ float bf_hi(unsigned u) { return __uint_as_float(u & 0xffff0000u); }
__device__ __forceinline__ float bf2f(bf16 h) { return __uint_as_float(((unsigned)h) << 16); }
__device__ __forceinline__ bf16 f2bf(float f) { return (bf16)(pkbf(f, 0.f) & 0xffffu); }
__device__ __forceinline__ float fast_exp2(float x) { return __builtin_amdgcn_exp2f(x); }
__device__ __forceinline__ float sigmoidf_(float x) { return 1.f / (1.f + __expf(-x)); }
__device__ __forceinline__ float siluf_(float x) { return x / (1.f + __expf(-x)); }
__device__ __forceinline__ float shx(float v, int m, int lane) { return __int_as_float(__builtin_amdgcn_ds_bpermute((lane ^ m) << 2, __float_as_int(v))); }
__device__ __forceinline__ float wave_sum(float v, int lane) {
#pragma unroll
    for (int o = 1; o < 64; o <<= 1) v += shx(v, o, lane);
    return v;
}
__device__ __forceinline__ int modrow(int row) { return row < MLAT ? (row >> 13) : 4; }
namespace pg8 {
#define PG8_LAS __attribute__((address_space(3)))
typedef unsigned short bf16_t;
typedef short bf16x8 __attribute__((ext_vector_type(8)));
typedef float f32x4 __attribute__((ext_vector_type(4)));
typedef unsigned u32x4 __attribute__((ext_vector_type(4)));
constexpr int BM = 256, BK = 64, HALF = 128, HTB = HALF * BK * 2  , STAGE_BYTES = 8 * HTB, NXCD = 8, WGM = 8;

__host__ __device__ __forceinline__ int lds_byte(int r, int c) { const int st = (r >> 4) * 2 + (c >> 5), rr = r & 15, cc = c & 31, ob = rr * 64 + cc * 2; return st * 1024 + (ob ^ (((ob >> 9) & 1) << 5)); }
__host__ __device__ __forceinline__ void stage_rc(int b, int& R, int& C) { const int st = b / 1024, sb = b % 1024, swz = sb ^ (((sb >> 9) & 1) << 5); R = (st >> 1) * 16 + swz / 64; C = (st & 1) * 32 + (swz % 64) / 2; }
__host__ __device__ __forceinline__ int perm32(int rho) { const int n = rho >> 4, i = rho & 15; return 8 * (i >> 2) + 4 * n + (i & 3); }

struct Unit { int pm, pn; long boff; };
struct Gemm { const bf16_t* A; const bf16_t* Bt; int M, N, K; };

struct StaticOrder {
    int nM, nN, nwg, G, c;
    __host__ __device__ void init(int M, int N, int G_, int c_) { nM = M / BM; nN = N / BM; nwg = nM * nN; G = G_; c = c_; }
    __host__ __device__ bool next(int i, Unit& u) const {
        const long L = (long)i * G + c; if (L >= nwg) return false;
        int wgid = (int)L; { const int q = nwg / NXCD, r = nwg % NXCD, xcd = wgid % NXCD, off = wgid / NXCD; wgid = (xcd < r ? xcd * (q + 1) : r * (q + 1) + (xcd - r) * q) + off; }
        const int nig = WGM * nN, gid = wgid / nig, fm = gid * WGM, gsz = (nM - fm) < WGM ? (nM - fm) : WGM;
        u.pm = fm + ((wgid % nig) % gsz); u.pn = (wgid % nig) / gsz; u.boff = 0; return true;
    }
    __device__ __forceinline__ void a_ready(const Unit&) const {}
    __device__ __forceinline__ void done(const Unit&) const {}
};

__device__ __forceinline__ unsigned cvt_pk_bf16(float lo, float hi) { unsigned r; asm volatile("v_cvt_pk_bf16_f32 %0, %1, %2" : "=v"(r) : "v"(lo), "v"(hi)); return r; }
typedef float f32x2 __attribute__((ext_vector_type(2)));
template <class Epi, class Sched, bool ALIGN_EPI = false, bool SP2 = false>
__device__ __forceinline__ void gemm_phase(PG8_LAS unsigned char* lds, const Gemm g, const Sched& S, const Epi& E, int tid_in) {
    int tid_ = tid_in; asm volatile("" : "+v"(tid_));
    const int tid = tid_, wid = __builtin_amdgcn_readfirstlane(tid >> 6), lane = tid & 63, wr = wid >> 2, wc = wid & 3, fr = lane & 15, fq = lane >> 4;
    const int K = g.K, nt = K / BK;
    unsigned voffA[2], voffB[2];
#pragma unroll
    for (int i = 0; i < 2; ++i) { int R, C; stage_rc(tid * 16 + i * 8192, R, C); const int Rb = Epi::PERM ? ((R & ~31) + perm32(R & 31)) : R;
        voffA[i] = (unsigned)(R * K + C) * 2u; voffB[i] = (unsigned)(Rb * K + C) * 2u; }
    const size_t kstep = (size_t)(BK * 2);
    const size_t hstep = (size_t)HALF * K * 2;
    const size_t tstep = 2 * hstep;
    const unsigned ldsw = (unsigned)wid * 1024u;
    const int aoff = lds_byte(wr * 64 + fr, fq * 8), boff = lds_byte(wc * 32 + fr, fq * 8);
#define PG8_SA(b, h) (((b) * 2 + (h)) * HTB)
#define PG8_SB(b, h) ((4 + (b) * 2 + (h)) * HTB)
#define PG8_STAGE(bufoff, gbase, voff) do { _Pragma("unroll") for (int _i = 0; _i < 2; ++_i) \
        __builtin_amdgcn_global_load_lds((const unsigned*)((const char*)(gbase) + (voff)[_i]), (PG8_LAS unsigned*)(lds + (bufoff) + ldsw + _i * 8192), 16, 0, 0); } while (0)
#define PG8_LDA(dst, b, h) do { _Pragma("unroll") for (int m = 0; m < 4; ++m) _Pragma("unroll") for (int k = 0; k < 2; ++k) dst[m][k] = *(const PG8_LAS bf16x8*)(lds + PG8_SA(b, h) + aoff + m * 2048 + k * 1024); } while (0)
#define PG8_LDB(dst, b, h) do { _Pragma("unroll") for (int n = 0; n < 2; ++n) _Pragma("unroll") for (int k = 0; k < 2; ++k) dst[n][k] = *(const PG8_LAS bf16x8*)(lds + PG8_SB(b, h) + boff + n * 2048 + k * 1024); } while (0)
#define PG8_MMA(ai, bj, At, Bt) do { __builtin_amdgcn_s_setprio(1); _Pragma("unroll") for (int m = 0; m < 4; ++m) _Pragma("unroll") for (int n = 0; n < 2; ++n) _Pragma("unroll") for (int k = 0; k < 2; ++k) \
        acc[ai][bj][m][n] = __builtin_amdgcn_mfma_f32_16x16x32_bf16(Bt[n][k], At[m][k], acc[ai][bj][m][n], 0, 0, 0); __builtin_amdgcn_s_setprio(0); } while (0)
#define PG8_WAIT_V(n) asm volatile("s_waitcnt vmcnt(" #n ")" ::: "memory")
#define PG8_WAIT_L(n) asm volatile("s_waitcnt lgkmcnt(" #n ")" ::: "memory")
#define PG8_BAR __builtin_amdgcn_s_barrier()
#define PG8_SCHED __builtin_amdgcn_sched_barrier(0)
    Unit cur, nxt; int ui = 0;
    if (!S.next(0, cur)) return;
    f32x4 acc[2][2][4][2];
#pragma unroll
    for (int a = 0; a < 2; ++a)
#pragma unroll
        for (int b = 0; b < 2; ++b)
#pragma unroll
            for (int m = 0; m < 4; ++m)
#pragma unroll
                for (int n = 0; n < 2; ++n) acc[a][b][m][n] = (f32x4){0.f, 0.f, 0.f, 0.f};
    bf16x8 At[4][2], B0[2][2], B1[2][2];
    const char* cA = (const char*)g.A + (size_t)cur.pm * tstep; const char* cB = (const char*)g.Bt + (size_t)cur.pn * tstep + cur.boff;
    S.a_ready(cur);
    if constexpr (SP2) {
        PG8_STAGE(PG8_SB(0, 0), cB, voffB); PG8_STAGE(PG8_SB(0, 1), cB + hstep, voffB); PG8_STAGE(PG8_SA(0, 0), cA, voffA); PG8_STAGE(PG8_SA(0, 1), cA + hstep, voffA);
        if (wr == 1) PG8_BAR;
        PG8_WAIT_V(2); PG8_BAR;
        PG8_STAGE(PG8_SB(1, 0), cB + kstep, voffB); PG8_STAGE(PG8_SA(1, 0), cA + kstep, voffA); PG8_STAGE(PG8_SB(1, 1), cB + hstep + kstep, voffB);
        PG8_WAIT_V(6); PG8_BAR;
    } else {
        PG8_STAGE(PG8_SB(0, 0), cB, voffB); PG8_STAGE(PG8_SA(0, 0), cA, voffA); PG8_STAGE(PG8_SB(0, 1), cB + hstep, voffB); PG8_STAGE(PG8_SA(0, 1), cA + hstep, voffA);
        if (wr == 1) PG8_BAR;
        PG8_WAIT_V(4); PG8_BAR;
        PG8_STAGE(PG8_SB(1, 0), cB + kstep, voffB); PG8_STAGE(PG8_SA(1, 0), cA + kstep, voffA); PG8_STAGE(PG8_SB(1, 1), cB + hstep + kstep, voffB);
        PG8_WAIT_V(6); PG8_BAR;
    }
    for (;;) {
        const bool has_next = S.next(ui + 1, nxt);
        const char* nA = has_next ? (const char*)g.A + (size_t)nxt.pm * tstep : cA; const char* nB = has_next ? (const char*)g.Bt + (size_t)nxt.pn * tstep + nxt.boff : cB;
        for (int t = 0; t < nt; t += 2) {
            const bool last = (t == nt - 2);
            const char* a1 = cA + (size_t)(t + 1) * kstep;
            const char* a2 = last ? nA : cA + (size_t)(t + 2) * kstep; const char* b2 = last ? nB : cB + (size_t)(t + 2) * kstep;
            const char* a3 = a2 + kstep; const char* b3 = b2 + kstep;
            if (last && has_next) S.a_ready(nxt);
            if constexpr (SP2) {
            PG8_LDB(B0, 0, 0); PG8_LDB(B1, 0, 1); PG8_SCHED; PG8_LDA(At, 0, 0); PG8_STAGE(PG8_SA(1, 1), a1 + hstep, voffA);
            PG8_WAIT_V(8); PG8_WAIT_L(0); PG8_BAR; PG8_MMA(0, 0, At, B0); PG8_MMA(0, 1, At, B1); PG8_BAR; PG8_SCHED;
            PG8_LDA(At, 0, 1); PG8_STAGE(PG8_SB(0, 0), b2, voffB); PG8_STAGE(PG8_SB(0, 1), b2 + hstep, voffB); PG8_STAGE(PG8_SA(0, 0), a2, voffA);
            PG8_WAIT_V(8); PG8_WAIT_L(0); PG8_BAR; PG8_MMA(1, 0, At, B0); PG8_MMA(1, 1, At, B1); PG8_BAR; PG8_SCHED;
            PG8_LDB(B0, 1, 0); PG8_LDB(B1, 1, 1); PG8_SCHED; PG8_LDA(At, 1, 0); PG8_STAGE(PG8_SA(0, 1), a2 + hstep, voffA);
            PG8_WAIT_V(8); PG8_WAIT_L(0); PG8_BAR; PG8_MMA(0, 0, At, B0); PG8_MMA(0, 1, At, B1); PG8_BAR; PG8_SCHED;
            PG8_LDA(At, 1, 1); PG8_STAGE(PG8_SB(1, 0), b3, voffB); PG8_STAGE(PG8_SB(1, 1), b3 + hstep, voffB); PG8_STAGE(PG8_SA(1, 0), a3, voffA);
            PG8_WAIT_V(8); PG8_WAIT_L(0); PG8_BAR; PG8_MMA(1, 0, At, B0); PG8_MMA(1, 1, At, B1); PG8_BAR; PG8_SCHED;
            } else {
            PG8_LDB(B0, 0, 0); PG8_SCHED; PG8_LDA(At, 0, 0); PG8_STAGE(PG8_SA(1, 1), a1 + hstep, voffA);
            PG8_WAIT_L(8); PG8_BAR; PG8_WAIT_L(0); PG8_MMA(0, 0, At, B0); PG8_BAR; PG8_SCHED;
            PG8_LDB(B1, 0, 1); PG8_STAGE(PG8_SB(0, 0), b2, voffB);
            PG8_BAR; PG8_WAIT_L(0); PG8_MMA(0, 1, At, B1); PG8_BAR;
            PG8_LDA(At, 0, 1); PG8_STAGE(PG8_SA(0, 0), a2, voffA);
            PG8_BAR; PG8_WAIT_L(0); PG8_MMA(1, 0, At, B0); PG8_BAR; PG8_SCHED;
            PG8_STAGE(PG8_SB(0, 1), b2 + hstep, voffB);
            PG8_WAIT_V(6); PG8_BAR; PG8_MMA(1, 1, At, B1); PG8_BAR;
            PG8_LDB(B0, 1, 0); PG8_SCHED; PG8_LDA(At, 1, 0); PG8_STAGE(PG8_SA(0, 1), a2 + hstep, voffA);
            PG8_WAIT_L(8); PG8_BAR; PG8_WAIT_L(0); PG8_MMA(0, 0, At, B0); PG8_BAR; PG8_SCHED;
            PG8_LDB(B1, 1, 1); PG8_STAGE(PG8_SB(1, 0), b3, voffB);
            PG8_BAR; PG8_WAIT_L(0); PG8_MMA(0, 1, At, B1); PG8_BAR;
            PG8_LDA(At, 1, 1); PG8_STAGE(PG8_SA(1, 0), a3, voffA);
            PG8_BAR; PG8_WAIT_L(0); PG8_MMA(1, 0, At, B0); PG8_BAR; PG8_SCHED;
            PG8_STAGE(PG8_SB(1, 1), b3 + hstep, voffB);
            PG8_WAIT_V(6); PG8_BAR; PG8_MMA(1, 1, At, B1); PG8_BAR;
            }
        }
        if constexpr (ALIGN_EPI) { if (wr == 0) PG8_BAR; }
        if constexpr (!Epi::AFTER_DRAIN) { int l2_; asm volatile("v_mbcnt_lo_u32_b32 %0, -1, 0\n\tv_mbcnt_hi_u32_b32 %0, -1, %0" : "=v"(l2_)); const int fr2 = l2_ & 15, fq2 = l2_ >> 4;     E(acc, cur, wr, wc, fr2, fq2); S.done(cur); }
        if (!has_next) break;
#pragma unroll
        for (int a = 0; a < 2; ++a)
#pragma unroll
            for (int b = 0; b < 2; ++b)
#pragma unroll
                for (int m = 0; m < 4; ++m)
#pragma unroll
                    for (int n = 0; n < 2; ++n) acc[a][b][m][n] = (f32x4){0.f, 0.f, 0.f, 0.f};
        cur = nxt; cA = nA; cB = nB; ++ui;
        if constexpr (ALIGN_EPI) { if (wr == 1) PG8_BAR; }
    }
    PG8_WAIT_V(0);
    if constexpr (!ALIGN_EPI) { if (wr == 0) PG8_BAR; }
    PG8_BAR;
    if constexpr (Epi::AFTER_DRAIN) { E.fused(acc, cur, wr, wc, fr, fq, lds, wid, lane); S.done(cur); }
#undef PG8_SA
#undef PG8_SB
#undef PG8_STAGE
#undef PG8_LDA
#undef PG8_LDB
#undef PG8_MMA
#undef PG8_WAIT_V
#undef PG8_WAIT_L
#undef PG8_BAR
#undef PG8_SCHED
}
}
namespace pg8 {
constexpr int NEXP_ = 8;
template <class F> __device__ __forceinline__ void walk8(const f32x4 (&acc)[2][2][4][2], const Unit& u, int wr, int wc, int fr, int fq, const F& f) {
    const int row0 = u.pm * BM + wr * 64 + fr, col0 = u.pn * BM + wc * 32 + 8 * fq;
#pragma unroll
    for (int ai = 0; ai < 2; ++ai)
#pragma unroll
        for (int m = 0; m < 4; ++m)
#pragma unroll
            for (int bj = 0; bj < 2; ++bj) {
                const f32x4 a = acc[ai][bj][m][0], b = acc[ai][bj][m][1];
                float v[8] = {a[0], a[1], a[2], a[3], b[0], b[1], b[2], b[3]};
                f.emit(row0 + ai * HALF + m * 16, col0 + bj * HALF, v);
                asm volatile("" ::: "memory");
            }
}
__device__ __forceinline__ u32x4 pack8(const float (&v)[8], float s) {
    u32x4 w; w.x = cvt_pk_bf16(v[0] * s, v[1] * s); w.y = cvt_pk_bf16(v[2] * s, v[3] * s); w.z = cvt_pk_bf16(v[4] * s, v[5] * s); w.w = cvt_pk_bf16(v[6] * s, v[7] * s); return w;
}
struct EpiRawF32 {
    static constexpr bool PERM = true, AFTER_DRAIN = false;
    float* O; int ldc;
    __device__ __forceinline__ void emit(int row, int col, const float (&v)[8]) const {
        float* p = O + (size_t)row * ldc + col; *(f32x4*)p = (f32x4){v[0], v[1], v[2], v[3]}; *(f32x4*)(p + 4) = (f32x4){v[4], v[5], v[6], v[7]};
    }
    __device__ __forceinline__ void operator()(const f32x4 (&acc)[2][2][4][2], const Unit& u, int wr, int wc, int fr, int fq) const { walk8(acc, u, wr, wc, fr, fq, *this); }
};
struct EpiPlainBf16 {
    static constexpr bool PERM = true, AFTER_DRAIN = false;
    bf16_t* O; int ldc;
    __device__ __forceinline__ void emit(int row, int col, const float (&v)[8]) const { *(u32x4*)(O + (size_t)row * ldc + col) = pack8(v, 1.f); }
    __device__ __forceinline__ void operator()(const f32x4 (&acc)[2][2][4][2], const Unit& u, int wr, int wc, int fr, int fq) const { walk8(acc, u, wr, wc, fr, fq, *this); }
};
struct EpiMlaQ {
    static constexpr bool PERM = true, AFTER_DRAIN = false;
    bf16_t* Qm; const float* ropeB;
    __device__ __forceinline__ void emit(int row, int col, const float (&v)[8]) const {
        const int head = col / 96, c = col - head * 96;
        bf16_t* q = Qm + (size_t)row * 768 + head * 96;
        const bool isr = c >= 64;
        const int g = (c - 64) >> 3, axis = g >> 1, base = axis * 16 + (g & 1) * 4;
        f32x4 cs0 = {1.f, 0.f, 1.f, 0.f}, cs1 = {1.f, 0.f, 1.f, 0.f};
        if (isr && row < MLAT) { const int t = row & (SEQ - 1), pos = axis ? (t & 63) : (t >> 6); const float* cs = ropeB + (pos * 8 + (g & 1) * 4) * 2; cs0 = *(const f32x4*)cs; cs1 = *(const f32x4*)(cs + 4); }
        const float o10 = v[0] * cs0[0] - v[4] * cs0[1], o20 = v[4] * cs0[0] + v[0] * cs0[1], o11 = v[1] * cs0[2] - v[5] * cs0[3], o21 = v[5] * cs0[2] + v[1] * cs0[3];
        const float o12 = v[2] * cs1[0] - v[6] * cs1[1], o22 = v[6] * cs1[0] + v[2] * cs1[1], o13 = v[3] * cs1[2] - v[7] * cs1[3], o23 = v[7] * cs1[2] + v[3] * cs1[3];
        typedef unsigned u32x2 __attribute__((ext_vector_type(2)));
        u32x2 w1, w2; w1.x = cvt_pk_bf16(o10 * C2_96, o11 * C2_96); w1.y = cvt_pk_bf16(o12 * C2_96, o13 * C2_96); w2.x = cvt_pk_bf16(o20 * C2_96, o21 * C2_96); w2.y = cvt_pk_bf16(o22 * C2_96, o23 * C2_96);
        bf16_t* p1 = isr ? q + 64 + base : q + c; bf16_t* p2 = isr ? q + 64 + base + 8 : q + c + 4;
        *(u32x2*)p1 = w1; *(u32x2*)p2 = w2;
    }
    __device__ __forceinline__ void operator()(const f32x4 (&acc)[2][2][4][2], const Unit& u, int wr, int wc, int fr, int fq) const { walk8(acc, u, wr, wc, fr, fq, *this); }
};
struct EpiMlaKV {
    static constexpr bool PERM = true, AFTER_DRAIN = false;
    bf16_t* Km; bf16_t* Vm;
    __device__ __forceinline__ void emit(int row, int col, const float (&v)[8]) const {
        const int head = col >> 7, c = col & 127;
        if (c < 64) *(u32x4*)(Km + (size_t)row * 768 + head * 96 + c) = pack8(v, 1.f);
        else        *(u32x4*)(Vm + (size_t)row * 512 + head * 64 + (c - 64)) = pack8(v, 1.f);
    }
    __device__ __forceinline__ void operator()(const f32x4 (&acc)[2][2][4][2], const Unit& u, int wr, int wc, int fr, int fq) const { walk8(acc, u, wr, wc, fr, fq, *this); }
};
struct EpiResid {
    static constexpr bool PERM = true, AFTER_DRAIN = false;
    float* X; const float* gate;
    __device__ __forceinline__ void emit(int row, int col, const float (&v)[8]) const {
        float* p = X + (size_t)row * 1024 + col; const float* g = gate + (size_t)(row < MLAT ? (row >> 13) : 4) * 6144 + col;
        const f32x4 x0 = *(const f32x4*)p, x1 = *(const f32x4*)(p + 4), g0 = *(const f32x4*)g, g1 = *(const f32x4*)(g + 4);
        *(f32x4*)p = x0 * ALPHA + g0 * (f32x4){v[0], v[1], v[2], v[3]}; *(f32x4*)(p + 4) = x1 * ALPHA + g1 * (f32x4){v[4], v[5], v[6], v[7]};
    }
    __device__ __forceinline__ void operator()(const f32x4 (&acc)[2][2][4][2], const Unit& u, int wr, int wc, int fr, int fq) const { walk8(acc, u, wr, wc, fr, fq, *this); }
};
struct EpiSwiglu {
    static constexpr bool PERM = true, AFTER_DRAIN = false;
    bf16_t* Hd; int ldh;
    __device__ __forceinline__ void emit(int row, int col, const float (&v)[8]) const {
        float h[4];
#pragma unroll
        for (int e = 0; e < 4; ++e) h[e] = v[e] / (1.f + __expf(-v[e])) * v[e + 4];
        typedef unsigned u32x2 __attribute__((ext_vector_type(2)));
        u32x2 w; w.x = cvt_pk_bf16(h[0], h[1]); w.y = cvt_pk_bf16(h[2], h[3]);
        *(u32x2*)(Hd + (size_t)row * ldh + (col >> 1)) = w;
    }
    __device__ __forceinline__ void operator()(const f32x4 (&acc)[2][2][4][2], const Unit& u, int wr, int wc, int fr, int fq) const { walk8(acc, u, wr, wc, fr, fq, *this); }
};
struct EpiOddIn {
    static constexpr bool PERM = true, AFTER_DRAIN = false;
    bf16_t *Qn, *Kn, *Vn, *Qd, *Vd, *Sg; float *Zf, *Zb;
    __device__ __forceinline__ void emit(int row, int col, const float (&v)[8]) const {
        const int sec = col >> 9, c = col & 511; const size_t o = (size_t)row * 512 + c;
        if (sec == 0) { *(u32x4*)(Qn + o) = pack8(v, C2_64); }
        else if (sec == 1) { *(u32x4*)(Kn + o) = pack8(v, 1.f); }
        else if (sec == 2) { *(u32x4*)(Vn + o) = pack8(v, 1.f); }
        else if (sec == 4) { *(u32x4*)(Vd + o) = pack8(v, 1.f); }
        else if (sec == 5 || sec == 6) { float* p = (sec == 5 ? Zf : Zb) + o; *(f32x4*)p = (f32x4){v[0], v[1], v[2], v[3]}; *(f32x4*)(p + 4) = (f32x4){v[4], v[5], v[6], v[7]}; }
        else { float s[8];
#pragma unroll
            for (int e = 0; e < 8; ++e) s[e] = v[e] / (1.f + __expf(-v[e]));
            *(u32x4*)((sec == 3 ? Qd : Sg) + o) = pack8(s, 1.f); }
    }
    __device__ __forceinline__ void operator()(const f32x4 (&acc)[2][2][4][2], const Unit& u, int wr, int wc, int fr, int fq) const { walk8(acc, u, wr, wc, fr, fq, *this); }
};
struct GroupedOrder {
    int nM, nN, nwg, G, c; int toff[NEXP_ + 1]; long estride;
    __device__ __forceinline__ bool next(int i, Unit& u) const {
        const long L = (long)i * G + c; if (L >= nwg) return false;
        int wgid = (int)L; { const int q = nwg / NXCD, r = nwg % NXCD, xcd = wgid % NXCD, off = wgid / NXCD; wgid = (xcd < r ? xcd * (q + 1) : r * (q + 1) + (xcd - r) * q) + off; }
        const int nig = WGM * nN, gid = wgid / nig, fm = gid * WGM, gsz = (nM - fm) < WGM ? (nM - fm) : WGM;
        u.pm = fm + ((wgid % nig) % gsz); u.pn = (wgid % nig) / gsz;
        int e = 0;
#pragma unroll
        for (int k = 1; k < NEXP_; ++k) e += (u.pm >= toff[k]) ? 1 : 0;
        u.boff = (long)e * estride; return true;
    }
    __device__ __forceinline__ void a_ready(const Unit&) const {}
    __device__ __forceinline__ void done(const Unit&) const {}
};
}
#define XB_TMO      128
#define XB_XCNT(j)  (256  + 64 * (j))
#define XB_XSUB(j)  (1280 + 64 * (j))
#define XB_XGEN(j)  (2304 + 64 * (j))
#define XB_TOP      3328
#define XB_TOPGEN   3392
#define XCD_BAR_WORDS 3456
#define XB_SPIN_CAP (1u << 18)

__device__ __forceinline__ unsigned xb_ld(unsigned* p)              { return __hip_atomic_load(p, __ATOMIC_RELAXED, __HIP_MEMORY_SCOPE_AGENT); }
__device__ __forceinline__ unsigned xb_add(unsigned* p, unsigned v) { return __hip_atomic_fetch_add(p, v, __ATOMIC_RELAXED, __HIP_MEMORY_SCOPE_AGENT); }
__device__ __forceinline__ unsigned xb_xcc_id() { return (unsigned)__builtin_amdgcn_s_getreg((3 << 11) | 20) & 0xFu; }
#define XB_SPIN(cond, bar) do { unsigned _sp = 0; while (cond) { __builtin_amdgcn_s_sleep(1); \
    if ((++_sp & 255u) == 0u) { if (xb_ld(&(bar)[XB_TMO])) break; if (_sp > XB_SPIN_CAP) { atomicAdd(&(bar)[XB_TMO], 1u); break; } } } } while (0)

struct XcdBarrier {
    unsigned* bar; unsigned x;
    volatile LAS unsigned* st;
};

__device__ __forceinline__ XcdBarrier xcd_barrier_post(unsigned* bar, volatile LAS unsigned* st) {
    XcdBarrier b; b.bar = bar; b.x = xb_xcc_id(); b.st = st;
    if (threadIdx.x == 0) (void)xb_add(&bar[XB_XCNT(b.x)], 1u);
    return b;
}
__device__ __forceinline__ void xcd_barrier_complete(unsigned* bar, unsigned x, unsigned& nloc, unsigned& nx) {
    const unsigned G = gridDim.x * gridDim.y * gridDim.z;
    unsigned sum, cnt, mine, sp = 0u;
    for (;;) {
        sum = 0u; cnt = 0u; mine = 0u;
#pragma unroll
        for (unsigned j = 0; j < 16; ++j) { const unsigned c = xb_ld(&bar[XB_XCNT(j)]); sum += c; cnt += (c > 0u) ? 1u : 0u; mine = (j == x) ? c : mine; }
        if (sum == G) break;
        __builtin_amdgcn_s_sleep(1);
        if ((++sp & 255u) == 0u) { if (xb_ld(&bar[XB_TMO])) break; if (sp > XB_SPIN_CAP) { atomicAdd(&bar[XB_TMO], 1u); break; } }
    }
    nloc = mine > 0u ? mine : 1u; nx = cnt > 0u ? cnt : 1u;
}

__device__ __forceinline__ void xcd_barrier(const XcdBarrier& b) {
    asm volatile("s_waitcnt vmcnt(0)" ::: "memory");
    __syncthreads();
    if (threadIdx.x == 0) {
        unsigned* bar = b.bar;
        __builtin_amdgcn_s_waitcnt(0);
        unsigned nloc = b.st[0], nx = b.st[1];
        if (nloc == 0u) { xcd_barrier_complete(bar, b.x, nloc, nx); b.st[0] = nloc; b.st[1] = nx; }
        const unsigned old = xb_add(&bar[XB_XSUB(b.x)], 1u);
        const unsigned gen = old / nloc;
        if (old + 1u == (gen + 1u) * nloc) {
            __builtin_amdgcn_fence(__ATOMIC_RELEASE, "agent");
            asm volatile("s_waitcnt vmcnt(0)" ::: "memory");
            const unsigned og = xb_add(&bar[XB_TOP], 1u);
            const unsigned tg = og / nx;
            if (og + 1u == (tg + 1u) * nx) xb_add(&bar[XB_TOPGEN], 1u);
            else XB_SPIN(xb_ld(&bar[XB_TOPGEN]) == tg, bar);
            __builtin_amdgcn_fence(__ATOMIC_ACQUIRE, "agent");
            xb_add(&bar[XB_XGEN(b.x)], 1u);
            asm volatile("s_waitcnt vmcnt(0)" ::: "memory");
        } else {
            XB_SPIN(xb_ld(&bar[XB_XGEN(b.x)]) == gen, bar);
            __builtin_amdgcn_fence(__ATOMIC_ACQUIRE, "agent");
            asm volatile("s_waitcnt vmcnt(0)" ::: "memory");
        }
    }
    __syncthreads();
}
struct Frame {
    LAS unsigned char* lds;
    gu32* ctl;
    unsigned char* ws;
    int tid, lane, wave, vcu, G;
};
struct Args { const float* in[30]; float* out; unsigned char* ws; int ph_lo, ph_hi; };
struct InTab { LAS unsigned long long* t;
    __device__ __forceinline__ const float* operator[](int i) const { const unsigned long long v = t[i]; const unsigned lo = __builtin_amdgcn_readfirstlane((unsigned)v), hi = __builtin_amdgcn_readfirstlane((unsigned)(v >> 32)); return (const float*)(((unsigned long long)hi << 32) | lo); } };
struct PArgs { InTab in; float* out; };
#define LDS_WAIT() asm volatile("s_waitcnt lgkmcnt(0)" ::: "memory")
#define VM_WAIT() asm volatile("s_waitcnt vmcnt(0)" ::: "memory")
enum { I_X = 0, I_C, I_CTX, I_CCTX, I_ADAW, I_ADAB, I_LN1G, I_LN1B, I_LN2G, I_LN2B, I_EVWIN, I_QNG, I_KNG, I_CQG, I_CKVG, I_WUQ, I_WUKV, I_EVWOUT,
       I_FFG, I_FFU, I_FFD, I_ODWIN, I_RPB, I_LBL, I_ONG, I_ODWOUT, I_ROUTER, I_MG, I_MU, I_MD };

__device__ __forceinline__ void cvt_item(const float* src0, const float* src1, int K, int N, int Np, bf16* dst, int mode, int item, LAS float* scr, int lane) {
    const int nblk = Np >> 5, kb = item / nblk, nb = item - kb * nblk, k0 = 64 * kb, n0 = 32 * nb;
    const int np = n0 + (lane & 31);
    const float* src = src0; int col = np; bool ok = np < N;
    if (mode == 1) { const int head = np / 96, c = np - head * 96; if (c >= 64) { const int r = c - 64, g = r >> 3, e = r & 7; const int base = (g >> 1) * 16 + (g & 1) * 4; col = head * 96 + 64 + base + (e < 4 ? e : 8 + (e - 4)); } }
    else if (mode == 2) { src = (np & 4) ? src1 : src0; col = ((np >> 3) << 2) + (np & 3); ok = true; }
#pragma unroll 8
    for (int i = 0; i < 32; ++i) { const int kk = 2 * i + (lane >> 5); scr[kk * 33 + (lane & 31)] = ok ? src[(size_t)(k0 + kk) * N + col] : 0.f; }
    LDS_WAIT(); asm volatile("" ::: "memory");
    const int c8 = lane & 7;
#pragma unroll
    for (int j = 0; j < 4; ++j) { const int n = (lane >> 3) + 8 * j; const LAS float* s = scr + (8 * c8) * 33 + n;
        v4u o; o.x = pkbf(s[0 * 33], s[1 * 33]); o.y = pkbf(s[2 * 33], s[3 * 33]); o.z = pkbf(s[4 * 33], s[5 * 33]); o.w = pkbf(s[6 * 33], s[7 * 33]);
        *(GAS v4u*)(dst + (size_t)(n0 + n) * K + k0 + 8 * c8) = o; }
    LDS_WAIT(); asm volatile("" ::: "memory");
}
__device__ __forceinline__ void sincos_red(float ang, float& s, float& c) {
    const float n = __builtin_rintf(ang * 0.636619772367581343f);
    float y = __builtin_fmaf(-n, 1.5703125f, ang); y = __builtin_fmaf(-n, 4.837512969970703125e-4f, y); y = __builtin_fmaf(-n, 7.54978995489188e-8f, y);
    const float z = y * y;
    const float sy = y + y * z * (-1.6666654611e-1f + z * (8.3321608736e-3f + z * (-1.9515295891e-4f)));
    const float cy = 1.0f - 0.5f * z + z * z * (4.166664568298827e-2f + z * (-1.388731625493765e-3f + z * 2.443315711809948e-5f));
    const int q = ((int)n) & 3;
    s = (q == 0) ? sy : (q == 1) ? cy : (q == 2) ? -sy : -cy;
    c = (q == 0) ? cy : (q == 1) ? -sy : (q == 2) ? -cy : sy;
}
__device__ __forceinline__ float inv_freq_pow(double r, int f) { double v = 1.0; for (int i = 0; i < f; ++i) v *= r; return (float)v; }

__device__ __forceinline__ void phase_cv(Frame& F, const PArgs& A, int j) {
    const int gw = F.vcu * NWAVES + F.wave, NGW = F.G * NWAVES;
    float* mods = (float*)(F.ws + WS_SMALL + SM_MODS);
    if (j == 0) {
        LAS float* Ssm = (LAS float*)F.lds;
        LAS float* Psm = (LAS float*)(F.lds + 20480);
        if ((int)blockIdx.x < 192) {
            for (int i = F.tid; i < 5 * 1024; i += NTHR) { const int r = i >> 10, k = i & 1023; const float cv = (r < 4) ? A.in[I_C][r * 1024 + k] : A.in[I_CCTX][k]; Ssm[i] = cv / (1.f + __expf(-cv)); }
            __syncthreads();
            for (int u = blockIdx.x; u < 192; u += F.G) {
                const int l = u / 48, n = (u - l * 48) * 128 + 2 * F.lane;
                float a0[5] = {0.f, 0.f, 0.f, 0.f, 0.f}, a1[5] = {0.f, 0.f, 0.f, 0.f, 0.f};
                const float* wp = A.in[I_ADAW] + ((size_t)l * 1024 + F.wave * 128) * 6144 + n;
#pragma unroll 4
                for (int k = 0; k < 128; ++k) { const float2 w = *(const float2*)(wp + (size_t)k * 6144); const int kk = F.wave * 128 + k;
#pragma unroll
                    for (int r = 0; r < 5; ++r) { const float sv = Ssm[r * 1024 + kk]; a0[r] += sv * w.x; a1[r] += sv * w.y; } }
#pragma unroll
                for (int r = 0; r < 5; ++r) { Psm[(F.wave * 5 + r) * 128 + 2 * F.lane] = a0[r]; Psm[(F.wave * 5 + r) * 128 + 2 * F.lane + 1] = a1[r]; }
                __syncthreads();
                for (int i = F.tid; i < 640; i += NTHR) { const int r = i >> 7, c = i & 127; float s = 0.f;
#pragma unroll
                    for (int w = 0; w < 8; ++w) s += Psm[(w * 5 + r) * 128 + c];
                    const int nn = (u - l * 48) * 128 + c; mods[((size_t)l * 5 + r) * 6144 + nn] = s + A.in[I_ADAB][l * 6144 + nn]; }
                __syncthreads();
            }
        } else if ((int)blockIdx.x == 192) {
            float* ra = (float*)(F.ws + WS_SMALL + SM_ROPEA); float* rb = (float*)(F.ws + WS_SMALL + SM_ROPEB); float* lb = (float*)(F.ws + WS_SMALL + SM_LB);
            for (int i = F.tid; i < 128 * 16; i += NTHR) { const int pos = i >> 4, f = i & 15; const float inv = inv_freq_pow(0.56234132519034908, f); float s, c; sincos_red((float)pos * inv, s, c); ra[2 * i] = c; ra[2 * i + 1] = s; }
            for (int i = F.tid; i < 128 * 8; i += NTHR) { const int pos = i >> 3, f = i & 7; const float inv = inv_freq_pow(0.31622776601683794, f); float s, c; sincos_red((float)pos * inv, s, c); rb[2 * i] = c; rb[2 * i + 1] = s; }
            for (int i = F.tid; i < 2 * 512; i += NTHR) { const int dir = i >> 9, c = i & 511; const float l0 = A.in[I_LBL][(dir * 2 + 0) * 512 + c], l1 = A.in[I_LBL][(dir * 2 + 1) * 512 + c];
                const float mx = fmaxf(l0, l1), e0 = __expf(l0 - mx), e1 = __expf(l1 - mx), p0 = e0 / (e0 + e1), p1 = e1 / (e0 + e1);
                lb[(0 * 2 + dir) * 512 + c] = p0 - p0; lb[(1 * 2 + dir) * 512 + c] = (p0 + p1) - p0; }
        }
        __syncthreads();
    }
    LAS float* scr = (LAS float*)(F.lds + 49152 + F.wave * 8704);
    bf16* W = (bf16*)(F.ws + WS_W); bf16* WM = (bf16*)(F.ws + WS_WMOE);
    constexpr int N1 = 2 * 768, N2 = 2 * 144, N3 = 2 * 128, N4 = 2 * 512, N5 = 2 * 2816, N6 = 2 * 1408, N7 = 2 * 2048, N8 = 2 * 512, N9 = 8 * 3584, N10 = 8 * 1792;
    const int nfix = (j == 0) ? (N1 + N2 + N3 + N4 + N5 + N6 + N7 + N8) : 0;
    const int total = nfix + N9 + N10;
    for (int it = gw; it < total; it += NGW) {
        int r = it; const float* s0; const float* s1 = nullptr; int K, N, Np, mode = 0, item; bf16* d;
        if (r >= nfix) { r -= nfix;
            if (r < N9) { const int e = r / 3584; item = r - e * 3584; const size_t so = ((size_t)(j * 8 + e)) * 1024 * 3584; s0 = A.in[I_MG] + so; s1 = A.in[I_MU] + so; K = 1024; N = 3584; Np = 7168; mode = 2; d = WM + WM_GU + (size_t)e * 7168 * 1024; }
            else { r -= N9; const int e = r / 1792; item = r - e * 1792; s0 = A.in[I_MD] + ((size_t)(j * 8 + e)) * 3584 * 1024; K = 3584; N = 1024; Np = 1024; d = WM + WM_D + (size_t)e * 1024 * 3584; }
        } else if (r < N1) { const int b = r / 768; item = r - b * 768; s0 = A.in[I_EVWIN] + (size_t)b * 1024 * EV_IN; K = 1024; N = EV_IN; Np = EV_INP; d = W + W_EVIN + (size_t)b * EV_INP * 1024; }
        else if ((r -= N1) < N2) { const int b = r / 144; item = r - b * 144; s0 = A.in[I_WUQ] + (size_t)b * 384 * 768; K = 384; N = 768; Np = 768; mode = 1; d = W + W_UQ + (size_t)b * 768 * 384; }
        else if ((r -= N2) < N3) { const int b = r / 128; item = r - b * 128; s0 = A.in[I_WUKV] + (size_t)b * 256 * 1024; K = 256; N = 1024; Np = 1024; d = W + W_UKV + (size_t)b * 1024 * 256; }
        else if ((r -= N3) < N4) { const int b = r / 512; item = r - b * 512; s0 = A.in[I_EVWOUT] + (size_t)b * 1024 * 1024; K = 1024; N = 1024; Np = 1024; d = W + W_EVOUT + (size_t)b * 1024 * 1024; }
        else if ((r -= N4) < N5) { const int b = r / 2816; item = r - b * 2816; s0 = A.in[I_FFG] + (size_t)b * 1024 * DFF; s1 = A.in[I_FFU] + (size_t)b * 1024 * DFF; K = 1024; N = DFF; Np = 2 * DFF; mode = 2; d = W + W_FFGU + (size_t)b * 2 * DFF * 1024; }
        else if ((r -= N5) < N6) { const int b = r / 1408; item = r - b * 1408; s0 = A.in[I_FFD] + (size_t)b * DFF * 1024; K = DFF; N = 1024; Np = 1024; d = W + W_FFD + (size_t)b * 1024 * DFF; }
        else if ((r -= N6) < N7) { const int b = r / 2048; item = r - b * 2048; s0 = A.in[I_ODWIN] + (size_t)b * 1024 * 4096; K = 1024; N = 4096; Np = 4096; d = W + W_ODIN + (size_t)b * 4096 * 1024; }
        else { r -= N7; const int b = r / 512; item = r - b * 512; s0 = A.in[I_ODWOUT] + (size_t)b * 1024 * 1024; K = 1024; N = 1024; Np = 1024; d = W + W_ODOUT + (size_t)b * 1024 * 1024; }
        cvt_item(s0, s1, K, N, Np, d, mode, item, scr, F.lane);
    }
}

__device__ __forceinline__ void store_bf16_row(bf16* orow, int lane, const f32x4 (&v)[4]) {
    GAS unsigned long long* o8 = (GAS unsigned long long*)orow + lane;
#pragma unroll
    for (int j = 0; j < 4; ++j) o8[64 * j] = (unsigned long long)pkbf(v[j].x, v[j].y) | ((unsigned long long)pkbf(v[j].z, v[j].w) << 32);
}
__device__ __forceinline__ void phase_mod(Frame& F, const PArgs& A) {
    const int gw = F.vcu * NWAVES + F.wave, NGW = F.G * NWAVES;
    const float* mods = (const float*)(F.ws + WS_SMALL + SM_MODS);
    float* X = (float*)(F.ws + WS_X); bf16* H = (bf16*)(F.ws + WS_H);
    for (int m = gw; m < MROWS; m += NGW) {
        const float* src = (m < MLAT) ? A.in[I_X] + (size_t)m * 1024 : A.in[I_CTX] + (size_t)(m - MLAT) * 1024;
        const float* md = mods + (size_t)modrow(m) * 6144;
        f32x4 v[4], h[4];
#pragma unroll
        for (int j = 0; j < 4; ++j) { v[j] = *((const f32x4*)src + F.lane + 64 * j); const f32x4 sh = *((const f32x4*)md + F.lane + 64 * j), sc = *((const f32x4*)(md + 1024) + F.lane + 64 * j);
            h[j] = v[j] * (sc + 1.0f) + sh; *((f32x4*)(X + (size_t)m * 1024) + F.lane + 64 * j) = v[j]; }
        store_bf16_row(H + (size_t)m * 1024, F.lane, h);
    }
}
template <bool MOE, bool ROUTER>
__device__ __forceinline__ void phase_ln(Frame& F, const PArgs& A, const float* lng, const float* lnb, const float* mshift  , const float* g5  ,
                                         const float* router, int jodd, bool last) {
    const int gw = F.vcu * NWAVES + F.wave, NGW = F.G * NWAVES;
    float* X = (float*)(F.ws + WS_X); bf16* H = (bf16*)(F.ws + WS_H);
    int* topk = (int*)(F.ws + WS_TOPK);
    const bf16* Y = (const bf16*)(F.ws + WS_XG);
    LAS unsigned* lcnt = (LAS unsigned*)(F.lds);
    if (ROUTER) { if (F.tid < 8) lcnt[F.tid] = 0u; __syncthreads(); }
    f32x4 gv[4], bv[4];
#pragma unroll
    for (int j = 0; j < 4; ++j) { gv[j] = *((const f32x4*)lng + F.lane + 64 * j); bv[j] = *((const f32x4*)lnb + F.lane + 64 * j); }
    for (int m = gw; m < MROWS; m += NGW) {
        float* xr = X + (size_t)m * 1024; const int mr = modrow(m);
        f32x4 v[4];
#pragma unroll
        for (int j = 0; j < 4; ++j) v[j] = *((const f32x4*)xr + F.lane + 64 * j);
        if (MOE) {
            const int r1 = topk[m * 6 + 4], r2 = topk[m * 6 + 5]; const float w1 = __int_as_float(topk[m * 6 + 2]), w2 = __int_as_float(topk[m * 6 + 3]);
            const float* gg = g5 + (size_t)mr * 6144;
#pragma unroll
            for (int j = 0; j < 4; ++j) { const v2u y1 = *((const v2u*)(Y + (size_t)r1 * 1024) + F.lane + 64 * j), y2 = *((const v2u*)(Y + (size_t)r2 * 1024) + F.lane + 64 * j);
                const f32x4 gq = *((const f32x4*)gg + F.lane + 64 * j);
                f32x4 yy; yy.x = w1 * bf_lo(y1.x) + w2 * bf_lo(y2.x); yy.y = w1 * bf_hi(y1.x) + w2 * bf_hi(y2.x); yy.z = w1 * bf_lo(y1.y) + w2 * bf_lo(y2.y); yy.w = w1 * bf_hi(y1.y) + w2 * bf_hi(y2.y);
                v[j] = v[j] * ALPHA + gq * yy; }
        }
        float s = 0.f;
#pragma unroll
        for (int j = 0; j < 4; ++j) s += (v[j].x + v[j].y) + (v[j].z + v[j].w);
        const float mean = wave_sum(s, F.lane) * (1.f / 1024.f); float s2 = 0.f;
#pragma unroll
        for (int j = 0; j < 4; ++j) { v[j] = v[j] - mean; s2 += (v[j].x * v[j].x + v[j].y * v[j].y) + (v[j].z * v[j].z + v[j].w * v[j].w); }
        const float rstd = 1.f / sqrtf(wave_sum(s2, F.lane) * (1.f / 1024.f) + 1e-6f);
#pragma unroll
        for (int j = 0; j < 4; ++j) { v[j] = v[j] * rstd * gv[j] + bv[j]; *((f32x4*)xr + F.lane + 64 * j) = v[j]; }
        if (last) { if (m < MLAT) {
#pragma unroll
                for (int j = 0; j < 4; ++j) *((f32x4*)(A.out + (size_t)m * 1024) + F.lane + 64 * j) = v[j]; }
            continue; }
        const float* md = mshift + (size_t)mr * 6144;
#pragma unroll
        for (int j = 0; j < 4; ++j) { const f32x4 sh = *((const f32x4*)md + F.lane + 64 * j), sc = *((const f32x4*)(md + 1024) + F.lane + 64 * j); v[j] = v[j] * (sc + 1.0f) + sh; }
        store_bf16_row(H + (size_t)m * 1024, F.lane, v);
        if (ROUTER) {
            float lg[8] = {0.f, 0.f, 0.f, 0.f, 0.f, 0.f, 0.f, 0.f};
#pragma unroll
            for (int j = 0; j < 4; ++j) { const float* rp = router + (size_t)(4 * F.lane + 256 * j) * 8;
#pragma unroll
                for (int i = 0; i < 4; ++i) { const f32x4 ra = *(const f32x4*)(rp + 8 * i), rb = *(const f32x4*)(rp + 8 * i + 4); const float hv = v[j][i];
                    lg[0] += hv * ra.x; lg[1] += hv * ra.y; lg[2] += hv * ra.z; lg[3] += hv * ra.w; lg[4] += hv * rb.x; lg[5] += hv * rb.y; lg[6] += hv * rb.z; lg[7] += hv * rb.w; } }
#pragma unroll
            for (int e = 0; e < 8; ++e) lg[e] = wave_sum(lg[e], F.lane);
            int e1 = 0; float v1 = lg[0];
#pragma unroll
            for (int e = 1; e < 8; ++e) if (lg[e] > v1) { v1 = lg[e]; e1 = e; }
            int e2 = -1; float v2 = -INFINITY;
#pragma unroll
            for (int e = 0; e < 8; ++e) if (e != e1 && lg[e] > v2) { v2 = lg[e]; e2 = e; }
            const float w1 = 1.f / (1.f + __expf(v2 - v1)), w2 = 1.f - w1;
            if (F.lane == 0) { topk[m * 6 + 0] = e1; topk[m * 6 + 1] = e2; topk[m * 6 + 2] = __float_as_int(w1); topk[m * 6 + 3] = __float_as_int(w2);
                atomicAdd((unsigned*)&lcnt[e1], 1u); atomicAdd((unsigned*)&lcnt[e2], 1u); }
        }
    }
    if (ROUTER) { LDS_WAIT(); __syncthreads(); if (F.tid < 8) __hip_atomic_fetch_add((unsigned*)(F.ctl + CW_CNT + 64 * jodd) + F.tid, lcnt[F.tid], __ATOMIC_RELAXED, __HIP_MEMORY_SCOPE_AGENT); }
}
typedef short v4i16_t __attribute__((ext_vector_type(4)));
__device__ __forceinline__ int crow(int r, int hi) { return (r & 3) + 8 * (r >> 2) + 4 * hi; }
__device__ __forceinline__ float swap_max(float m) { auto rr = __builtin_amdgcn_permlane32_swap(__float_as_uint(m), __float_as_uint(m), false, false); return fmaxf(__uint_as_float(rr[0]), __uint_as_float(rr[1])); }
__device__ __forceinline__ float swap_sum(float m) { auto rr = __builtin_amdgcn_permlane32_swap(__float_as_uint(m), __float_as_uint(m), false, false); return __uint_as_float(rr[0]) + __uint_as_float(rr[1]); }

template <int DK, int MODE>
__device__ __forceinline__ void attn_unit(LAS unsigned char* lds, int tid, const bf16* Q, int qp, const bf16* K1, const bf16* V1, int nt1, const bf16* K2, const bf16* V2, int nt2,
                                          int kp, int vp, bf16* O, int op, int rq0, int kr0, const float* rpbh) {
    constexpr int KROW = DK * 2 + 16, KSZ = 64 * KROW, CPK = DK / 8  , NPK = 64 * CPK;
    constexpr int VB = 2 * KSZ, SCR = VB + 16384, BIAS = SCR + 2048;
    const int lane = tid & 63, r32 = lane & 31, hi = lane >> 5; const int wid = __builtin_amdgcn_readfirstlane(tid >> 6);
    const int NT = nt1 + nt2;
    LAS float* wsf = (LAS float*)(lds + SCR) + wid * 64;
    const int kkey0 = tid / CPK, kch0 = tid - kkey0 * CPK;
    const int kkey1 = (tid + 512) / CPK, kch1 = (tid + 512) - kkey1 * CPK;
    const bool two = (NPK > 512) && (tid + 512 < NPK);
    const int vkey = tid >> 3, vch = tid & 7;
    const int vdst = ((vkey >> 3) * 2 + (vch >> 2)) * 512 + (vkey & 7) * 64 + (vch & 3) * 16;
    v4u kreg0, kreg1 = {0u, 0u, 0u, 0u}, vreg;
#define ATT_LOAD(t) do { const int t_ = (t); const bf16* kb_ = (t_ < nt1) ? K1 + (size_t)t_ * 64 * kp : K2 + (size_t)(t_ - nt1) * 64 * kp; \
        const bf16* vb_ = (t_ < nt1) ? V1 + (size_t)t_ * 64 * vp : V2 + (size_t)(t_ - nt1) * 64 * vp; \
        kreg0 = *(const GAS v4u*)(kb_ + (size_t)kkey0 * kp + kch0 * 8); if (two) kreg1 = *(const GAS v4u*)(kb_ + (size_t)kkey1 * kp + kch1 * 8); \
        vreg = *(const GAS v4u*)(vb_ + (size_t)vkey * vp + vch * 8); } while (0)
#define ATT_STORE(buf) do { LAS unsigned char* kd_ = lds + (buf) * KSZ; *(LAS v4u*)(kd_ + kkey0 * KROW + kch0 * 16) = kreg0; if (two) *(LAS v4u*)(kd_ + kkey1 * KROW + kch1 * 16) = kreg1; \
        *(LAS v4u*)(lds + VB + (buf) * 8192 + vdst) = vreg; } while (0)
    ATT_LOAD(0);
    if (MODE == 1) { LAS float* bs = (LAS float*)(lds + BIAS); for (int i = tid; i < 15 * 31; i += NTHR) bs[i] = rpbh[i] * LOG2E; }
    bf16x8 qr[DK / 16];
#pragma unroll
    for (int d0 = 0; d0 < DK / 16; ++d0) qr[d0] = *(const GAS bf16x8*)(Q + (size_t)(wid * 32 + r32) * qp + d0 * 16 + hi * 8);
    ATT_STORE(0);
    __syncthreads();
    float m_run = -INFINITY, l_run = 0.f; f32x16 o0 = {}, o1 = {};
    const int rq = rq0 + (wid >> 1), rsq = min(max(rq - 4, 0), 120), qc = (wid & 1) * 32 + r32, cs = min(max(qc - 8, 0), 48);
    const int koff = r32 * KROW + hi * 16;
    const int vlane = (4 * hi + ((lane & 15) >> 2)) * 64 + ((lane >> 4) & 1) * 32 + (lane & 3) * 8;
    for (int t = 0; t < NT; ++t) {
        const int buf = t & 1;
        if (t + 1 < NT) ATT_LOAD(t + 1);
        bool act = true; int kr = 0;
        if (MODE == 1) { kr = kr0 + t; act = (t >= nt1) || (kr >= rsq && kr < rsq + 8); }
        if (act) {
            const LAS unsigned char* kb = lds + buf * KSZ + koff;
            f32x16 s0 = {}, s1 = {};
#pragma unroll
            for (int d0 = 0; d0 < DK / 16; ++d0) {
                const bf16x8 a0 = *(const LAS bf16x8*)(kb + d0 * 32), a1 = *(const LAS bf16x8*)(kb + 32 * KROW + d0 * 32);
                s0 = __builtin_amdgcn_mfma_f32_32x32x16_bf16(a0, qr[d0], s0, 0, 0, 0);
                s1 = __builtin_amdgcn_mfma_f32_32x32x16_bf16(a1, qr[d0], s1, 0, 0, 0);
            }
            if (MODE == 1) { if (t < nt1) {
                const LAS float* bs = (const LAS float*)(lds + BIAS) + (kr - rq + 7) * 31 - qc + 15;
#pragma unroll
                for (int r = 0; r < 16; ++r) { const int kc0 = crow(r, hi), kc1 = kc0 + 32;
                    const bool v0 = (kc0 >= cs) && (kc0 < cs + 16), v1 = (kc1 >= cs) && (kc1 < cs + 16);
                    s0[r] = v0 ? s0[r] + bs[v0 ? kc0 : cs] : -INFINITY; s1[r] = v1 ? s1[r] + bs[v1 ? kc1 : cs] : -INFINITY; } } }
            float mx = fmaxf(s0[0], s1[0]);
#pragma unroll
            for (int r = 1; r < 16; ++r) mx = fmaxf(mx, fmaxf(s0[r], s1[r]));
            mx = swap_max(mx);
            const float mnew = fmaxf(m_run, mx);
            if (__any(mnew > m_run)) {
                const float f = fast_exp2(m_run - mnew); l_run *= f; if (hi == 0) wsf[r32] = f; LDS_WAIT();
#pragma unroll
                for (int r = 0; r < 16; ++r) { const float fr_ = wsf[crow(r, hi)]; o0[r] *= fr_; o1[r] *= fr_; }
                m_run = mnew;
            }
            float ls = 0.f;
#pragma unroll
            for (int r = 0; r < 16; ++r) { s0[r] = fast_exp2(s0[r] - m_run); s1[r] = fast_exp2(s1[r] - m_run); ls += s0[r] + s1[r]; }
            l_run += ls;
            v4u pw[4];
            pw[0] = (v4u){pkbf(s0[0], s0[1]), pkbf(s0[2], s0[3]), pkbf(s0[4], s0[5]), pkbf(s0[6], s0[7])};
            pw[1] = (v4u){pkbf(s0[8], s0[9]), pkbf(s0[10], s0[11]), pkbf(s0[12], s0[13]), pkbf(s0[14], s0[15])};
            pw[2] = (v4u){pkbf(s1[0], s1[1]), pkbf(s1[2], s1[3]), pkbf(s1[4], s1[5]), pkbf(s1[6], s1[7])};
            pw[3] = (v4u){pkbf(s1[8], s1[9]), pkbf(s1[10], s1[11]), pkbf(s1[12], s1[13]), pkbf(s1[14], s1[15])};
            const LAS unsigned char* vb = lds + VB + buf * 8192 + vlane;
#pragma unroll
            for (int ks = 0; ks < 4; ++ks) {
                const bf16x8 pa = __builtin_bit_cast(bf16x8, pw[ks]);
#pragma unroll
                for (int db = 0; db < 2; ++db) {
                    const v4i16_t lo = __builtin_amdgcn_ds_read_tr16_b64_v4i16((LAS v4i16_t*)(vb + ((ks * 2 + 0) * 2 + db) * 512));
                    const v4i16_t hh = __builtin_amdgcn_ds_read_tr16_b64_v4i16((LAS v4i16_t*)(vb + ((ks * 2 + 1) * 2 + db) * 512));
                    const bf16x8 vf = (bf16x8){lo[0], lo[1], lo[2], lo[3], hh[0], hh[1], hh[2], hh[3]};
                    if (db == 0) o0 = __builtin_amdgcn_mfma_f32_32x32x16_bf16(pa, vf, o0, 0, 0, 0);
                    else         o1 = __builtin_amdgcn_mfma_f32_32x32x16_bf16(pa, vf, o1, 0, 0, 0);
                }
            }
        }
        if (t + 1 < NT) ATT_STORE(buf ^ 1);
        __syncthreads();
    }
    const float lt = swap_sum(l_run);
    if (hi == 0) wsf[32 + r32] = 1.f / lt;
    LDS_WAIT();
#pragma unroll
    for (int r = 0; r < 16; ++r) { const int q = crow(r, hi); const float il = wsf[32 + q]; bf16* orow = O + (size_t)(wid * 32 + q) * op;
        orow[r32] = f2bf(o0[r] * il); orow[32 + r32] = f2bf(o1[r] * il); }
    __syncthreads();
#undef ATT_LOAD
#undef ATT_STORE
}
__device__ __forceinline__ int hg_blk_row(int b, int blk) { return blk < 2 ? MLAT + b * CTXL + 128 * blk : b * SEQ + 128 * (blk - 2); }
__device__ __forceinline__ int hg_mc_of_blk(int dir, int blk) { return dir ? (blk < 2 ? 1 - blk : 67 - blk) : blk; }
template <int KT> __device__ __forceinline__ f32x16 mma_nt(f32x16 acc, const LAS bf16* A, int lda, const LAS bf16* Bt, int ldb, int r32, int hi) {
    const LAS bf16* ap = A + r32 * lda + 8 * hi; const LAS bf16* bp = Bt + r32 * ldb + 8 * hi;
#pragma unroll
    for (int k0 = 0; k0 < KT; k0 += 16) acc = __builtin_amdgcn_mfma_f32_32x32x16_bf16(*(const LAS bf16x8*)(ap + k0), *(const LAS bf16x8*)(bp + k0), acc, 0, 0, 0);
    return acc;
}
__device__ __forceinline__ void ldq16(const bf16* p, float (&o)[16]) {
    const v4u a = *(const GAS v4u*)p, b = *(const GAS v4u*)(p + 8);
    o[0] = bf_lo(a.x); o[1] = bf_hi(a.x); o[2] = bf_lo(a.y); o[3] = bf_hi(a.y); o[4] = bf_lo(a.z); o[5] = bf_hi(a.z); o[6] = bf_lo(a.w); o[7] = bf_hi(a.w);
    o[8] = bf_lo(b.x); o[9] = bf_hi(b.x); o[10] = bf_lo(b.y); o[11] = bf_hi(b.y); o[12] = bf_lo(b.z); o[13] = bf_hi(b.z); o[14] = bf_lo(b.w); o[15] = bf_hi(b.w);
}
__device__ __forceinline__ void ldf16(const float* p, float (&o)[16]) {
#pragma unroll
    for (int k = 0; k < 4; ++k) { const f32x4 a = *((const GAS f32x4*)p + k); o[4 * k] = a.x; o[4 * k + 1] = a.y; o[4 * k + 2] = a.z; o[4 * k + 3] = a.w; }
}
__device__ __forceinline__ void st16(LAS bf16* p, const float (&v)[16]) {
    *(LAS v4u*)p = (v4u){pkbf(v[0], v[1]), pkbf(v[2], v[3]), pkbf(v[4], v[5]), pkbf(v[6], v[7])};
    *(LAS v4u*)(p + 8) = (v4u){pkbf(v[8], v[9]), pkbf(v[10], v[11]), pkbf(v[12], v[13]), pkbf(v[14], v[15])};
}

__device__ __forceinline__ void ldq8(const bf16* p, float (&o)[8]) { const v4u a = *(const GAS v4u*)p;
    o[0] = bf_lo(a.x); o[1] = bf_hi(a.x); o[2] = bf_lo(a.y); o[3] = bf_hi(a.y); o[4] = bf_lo(a.z); o[5] = bf_hi(a.z); o[6] = bf_lo(a.w); o[7] = bf_hi(a.w); }
__device__ __forceinline__ void ldf8(const float* p, float (&o)[8]) { const f32x4 a = *(const GAS f32x4*)p, b = *((const GAS f32x4*)p + 1); o[0] = a.x; o[1] = a.y; o[2] = a.z; o[3] = a.w; o[4] = b.x; o[5] = b.y; o[6] = b.z; o[7] = b.w; }
__device__ __forceinline__ void st8(LAS bf16* p, const float (&v)[8]) { *(LAS v4u*)p = (v4u){pkbf(v[0], v[1]), pkbf(v[2], v[3]), pkbf(v[4], v[5]), pkbf(v[6], v[7])}; }

struct HgT { const bf16 *Qd, *Vd, *Sg; const float *Zf, *Zb; const float* lb  ; float* HST; float* HDM; const float* ong; bf16* OO; };

__device__ __forceinline__ void hg_a_unit(Frame& F, const HgT& T, int chain, int mc) {
    const int dir = chain & 1, h = (chain >> 1) & 3, b = chain >> 3, hoff = h * 128;
    const int row0 = hg_blk_row(b, hg_mc_of_blk(dir, mc));
    const float* Z = dir ? T.Zb : T.Zf;
    LAS float* Lf = (LAS float*)F.lds;
    LAS float* PT = (LAS float*)(F.lds + 65536);
    LAS bf16* KET = (LAS bf16*)(F.lds + 67584);
    LAS bf16* VT = (LAS bf16*)(F.lds + 67584 + 34816);
    const int tid = F.tid, lane = F.lane, r32 = lane & 31, hi = lane >> 5, wid = F.wave;
    const int ti = tid >> 2, cg = tid & 3;
#pragma unroll 1
    for (int q8 = 0; q8 < 4; ++q8) { const int e0 = 32 * cg + 8 * q8; float z[8]; ldf8(Z + (size_t)(row0 + ti) * 512 + hoff + e0, z); float lbv[8]; ldf8(T.lb + dir * 512 + hoff + e0, lbv);
#pragma unroll
        for (int k = 0; k < 8; ++k) Lf[ti * 128 + e0 + k] = __logf(lbv[k] + (1.f - lbv[k]) * sigmoidf_(z[k])); }
    __syncthreads();
    { const int e = tid & 127, p = tid >> 7; float run = 0.f;
      if (dir == 0) { for (int i = 32 * p + 31; i >= 32 * p; --i) { const float tmp = Lf[i * 128 + e]; Lf[i * 128 + e] = run; run += tmp; } }
      else          { for (int i = 32 * p; i < 32 * p + 32; ++i) { const float tmp = Lf[i * 128 + e]; Lf[i * 128 + e] = run; run += tmp; } }
      PT[p * 128 + e] = run; }
    __syncthreads();
    { const int p = ti >> 5;
#pragma unroll 1
      for (int q8 = 0; q8 < 4; ++q8) { const int e0 = 32 * cg + 8 * q8; float z[8], v[8], lbv[8]; ldf8(Z + (size_t)(row0 + ti) * 512 + hoff + e0, z); ldq8(T.Vd + (size_t)(row0 + ti) * 512 + hoff + e0, v); ldf8(T.lb + dir * 512 + hoff + e0, lbv);
#pragma unroll
        for (int k = 0; k < 8; ++k) { const int e = e0 + k; const float kk = (1.f - lbv[k]) * sigmoidf_(-z[k]);
            const float p0 = PT[e], p1 = PT[128 + e], p2 = PT[256 + e], p3 = PT[384 + e];
            float w = Lf[ti * 128 + e];
            if (dir == 0) w += (p < 3 ? p3 : 0.f) + (p < 2 ? p2 : 0.f) + (p < 1 ? p1 : 0.f); else w += (p > 0 ? p0 : 0.f) + (p > 1 ? p1 : 0.f) + (p > 2 ? p2 : 0.f);
            KET[e * 136 + ti] = f2bf(kk * __expf(w)); VT[e * 136 + ti] = f2bf(v[k]); } } }
    if (tid < 128) { const float tot = PT[tid] + PT[128 + tid] + PT[256 + tid] + PT[384 + tid]; T.HDM[((size_t)chain * 66 + mc) * 128 + tid] = __expf(tot); }
    __syncthreads();
    { const int ei = wid & 3, fp = wid >> 2; float* dst = T.HST + ((size_t)chain * 66 + mc) * 16384;
#pragma unroll
      for (int k = 0; k < 2; ++k) { const int fi = 2 * fp + k; f32x16 acc = {}; acc = mma_nt<128>(acc, KET + 32 * ei * 136, 136, VT + 32 * fi * 136, 136, r32, hi);
#pragma unroll
          for (int r = 0; r < 16; ++r) dst[(32 * ei + crow(r, hi)) * 128 + 32 * fi + r32] = acc[r]; } }
    __syncthreads();
}
__device__ __forceinline__ void phase_hg_b(Frame& F, const HgT& T) {
    const int g = F.vcu * NTHR + F.tid;
    for (int gi = g; gi < 32 * 4096; gi += F.G * NTHR) {
        const int chain = gi >> 12, idx = gi & 4095, e = idx >> 5, f4 = idx & 31;
        f32x4* base = (f32x4*)(T.HST + (size_t)chain * 66 * 16384 + e * 128) + f4; const float* dmp = T.HDM + (size_t)chain * 66 * 128 + e;
        f32x4 S = {0.f, 0.f, 0.f, 0.f};
#pragma unroll 6
        for (int mc = 0; mc < 66; ++mc) { const f32x4 kv = base[(size_t)mc * 4096]; const float d = dmp[mc * 128]; base[(size_t)mc * 4096] = S; S = S * d + kv; }
    }
}
__device__ __forceinline__ void hg_c_unit(Frame& F, const HgT& T, int b, int h, int blk) {
    const int hoff = h * 128, row0 = hg_blk_row(b, blk);
    const int tid = F.tid, lane = F.lane, r32 = lane & 31, hi = lane >> 5, wid = F.wave;
    LAS float* Lf = (LAS float*)F.lds;
    LAS bf16* P = (LAS bf16*)F.lds;
    LAS float* PT = (LAS float*)(F.lds + 32768);
    LAS float* DE = (LAS float*)(F.lds + 34816);
    LAS float* BR = (LAS float*)(F.lds + 35328);
    LAS bf16* QB = (LAS bf16*)(F.lds + 35840);
    LAS bf16* QS = (LAS bf16*)(F.lds + 53248);
    LAS bf16* KS = (LAS bf16*)(F.lds + 70656);
    LAS bf16* KET = (LAS bf16*)(F.lds + 88064);
    LAS bf16* VT = (LAS bf16*)(F.lds + 106496);
    LAS bf16* ST = (LAS bf16*)(F.lds + 124928);
    LAS float* OUT = (LAS float*)(F.lds + 35840);
    const int ti = wid & 1, fi = wid >> 1;
    const int ei = wid & 3, fp = wid >> 2;
    f32x16 oacc0 = {}, oacc1 = {};
    const int si_ = tid >> 3, e0 = 16 * (tid & 7);
#pragma unroll 1
    for (int dir = 0; dir < 2; ++dir) {
        const int chain = (b * 4 + h) * 2 + dir; const float* Z = dir ? T.Zb : T.Zf;
        const float* Sin = T.HST + ((size_t)chain * 66 + hg_mc_of_blk(dir, blk)) * 16384;
        f32x16 S[2];
#pragma unroll
        for (int k = 0; k < 2; ++k)
#pragma unroll
            for (int r = 0; r < 16; ++r) S[k][r] = Sin[(32 * ei + crow(r, hi)) * 128 + 32 * (2 * fp + k) + r32];
#pragma unroll
        for (int k = 0; k < 2; ++k)
#pragma unroll
            for (int g = 0; g < 4; ++g) *(LAS v2u*)(ST + (32 * (2 * fp + k) + r32) * 136 + 32 * ei + 8 * g + 4 * hi) = (v2u){pkbf(S[k][4 * g], S[k][4 * g + 1]), pkbf(S[k][4 * g + 2], S[k][4 * g + 3])};
#pragma unroll 1
        for (int cc = 0; cc < 2; ++cc) {
            const int ci = dir ? 1 - cc : cc; const int rowc = row0 + 64 * ci;
#pragma unroll 1
            for (int hh = 0; hh < 2; ++hh) { const int e8 = e0 + 8 * hh; float z[8], lbv[8]; ldf8(Z + (size_t)(rowc + si_) * 512 + hoff + e8, z); ldf8(T.lb + dir * 512 + hoff + e8, lbv);
#pragma unroll
              for (int k = 0; k < 8; ++k) Lf[si_ * 128 + e8 + k] = __logf(lbv[k] + (1.f - lbv[k]) * sigmoidf_(z[k])); }
            __syncthreads();
            { const int e = tid & 127, p = tid >> 7; float run = 0.f;
              if (dir == 0) { for (int i = 16 * p; i < 16 * p + 16; ++i) { run += Lf[i * 128 + e]; Lf[i * 128 + e] = run; } }
              else          { for (int i = 16 * p + 15; i >= 16 * p; --i) { run += Lf[i * 128 + e]; Lf[i * 128 + e] = run; } }
              PT[p * 128 + e] = run; }
            __syncthreads();
            if (tid < 128) { const float p0 = PT[tid], p1 = PT[128 + tid], p2 = PT[256 + tid], p3 = PT[384 + tid];
                DE[tid] = __expf(p0 + p1 + p2 + p3);
                BR[tid] = dir ? (Lf[32 * 128 + tid] + p3) : (Lf[31 * 128 + tid] + p0); }
            __syncthreads();
            { const int p = si_ >> 4;
#pragma unroll 1
              for (int hh = 0; hh < 2; ++hh) { const int e8 = e0 + 8 * hh; float z[8], q[8], v[8], lbv[8], t1[8], t2[8], t3[8];
                ldf8(Z + (size_t)(rowc + si_) * 512 + hoff + e8, z); ldq8(T.Qd + (size_t)(rowc + si_) * 512 + hoff + e8, q); ldq8(T.Vd + (size_t)(rowc + si_) * 512 + hoff + e8, v); ldf8(T.lb + dir * 512 + hoff + e8, lbv);
#pragma unroll
                for (int k = 0; k < 8; ++k) { const int e = e8 + k; const float kk = (1.f - lbv[k]) * sigmoidf_(-z[k]);
                    const float p0 = PT[e], p1 = PT[128 + e], p2 = PT[256 + e], p3 = PT[384 + e];
                    float bb = Lf[si_ * 128 + e];
                    if (dir == 0) bb += (p > 0 ? p0 : 0.f) + (p > 1 ? p1 : 0.f) + (p > 2 ? p2 : 0.f); else bb += (p < 3 ? p3 : 0.f) + (p < 2 ? p2 : 0.f) + (p < 1 ? p1 : 0.f);
                    const float bend = (p0 + p1) + (p2 + p3), br = BR[e];
                    t1[k] = q[k] * __expf(bb); t2[k] = q[k] * __expf(bb - br); t3[k] = kk * __expf(br - bb);
                    KET[e * 72 + si_] = f2bf(kk * __expf(bend - bb)); VT[e * 72 + si_] = f2bf(v[k]); }
                st8(QB + si_ * 136 + e8, t1); st8(QS + si_ * 136 + e8, t2); st8(KS + si_ * 136 + e8, t3); } }
            __syncthreads();
            if (wid < 4) { const int tb = wid & 1, sb = wid >> 1; f32x16 sc = {}; sc = mma_nt<128>(sc, QS + 32 * tb * 136, 136, KS + 32 * sb * 136, 136, r32, hi);
#pragma unroll
                for (int r = 0; r < 16; ++r) { const int t = 32 * tb + crow(r, hi), s = 32 * sb + r32; const bool keep = dir ? (s >= t) : (s <= t); P[t * 72 + s] = f2bf(keep ? sc[r] : 0.f); } }
            __syncthreads();
            { f32x16 a = ci ? oacc1 : oacc0; a = mma_nt<64>(a, P + 32 * ti * 72, 72, VT + 32 * fi * 72, 72, r32, hi); a = mma_nt<128>(a, QB + 32 * ti * 136, 136, ST + 32 * fi * 136, 136, r32, hi); if (ci) oacc1 = a; else oacc0 = a; }
            __syncthreads();
#pragma unroll
            for (int k = 0; k < 2; ++k) {
#pragma unroll
                for (int r = 0; r < 16; ++r) S[k][r] *= DE[32 * ei + crow(r, hi)];
                S[k] = mma_nt<64>(S[k], KET + 32 * ei * 72, 72, VT + 32 * (2 * fp + k) * 72, 72, r32, hi);
#pragma unroll
                for (int g = 0; g < 4; ++g) *(LAS v2u*)(ST + (32 * (2 * fp + k) + r32) * 136 + 32 * ei + 8 * g + 4 * hi) = (v2u){pkbf(S[k][4 * g], S[k][4 * g + 1]), pkbf(S[k][4 * g + 2], S[k][4 * g + 3])};
            }
            __syncthreads();
        }
    }
#pragma unroll
    for (int r = 0; r < 16; ++r) { OUT[(32 * ti + crow(r, hi)) * 132 + 32 * fi + r32] = oacc0[r]; OUT[(64 + 32 * ti + crow(r, hi)) * 132 + 32 * fi + r32] = oacc1[r]; }
    __syncthreads();
    for (int k = 0; k < 16; ++k) { const int t = 16 * wid + k; const float a0 = OUT[t * 132 + lane], a1 = OUT[t * 132 + 64 + lane];
        const float ms = wave_sum(a0 * a0 + a1 * a1, lane) * (1.f / 128.f); const float rs = 1.f / sqrtf(ms + 1e-6f);
        const size_t ro = (size_t)(row0 + t) * 512 + hoff; bf16* orow = T.OO + (size_t)(row0 + t) * 1024 + 512 + hoff;
        orow[lane] = f2bf(a0 * rs * T.ong[lane] * bf2f(T.Sg[ro + lane])); orow[64 + lane] = f2bf(a1 * rs * T.ong[64 + lane] * bf2f(T.Sg[ro + 64 + lane])); }
    __syncthreads();
}
__device__ __forceinline__ void ld8(const float* p, float (&v)[8]) { const f32x4 a = *(const GAS f32x4*)p, b = *(const GAS f32x4*)(p + 4); v[0] = a.x; v[1] = a.y; v[2] = a.z; v[3] = a.w; v[4] = b.x; v[5] = b.y; v[6] = b.z; v[7] = b.w; }
__device__ __forceinline__ v4u pk8(const float (&v)[8], float s) { return (v4u){pkbf(v[0] * s, v[1] * s), pkbf(v[2] * s, v[3] * s), pkbf(v[4] * s, v[5] * s), pkbf(v[6] * s, v[7] * s)}; }
__device__ __forceinline__ void head_norm_rope(float (&v)[8], const float* g64, int l8  , bool rope, int trow, int tcol, const float* ropeA, int lane) {
    float ss = 0.f;
#pragma unroll
    for (int e = 0; e < 8; ++e) ss += v[e] * v[e];
    ss += shx(ss, 1, lane); ss += shx(ss, 2, lane); ss += shx(ss, 4, lane);
    const float rs = 1.f / sqrtf(ss * (1.f / 64.f) + 1e-6f);
#pragma unroll
    for (int e = 0; e < 8; ++e) v[e] = v[e] * rs * g64[8 * l8 + e];
    float pr[8];
#pragma unroll
    for (int e = 0; e < 8; ++e) pr[e] = shx(v[e], 2, lane);
    if (rope) { const int axis = l8 >> 2, pos = axis ? tcol : trow; const float* cs = ropeA + (pos * 16 + 8 * (l8 & 1)) * 2; const bool second = (l8 & 2) != 0;
#pragma unroll
        for (int e = 0; e < 8; ++e) { const float c_ = cs[2 * e], s_ = cs[2 * e + 1]; v[e] = second ? (v[e] * c_ + pr[e] * s_) : (v[e] * c_ - pr[e] * s_); } }
}
__device__ __forceinline__ void phase_even_post(Frame& F, const PArgs& A, int j) {
    const int gw = F.vcu * NWAVES + F.wave, NGW = F.G * NWAVES, lane = F.lane;
    const float* RAW = (const float*)(F.ws + WS_RAW);
    bf16 *QG = (bf16*)(F.ws + WS_QG), *KG = (bf16*)(F.ws + WS_KG), *VG = (bf16*)(F.ws + WS_VG), *CQN = (bf16*)(F.ws + WS_CQN), *CKVN = (bf16*)(F.ws + WS_CKVN), *KM = (bf16*)(F.ws + WS_KM);
    const float* ropeA = (const float*)(F.ws + WS_SMALL + SM_ROPEA); const float* ropeB = (const float*)(F.ws + WS_SMALL + SM_ROPEB);
    const float *qng = A.in[I_QNG] + j * 64, *kng = A.in[I_KNG] + j * 64, *cqg = A.in[I_CQG] + j * 384, *ckvg = A.in[I_CKVG] + j * 256;
    for (int m = gw; m < MROWS; m += NGW) {
        const float* r = RAW + (size_t)m * EV_INP; const bool lat = m < MLAT; const int t = m & (SEQ - 1), trow = t >> 6, tcol = t & 63;
        float v[8];
        ld8(r + 8 * lane, v); head_norm_rope(v, qng, lane & 7, lat, trow, tcol, ropeA, lane); *(GAS v4u*)(QG + (size_t)m * 512 + 8 * lane) = pk8(v, C2_64);
        { const int l = lane & 31; ld8(r + 512 + 8 * l, v); float w[8];
#pragma unroll
          for (int e = 0; e < 8; ++e) w[e] = v[e];
          head_norm_rope(w, kng, l & 7, lat, trow, tcol, ropeA, lane);
          if (lane < 16) *(GAS v4u*)(KG + (size_t)m * 128 + 8 * lane) = pk8(w, 1.f);
          else if (lane < 32) *(GAS v4u*)(VG + (size_t)m * 128 + 8 * (lane - 16)) = pk8(v, 1.f); }
        { const bool on = lane < 48; if (on) ld8(r + 768 + 8 * lane, v); float ss = 0.f;
          if (on) {
#pragma unroll
              for (int e = 0; e < 8; ++e) ss += v[e] * v[e]; }
          const float rs = 1.f / sqrtf(wave_sum(ss, lane) * (1.f / 384.f) + 1e-6f);
          if (on) {
#pragma unroll
              for (int e = 0; e < 8; ++e) v[e] = v[e] * rs * cqg[8 * lane + e];
              *(GAS v4u*)(CQN + (size_t)m * 384 + 8 * lane) = pk8(v, 1.f); } }
        { const bool on = lane < 32; if (on) ld8(r + 1152 + 8 * lane, v); float ss = 0.f;
          if (on) {
#pragma unroll
              for (int e = 0; e < 8; ++e) ss += v[e] * v[e]; }
          const float rs = 1.f / sqrtf(wave_sum(ss, lane) * (1.f / 256.f) + 1e-6f);
          if (on) {
#pragma unroll
              for (int e = 0; e < 8; ++e) v[e] = v[e] * rs * ckvg[8 * lane + e];
              *(GAS v4u*)(CKVN + (size_t)m * 256 + 8 * lane) = pk8(v, 1.f); } }
        { const int l4 = lane & 3; ld8(r + 1408 + 8 * l4, v); float pr[8];
#pragma unroll
          for (int e = 0; e < 8; ++e) pr[e] = shx(v[e], 1, lane);
          if (lat) { const int axis = l4 >> 1, pos = axis ? tcol : trow; const float* cs = ropeB + pos * 16; const bool second = (l4 & 1) != 0;
#pragma unroll
              for (int e = 0; e < 8; ++e) { const float c_ = cs[2 * e], s_ = cs[2 * e + 1]; v[e] = second ? (v[e] * c_ + pr[e] * s_) : (v[e] * c_ - pr[e] * s_); } }
          if (lane < 32) { const int head = lane >> 2; *(GAS v4u*)(KM + (size_t)m * 768 + head * 96 + 64 + 8 * l4) = pk8(v, 1.f); } }
    }
}
__device__ __forceinline__ void phase_even_attn(Frame& F) {
    const bf16 *QG = (const bf16*)(F.ws + WS_QG), *KG = (const bf16*)(F.ws + WS_KG), *VG = (const bf16*)(F.ws + WS_VG);
    const bf16 *QM = (const bf16*)(F.ws + WS_QM), *KM = (const bf16*)(F.ws + WS_KM), *VM = (const bf16*)(F.ws + WS_VM); bf16* OE = (bf16*)(F.ws + WS_OE);
    for (int u = F.vcu; u < 1024 + 32; u += F.G) {
        if (u < 1024) {
            const int qb = u & 31, hq = (u >> 5) & 3, kvh = (u >> 7) & 1, b = u >> 8, h = kvh * 4 + hq; const size_t r0 = (size_t)b * SEQ + qb * 256, kl = (size_t)b * SEQ, kc = (size_t)MLAT + b * CTXL;
            attn_unit<64, 0>(F.lds, F.tid, QG + r0 * 512 + h * 64, 512, KG + kl * 128 + kvh * 64, VG + kl * 128 + kvh * 64, 128, KG + kc * 128 + kvh * 64, VG + kc * 128 + kvh * 64, 4, 128, 128,
                             OE + r0 * 1024 + h * 64, 1024, 0, 0, nullptr);
        } else { const int id = u - 1024, h = id & 7, b = id >> 3, kvh = h >> 2; const size_t kc = (size_t)MLAT + b * CTXL;
            attn_unit<64, 0>(F.lds, F.tid, QG + kc * 512 + h * 64, 512, nullptr, nullptr, 0, KG + kc * 128 + kvh * 64, VG + kc * 128 + kvh * 64, 4, 128, 128, OE + kc * 1024 + h * 64, 1024, 0, 0, nullptr); }
    }
    for (int u = F.vcu; u < 1024 + 32; u += F.G) {
        if (u < 1024) {
            const int qb = u & 31, h = (u >> 5) & 7, b = u >> 8; const size_t r0 = (size_t)b * SEQ + qb * 256, kl = (size_t)b * SEQ, kc = (size_t)MLAT + b * CTXL;
            attn_unit<96, 0>(F.lds, F.tid, QM + r0 * 768 + h * 96, 768, KM + kl * 768 + h * 96, VM + kl * 512 + h * 64, 128, KM + kc * 768 + h * 96, VM + kc * 512 + h * 64, 4, 768, 512,
                             OE + r0 * 1024 + 512 + h * 64, 1024, 0, 0, nullptr);
        } else { const int id = u - 1024, h = id & 7, b = id >> 3; const size_t kc = (size_t)MLAT + b * CTXL;
            attn_unit<96, 0>(F.lds, F.tid, QM + kc * 768 + h * 96, 768, nullptr, nullptr, 0, KM + kc * 768 + h * 96, VM + kc * 512 + h * 64, 4, 768, 512, OE + kc * 1024 + 512 + h * 64, 1024, 0, 0, nullptr); }
    }
}
__device__ __forceinline__ void phase_odd_mix(Frame& F, const PArgs& A, const HgT& T, int j) {
    const bf16 *QN = (const bf16*)(F.ws + WS_QN), *KN = (const bf16*)(F.ws + WS_KN), *VN = (const bf16*)(F.ws + WS_VN); bf16* OO = (bf16*)(F.ws + WS_OO);
    const float* rpb = A.in[I_RPB] + (size_t)j * 8 * 15 * 31;
#ifndef NO_NA
    for (int u = F.vcu; u < 1024; u += F.G) {
        const int rg = u & 31, h = (u >> 5) & 7, b = u >> 8; const int rlo = min(max(4 * rg - 4, 0), 120), rhi = min(max(4 * rg + 3 - 4, 0), 120) + 8;
        const size_t r0 = (size_t)b * SEQ + (size_t)rg * 256, kl = (size_t)b * SEQ + (size_t)rlo * 64, kc = (size_t)MLAT + b * CTXL;
        attn_unit<64, 1>(F.lds, F.tid, QN + r0 * 512 + h * 64, 512, KN + kl * 512 + h * 64, VN + kl * 512 + h * 64, rhi - rlo, KN + kc * 512 + h * 64, VN + kc * 512 + h * 64, 4, 512, 512,
                         OO + r0 * 1024 + h * 64, 1024, 4 * rg, rlo, rpb + h * 465);
    }
#endif
    for (int u = F.vcu; u < 32; u += F.G) {
        const int h = u & 7, b = u >> 3; const size_t kc = (size_t)MLAT + b * CTXL;
        attn_unit<64, 0>(F.lds, F.tid, QN + kc * 512 + h * 64, 512, nullptr, nullptr, 0, KN + kc * 512 + h * 64, VN + kc * 512 + h * 64, 4, 512, 512, OO + kc * 1024 + h * 64, 1024, 0, 0, nullptr);
    }
#ifndef NO_HA
    for (int u = F.vcu; u < 2112; u += F.G) hg_a_unit(F, T, u / 66, u % 66);
#endif
}
__device__ __forceinline__ void moe_offsets(const gu32* cnt, int (&off)[9]) {
    int a = 0;
#pragma unroll
    for (int e = 0; e < 8; ++e) { off[e] = a; const int c = (int)__hip_atomic_load(cnt + e, __ATOMIC_RELAXED, __HIP_MEMORY_SCOPE_AGENT); a += (c + 255) & ~255; }
    off[8] = a;
}
__device__ __forceinline__ void phase_moe_dispatch(Frame& F, int j) {
    int* topk = (int*)(F.ws + WS_TOPK); const bf16* H = (const bf16*)(F.ws + WS_H); bf16* XG = (bf16*)(F.ws + WS_XG);
    LAS unsigned* lc = (LAS unsigned*)F.lds;
    LAS int* lrow = (LAS int*)(F.lds + 256);
    int off[9]; moe_offsets(F.ctl + CW_CNT + 64 * j, off);
    const int per = MROWS / 256;
    for (int c0 = F.vcu * per; c0 < MROWS; c0 += F.G * per) {
        if (F.tid < 8) lc[F.tid] = 0u;
        __syncthreads();
        int e1 = 0, e2 = 0, li1 = 0, li2 = 0; const bool on = F.tid < per;
        if (on) { e1 = topk[(c0 + F.tid) * 6]; e2 = topk[(c0 + F.tid) * 6 + 1]; li1 = (int)atomicAdd((unsigned*)&lc[e1], 1u); li2 = (int)atomicAdd((unsigned*)&lc[e2], 1u); }
        __syncthreads();
        if (F.tid < 8) lc[8 + F.tid] = __hip_atomic_fetch_add((unsigned*)(F.ctl + CW_CNT2 + 64 * j) + F.tid, lc[F.tid], __ATOMIC_RELAXED, __HIP_MEMORY_SCOPE_AGENT);
        __syncthreads();
        if (on) {
            int o1 = 0, o2 = 0;
#pragma unroll
            for (int e = 0; e < 8; ++e) { o1 = (e == e1) ? off[e] : o1; o2 = (e == e2) ? off[e] : o2; }
            const int r1 = o1 + (int)lc[8 + e1] + li1, r2 = o2 + (int)lc[8 + e2] + li2;
            topk[(c0 + F.tid) * 6 + 4] = r1; topk[(c0 + F.tid) * 6 + 5] = r2; lrow[2 * F.tid] = r1; lrow[2 * F.tid + 1] = r2;
        }
        __syncthreads();
        for (int p = F.wave; p < 2 * per; p += NWAVES) { const int tok = c0 + (p >> 1), dst = lrow[p];
            const GAS v4u* s = (const GAS v4u*)(H + (size_t)tok * 1024) + F.lane; GAS v4u* d = (GAS v4u*)(XG + (size_t)dst * 1024) + F.lane;
            const v4u a = s[0], b2 = s[64]; d[0] = a; d[64] = b2; }
        __syncthreads();
    }
}
constexpr int PH_CV = 0, PH_MOD = 1, PH_E1 = 2, PH_E2 = 3, PH_E3 = 4, PH_E5 = 5, PH_E6 = 6, PH_E7 = 7, PH_E8 = 8, PH_E9 = 9, PH_E10 = 10,
              PH_O1 = 11, PH_O2 = 12, PH_O3 = 13, PH_O4 = 14, PH_O5 = 15, PH_O6 = 16, PH_O7 = 17, PH_O8 = 18, PH_O9 = 19, PH_O10 = 20, PH_PER = 21;
constexpr int NPHASES = 2 * PH_PER;

__global__ void __launch_bounds__(NTHR, 2) mk_fwd(Args args) {
    extern __shared__ __attribute__((aligned(16))) unsigned char lds[];
    Frame F;
    F.lds = (LAS unsigned char*)lds; F.ws = args.ws; F.ctl = (gu32*)(args.ws + WS_CTL);
    F.tid = threadIdx.x; F.lane = F.tid & 63; F.wave = __builtin_amdgcn_readfirstlane(F.tid >> 6);
    F.G = gridDim.x; { const int bx = blockIdx.x; F.vcu = (F.G % 8 == 0) ? (bx % 8) * (F.G / 8) + bx / 8 : bx; }
    volatile LAS unsigned* MISC = (volatile LAS unsigned*)(F.lds + MISC_OFF);
    if (F.tid < 64) MISC[F.tid] = 0u;
    { LAS unsigned long long* tab = (LAS unsigned long long*)(F.lds + MISC_OFF + 256);
      if (F.tid == 0) {
#pragma unroll
          for (int i = 0; i < 30; ++i) tab[i] = (unsigned long long)args.in[i];
          tab[30] = (unsigned long long)args.out; } }
    __syncthreads();
    const int lo = args.ph_lo, hi = args.ph_hi; const int wv0 = F.wave;
    const bool multi = (hi - lo) > 1;
    XcdBarrier bar; bar.bar = (unsigned*)(F.ctl + CW_BAR); bar.x = 0; bar.st = nullptr;
    if (multi) bar = xcd_barrier_post((unsigned*)(F.ctl + CW_BAR), MISC + 8);
#ifndef PHMASK
#define PHMASK 0x1fffff
#endif
#define IN(k) ((((PHMASK) >> ((k) % PH_PER)) & 1) && lo <= (k) && (k) < hi)
#define MKT HgT T; T.Qd = (const bf16*)(ws + WS_QD); T.Vd = (const bf16*)(ws + WS_VD); T.Sg = (const bf16*)(ws + WS_SG); T.Zf = (const float*)(ws + WS_ZF); T.Zb = (const float*)(ws + WS_ZB); \
    T.lb = (const float*)(ws + WS_SMALL + SM_LB) + j * 1024; T.HST = (float*)(ws + WS_HST); T.HDM = (float*)(ws + WS_HDM); T.ong = PA.in[I_ONG] + j * 128; T.OO = (bf16*)(ws + WS_OO);
#define FRESH() int t_; asm volatile("v_mbcnt_lo_u32_b32 %0, -1, 0\n\tv_mbcnt_hi_u32_b32 %0, -1, %0" : "=v"(t_)); t_ += wv0 * 64; F.tid = t_; F.lane = t_ & 63; F.wave = __builtin_amdgcn_readfirstlane(t_ >> 6); \
    unsigned char* ws = ws0; asm volatile("" : "+s"(ws)); F.ws = ws; F.ctl = (gu32*)(ws + WS_CTL); PArgs PA; PA.in.t = (LAS unsigned long long*)(F.lds + MISC_OFF + 256); PA.out = (float*)PA.in[30]; \
    float* mods = (float*)(ws + WS_SMALL + SM_MODS); bf16* W = (bf16*)(ws + WS_W); bf16* WM = (bf16*)(ws + WS_WMOE); bf16* H = (bf16*)(ws + WS_H); float* X = (float*)(ws + WS_X); \
    const float* modE = mods + (size_t)Le * 5 * 6144; const float* modO = mods + (size_t)Lo * 5 * 6144; (void)W; (void)WM; (void)H; (void)X; (void)modE; (void)modO;
#define SEAM(k) do { if (IN(k) && IN((k) + 1)) xcd_barrier(bar); } while (0)
    unsigned char* const ws0 = args.ws;
#pragma unroll 1
    for (int j = 0; j < 2; ++j) {
        const int pb = j * PH_PER, Le = 2 * j, Lo = 2 * j + 1;
        if (IN(pb + PH_CV)) { FRESH(); phase_cv(F, PA, j); } SEAM(pb + PH_CV);
        if (IN(pb + PH_MOD)) { FRESH(); if (j == 0) phase_mod(F, PA); } SEAM(pb + PH_MOD);
        if (IN(pb + PH_E1)) { FRESH();
            pg8::Gemm g{H, W + W_EVIN + (size_t)j * EV_INP * 1024, MROWS, EV_INP, 1024}; pg8::StaticOrder S; S.init(MROWS, EV_INP, F.G, (int)blockIdx.x);
            pg8::EpiRawF32 E{(float*)(ws + WS_RAW), EV_INP};
            pg8::gemm_phase<pg8::EpiRawF32, pg8::StaticOrder, true, true>(F.lds, g, S, E, F.tid);
        } SEAM(pb + PH_E1);
        if (IN(pb + PH_E2)) { FRESH(); phase_even_post(F, PA, j); } SEAM(pb + PH_E2);
        if (IN(pb + PH_E3)) { FRESH();
            { pg8::Gemm g{(const bf16*)(ws + WS_CQN), W + W_UQ + (size_t)j * 768 * 384, MROWS, 768, 384}; pg8::StaticOrder S; S.init(MROWS, 768, F.G, (int)blockIdx.x);
              pg8::EpiMlaQ E{(bf16*)(ws + WS_QM), (const float*)(ws + WS_SMALL + SM_ROPEB)};
              pg8::gemm_phase<pg8::EpiMlaQ, pg8::StaticOrder, true, true>(F.lds, g, S, E, F.tid); }
            { asm volatile("v_mbcnt_lo_u32_b32 %0, -1, 0\n\tv_mbcnt_hi_u32_b32 %0, -1, %0" : "=v"(t_)); t_ += wv0 * 64; F.tid = t_; F.lane = t_ & 63;
              pg8::Gemm g{(const bf16*)(ws + WS_CKVN), W + W_UKV + (size_t)j * 1024 * 256, MROWS, 1024, 256}; pg8::StaticOrder S; S.init(MROWS, 1024, F.G, (int)blockIdx.x);
              pg8::EpiMlaKV E{(bf16*)(ws + WS_KM), (bf16*)(ws + WS_VM)};
              pg8::gemm_phase<pg8::EpiMlaKV, pg8::StaticOrder, true, true>(F.lds, g, S, E, F.tid); }
        } SEAM(pb + PH_E3);
        if (IN(pb + PH_E5)) { FRESH(); phase_even_attn(F); } SEAM(pb + PH_E5);
        if (IN(pb + PH_E6)) { FRESH();
            pg8::Gemm g{(const bf16*)(ws + WS_OE), W + W_EVOUT + (size_t)j * 1024 * 1024, MROWS, 1024, 1024}; pg8::StaticOrder S; S.init(MROWS, 1024, F.G, (int)blockIdx.x);
            pg8::EpiResid E{X, modE + 2 * 1024};
            pg8::gemm_phase<pg8::EpiResid, pg8::StaticOrder, true, true>(F.lds, g, S, E, F.tid);
        } SEAM(pb + PH_E6);
        if (IN(pb + PH_E7)) { FRESH(); phase_ln<false, false>(F, PA, PA.in[I_LN1G] + Le * 1024, PA.in[I_LN1B] + Le * 1024, modE + 3 * 1024, nullptr, nullptr, 0, false); } SEAM(pb + PH_E7);
        if (IN(pb + PH_E8)) { FRESH();
            pg8::Gemm g{H, W + W_FFGU + (size_t)j * 2 * DFF * 1024, MROWS, 2 * DFF, 1024}; pg8::StaticOrder S; S.init(MROWS, 2 * DFF, F.G, (int)blockIdx.x);
            pg8::EpiSwiglu E{(bf16*)(ws + WS_FFH), DFF};
            pg8::gemm_phase<pg8::EpiSwiglu, pg8::StaticOrder, true, true>(F.lds, g, S, E, F.tid);
        } SEAM(pb + PH_E8);
        if (IN(pb + PH_E9)) { FRESH();
            pg8::Gemm g{(const bf16*)(ws + WS_FFH), W + W_FFD + (size_t)j * 1024 * DFF, MROWS, 1024, DFF}; pg8::StaticOrder S; S.init(MROWS, 1024, F.G, (int)blockIdx.x);
            pg8::EpiResid E{X, modE + 5 * 1024};
            pg8::gemm_phase<pg8::EpiResid, pg8::StaticOrder, true, true>(F.lds, g, S, E, F.tid);
        } SEAM(pb + PH_E9);
        if (IN(pb + PH_E10)) { FRESH(); phase_ln<false, false>(F, PA, PA.in[I_LN2G] + Le * 1024, PA.in[I_LN2B] + Le * 1024, modO + 0 * 1024, nullptr, nullptr, 0, false); } SEAM(pb + PH_E10);
        if (IN(pb + PH_O1)) { FRESH();
            pg8::Gemm g{H, W + W_ODIN + (size_t)j * 4096 * 1024, MROWS, 4096, 1024}; pg8::StaticOrder S; S.init(MROWS, 4096, F.G, (int)blockIdx.x);
            pg8::EpiOddIn E{(bf16*)(ws + WS_QN), (bf16*)(ws + WS_KN), (bf16*)(ws + WS_VN), (bf16*)(ws + WS_QD), (bf16*)(ws + WS_VD), (bf16*)(ws + WS_SG), (float*)(ws + WS_ZF), (float*)(ws + WS_ZB)};
            pg8::gemm_phase<pg8::EpiOddIn, pg8::StaticOrder, true, true>(F.lds, g, S, E, F.tid);
        } SEAM(pb + PH_O1);
        if (IN(pb + PH_O2)) { FRESH(); MKT phase_odd_mix(F, PA, T, j); } SEAM(pb + PH_O2);
        if (IN(pb + PH_O3)) { FRESH(); MKT phase_hg_b(F, T); } SEAM(pb + PH_O3);
        if (IN(pb + PH_O4)) { FRESH(); MKT for (int u = F.vcu; u < 16 * 66; u += F.G) hg_c_unit(F, T, u / 264, (u / 66) & 3, u % 66); } SEAM(pb + PH_O4);
        if (IN(pb + PH_O5)) { FRESH();
            pg8::Gemm g{(const bf16*)(ws + WS_OO), W + W_ODOUT + (size_t)j * 1024 * 1024, MROWS, 1024, 1024}; pg8::StaticOrder S; S.init(MROWS, 1024, F.G, (int)blockIdx.x);
            pg8::EpiResid E{X, modO + 2 * 1024};
            pg8::gemm_phase<pg8::EpiResid, pg8::StaticOrder, true, true>(F.lds, g, S, E, F.tid);
        } SEAM(pb + PH_O5);
        if (IN(pb + PH_O6)) { FRESH(); phase_ln<false, true>(F, PA, PA.in[I_LN1G] + Lo * 1024, PA.in[I_LN1B] + Lo * 1024, modO + 3 * 1024, nullptr, PA.in[I_ROUTER] + (size_t)j * 1024 * 8, j, false); } SEAM(pb + PH_O6);
        if (IN(pb + PH_O7)) { FRESH(); phase_moe_dispatch(F, j); } SEAM(pb + PH_O7);
        if (IN(pb + PH_O8)) { FRESH();
            int off[9]; moe_offsets(F.ctl + CW_CNT + 64 * j, off);
            pg8::GroupedOrder S; S.nM = off[8] >> 8; S.nN = 2 * DFFE / 256; S.nwg = S.nM * S.nN; S.G = F.G; S.c = (int)blockIdx.x; S.estride = (long)2 * DFFE * 1024 * 2;
#pragma unroll
            for (int e = 0; e < 9; ++e) S.toff[e] = off[e] >> 8;
            pg8::Gemm g{(const bf16*)(ws + WS_XG), WM + WM_GU, MOE_ROWS, 2 * DFFE, 1024};
            pg8::EpiSwiglu E{(bf16*)(ws + WS_MH), DFFE};
            pg8::gemm_phase<pg8::EpiSwiglu, pg8::GroupedOrder, true, true>(F.lds, g, S, E, F.tid);
        } SEAM(pb + PH_O8);
        if (IN(pb + PH_O9)) { FRESH();
            int off[9]; moe_offsets(F.ctl + CW_CNT + 64 * j, off);
            pg8::GroupedOrder S; S.nM = off[8] >> 8; S.nN = 1024 / 256; S.nwg = S.nM * S.nN; S.G = F.G; S.c = (int)blockIdx.x; S.estride = (long)1024 * DFFE * 2;
#pragma unroll
            for (int e = 0; e < 9; ++e) S.toff[e] = off[e] >> 8;
            pg8::Gemm g{(const bf16*)(ws + WS_MH), WM + WM_D, MOE_ROWS, 1024, DFFE};
            pg8::EpiPlainBf16 E{(bf16*)(ws + WS_XG), 1024};
            pg8::gemm_phase<pg8::EpiPlainBf16, pg8::GroupedOrder, true, true>(F.lds, g, S, E, F.tid);
        } SEAM(pb + PH_O9);
        if (IN(pb + PH_O10)) { FRESH(); phase_ln<true, false>(F, PA, PA.in[I_LN2G] + Lo * 1024, PA.in[I_LN2B] + Lo * 1024, mods + (size_t)(j == 0 ? 2 : 0) * 5 * 6144, modO + 5 * 1024, nullptr, 0, j == 1); }
        if (j == 0) SEAM(pb + PH_O10);
    }
#undef IN
#undef SEAM
}

extern "C" void kernel_launch(void* const* d_in, const int* in_sizes, int n_in, void* d_out, int out_size, void* d_ws, size_t ws_size, hipStream_t stream) {
    static int grid = 0;
    if (grid == 0) {
        if (n_in != 30 || in_sizes[0] != MLAT * DM || out_size != MLAT * DM || ws_size < WS_END) { fprintf(stderr, "kernel_launch: unexpected shapes / workspace (n_in %d, ws %zu)\n", n_in, ws_size); grid = -1; return; }
        int dev = 0, cus = 0, per_cu = 0;
        if (hipGetDevice(&dev) != hipSuccess || hipDeviceGetAttribute(&cus, hipDeviceAttributeMultiprocessorCount, dev) != hipSuccess) { grid = -1; return; }
        if (hipFuncSetAttribute((const void*)mk_fwd, hipFuncAttributeMaxDynamicSharedMemorySize, LDS_BYTES) != hipSuccess) { fprintf(stderr, "kernel_launch: hipFuncSetAttribute failed\n"); grid = -1; return; }
        if (hipOccupancyMaxActiveBlocksPerMultiprocessor(&per_cu, (const void*)mk_fwd, NTHR, LDS_BYTES) != hipSuccess || per_cu < 1) { fprintf(stderr, "kernel_launch: occupancy query says %d\n", per_cu); }
        (void)hipGetLastError();
        grid = cus;
        if (grid != 256) { fprintf(stderr, "kernel_launch: built for 256 CUs, found %d\n", cus); grid = -1; return; }
    }
    if (grid < 0) return;
    if (hipMemsetAsync((char*)d_ws + WS_CTL, 0, CTL_ZERO_BYTES, stream) != hipSuccess) return;
    Args a{};
    for (int i = 0; i < 30; ++i) a.in[i] = (const float*)d_in[i];
    a.out = (float*)d_out; a.ws = (unsigned char*)d_ws;
#if MK_MULTI
    for (int ph = 0; ph < NPHASES; ++ph) {
        if (ph == PH_PER + PH_MOD) continue;
        a.ph_lo = ph; a.ph_hi = ph + 1;
        hipLaunchKernelGGL(mk_fwd, dim3(grid), dim3(NTHR), LDS_BYTES, stream, a);
    }
#else
    a.ph_lo = 0; a.ph_hi = NPHASES;
    hipLaunchKernelGGL(mk_fwd, dim3(grid), dim3(NTHR), LDS_BYTES, stream, a);
#endif
}
```

```cpp
#include <hip/hip_runtime.h>
#include <cstdio>
#include <cstdint>

#ifndef MK_MULTI
#define MK_MULTI 0
#endif

constexpr int DM = 1024, NB = 4, SEQ = 8192, CTXL = 256, GRIDW = 64;
constexpr int MLAT = NB * SEQ, MCTX = NB * CTXL, MROWS = MLAT + MCTX;
constexpr int DEPTH = 4;
constexpr int EV_IN = 1440, EV_INP = 1536;
constexpr int DFF = 2816, DFFE = 3584, NEXP = 8;
constexpr int MOE_ROWS = 2 * MROWS + NEXP * 256;
constexpr float ALPHA = 1.6817928305074290f;
constexpr float LOG2E = 1.4426950408889634f;
constexpr float C2_64 = 0.125f * LOG2E;
constexpr float C2_96 = 0.10206207261596577f * LOG2E;

constexpr size_t MiB = 1u << 20;
constexpr size_t WS_CTL = 0, CTL_ZERO_BYTES = 1 * MiB;
constexpr size_t WS_SMALL = 2 * MiB;
constexpr size_t WS_TOPK = 4 * MiB;
constexpr size_t WS_W = 6 * MiB;
constexpr size_t WS_WMOE = 72 * MiB;
constexpr size_t WS_X = 240 * MiB;
constexpr size_t WS_H = 372 * MiB;
constexpr size_t WS_S = 438 * MiB;
constexpr size_t WS_RAW = WS_S;
constexpr size_t WS_QG = 636 * MiB, WS_KG = 669 * MiB, WS_VG = 678 * MiB, WS_CQN = 687 * MiB, WS_CKVN = 712 * MiB;
constexpr size_t WS_QM = 729 * MiB, WS_KM = 779 * MiB, WS_VM = 829 * MiB, WS_OE = 862 * MiB;
constexpr size_t WS_FFH = WS_S;
constexpr size_t WS_QN = 438 * MiB, WS_KN = 471 * MiB, WS_VN = 504 * MiB, WS_QD = 537 * MiB, WS_VD = 570 * MiB, WS_SG = 603 * MiB;
constexpr size_t WS_ZF = 636 * MiB, WS_ZB = 702 * MiB, WS_OO = 768 * MiB, WS_HST = 834 * MiB, WS_HDM = 966 * MiB;
constexpr size_t WS_MH = 372 * MiB;
constexpr size_t WS_XG = 848 * MiB;
constexpr size_t WS_END = 984 * MiB;
static_assert(WS_QG >= WS_RAW + (size_t)MROWS * EV_INP * 4 && WS_OE + (size_t)MROWS * 2048 <= 984 * MiB, "even map");
static_assert(WS_HST + (size_t)32 * 66 * 65536 <= WS_HDM && WS_HDM + (size_t)32 * 66 * 512 <= WS_END, "odd map");
static_assert(WS_MH + (size_t)MOE_ROWS * DFFE * 2 <= WS_XG && WS_XG + (size_t)MOE_ROWS * 2048 <= WS_END, "moe map");
constexpr size_t SM_MODS = 0;
constexpr size_t SM_ROPEA = 512 * 1024;
constexpr size_t SM_ROPEB = SM_ROPEA + 16384;
constexpr size_t SM_LB = SM_ROPEB + 8192;
constexpr size_t W_EVIN = 0;
constexpr size_t W_UQ = W_EVIN + (size_t)2 * 1536 * 1024;
constexpr size_t W_UKV = W_UQ + (size_t)2 * 768 * 384;
constexpr size_t W_EVOUT = W_UKV + (size_t)2 * 1024 * 256;
constexpr size_t W_FFGU = W_EVOUT + (size_t)2 * 1024 * 1024;
constexpr size_t W_FFD = W_FFGU + (size_t)2 * 5632 * 1024;
constexpr size_t W_ODIN = W_FFD + (size_t)2 * 1024 * 2816;
constexpr size_t W_ODOUT = W_ODIN + (size_t)2 * 4096 * 1024;
constexpr size_t W_ENDE = W_ODOUT + (size_t)2 * 1024 * 1024;
static_assert(W_ENDE * 2 <= 66 * MiB, "weights map");
constexpr size_t WM_GU = 0;
constexpr size_t WM_D = (size_t)8 * 7168 * 1024;
constexpr int CW_BAR = 4096;
constexpr int CW_CNT = 8192;
constexpr int CW_CNT2 = 8192 + 256;
constexpr int LDS_BYTES = 160256;
constexpr int MISC_OFF = LDS_BYTES - 512;
constexpr int NWAVES = 8, NTHR = 512;

#define GAS __attribute__((address_space(1)))
#define LAS __attribute__((address_space(3)))
typedef unsigned short bf16;
typedef unsigned v4u __attribute__((ext_vector_type(4)));
typedef unsigned v2u __attribute__((ext_vector_type(2)));
typedef float f32x4 __attribute__((ext_vector_type(4)));
typedef float f32x16 __attribute__((ext_vector_type(16)));
typedef short bf16x8 __attribute__((ext_vector_type(8)));
typedef short s16x4 __attribute__((ext_vector_type(4)));
typedef GAS unsigned gu32;

__device__ __forceinline__ unsigned pkbf(float lo, float hi) { unsigned r; asm volatile("v_cvt_pk_bf16_f32 %0, %1, %2" : "=v"(r) : "v"(lo), "v"(hi)); return r; }
__device__ __forceinline__ float bf_lo(unsigned u) { return __uint_as_float(u << 16); }
__device__ __forceinline__ float bf_hi(unsigned u) { return __uint_as_float(u & 0xffff0000u); }
__device__ __forceinline__ float bf2f(bf16 h) { return __uint_as_float(((unsigned)h) << 16); }
__device__ __forceinline__ bf16 f2bf(float f) { return (bf16)(pkbf(f, 0.f) & 0xffffu); }
__device__ __forceinline__ float fast_exp2(float x) { return __builtin_amdgcn_exp2f(x); }
__device__ __forceinline__ float sigmoidf_(float x) { return 1.f / (1.f + __expf(-x)); }
__device__ __forceinline__ float siluf_(float x) { return x / (1.f + __expf(-x)); }
__device__ __forceinline__ float shx(float v, int m, int lane) { return __int_as_float(__builtin_amdgcn_ds_bpermute((lane ^ m) << 2, __float_as_int(v))); }
__device__ __forceinline__ float wave_sum(float v, int lane) {
#pragma unroll
    for (int o = 1; o < 64; o <<= 1) v += shx(v, o, lane);
    return v;
}
__device__ __forceinline__ int modrow(int row) { return row < MLAT ? (row >> 13) : 4; }
namespace pg8 {
#define PG8_LAS __attribute__((address_space(3)))
typedef unsigned short bf16_t;
typedef short bf16x8 __attribute__((ext_vector_type(8)));
typedef float f32x4 __attribute__((ext_vector_type(4)));
typedef unsigned u32x4 __attribute__((ext_vector_type(4)));
constexpr int BM = 256, BK = 64, HALF = 128, HTB = HALF * BK * 2  , STAGE_BYTES = 8 * HTB, NXCD = 8, WGM = 8;

__host__ __device__ __forceinline__ int lds_byte(int r, int c) { const int st = (r >> 4) * 2 + (c >> 5), rr = r & 15, cc = c & 31, ob = rr * 64 + cc * 2; return st * 1024 + (ob ^ (((ob >> 9) & 1) << 5)); }
__host__ __device__ __forceinline__ void stage_rc(int b, int& R, int& C) { const int st = b / 1024, sb = b % 1024, swz = sb ^ (((sb >> 9) & 1) << 5); R = (st >> 1) * 16 + swz / 64; C = (st & 1) * 32 + (swz % 64) / 2; }
__host__ __device__ __forceinline__ int perm32(int rho) { const int n = rho >> 4, i = rho & 15; return 8 * (i >> 2) + 4 * n + (i & 3); }

struct Unit { int pm, pn; long boff; };
struct Gemm { const bf16_t* A; const bf16_t* Bt; int M, N, K; };

struct StaticOrder {
    int nM, nN, nwg, G, c;
    __host__ __device__ void init(int M, int N, int G_, int c_) { nM = M / BM; nN = N / BM; nwg = nM * nN; G = G_; c = c_; }
    __host__ __device__ bool next(int i, Unit& u) const {
        const long L = (long)i * G + c; if (L >= nwg) return false;
        int wgid = (int)L; { const int q = nwg / NXCD, r = nwg % NXCD, xcd = wgid % NXCD, off = wgid / NXCD; wgid = (xcd < r ? xcd * (q + 1) : r * (q + 1) + (xcd - r) * q) + off; }
        const int nig = WGM * nN, gid = wgid / nig, fm = gid * WGM, gsz = (nM - fm) < WGM ? (nM - fm) : WGM;
        u.pm = fm + ((wgid % nig) % gsz); u.pn = (wgid % nig) / gsz; u.boff = 0; return true;
    }
    __device__ __forceinline__ void a_ready(const Unit&) const {}
    __device__ __forceinline__ void done(const Unit&) const {}
};

__device__ __forceinline__ unsigned cvt_pk_bf16(float lo, float hi) { unsigned r; asm volatile("v_cvt_pk_bf16_f32 %0, %1, %2" : "=v"(r) : "v"(lo), "v"(hi)); return r; }
typedef float f32x2 __attribute__((ext_vector_type(2)));
template <class Epi, class Sched, bool ALIGN_EPI = false, bool SP2 = false>
__device__ __forceinline__ void gemm_phase(PG8_LAS unsigned char* lds, const Gemm g, const Sched& S, const Epi& E, int tid_in) {
    int tid_ = tid_in; asm volatile("" : "+v"(tid_));
    const int tid = tid_, wid = __builtin_amdgcn_readfirstlane(tid >> 6), lane = tid & 63, wr = wid >> 2, wc = wid & 3, fr = lane & 15, fq = lane >> 4;
    const int K = g.K, nt = K / BK;
    unsigned voffA[2], voffB[2];
#pragma unroll
    for (int i = 0; i < 2; ++i) { int R, C; stage_rc(tid * 16 + i * 8192, R, C); const int Rb = Epi::PERM ? ((R & ~31) + perm32(R & 31)) : R;
        voffA[i] = (unsigned)(R * K + C) * 2u; voffB[i] = (unsigned)(Rb * K + C) * 2u; }
    const size_t kstep = (size_t)(BK * 2);
    const size_t hstep = (size_t)HALF * K * 2;
    const size_t tstep = 2 * hstep;
    const unsigned ldsw = (unsigned)wid * 1024u;
    const int aoff = lds_byte(wr * 64 + fr, fq * 8), boff = lds_byte(wc * 32 + fr, fq * 8);
#define PG8_SA(b, h) (((b) * 2 + (h)) * HTB)
#define PG8_SB(b, h) ((4 + (b) * 2 + (h)) * HTB)
#define PG8_STAGE(bufoff, gbase, voff) do { _Pragma("unroll") for (int _i = 0; _i < 2; ++_i) \
        __builtin_amdgcn_global_load_lds((const unsigned*)((const char*)(gbase) + (voff)[_i]), (PG8_LAS unsigned*)(lds + (bufoff) + ldsw + _i * 8192), 16, 0, 0); } while (0)
#define PG8_LDA(dst, b, h) do { _Pragma("unroll") for (int m = 0; m < 4; ++m) _Pragma("unroll") for (int k = 0; k < 2; ++k) dst[m][k] = *(const PG8_LAS bf16x8*)(lds + PG8_SA(b, h) + aoff + m * 2048 + k * 1024); } while (0)
#define PG8_LDB(dst, b, h) do { _Pragma("unroll") for (int n = 0; n < 2; ++n) _Pragma("unroll") for (int k = 0; k < 2; ++k) dst[n][k] = *(const PG8_LAS bf16x8*)(lds + PG8_SB(b, h) + boff + n * 2048 + k * 1024); } while (0)
#define PG8_MMA(ai, bj, At, Bt) do { __builtin_amdgcn_s_setprio(1); _Pragma("unroll") for (int m = 0; m < 4; ++m) _Pragma("unroll") for (int n = 0; n < 2; ++n) _Pragma("unroll") for (int k = 0; k < 2; ++k) \
        acc[ai][bj][m][n] = __builtin_amdgcn_mfma_f32_16x16x32_bf16(Bt[n][k], At[m][k], acc[ai][bj][m][n], 0, 0, 0); __builtin_amdgcn_s_setprio(0); } while (0)
#define PG8_WAIT_V(n) asm volatile("s_waitcnt vmcnt(" #n ")" ::: "memory")
#define PG8_WAIT_L(n) asm volatile("s_waitcnt lgkmcnt(" #n ")" ::: "memory")
#define PG8_BAR __builtin_amdgcn_s_barrier()
#define PG8_SCHED __builtin_amdgcn_sched_barrier(0)
    Unit cur, nxt; int ui = 0;
    if (!S.next(0, cur)) return;
    f32x4 acc[2][2][4][2];
#pragma unroll
    for (int a = 0; a < 2; ++a)
#pragma unroll
        for (int b = 0; b < 2; ++b)
#pragma unroll
            for (int m = 0; m < 4; ++m)
#pragma unroll
                for (int n = 0; n < 2; ++n) acc[a][b][m][n] = (f32x4){0.f, 0.f, 0.f, 0.f};
    bf16x8 At[4][2], B0[2][2], B1[2][2];
    const char* cA = (const char*)g.A + (size_t)cur.pm * tstep; const char* cB = (const char*)g.Bt + (size_t)cur.pn * tstep + cur.boff;
    S.a_ready(cur);
    if constexpr (SP2) {
        PG8_STAGE(PG8_SB(0, 0), cB, voffB); PG8_STAGE(PG8_SB(0, 1), cB + hstep, voffB); PG8_STAGE(PG8_SA(0, 0), cA, voffA); PG8_STAGE(PG8_SA(0, 1), cA + hstep, voffA);
        if (wr == 1) PG8_BAR;
        PG8_WAIT_V(2); PG8_BAR;
        PG8_STAGE(PG8_SB(1, 0), cB + kstep, voffB); PG8_STAGE(PG8_SA(1, 0), cA + kstep, voffA); PG8_STAGE(PG8_SB(1, 1), cB + hstep + kstep, voffB);
        PG8_WAIT_V(6); PG8_BAR;
    } else {
        PG8_STAGE(PG8_SB(0, 0), cB, voffB); PG8_STAGE(PG8_SA(0, 0), cA, voffA); PG8_STAGE(PG8_SB(0, 1), cB + hstep, voffB); PG8_STAGE(PG8_SA(0, 1), cA + hstep, voffA);
        if (wr == 1) PG8_BAR;
        PG8_WAIT_V(4); PG8_BAR;
        PG8_STAGE(PG8_SB(1, 0), cB + kstep, voffB); PG8_STAGE(PG8_SA(1, 0), cA + kstep, voffA); PG8_STAGE(PG8_SB(1, 1), cB + hstep + kstep, voffB);
        PG8_WAIT_V(6); PG8_BAR;
    }
    for (;;) {
        const bool has_next = S.next(ui + 1, nxt);
        const char* nA = has_next ? (const char*)g.A + (size_t)nxt.pm * tstep : cA; const char* nB = has_next ? (const char*)g.Bt + (size_t)nxt.pn * tstep + nxt.boff : cB;
        for (int t = 0; t < nt; t += 2) {
            const bool last = (t == nt - 2);
            const char* a1 = cA + (size_t)(t + 1) * kstep;
            const char* a2 = last ? nA : cA + (size_t)(t + 2) * kstep; const char* b2 = last ? nB : cB + (size_t)(t + 2) * kstep;
            const char* a3 = a2 + kstep; const char* b3 = b2 + kstep;
            if (last && has_next) S.a_ready(nxt);
            if constexpr (SP2) {
            PG8_LDB(B0, 0, 0); PG8_LDB(B1, 0, 1); PG8_SCHED; PG8_LDA(At, 0, 0); PG8_STAGE(PG8_SA(1, 1), a1 + hstep, voffA);
            PG8_WAIT_V(8); PG8_WAIT_L(0); PG8_BAR; PG8_MMA(0, 0, At, B0); PG8_MMA(0, 1, At, B1); PG8_BAR; PG8_SCHED;
            PG8_LDA(At, 0, 1); PG8_STAGE(PG8_SB(0, 0), b2, voffB); PG8_STAGE(PG8_SB(0, 1), b2 + hstep, voffB); PG8_STAGE(PG8_SA(0, 0), a2, voffA);
            PG8_WAIT_V(8); PG8_WAIT_L(0); PG8_BAR; PG8_MMA(1, 0, At, B0); PG8_MMA(1, 1, At, B1); PG8_BAR; PG8_SCHED;
            PG8_LDB(B0, 1, 0); PG8_LDB(B1, 1, 1); PG8_SCHED; PG8_LDA(At, 1, 0); PG8_STAGE(PG8_SA(0, 1), a2 + hstep, voffA);
            PG8_WAIT_V(8); PG8_WAIT_L(0); PG8_BAR; PG8_MMA(0, 0, At, B0); PG8_MMA(0, 1, At, B1); PG8_BAR; PG8_SCHED;
            PG8_LDA(At, 1, 1); PG8_STAGE(PG8_SB(1, 0), b3, voffB); PG8_STAGE(PG8_SB(1, 1), b3 + hstep, voffB); PG8_STAGE(PG8_SA(1, 0), a3, voffA);
            PG8_WAIT_V(8); PG8_WAIT_L(0); PG8_BAR; PG8_MMA(1, 0, At, B0); PG8_MMA(1, 1, At, B1); PG8_BAR; PG8_SCHED;
            } else {
            PG8_LDB(B0, 0, 0); PG8_SCHED; PG8_LDA(At, 0, 0); PG8_STAGE(PG8_SA(1, 1), a1 + hstep, voffA);
            PG8_WAIT_L(8); PG8_BAR; PG8_WAIT_L(0); PG8_MMA(0, 0, At, B0); PG8_BAR; PG8_SCHED;
            PG8_LDB(B1, 0, 1); PG8_STAGE(PG8_SB(0, 0), b2, voffB);
            PG8_BAR; PG8_WAIT_L(0); PG8_MMA(0, 1, At, B1); PG8_BAR;
            PG8_LDA(At, 0, 1); PG8_STAGE(PG8_SA(0, 0), a2, voffA);
            PG8_BAR; PG8_WAIT_L(0); PG8_MMA(1, 0, At, B0); PG8_BAR; PG8_SCHED;
            PG8_STAGE(PG8_SB(0, 1), b2 + hstep, voffB);
            PG8_WAIT_V(6); PG8_BAR; PG8_MMA(1, 1, At, B1); PG8_BAR;
            PG8_LDB(B0, 1, 0); PG8_SCHED; PG8_LDA(At, 1, 0); PG8_STAGE(PG8_SA(0, 1), a2 + hstep, voffA);
            PG8_WAIT_L(8); PG8_BAR; PG8_WAIT_L(0); PG8_MMA(0, 0, At, B0); PG8_BAR; PG8_SCHED;
            PG8_LDB(B1, 1, 1); PG8_STAGE(PG8_SB(1, 0), b3, voffB);
            PG8_BAR; PG8_WAIT_L(0); PG8_MMA(0, 1, At, B1); PG8_BAR;
            PG8_LDA(At, 1, 1); PG8_STAGE(PG8_SA(1, 0), a3, voffA);
            PG8_BAR; PG8_WAIT_L(0); PG8_MMA(1, 0, At, B0); PG8_BAR; PG8_SCHED;
            PG8_STAGE(PG8_SB(1, 1), b3 + hstep, voffB);
            PG8_WAIT_V(6); PG8_BAR; PG8_MMA(1, 1, At, B1); PG8_BAR;
            }
        }
        if constexpr (ALIGN_EPI) { if (wr == 0) PG8_BAR; }
        if constexpr (!Epi::AFTER_DRAIN) { int l2_; asm volatile("v_mbcnt_lo_u32_b32 %0, -1, 0\n\tv_mbcnt_hi_u32_b32 %0, -1, %0" : "=v"(l2_)); const int fr2 = l2_ & 15, fq2 = l2_ >> 4;     E(acc, cur, wr, wc, fr2, fq2); S.done(cur); }
        if (!has_next) break;
#pragma unroll
        for (int a = 0; a < 2; ++a)
#pragma unroll
            for (int b = 0; b < 2; ++b)
#pragma unroll
                for (int m = 0; m < 4; ++m)
#pragma unroll
                    for (int n = 0; n < 2; ++n) acc[a][b][m][n] = (f32x4){0.f, 0.f, 0.f, 0.f};
        cur = nxt; cA = nA; cB = nB; ++ui;
        if constexpr (ALIGN_EPI) { if (wr == 1) PG8_BAR; }
    }
    PG8_WAIT_V(0);
    if constexpr (!ALIGN_EPI) { if (wr == 0) PG8_BAR; }
    PG8_BAR;
    if constexpr (Epi::AFTER_DRAIN) { E.fused(acc, cur, wr, wc, fr, fq, lds, wid, lane); S.done(cur); }
#undef PG8_SA
#undef PG8_SB
#undef PG8_STAGE
#undef PG8_LDA
#undef PG8_LDB
#undef PG8_MMA
#undef PG8_WAIT_V
#undef PG8_WAIT_L
#undef PG8_BAR
#undef PG8_SCHED
}
}
namespace pg8 {
constexpr int NEXP_ = 8;
template <class F> __device__ __forceinline__ void walk8(const f32x4 (&acc)[2][2][4][2], const Unit& u, int wr, int wc, int fr, int fq, const F& f) {
    const int row0 = u.pm * BM + wr * 64 + fr, col0 = u.pn * BM + wc * 32 + 8 * fq;
#pragma unroll
    for (int ai = 0; ai < 2; ++ai)
#pragma unroll
        for (int m = 0; m < 4; ++m)
#pragma unroll
            for (int bj = 0; bj < 2; ++bj) {
                const f32x4 a = acc[ai][bj][m][0], b = acc[ai][bj][m][1];
                float v[8] = {a[0], a[1], a[2], a[3], b[0], b[1], b[2], b[3]};
                f.emit(row0 + ai * HALF + m * 16, col0 + bj * HALF, v);
                asm volatile("" ::: "memory");
            }
}
__device__ __forceinline__ u32x4 pack8(const float (&v)[8], float s) {
    u32x4 w; w.x = cvt_pk_bf16(v[0] * s, v[1] * s); w.y = cvt_pk_bf16(v[2] * s, v[3] * s); w.z = cvt_pk_bf16(v[4] * s, v[5] * s); w.w = cvt_pk_bf16(v[6] * s, v[7] * s); return w;
}
struct EpiRawF32 {
    static constexpr bool PERM = true, AFTER_DRAIN = false;
    float* O; int ldc;
    __device__ __forceinline__ void emit(int row, int col, const float (&v)[8]) const {
        float* p = O + (size_t)row * ldc + col; *(f32x4*)p = (f32x4){v[0], v[1], v[2], v[3]}; *(f32x4*)(p + 4) = (f32x4){v[4], v[5], v[6], v[7]};
    }
    __device__ __forceinline__ void operator()(const f32x4 (&acc)[2][2][4][2], const Unit& u, int wr, int wc, int fr, int fq) const { walk8(acc, u, wr, wc, fr, fq, *this); }
};
struct EpiPlainBf16 {
    static constexpr bool PERM = true, AFTER_DRAIN = false;
    bf16_t* O; int ldc;
    __device__ __forceinline__ void emit(int row, int col, const float (&v)[8]) const { *(u32x4*)(O + (size_t)row * ldc + col) = pack8(v, 1.f); }
    __device__ __forceinline__ void operator()(const f32x4 (&acc)[2][2][4][2], const Unit& u, int wr, int wc, int fr, int fq) const { walk8(acc, u, wr, wc, fr, fq, *this); }
};
struct EpiMlaQ {
    static constexpr bool PERM = true, AFTER_DRAIN = false;
    bf16_t* Qm; const float* ropeB;
    __device__ __forceinline__ void emit(int row, int col, const float (&v)[8]) const {
        const int head = col / 96, c = col - head * 96;
        bf16_t* q = Qm + (size_t)row * 768 + head * 96;
        const bool isr = c >= 64;
        const int g = (c - 64) >> 3, axis = g >> 1, base = axis * 16 + (g & 1) * 4;
        f32x4 cs0 = {1.f, 0.f, 1.f, 0.f}, cs1 = {1.f, 0.f, 1.f, 0.f};
        if (isr && row < MLAT) { const int t = row & (SEQ - 1), pos = axis ? (t & 63) : (t >> 6); const float* cs = ropeB + (pos * 8 + (g & 1) * 4) * 2; cs0 = *(const f32x4*)cs; cs1 = *(const f32x4*)(cs + 4); }
        const float o10 = v[0] * cs0[0] - v[4] * cs0[1], o20 = v[4] * cs0[0] + v[0] * cs0[1], o11 = v[1] * cs0[2] - v[5] * cs0[3], o21 = v[5] * cs0[2] + v[1] * cs0[3];
        const float o12 = v[2] * cs1[0] - v[6] * cs1[1], o22 = v[6] * cs1[0] + v[2] * cs1[1], o13 = v[3] * cs1[2] - v[7] * cs1[3], o23 = v[7] * cs1[2] + v[3] * cs1[3];
        typedef unsigned u32x2 __attribute__((ext_vector_type(2)));
        u32x2 w1, w2; w1.x = cvt_pk_bf16(o10 * C2_96, o11 * C2_96); w1.y = cvt_pk_bf16(o12 * C2_96, o13 * C2_96); w2.x = cvt_pk_bf16(o20 * C2_96, o21 * C2_96); w2.y = cvt_pk_bf16(o22 * C2_96, o23 * C2_96);
        bf16_t* p1 = isr ? q + 64 + base : q + c; bf16_t* p2 = isr ? q + 64 + base + 8 : q + c + 4;
        *(u32x2*)p1 = w1; *(u32x2*)p2 = w2;
    }
    __device__ __forceinline__ void operator()(const f32x4 (&acc)[2][2][4][2], const Unit& u, int wr, int wc, int fr, int fq) const { walk8(acc, u, wr, wc, fr, fq, *this); }
};
struct EpiMlaKV {
    static constexpr bool PERM = true, AFTER_DRAIN = false;
    bf16_t* Km; bf16_t* Vm;
    __device__ __forceinline__ void emit(int row, int col, const float (&v)[8]) const {
        const int head = col >> 7, c = col & 127;
        if (c < 64) *(u32x4*)(Km + (size_t)row * 768 + head * 96 + c) = pack8(v, 1.f);
        else        *(u32x4*)(Vm + (size_t)row * 512 + head * 64 + (c - 64)) = pack8(v, 1.f);
    }
    __device__ __forceinline__ void operator()(const f32x4 (&acc)[2][2][4][2], const Unit& u, int wr, int wc, int fr, int fq) const { walk8(acc, u, wr, wc, fr, fq, *this); }
};
struct EpiResid {
    static constexpr bool PERM = true, AFTER_DRAIN = false;
    float* X; const float* gate;
    __device__ __forceinline__ void emit(int row, int col, const float (&v)[8]) const {
        float* p = X + (size_t)row * 1024 + col; const float* g = gate + (size_t)(row < MLAT ? (row >> 13) : 4) * 6144 + col;
        const f32x4 x0 = *(const f32x4*)p, x1 = *(const f32x4*)(p + 4), g0 = *(const f32x4*)g, g1 = *(const f32x4*)(g + 4);
        *(f32x4*)p = x0 * ALPHA + g0 * (f32x4){v[0], v[1], v[2], v[3]}; *(f32x4*)(p + 4) = x1 * ALPHA + g1 * (f32x4){v[4], v[5], v[6], v[7]};
    }
    __device__ __forceinline__ void operator()(const f32x4 (&acc)[2][2][4][2], const Unit& u, int wr, int wc, int fr, int fq) const { walk8(acc, u, wr, wc, fr, fq, *this); }
};
struct EpiSwiglu {
    static constexpr bool PERM = true, AFTER_DRAIN = false;
    bf16_t* Hd; int ldh;
    __device__ __forceinline__ void emit(int row, int col, const float (&v)[8]) const {
        float h[4];
#pragma unroll
        for (int e = 0; e < 4; ++e) h[e] = v[e] / (1.f + __expf(-v[e])) * v[e + 4];
        typedef unsigned u32x2 __attribute__((ext_vector_type(2)));
        u32x2 w; w.x = cvt_pk_bf16(h[0], h[1]); w.y = cvt_pk_bf16(h[2], h[3]);
        *(u32x2*)(Hd + (size_t)row * ldh + (col >> 1)) = w;
    }
    __device__ __forceinline__ void operator()(const f32x4 (&acc)[2][2][4][2], const Unit& u, int wr, int wc, int fr, int fq) const { walk8(acc, u, wr, wc, fr, fq, *this); }
};
struct EpiOddIn {
    static constexpr bool PERM = true, AFTER_DRAIN = false;
    bf16_t *Qn, *Kn, *Vn, *Qd, *Vd, *Sg; float *Zf, *Zb;
    __device__ __forceinline__ void emit(int row, int col, const float (&v)[8]) const {
        const int sec = col >> 9, c = col & 511; const size_t o = (size_t)row * 512 + c;
        if (sec == 0) { *(u32x4*)(Qn + o) = pack8(v, C2_64); }
        else if (sec == 1) { *(u32x4*)(Kn + o) = pack8(v, 1.f); }
        else if (sec == 2) { *(u32x4*)(Vn + o) = pack8(v, 1.f); }
        else if (sec == 4) { *(u32x4*)(Vd + o) = pack8(v, 1.f); }
        else if (sec == 5 || sec == 6) { float* p = (sec == 5 ? Zf : Zb) + o; *(f32x4*)p = (f32x4){v[0], v[1], v[2], v[3]}; *(f32x4*)(p + 4) = (f32x4){v[4], v[5], v[6], v[7]}; }
        else { float s[8];
#pragma unroll
            for (int e = 0; e < 8; ++e) s[e] = v[e] / (1.f + __expf(-v[e]));
            *(u32x4*)((sec == 3 ? Qd : Sg) + o) = pack8(s, 1.f); }
    }
    __device__ __forceinline__ void operator()(const f32x4 (&acc)[2][2][4][2], const Unit& u, int wr, int wc, int fr, int fq) const { walk8(acc, u, wr, wc, fr, fq, *this); }
};
struct GroupedOrder {
    int nM, nN, nwg, G, c; int toff[NEXP_ + 1]; long estride;
    __device__ __forceinline__ bool next(int i, Unit& u) const {
        const long L = (long)i * G + c; if (L >= nwg) return false;
        int wgid = (int)L; { const int q = nwg / NXCD, r = nwg % NXCD, xcd = wgid % NXCD, off = wgid / NXCD; wgid = (xcd < r ? xcd * (q + 1) : r * (q + 1) + (xcd - r) * q) + off; }
        const int nig = WGM * nN, gid = wgid / nig, fm = gid * WGM, gsz = (nM - fm) < WGM ? (nM - fm) : WGM;
        u.pm = fm + ((wgid % nig) % gsz); u.pn = (wgid % nig) / gsz;
        int e = 0;
#pragma unroll
        for (int k = 1; k < NEXP_; ++k) e += (u.pm >= toff[k]) ? 1 : 0;
        u.boff = (long)e * estride; return true;
    }
    __device__ __forceinline__ void a_ready(const Unit&) const {}
    __device__ __forceinline__ void done(const Unit&) const {}
};
}
#define XB_TMO      128
#define XB_XCNT(j)  (256  + 64 * (j))
#define XB_XSUB(j)  (1280 + 64 * (j))
#define XB_XGEN(j)  (2304 + 64 * (j))
#define XB_TOP      3328
#define XB_TOPGEN   3392
#define XCD_BAR_WORDS 3456
#define XB_SPIN_CAP (1u << 18)

__device__ __forceinline__ unsigned xb_ld(unsigned* p)              { return __hip_atomic_load(p, __ATOMIC_RELAXED, __HIP_MEMORY_SCOPE_AGENT); }
__device__ __forceinline__ unsigned xb_add(unsigned* p, unsigned v) { return __hip_atomic_fetch_add(p, v, __ATOMIC_RELAXED, __HIP_MEMORY_SCOPE_AGENT); }
__device__ __forceinline__ unsigned xb_xcc_id() { return (unsigned)__builtin_amdgcn_s_getreg((3 << 11) | 20) & 0xFu; }
#define XB_SPIN(cond, bar) do { unsigned _sp = 0; while (cond) { __builtin_amdgcn_s_sleep(1); \
    if ((++_sp & 255u) == 0u) { if (xb_ld(&(bar)[XB_TMO])) break; if (_sp > XB_SPIN_CAP) { atomicAdd(&(bar)[XB_TMO], 1u); break; } } } } while (0)

struct XcdBarrier {
    unsigned* bar; unsigned x;
    volatile LAS unsigned* st;
};

__device__ __forceinline__ XcdBarrier xcd_barrier_post(unsigned* bar, volatile LAS unsigned* st) {
    XcdBarrier b; b.bar = bar; b.x = xb_xcc_id(); b.st = st;
    if (threadIdx.x == 0) (void)xb_add(&bar[XB_XCNT(b.x)], 1u);
    return b;
}
__device__ __forceinline__ void xcd_barrier_complete(unsigned* bar, unsigned x, unsigned& nloc, unsigned& nx) {
    const unsigned G = gridDim.x * gridDim.y * gridDim.z;
    unsigned sum, cnt, mine, sp = 0u;
    for (;;) {
        sum = 0u; cnt = 0u; mine = 0u;
#pragma unroll
        for (unsigned j = 0; j < 16; ++j) { const unsigned c = xb_ld(&bar[XB_XCNT(j)]); sum += c; cnt += (c > 0u) ? 1u : 0u; mine = (j == x) ? c : mine; }
        if (sum == G) break;
        __builtin_amdgcn_s_sleep(1);
        if ((++sp & 255u) == 0u) { if (xb_ld(&bar[XB_TMO])) break; if (sp > XB_SPIN_CAP) { atomicAdd(&bar[XB_TMO], 1u); break; } }
    }
    nloc = mine > 0u ? mine : 1u; nx = cnt > 0u ? cnt : 1u;
}

__device__ __forceinline__ void xcd_barrier(const XcdBarrier& b) {
    asm volatile("s_waitcnt vmcnt(0)" ::: "memory");
    __syncthreads();
    if (threadIdx.x == 0) {
        unsigned* bar = b.bar;
        __builtin_amdgcn_s_waitcnt(0);
        unsigned nloc = b.st[0], nx = b.st[1];
        if (nloc == 0u) { xcd_barrier_complete(bar, b.x, nloc, nx); b.st[0] = nloc; b.st[1] = nx; }
        const unsigned old = xb_add(&bar[XB_XSUB(b.x)], 1u);
        const unsigned gen = old / nloc;
        if (old + 1u == (gen + 1u) * nloc) {
            __builtin_amdgcn_fence(__ATOMIC_RELEASE, "agent");
            asm volatile("s_waitcnt vmcnt(0)" ::: "memory");
            const unsigned og = xb_add(&bar[XB_TOP], 1u);
            const unsigned tg = og / nx;
            if (og + 1u == (tg + 1u) * nx) xb_add(&bar[XB_TOPGEN], 1u);
            else XB_SPIN(xb_ld(&bar[XB_TOPGEN]) == tg, bar);
            __builtin_amdgcn_fence(__ATOMIC_ACQUIRE, "agent");
            xb_add(&bar[XB_XGEN(b.x)], 1u);
            asm volatile("s_waitcnt vmcnt(0)" ::: "memory");
        } else {
            XB_SPIN(xb_ld(&bar[XB_XGEN(b.x)]) == gen, bar);
            __builtin_amdgcn_fence(__ATOMIC_ACQUIRE, "agent");
            asm volatile("s_waitcnt vmcnt(0)" ::: "memory");
        }
    }
    __syncthreads();
}
struct Frame {
    LAS unsigned char* lds;
    gu32* ctl;
    unsigned char* ws;
    int tid, lane, wave, vcu, G;
};
struct Args { const float* in[30]; float* out; unsigned char* ws; int ph_lo, ph_hi; };
struct InTab { LAS unsigned long long* t;
    __device__ __forceinline__ const float* operator[](int i) const { const unsigned long long v = t[i]; const unsigned lo = __builtin_amdgcn_readfirstlane((unsigned)v), hi = __builtin_amdgcn_readfirstlane((unsigned)(v >> 32)); return (const float*)(((unsigned long long)hi << 32) | lo); } };
struct PArgs { InTab in; float* out; };
#define LDS_WAIT() asm volatile("s_waitcnt lgkmcnt(0)" ::: "memory")
#define VM_WAIT() asm volatile("s_waitcnt vmcnt(0)" ::: "memory")
enum { I_X = 0, I_C, I_CTX, I_CCTX, I_ADAW, I_ADAB, I_LN1G, I_LN1B, I_LN2G, I_LN2B, I_EVWIN, I_QNG, I_KNG, I_CQG, I_CKVG, I_WUQ, I_WUKV, I_EVWOUT,
       I_FFG, I_FFU, I_FFD, I_ODWIN, I_RPB, I_LBL, I_ONG, I_ODWOUT, I_ROUTER, I_MG, I_MU, I_MD };

__device__ __forceinline__ void cvt_item(const float* src0, const float* src1, int K, int N, int Np, bf16* dst, int mode, int item, LAS float* scr, int lane) {
    const int nblk = Np >> 5, kb = item / nblk, nb = item - kb * nblk, k0 = 64 * kb, n0 = 32 * nb;
    const int np = n0 + (lane & 31);
    const float* src = src0; int col = np; bool ok = np < N;
    if (mode == 1) { const int head = np / 96, c = np - head * 96; if (c >= 64) { const int r = c - 64, g = r >> 3, e = r & 7; const int base = (g >> 1) * 16 + (g & 1) * 4; col = head * 96 + 64 + base + (e < 4 ? e : 8 + (e - 4)); } }
    else if (mode == 2) { src = (np & 4) ? src1 : src0; col = ((np >> 3) << 2) + (np & 3); ok = true; }
#pragma unroll 8
    for (int i = 0; i < 32; ++i) { const int kk = 2 * i + (lane >> 5); scr[kk * 33 + (lane & 31)] = ok ? src[(size_t)(k0 + kk) * N + col] : 0.f; }
    LDS_WAIT(); asm volatile("" ::: "memory");
    const int c8 = lane & 7;
#pragma unroll
    for (int j = 0; j < 4; ++j) { const int n = (lane >> 3) + 8 * j; const LAS float* s = scr + (8 * c8) * 33 + n;
        v4u o; o.x = pkbf(s[0 * 33], s[1 * 33]); o.y = pkbf(s[2 * 33], s[3 * 33]); o.z = pkbf(s[4 * 33], s[5 * 33]); o.w = pkbf(s[6 * 33], s[7 * 33]);
        *(GAS v4u*)(dst + (size_t)(n0 + n) * K + k0 + 8 * c8) = o; }
    LDS_WAIT(); asm volatile("" ::: "memory");
}
__device__ __forceinline__ void sincos_red(float ang, float& s, float& c) {
    const float n = __builtin_rintf(ang * 0.636619772367581343f);
    float y = __builtin_fmaf(-n, 1.5703125f, ang); y = __builtin_fmaf(-n, 4.837512969970703125e-4f, y); y = __builtin_fmaf(-n, 7.54978995489188e-8f, y);
    const float z = y * y;
    const float sy = y + y * z * (-1.6666654611e-1f + z * (8.3321608736e-3f + z * (-1.9515295891e-4f)));
    const float cy = 1.0f - 0.5f * z + z * z * (4.166664568298827e-2f + z * (-1.388731625493765e-3f + z * 2.443315711809948e-5f));
    const int q = ((int)n) & 3;
    s = (q == 0) ? sy : (q == 1) ? cy : (q == 2) ? -sy : -cy;
    c = (q == 0) ? cy : (q == 1) ? -sy : (q == 2) ? -cy : sy;
}
__device__ __forceinline__ float inv_freq_pow(double r, int f) { double v = 1.0; for (int i = 0; i < f; ++i) v *= r; return (float)v; }

__device__ __forceinline__ void phase_cv(Frame& F, const PArgs& A, int j) {
    const int gw = F.vcu * NWAVES + F.wave, NGW = F.G * NWAVES;
    float* mods = (float*)(F.ws + WS_SMALL + SM_MODS);
    if (j == 0) {
        LAS float* Ssm = (LAS float*)F.lds;
        LAS float* Psm = (LAS float*)(F.lds + 20480);
        if ((int)blockIdx.x < 192) {
            for (int i = F.tid; i < 5 * 1024; i += NTHR) { const int r = i >> 10, k = i & 1023; const float cv = (r < 4) ? A.in[I_C][r * 1024 + k] : A.in[I_CCTX][k]; Ssm[i] = cv / (1.f + __expf(-cv)); }
            __syncthreads();
            for (int u = blockIdx.x; u < 192; u += F.G) {
                const int l = u / 48, n = (u - l * 48) * 128 + 2 * F.lane;
                float a0[5] = {0.f, 0.f, 0.f, 0.f, 0.f}, a1[5] = {0.f, 0.f, 0.f, 0.f, 0.f};
                const float* wp = A.in[I_ADAW] + ((size_t)l * 1024 + F.wave * 128) * 6144 + n;
#pragma unroll 4
                for (int k = 0; k < 128; ++k) { const float2 w = *(const float2*)(wp + (size_t)k * 6144); const int kk = F.wave * 128 + k;
#pragma unroll
                    for (int r = 0; r < 5; ++r) { const float sv = Ssm[r * 1024 + kk]; a0[r] += sv * w.x; a1[r] += sv * w.y; } }
#pragma unroll
                for (int r = 0; r < 5; ++r) { Psm[(F.wave * 5 + r) * 128 + 2 * F.lane] = a0[r]; Psm[(F.wave * 5 + r) * 128 + 2 * F.lane + 1] = a1[r]; }
                __syncthreads();
                for (int i = F.tid; i < 640; i += NTHR) { const int r = i >> 7, c = i & 127; float s = 0.f;
#pragma unroll
                    for (int w = 0; w < 8; ++w) s += Psm[(w * 5 + r) * 128 + c];
                    const int nn = (u - l * 48) * 128 + c; mods[((size_t)l * 5 + r) * 6144 + nn] = s + A.in[I_ADAB][l * 6144 + nn]; }
                __syncthreads();
            }
        } else if ((int)blockIdx.x == 192) {
            float* ra = (float*)(F.ws + WS_SMALL + SM_ROPEA); float* rb = (float*)(F.ws + WS_SMALL + SM_ROPEB); float* lb = (float*)(F.ws + WS_SMALL + SM_LB);
            for (int i = F.tid; i < 128 * 16; i += NTHR) { const int pos = i >> 4, f = i & 15; const float inv = inv_freq_pow(0.56234132519034908, f); float s, c; sincos_red((float)pos * inv, s, c); ra[2 * i] = c; ra[2 * i + 1] = s; }
            for (int i = F.tid; i < 128 * 8; i += NTHR) { const int pos = i >> 3, f = i & 7; const float inv = inv_freq_pow(0.31622776601683794, f); float s, c; sincos_red((float)pos * inv, s, c); rb[2 * i] = c; rb[2 * i + 1] = s; }
            for (int i = F.tid; i < 2 * 512; i += NTHR) { const int dir = i >> 9, c = i & 511; const float l0 = A.in[I_LBL][(dir * 2 + 0) * 512 + c], l1 = A.in[I_LBL][(dir * 2 + 1) * 512 + c];
                const float mx = fmaxf(l0, l1), e0 = __expf(l0 - mx), e1 = __expf(l1 - mx), p0 = e0 / (e0 + e1), p1 = e1 / (e0 + e1);
                lb[(0 * 2 + dir) * 512 + c] = p0 - p0; lb[(1 * 2 + dir) * 512 + c] = (p0 + p1) - p0; }
        }
        __syncthreads();
    }
    LAS float* scr = (LAS float*)(F.lds + 49152 + F.wave * 8704);
    bf16* W = (bf16*)(F.ws + WS_W); bf16* WM = (bf16*)(F.ws + WS_WMOE);
    constexpr int N1 = 2 * 768, N2 = 2 * 144, N3 = 2 * 128, N4 = 2 * 512, N5 = 2 * 2816, N6 = 2 * 1408, N7 = 2 * 2048, N8 = 2 * 512, N9 = 8 * 3584, N10 = 8 * 1792;
    const int nfix = (j == 0) ? (N1 + N2 + N3 + N4 + N5 + N6 + N7 + N8) : 0;
    const int total = nfix + N9 + N10;
    for (int it = gw; it < total; it += NGW) {
        int r = it; const float* s0; const float* s1 = nullptr; int K, N, Np, mode = 0, item; bf16* d;
        if (r >= nfix) { r -= nfix;
            if (r < N9) { const int e = r / 3584; item = r - e * 3584; const size_t so = ((size_t)(j * 8 + e)) * 1024 * 3584; s0 = A.in[I_MG] + so; s1 = A.in[I_MU] + so; K = 1024; N = 3584; Np = 7168; mode = 2; d = WM + WM_GU + (size_t)e * 7168 * 1024; }
            else { r -= N9; const int e = r / 1792; item = r - e * 1792; s0 = A.in[I_MD] + ((size_t)(j * 8 + e)) * 3584 * 1024; K = 3584; N = 1024; Np = 1024; d = WM + WM_D + (size_t)e * 1024 * 3584; }
        } else if (r < N1) { const int b = r / 768; item = r - b * 768; s0 = A.in[I_EVWIN] + (size_t)b * 1024 * EV_IN; K = 1024; N = EV_IN; Np = EV_INP; d = W + W_EVIN + (size_t)b * EV_INP * 1024; }
        else if ((r -= N1) < N2) { const int b = r / 144; item = r - b * 144; s0 = A.in[I_WUQ] + (size_t)b * 384 * 768; K = 384; N = 768; Np = 768; mode = 1; d = W + W_UQ + (size_t)b * 768 * 384; }
        else if ((r -= N2) < N3) { const int b = r / 128; item = r - b * 128; s0 = A.in[I_WUKV] + (size_t)b * 256 * 1024; K = 256; N = 1024; Np = 1024; d = W + W_UKV + (size_t)b * 1024 * 256; }
        else if ((r -= N3) < N4) { const int b = r / 512; item = r - b * 512; s0 = A.in[I_EVWOUT] + (size_t)b * 1024 * 1024; K = 1024; N = 1024; Np = 1024; d = W + W_EVOUT + (size_t)b * 1024 * 1024; }
        else if ((r -= N4) < N5) { const int b = r / 2816; item = r - b * 2816; s0 = A.in[I_FFG] + (size_t)b * 1024 * DFF; s1 = A.in[I_FFU] + (size_t)b * 1024 * DFF; K = 1024; N = DFF; Np = 2 * DFF; mode = 2; d = W + W_FFGU + (size_t)b * 2 * DFF * 1024; }
        else if ((r -= N5) < N6) { const int b = r / 1408; item = r - b * 1408; s0 = A.in[I_FFD] + (size_t)b * DFF * 1024; K = DFF; N = 1024; Np = 1024; d = W + W_FFD + (size_t)b * 1024 * DFF; }
        else if ((r -= N6) < N7) { const int b = r / 2048; item = r - b * 2048; s0 = A.in[I_ODWIN] + (size_t)b * 1024 * 4096; K = 1024; N = 4096; Np = 4096; d = W + W_ODIN + (size_t)b * 4096 * 1024; }
        else { r -= N7; const int b = r / 512; item = r - b * 512; s0 = A.in[I_ODWOUT] + (size_t)b * 1024 * 1024; K = 1024; N = 1024; Np = 1024; d = W + W_ODOUT + (size_t)b * 1024 * 1024; }
        cvt_item(s0, s1, K, N, Np, d, mode, item, scr, F.lane);
    }
}

__device__ __forceinline__ void store_bf16_row(bf16* orow, int lane, const f32x4 (&v)[4]) {
    GAS unsigned long long* o8 = (GAS unsigned long long*)orow + lane;
#pragma unroll
    for (int j = 0; j < 4; ++j) o8[64 * j] = (unsigned long long)pkbf(v[j].x, v[j].y) | ((unsigned long long)pkbf(v[j].z, v[j].w) << 32);
}
__device__ __forceinline__ void phase_mod(Frame& F, const PArgs& A) {
    const int gw = F.vcu * NWAVES + F.wave, NGW = F.G * NWAVES;
    const float* mods = (const float*)(F.ws + WS_SMALL + SM_MODS);
    float* X = (float*)(F.ws + WS_X); bf16* H = (bf16*)(F.ws + WS_H);
    for (int m = gw; m < MROWS; m += NGW) {
        const float* src = (m < MLAT) ? A.in[I_X] + (size_t)m * 1024 : A.in[I_CTX] + (size_t)(m - MLAT) * 1024;
        const float* md = mods + (size_t)modrow(m) * 6144;
        f32x4 v[4], h[4];
#pragma unroll
        for (int j = 0; j < 4; ++j) { v[j] = *((const f32x4*)src + F.lane + 64 * j); const f32x4 sh = *((const f32x4*)md + F.lane + 64 * j), sc = *((const f32x4*)(md + 1024) + F.lane + 64 * j);
            h[j] = v[j] * (sc + 1.0f) + sh; *((f32x4*)(X + (size_t)m * 1024) + F.lane + 64 * j) = v[j]; }
        store_bf16_row(H + (size_t)m * 1024, F.lane, h);
    }
}
template <bool MOE, bool ROUTER>
__device__ __forceinline__ void phase_ln(Frame& F, const PArgs& A, const float* lng, const float* lnb, const float* mshift  , const float* g5  ,
                                         const float* router, int jodd, bool last) {
    const int gw = F.vcu * NWAVES + F.wave, NGW = F.G * NWAVES;
    float* X = (float*)(F.ws + WS_X); bf16* H = (bf16*)(F.ws + WS_H);
    int* topk = (int*)(F.ws + WS_TOPK);
    const bf16* Y = (const bf16*)(F.ws + WS_XG);
    LAS unsigned* lcnt = (LAS unsigned*)(F.lds);
    if (ROUTER) { if (F.tid < 8) lcnt[F.tid] = 0u; __syncthreads(); }
    f32x4 gv[4], bv[4];
#pragma unroll
    for (int j = 0; j < 4; ++j) { gv[j] = *((const f32x4*)lng + F.lane + 64 * j); bv[j] = *((const f32x4*)lnb + F.lane + 64 * j); }
    for (int m = gw; m < MROWS; m += NGW) {
        float* xr = X + (size_t)m * 1024; const int mr = modrow(m);
        f32x4 v[4];
#pragma unroll
        for (int j = 0; j < 4; ++j) v[j] = *((const f32x4*)xr + F.lane + 64 * j);
        if (MOE) {
            const int r1 = topk[m * 6 + 4], r2 = topk[m * 6 + 5]; const float w1 = __int_as_float(topk[m * 6 + 2]), w2 = __int_as_float(topk[m * 6 + 3]);
            const float* gg = g5 + (size_t)mr * 6144;
#pragma unroll
            for (int j = 0; j < 4; ++j) { const v2u y1 = *((const v2u*)(Y + (size_t)r1 * 1024) + F.lane + 64 * j), y2 = *((const v2u*)(Y + (size_t)r2 * 1024) + F.lane + 64 * j);
                const f32x4 gq = *((const f32x4*)gg + F.lane + 64 * j);
                f32x4 yy; yy.x = w1 * bf_lo(y1.x) + w2 * bf_lo(y2.x); yy.y = w1 * bf_hi(y1.x) + w2 * bf_hi(y2.x); yy.z = w1 * bf_lo(y1.y) + w2 * bf_lo(y2.y); yy.w = w1 * bf_hi(y1.y) + w2 * bf_hi(y2.y);
                v[j] = v[j] * ALPHA + gq * yy; }
        }
        float s = 0.f;
#pragma unroll
        for (int j = 0; j < 4; ++j) s += (v[j].x + v[j].y) + (v[j].z + v[j].w);
        const float mean = wave_sum(s, F.lane) * (1.f / 1024.f); float s2 = 0.f;
#pragma unroll
        for (int j = 0; j < 4; ++j) { v[j] = v[j] - mean; s2 += (v[j].x * v[j].x + v[j].y * v[j].y) + (v[j].z * v[j].z + v[j].w * v[j].w); }
        const float rstd = 1.f / sqrtf(wave_sum(s2, F.lane) * (1.f / 1024.f) + 1e-6f);
#pragma unroll
        for (int j = 0; j < 4; ++j) { v[j] = v[j] * rstd * gv[j] + bv[j]; *((f32x4*)xr + F.lane + 64 * j) = v[j]; }
        if (last) { if (m < MLAT) {
#pragma unroll
                for (int j = 0; j < 4; ++j) *((f32x4*)(A.out + (size_t)m * 1024) + F.lane + 64 * j) = v[j]; }
            continue; }
        const float* md = mshift + (size_t)mr * 6144;
#pragma unroll
        for (int j = 0; j < 4; ++j) { const f32x4 sh = *((const f32x4*)md + F.lane + 64 * j), sc = *((const f32x4*)(md + 1024) + F.lane + 64 * j); v[j] = v[j] * (sc + 1.0f) + sh; }
        store_bf16_row(H + (size_t)m * 1024, F.lane, v);
        if (ROUTER) {
            float lg[8] = {0.f, 0.f, 0.f, 0.f, 0.f, 0.f, 0.f, 0.f};
#pragma unroll
            for (int j = 0; j < 4; ++j) { const float* rp = router + (size_t)(4 * F.lane + 256 * j) * 8;
#pragma unroll
                for (int i = 0; i < 4; ++i) { const f32x4 ra = *(const f32x4*)(rp + 8 * i), rb = *(const f32x4*)(rp + 8 * i + 4); const float hv = v[j][i];
                    lg[0] += hv * ra.x; lg[1] += hv * ra.y; lg[2] += hv * ra.z; lg[3] += hv * ra.w; lg[4] += hv * rb.x; lg[5] += hv * rb.y; lg[6] += hv * rb.z; lg[7] += hv * rb.w; } }
#pragma unroll
            for (int e = 0; e < 8; ++e) lg[e] = wave_sum(lg[e], F.lane);
            int e1 = 0; float v1 = lg[0];
#pragma unroll
            for (int e = 1; e < 8; ++e) if (lg[e] > v1) { v1 = lg[e]; e1 = e; }
            int e2 = -1; float v2 = -INFINITY;
#pragma unroll
            for (int e = 0; e < 8; ++e) if (e != e1 && lg[e] > v2) { v2 = lg[e]; e2 = e; }
            const float w1 = 1.f / (1.f + __expf(v2 - v1)), w2 = 1.f - w1;
            if (F.lane == 0) { topk[m * 6 + 0] = e1; topk[m * 6 + 1] = e2; topk[m * 6 + 2] = __float_as_int(w1); topk[m * 6 + 3] = __float_as_int(w2);
                atomicAdd((unsigned*)&lcnt[e1], 1u); atomicAdd((unsigned*)&lcnt[e2], 1u); }
        }
    }
    if (ROUTER) { LDS_WAIT(); __syncthreads(); if (F.tid < 8) __hip_atomic_fetch_add((unsigned*)(F.ctl + CW_CNT + 64 * jodd) + F.tid, lcnt[F.tid], __ATOMIC_RELAXED, __HIP_MEMORY_SCOPE_AGENT); }
}
typedef short v4i16_t __attribute__((ext_vector_type(4)));
__device__ __forceinline__ int crow(int r, int hi) { return (r & 3) + 8 * (r >> 2) + 4 * hi; }
__device__ __forceinline__ float swap_max(float m) { auto rr = __builtin_amdgcn_permlane32_swap(__float_as_uint(m), __float_as_uint(m), false, false); return fmaxf(__uint_as_float(rr[0]), __uint_as_float(rr[1])); }
__device__ __forceinline__ float swap_sum(float m) { auto rr = __builtin_amdgcn_permlane32_swap(__float_as_uint(m), __float_as_uint(m), false, false); return __uint_as_float(rr[0]) + __uint_as_float(rr[1]); }

template <int DK, int MODE>
__device__ __forceinline__ void attn_unit(LAS unsigned char* lds, int tid, const bf16* Q, int qp, const bf16* K1, const bf16* V1, int nt1, const bf16* K2, const bf16* V2, int nt2,
                                          int kp, int vp, bf16* O, int op, int rq0, int kr0, const float* rpbh) {
    constexpr int KROW = DK * 2 + 16, KSZ = 64 * KROW, CPK = DK / 8  , NPK = 64 * CPK;
    constexpr int VB = 2 * KSZ, SCR = VB + 16384, BIAS = SCR + 2048;
    const int lane = tid & 63, r32 = lane & 31, hi = lane >> 5; const int wid = __builtin_amdgcn_readfirstlane(tid >> 6);
    const int NT = nt1 + nt2;
    LAS float* wsf = (LAS float*)(lds + SCR) + wid * 64;
    const int kkey0 = tid / CPK, kch0 = tid - kkey0 * CPK;
    const int kkey1 = (tid + 512) / CPK, kch1 = (tid + 512) - kkey1 * CPK;
    const bool two = (NPK > 512) && (tid + 512 < NPK);
    const int vkey = tid >> 3, vch = tid & 7;
    const int vdst = ((vkey >> 3) * 2 + (vch >> 2)) * 512 + (vkey & 7) * 64 + (vch & 3) * 16;
    v4u kreg0, kreg1 = {0u, 0u, 0u, 0u}, vreg;
#define ATT_LOAD(t) do { const int t_ = (t); const bf16* kb_ = (t_ < nt1) ? K1 + (size_t)t_ * 64 * kp : K2 + (size_t)(t_ - nt1) * 64 * kp; \
        const bf16* vb_ = (t_ < nt1) ? V1 + (size_t)t_ * 64 * vp : V2 + (size_t)(t_ - nt1) * 64 * vp; \
        kreg0 = *(const GAS v4u*)(kb_ + (size_t)kkey0 * kp + kch0 * 8); if (two) kreg1 = *(const GAS v4u*)(kb_ + (size_t)kkey1 * kp + kch1 * 8); \
        vreg = *(const GAS v4u*)(vb_ + (size_t)vkey * vp + vch * 8); } while (0)
#define ATT_STORE(buf) do { LAS unsigned char* kd_ = lds + (buf) * KSZ; *(LAS v4u*)(kd_ + kkey0 * KROW + kch0 * 16) = kreg0; if (two) *(LAS v4u*)(kd_ + kkey1 * KROW + kch1 * 16) = kreg1; \
        *(LAS v4u*)(lds + VB + (buf) * 8192 + vdst) = vreg; } while (0)
    ATT_LOAD(0);
    if (MODE == 1) { LAS float* bs = (LAS float*)(lds + BIAS); for (int i = tid; i < 15 * 31; i += NTHR) bs[i] = rpbh[i] * LOG2E; }
    bf16x8 qr[DK / 16];
#pragma unroll
    for (int d0 = 0; d0 < DK / 16; ++d0) qr[d0] = *(const GAS bf16x8*)(Q + (size_t)(wid * 32 + r32) * qp + d0 * 16 + hi * 8);
    ATT_STORE(0);
    __syncthreads();
    float m_run = -INFINITY, l_run = 0.f; f32x16 o0 = {}, o1 = {};
    const int rq = rq0 + (wid >> 1), rsq = min(max(rq - 4, 0), 120), qc = (wid & 1) * 32 + r32, cs = min(max(qc - 8, 0), 48);
    const int koff = r32 * KROW + hi * 16;
    const int vlane = (4 * hi + ((lane & 15) >> 2)) * 64 + ((lane >> 4) & 1) * 32 + (lane & 3) * 8;
    for (int t = 0; t < NT; ++t) {
        const int buf = t & 1;
        if (t + 1 < NT) ATT_LOAD(t + 1);
        bool act = true; int kr = 0;
        if (MODE == 1) { kr = kr0 + t; act = (t >= nt1) || (kr >= rsq && kr < rsq + 8); }
        if (act) {
            const LAS unsigned char* kb = lds + buf * KSZ + koff;
            f32x16 s0 = {}, s1 = {};
#pragma unroll
            for (int d0 = 0; d0 < DK / 16; ++d0) {
                const bf16x8 a0 = *(const LAS bf16x8*)(kb + d0 * 32), a1 = *(const LAS bf16x8*)(kb + 32 * KROW + d0 * 32);
                s0 = __builtin_amdgcn_mfma_f32_32x32x16_bf16(a0, qr[d0], s0, 0, 0, 0);
                s1 = __builtin_amdgcn_mfma_f32_32x32x16_bf16(a1, qr[d0], s1, 0, 0, 0);
            }
            if (MODE == 1) { if (t < nt1) {
                const LAS float* bs = (const LAS float*)(lds + BIAS) + (kr - rq + 7) * 31 - qc + 15;
#pragma unroll
                for (int r = 0; r < 16; ++r) { const int kc0 = crow(r, hi), kc1 = kc0 + 32;
                    const bool v0 = (kc0 >= cs) && (kc0 < cs + 16), v1 = (kc1 >= cs) && (kc1 < cs + 16);
                    s0[r] = v0 ? s0[r] + bs[v0 ? kc0 : cs] : -INFINITY; s1[r] = v1 ? s1[r] + bs[v1 ? kc1 : cs] : -INFINITY; } } }
            float mx = fmaxf(s0[0], s1[0]);
#pragma unroll
            for (int r = 1; r < 16; ++r) mx = fmaxf(mx, fmaxf(s0[r], s1[r]));
            mx = swap_max(mx);
            const float mnew = fmaxf(m_run, mx);
            if (__any(mnew > m_run)) {
                const float f = fast_exp2(m_run - mnew); l_run *= f; if (hi == 0) wsf[r32] = f; LDS_WAIT();
#pragma unroll
                for (int r = 0; r < 16; ++r) { const float fr_ = wsf[crow(r, hi)]; o0[r] *= fr_; o1[r] *= fr_; }
                m_run = mnew;
            }
            float ls = 0.f;
#pragma unroll
            for (int r = 0; r < 16; ++r) { s0[r] = fast_exp2(s0[r] - m_run); s1[r] = fast_exp2(s1[r] - m_run); ls += s0[r] + s1[r]; }
            l_run += ls;
            v4u pw[4];
            pw[0] = (v4u){pkbf(s0[0], s0[1]), pkbf(s0[2], s0[3]), pkbf(s0[4], s0[5]), pkbf(s0[6], s0[7])};
            pw[1] = (v4u){pkbf(s0[8], s0[9]), pkbf(s0[10], s0[11]), pkbf(s0[12], s0[13]), pkbf(s0[14], s0[15])};
            pw[2] = (v4u){pkbf(s1[0], s1[1]), pkbf(s1[2], s1[3]), pkbf(s1[4], s1[5]), pkbf(s1[6], s1[7])};
            pw[3] = (v4u){pkbf(s1[8], s1[9]), pkbf(s1[10], s1[11]), pkbf(s1[12], s1[13]), pkbf(s1[14], s1[15])};
            const LAS unsigned char* vb = lds + VB + buf * 8192 + vlane;
#pragma unroll
            for (int ks = 0; ks < 4; ++ks) {
                const bf16x8 pa = __builtin_bit_cast(bf16x8, pw[ks]);
#pragma unroll
                for (int db = 0; db < 2; ++db) {
                    const v4i16_t lo = __builtin_amdgcn_ds_read_tr16_b64_v4i16((LAS v4i16_t*)(vb + ((ks * 2 + 0) * 2 + db) * 512));
                    const v4i16_t hh = __builtin_amdgcn_ds_read_tr16_b64_v4i16((LAS v4i16_t*)(vb + ((ks * 2 + 1) * 2 + db) * 512));
                    const bf16x8 vf = (bf16x8){lo[0], lo[1], lo[2], lo[3], hh[0], hh[1], hh[2], hh[3]};
                    if (db == 0) o0 = __builtin_amdgcn_mfma_f32_32x32x16_bf16(pa, vf, o0, 0, 0, 0);
                    else         o1 = __builtin_amdgcn_mfma_f32_32x32x16_bf16(pa, vf, o1, 0, 0, 0);
                }
            }
        }
        if (t + 1 < NT) ATT_STORE(buf ^ 1);
        __syncthreads();
    }
    const float lt = swap_sum(l_run);
    if (hi == 0) wsf[32 + r32] = 1.f / lt;
    LDS_WAIT();
#pragma unroll
    for (int r = 0; r < 16; ++r) { const int q = crow(r, hi); const float il = wsf[32 + q]; bf16* orow = O + (size_t)(wid * 32 + q) * op;
        orow[r32] = f2bf(o0[r] * il); orow[32 + r32] = f2bf(o1[r] * il); }
    __syncthreads();
#undef ATT_LOAD
#undef ATT_STORE
}
__device__ __forceinline__ int hg_blk_row(int b, int blk) { return blk < 2 ? MLAT + b * CTXL + 128 * blk : b * SEQ + 128 * (blk - 2); }
__device__ __forceinline__ int hg_mc_of_blk(int dir, int blk) { return dir ? (blk < 2 ? 1 - blk : 67 - blk) : blk; }
template <int KT> __device__ __forceinline__ f32x16 mma_nt(f32x16 acc, const LAS bf16* A, int lda, const LAS bf16* Bt, int ldb, int r32, int hi) {
    const LAS bf16* ap = A + r32 * lda + 8 * hi; const LAS bf16* bp = Bt + r32 * ldb + 8 * hi;
#pragma unroll
    for (int k0 = 0; k0 < KT; k0 += 16) acc = __builtin_amdgcn_mfma_f32_32x32x16_bf16(*(const LAS bf16x8*)(ap + k0), *(const LAS bf16x8*)(bp + k0), acc, 0, 0, 0);
    return acc;
}
__device__ __forceinline__ void ldq16(const bf16* p, float (&o)[16]) {
    const v4u a = *(const GAS v4u*)p, b = *(const GAS v4u*)(p + 8);
    o[0] = bf_lo(a.x); o[1] = bf_hi(a.x); o[2] = bf_lo(a.y); o[3] = bf_hi(a.y); o[4] = bf_lo(a.z); o[5] = bf_hi(a.z); o[6] = bf_lo(a.w); o[7] = bf_hi(a.w);
    o[8] = bf_lo(b.x); o[9] = bf_hi(b.x); o[10] = bf_lo(b.y); o[11] = bf_hi(b.y); o[12] = bf_lo(b.z); o[13] = bf_hi(b.z); o[14] = bf_lo(b.w); o[15] = bf_hi(b.w);
}
__device__ __forceinline__ void ldf16(const float* p, float (&o)[16]) {
#pragma unroll
    for (int k = 0; k < 4; ++k) { const f32x4 a = *((const GAS f32x4*)p + k); o[4 * k] = a.x; o[4 * k + 1] = a.y; o[4 * k + 2] = a.z; o[4 * k + 3] = a.w; }
}
__device__ __forceinline__ void st16(LAS bf16* p, const float (&v)[16]) {
    *(LAS v4u*)p = (v4u){pkbf(v[0], v[1]), pkbf(v[2], v[3]), pkbf(v[4], v[5]), pkbf(v[6], v[7])};
    *(LAS v4u*)(p + 8) = (v4u){pkbf(v[8], v[9]), pkbf(v[10], v[11]), pkbf(v[12], v[13]), pkbf(v[14], v[15])};
}

__device__ __forceinline__ void ldq8(const bf16* p, float (&o)[8]) { const v4u a = *(const GAS v4u*)p;
    o[0] = bf_lo(a.x); o[1] = bf_hi(a.x); o[2] = bf_lo(a.y); o[3] = bf_hi(a.y); o[4] = bf_lo(a.z); o[5] = bf_hi(a.z); o[6] = bf_lo(a.w); o[7] = bf_hi(a.w); }
__device__ __forceinline__ void ldf8(const float* p, float (&o)[8]) { const f32x4 a = *(const GAS f32x4*)p, b = *((const GAS f32x4*)p + 1); o[0] = a.x; o[1] = a.y; o[2] = a.z; o[3] = a.w; o[4] = b.x; o[5] = b.y; o[6] = b.z; o[7] = b.w; }
__device__ __forceinline__ void st8(LAS bf16* p, const float (&v)[8]) { *(LAS v4u*)p = (v4u){pkbf(v[0], v[1]), pkbf(v[2], v[3]), pkbf(v[4], v[5]), pkbf(v[6], v[7])}; }

struct HgT { const bf16 *Qd, *Vd, *Sg; const float *Zf, *Zb; const float* lb  ; float* HST; float* HDM; const float* ong; bf16* OO; };

__device__ __forceinline__ void hg_a_unit(Frame& F, const HgT& T, int chain, int mc) {
    const int dir = chain & 1, h = (chain >> 1) & 3, b = chain >> 3, hoff = h * 128;
    const int row0 = hg_blk_row(b, hg_mc_of_blk(dir, mc));
    const float* Z = dir ? T.Zb : T.Zf;
    LAS float* Lf = (LAS float*)F.lds;
    LAS float* PT = (LAS float*)(F.lds + 65536);
    LAS bf16* KET = (LAS bf16*)(F.lds + 67584);
    LAS bf16* VT = (LAS bf16*)(F.lds + 67584 + 34816);
    const int tid = F.tid, lane = F.lane, r32 = lane & 31, hi = lane >> 5, wid = F.wave;
    const int ti = tid >> 2, cg = tid & 3;
#pragma unroll 1
    for (int q8 = 0; q8 < 4; ++q8) { const int e0 = 32 * cg + 8 * q8; float z[8]; ldf8(Z + (size_t)(row0 + ti) * 512 + hoff + e0, z); float lbv[8]; ldf8(T.lb + dir * 512 + hoff + e0, lbv);
#pragma unroll
        for (int k = 0; k < 8; ++k) Lf[ti * 128 + e0 + k] = __logf(lbv[k] + (1.f - lbv[k]) * sigmoidf_(z[k])); }
    __syncthreads();
    { const int e = tid & 127, p = tid >> 7; float run = 0.f;
      if (dir == 0) { for (int i = 32 * p + 31; i >= 32 * p; --i) { const float tmp = Lf[i * 128 + e]; Lf[i * 128 + e] = run; run += tmp; } }
      else          { for (int i = 32 * p; i < 32 * p + 32; ++i) { const float tmp = Lf[i * 128 + e]; Lf[i * 128 + e] = run; run += tmp; } }
      PT[p * 128 + e] = run; }
    __syncthreads();
    { const int p = ti >> 5;
#pragma unroll 1
      for (int q8 = 0; q8 < 4; ++q8) { const int e0 = 32 * cg + 8 * q8; float z[8], v[8], lbv[8]; ldf8(Z + (size_t)(row0 + ti) * 512 + hoff + e0, z); ldq8(T.Vd + (size_t)(row0 + ti) * 512 + hoff + e0, v); ldf8(T.lb + dir * 512 + hoff + e0, lbv);
#pragma unroll
        for (int k = 0; k < 8; ++k) { const int e = e0 + k; const float kk = (1.f - lbv[k]) * sigmoidf_(-z[k]);
            const float p0 = PT[e], p1 = PT[128 + e], p2 = PT[256 + e], p3 = PT[384 + e];
            float w = Lf[ti * 128 + e];
            if (dir == 0) w += (p < 3 ? p3 : 0.f) + (p < 2 ? p2 : 0.f) + (p < 1 ? p1 : 0.f); else w += (p > 0 ? p0 : 0.f) + (p > 1 ? p1 : 0.f) + (p > 2 ? p2 : 0.f);
            KET[e * 136 + ti] = f2bf(kk * __expf(w)); VT[e * 136 + ti] = f2bf(v[k]); } } }
    if (tid < 128) { const float tot = PT[tid] + PT[128 + tid] + PT[256 + tid] + PT[384 + tid]; T.HDM[((size_t)chain * 66 + mc) * 128 + tid] = __expf(tot); }
    __syncthreads();
    { const int ei = wid & 3, fp = wid >> 2; float* dst = T.HST + ((size_t)chain * 66 + mc) * 16384;
#pragma unroll
      for (int k = 0; k < 2; ++k) { const int fi = 2 * fp + k; f32x16 acc = {}; acc = mma_nt<128>(acc, KET + 32 * ei * 136, 136, VT + 32 * fi * 136, 136, r32, hi);
#pragma unroll
          for (int r = 0; r < 16; ++r) dst[(32 * ei + crow(r, hi)) * 128 + 32 * fi + r32] = acc[r]; } }
    __syncthreads();
}
__device__ __forceinline__ void phase_hg_b(Frame& F, const HgT& T) {
    const int g = F.vcu * NTHR + F.tid;
    for (int gi = g; gi < 32 * 4096; gi += F.G * NTHR) {
        const int chain = gi >> 12, idx = gi & 4095, e = idx >> 5, f4 = idx & 31;
        f32x4* base = (f32x4*)(T.HST + (size_t)chain * 66 * 16384 + e * 128) + f4; const float* dmp = T.HDM + (size_t)chain * 66 * 128 + e;
        f32x4 S = {0.f, 0.f, 0.f, 0.f};
#pragma unroll 6
        for (int mc = 0; mc < 66; ++mc) { const f32x4 kv = base[(size_t)mc * 4096]; const float d = dmp[mc * 128]; base[(size_t)mc * 4096] = S; S = S * d + kv; }
    }
}
__device__ __forceinline__ void hg_c_unit(Frame& F, const HgT& T, int b, int h, int blk) {
    const int hoff = h * 128, row0 = hg_blk_row(b, blk);
    const int tid = F.tid, lane = F.lane, r32 = lane & 31, hi = lane >> 5, wid = F.wave;
    LAS float* Lf = (LAS float*)F.lds;
    LAS bf16* P = (LAS bf16*)F.lds;
    LAS float* PT = (LAS float*)(F.lds + 32768);
    LAS float* DE = (LAS float*)(F.lds + 34816);
    LAS float* BR = (LAS float*)(F.lds + 35328);
    LAS bf16* QB = (LAS bf16*)(F.lds + 35840);
    LAS bf16* QS = (LAS bf16*)(F.lds + 53248);
    LAS bf16* KS = (LAS bf16*)(F.lds + 70656);
    LAS bf16* KET = (LAS bf16*)(F.lds + 88064);
    LAS bf16* VT = (LAS bf16*)(F.lds + 106496);
    LAS bf16* ST = (LAS bf16*)(F.lds + 124928);
    LAS float* OUT = (LAS float*)(F.lds + 35840);
    const int ti = wid & 1, fi = wid >> 1;
    const int ei = wid & 3, fp = wid >> 2;
    f32x16 oacc0 = {}, oacc1 = {};
    const int si_ = tid >> 3, e0 = 16 * (tid & 7);
#pragma unroll 1
    for (int dir = 0; dir < 2; ++dir) {
        const int chain = (b * 4 + h) * 2 + dir; const float* Z = dir ? T.Zb : T.Zf;
        const float* Sin = T.HST + ((size_t)chain * 66 + hg_mc_of_blk(dir, blk)) * 16384;
        f32x16 S[2];
#pragma unroll
        for (int k = 0; k < 2; ++k)
#pragma unroll
            for (int r = 0; r < 16; ++r) S[k][r] = Sin[(32 * ei + crow(r, hi)) * 128 + 32 * (2 * fp + k) + r32];
#pragma unroll
        for (int k = 0; k < 2; ++k)
#pragma unroll
            for (int g = 0; g < 4; ++g) *(LAS v2u*)(ST + (32 * (2 * fp + k) + r32) * 136 + 32 * ei + 8 * g + 4 * hi) = (v2u){pkbf(S[k][4 * g], S[k][4 * g + 1]), pkbf(S[k][4 * g + 2], S[k][4 * g + 3])};
#pragma unroll 1
        for (int cc = 0; cc < 2; ++cc) {
            const int ci = dir ? 1 - cc : cc; const int rowc = row0 + 64 * ci;
#pragma unroll 1
            for (int hh = 0; hh < 2; ++hh) { const int e8 = e0 + 8 * hh; float z[8], lbv[8]; ldf8(Z + (size_t)(rowc + si_) * 512 + hoff + e8, z); ldf8(T.lb + dir * 512 + hoff + e8, lbv);
#pragma unroll
              for (int k = 0; k < 8; ++k) Lf[si_ * 128 + e8 + k] = __logf(lbv[k] + (1.f - lbv[k]) * sigmoidf_(z[k])); }
            __syncthreads();
            { const int e = tid & 127, p = tid >> 7; float run = 0.f;
              if (dir == 0) { for (int i = 16 * p; i < 16 * p + 16; ++i) { run += Lf[i * 128 + e]; Lf[i * 128 + e] = run; } }
              else          { for (int i = 16 * p + 15; i >= 16 * p; --i) { run += Lf[i * 128 + e]; Lf[i * 128 + e] = run; } }
              PT[p * 128 + e] = run; }
            __syncthreads();
            if (tid < 128) { const float p0 = PT[tid], p1 = PT[128 + tid], p2 = PT[256 + tid], p3 = PT[384 + tid];
                DE[tid] = __expf(p0 + p1 + p2 + p3);
                BR[tid] = dir ? (Lf[32 * 128 + tid] + p3) : (Lf[31 * 128 + tid] + p0); }
            __syncthreads();
            { const int p = si_ >> 4;
#pragma unroll 1
              for (int hh = 0; hh < 2; ++hh) { const int e8 = e0 + 8 * hh; float z[8], q[8], v[8], lbv[8], t1[8], t2[8], t3[8];
                ldf8(Z + (size_t)(rowc + si_) * 512 + hoff + e8, z); ldq8(T.Qd + (size_t)(rowc + si_) * 512 + hoff + e8, q); ldq8(T.Vd + (size_t)(rowc + si_) * 512 + hoff + e8, v); ldf8(T.lb + dir * 512 + hoff + e8, lbv);
#pragma unroll
                for (int k = 0; k < 8; ++k) { const int e = e8 + k; const float kk = (1.f - lbv[k]) * sigmoidf_(-z[k]);
                    const float p0 = PT[e], p1 = PT[128 + e], p2 = PT[256 + e], p3 = PT[384 + e];
                    float bb = Lf[si_ * 128 + e];
                    if (dir == 0) bb += (p > 0 ? p0 : 0.f) + (p > 1 ? p1 : 0.f) + (p > 2 ? p2 : 0.f); else bb += (p < 3 ? p3 : 0.f) + (p < 2 ? p2 : 0.f) + (p < 1 ? p1 : 0.f);
                    const float bend = (p0 + p1) + (p2 + p3), br = BR[e];
                    t1[k] = q[k] * __expf(bb); t2[k] = q[k] * __expf(bb - br); t3[k] = kk * __expf(br - bb);
                    KET[e * 72 + si_] = f2bf(kk * __expf(bend - bb)); VT[e * 72 + si_] = f2bf(v[k]); }
                st8(QB + si_ * 136 + e8, t1); st8(QS + si_ * 136 + e8, t2); st8(KS + si_ * 136 + e8, t3); } }
            __syncthreads();
            if (wid < 4) { const int tb = wid & 1, sb = wid >> 1; f32x16 sc = {}; sc = mma_nt<128>(sc, QS + 32 * tb * 136, 136, KS + 32 * sb * 136, 136, r32, hi);
#pragma unroll
                for (int r = 0; r < 16; ++r) { const int t = 32 * tb + crow(r, hi), s = 32 * sb + r32; const bool keep = dir ? (s >= t) : (s <= t); P[t * 72 + s] = f2bf(keep ? sc[r] : 0.f); } }
            __syncthreads();
            { f32x16 a = ci ? oacc1 : oacc0; a = mma_nt<64>(a, P + 32 * ti * 72, 72, VT + 32 * fi * 72, 72, r32, hi); a = mma_nt<128>(a, QB + 32 * ti * 136, 136, ST + 32 * fi * 136, 136, r32, hi); if (ci) oacc1 = a; else oacc0 = a; }
            __syncthreads();
#pragma unroll
            for (int k = 0; k < 2; ++k) {
#pragma unroll
                for (int r = 0; r < 16; ++r) S[k][r] *= DE[32 * ei + crow(r, hi)];
                S[k] = mma_nt<64>(S[k], KET + 32 * ei * 72, 72, VT + 32 * (2 * fp + k) * 72, 72, r32, hi);
#pragma unroll
                for (int g = 0; g < 4; ++g) *(LAS v2u*)(ST + (32 * (2 * fp + k) + r32) * 136 + 32 * ei + 8 * g + 4 * hi) = (v2u){pkbf(S[k][4 * g], S[k][4 * g + 1]), pkbf(S[k][4 * g + 2], S[k][4 * g + 3])};
            }
            __syncthreads();
        }
    }
#pragma unroll
    for (int r = 0; r < 16; ++r) { OUT[(32 * ti + crow(r, hi)) * 132 + 32 * fi + r32] = oacc0[r]; OUT[(64 + 32 * ti + crow(r, hi)) * 132 + 32 * fi + r32] = oacc1[r]; }
    __syncthreads();
    for (int k = 0; k < 16; ++k) { const int t = 16 * wid + k; const float a0 = OUT[t * 132 + lane], a1 = OUT[t * 132 + 64 + lane];
        const float ms = wave_sum(a0 * a0 + a1 * a1, lane) * (1.f / 128.f); const float rs = 1.f / sqrtf(ms + 1e-6f);
        const size_t ro = (size_t)(row0 + t) * 512 + hoff; bf16* orow = T.OO + (size_t)(row0 + t) * 1024 + 512 + hoff;
        orow[lane] = f2bf(a0 * rs * T.ong[lane] * bf2f(T.Sg[ro + lane])); orow[64 + lane] = f2bf(a1 * rs * T.ong[64 + lane] * bf2f(T.Sg[ro + 64 + lane])); }
    __syncthreads();
}
__device__ __forceinline__ void ld8(const float* p, float (&v)[8]) { const f32x4 a = *(const GAS f32x4*)p, b = *(const GAS f32x4*)(p + 4); v[0] = a.x; v[1] = a.y; v[2] = a.z; v[3] = a.w; v[4] = b.x; v[5] = b.y; v[6] = b.z; v[7] = b.w; }
__device__ __forceinline__ v4u pk8(const float (&v)[8], float s) { return (v4u){pkbf(v[0] * s, v[1] * s), pkbf(v[2] * s, v[3] * s), pkbf(v[4] * s, v[5] * s), pkbf(v[6] * s, v[7] * s)}; }
__device__ __forceinline__ void head_norm_rope(float (&v)[8], const float* g64, int l8  , bool rope, int trow, int tcol, const float* ropeA, int lane) {
    float ss = 0.f;
#pragma unroll
    for (int e = 0; e < 8; ++e) ss += v[e] * v[e];
    ss += shx(ss, 1, lane); ss += shx(ss, 2, lane); ss += shx(ss, 4, lane);
    const float rs = 1.f / sqrtf(ss * (1.f / 64.f) + 1e-6f);
#pragma unroll
    for (int e = 0; e < 8; ++e) v[e] = v[e] * rs * g64[8 * l8 + e];
    float pr[8];
#pragma unroll
    for (int e = 0; e < 8; ++e) pr[e] = shx(v[e], 2, lane);
    if (rope) { const int axis = l8 >> 2, pos = axis ? tcol : trow; const float* cs = ropeA + (pos * 16 + 8 * (l8 & 1)) * 2; const bool second = (l8 & 2) != 0;
#pragma unroll
        for (int e = 0; e < 8; ++e) { const float c_ = cs[2 * e], s_ = cs[2 * e + 1]; v[e] = second ? (v[e] * c_ + pr[e] * s_) : (v[e] * c_ - pr[e] * s_); } }
}
__device__ __forceinline__ void phase_even_post(Frame& F, const PArgs& A, int j) {
    const int gw = F.vcu * NWAVES + F.wave, NGW = F.G * NWAVES, lane = F.lane;
    const float* RAW = (const float*)(F.ws + WS_RAW);
    bf16 *QG = (bf16*)(F.ws + WS_QG), *KG = (bf16*)(F.ws + WS_KG), *VG = (bf16*)(F.ws + WS_VG), *CQN = (bf16*)(F.ws + WS_CQN), *CKVN = (bf16*)(F.ws + WS_CKVN), *KM = (bf16*)(F.ws + WS_KM);
    const float* ropeA = (const float*)(F.ws + WS_SMALL + SM_ROPEA); const float* ropeB = (const float*)(F.ws + WS_SMALL + SM_ROPEB);
    const float *qng = A.in[I_QNG] + j * 64, *kng = A.in[I_KNG] + j * 64, *cqg = A.in[I_CQG] + j * 384, *ckvg = A.in[I_CKVG] + j * 256;
    for (int m = gw; m < MROWS; m += NGW) {
        const float* r = RAW + (size_t)m * EV_INP; const bool lat = m < MLAT; const int t = m & (SEQ - 1), trow = t >> 6, tcol = t & 63;
        float v[8];
        ld8(r + 8 * lane, v); head_norm_rope(v, qng, lane & 7, lat, trow, tcol, ropeA, lane); *(GAS v4u*)(QG + (size_t)m * 512 + 8 * lane) = pk8(v, C2_64);
        { const int l = lane & 31; ld8(r + 512 + 8 * l, v); float w[8];
#pragma unroll
          for (int e = 0; e < 8; ++e) w[e] = v[e];
          head_norm_rope(w, kng, l & 7, lat, trow, tcol, ropeA, lane);
          if (lane < 16) *(GAS v4u*)(KG + (size_t)m * 128 + 8 * lane) = pk8(w, 1.f);
          else if (lane < 32) *(GAS v4u*)(VG + (size_t)m * 128 + 8 * (lane - 16)) = pk8(v, 1.f); }
        { const bool on = lane < 48; if (on) ld8(r + 768 + 8 * lane, v); float ss = 0.f;
          if (on) {
#pragma unroll
              for (int e = 0; e < 8; ++e) ss += v[e] * v[e]; }
          const float rs = 1.f / sqrtf(wave_sum(ss, lane) * (1.f / 384.f) + 1e-6f);
          if (on) {
#pragma unroll
              for (int e = 0; e < 8; ++e) v[e] = v[e] * rs * cqg[8 * lane + e];
              *(GAS v4u*)(CQN + (size_t)m * 384 + 8 * lane) = pk8(v, 1.f); } }
        { const bool on = lane < 32; if (on) ld8(r + 1152 + 8 * lane, v); float ss = 0.f;
          if (on) {
#pragma unroll
              for (int e = 0; e < 8; ++e) ss += v[e] * v[e]; }
          const float rs = 1.f / sqrtf(wave_sum(ss, lane) * (1.f / 256.f) + 1e-6f);
          if (on) {
#pragma unroll
              for (int e = 0; e < 8; ++e) v[e] = v[e] * rs * ckvg[8 * lane + e];
              *(GAS v4u*)(CKVN + (size_t)m * 256 + 8 * lane) = pk8(v, 1.f); } }
        { const int l4 = lane & 3; ld8(r + 1408 + 8 * l4, v); float pr[8];
#pragma unroll
          for (int e = 0; e < 8; ++e) pr[e] = shx(v[e], 1, lane);
          if (lat) { const int axis = l4 >> 1, pos = axis ? tcol : trow; const float* cs = ropeB + pos * 16; const bool second = (l4 & 1) != 0;
#pragma unroll
              for (int e = 0; e < 8; ++e) { const float c_ = cs[2 * e], s_ = cs[2 * e + 1]; v[e] = second ? (v[e] * c_ + pr[e] * s_) : (v[e] * c_ - pr[e] * s_); } }
          if (lane < 32) { const int head = lane >> 2; *(GAS v4u*)(KM + (size_t)m * 768 + head * 96 + 64 + 8 * l4) = pk8(v, 1.f); } }
    }
}
__device__ __forceinline__ void phase_even_attn(Frame& F) {
    const bf16 *QG = (const bf16*)(F.ws + WS_QG), *KG = (const bf16*)(F.ws + WS_KG), *VG = (const bf16*)(F.ws + WS_VG);
    const bf16 *QM = (const bf16*)(F.ws + WS_QM), *KM = (const bf16*)(F.ws + WS_KM), *VM = (const bf16*)(F.ws + WS_VM); bf16* OE = (bf16*)(F.ws + WS_OE);
    for (int u = F.vcu; u < 1024 + 32; u += F.G) {
        if (u < 1024) {
            const int qb = u & 31, hq = (u >> 5) & 3, kvh = (u >> 7) & 1, b = u >> 8, h = kvh * 4 + hq; const size_t r0 = (size_t)b * SEQ + qb * 256, kl = (size_t)b * SEQ, kc = (size_t)MLAT + b * CTXL;
            attn_unit<64, 0>(F.lds, F.tid, QG + r0 * 512 + h * 64, 512, KG + kl * 128 + kvh * 64, VG + kl * 128 + kvh * 64, 128, KG + kc * 128 + kvh * 64, VG + kc * 128 + kvh * 64, 4, 128, 128,
                             OE + r0 * 1024 + h * 64, 1024, 0, 0, nullptr);
        } else { const int id = u - 1024, h = id & 7, b = id >> 3, kvh = h >> 2; const size_t kc = (size_t)MLAT + b * CTXL;
            attn_unit<64, 0>(F.lds, F.tid, QG + kc * 512 + h * 64, 512, nullptr, nullptr, 0, KG + kc * 128 + kvh * 64, VG + kc * 128 + kvh * 64, 4, 128, 128, OE + kc * 1024 + h * 64, 1024, 0, 0, nullptr); }
    }
    for (int u = F.vcu; u < 1024 + 32; u += F.G) {
        if (u < 1024) {
            const int qb = u & 31, h = (u >> 5) & 7, b = u >> 8; const size_t r0 = (size_t)b * SEQ + qb * 256, kl = (size_t)b * SEQ, kc = (size_t)MLAT + b * CTXL;
            attn_unit<96, 0>(F.lds, F.tid, QM + r0 * 768 + h * 96, 768, KM + kl * 768 + h * 96, VM + kl * 512 + h * 64, 128, KM + kc * 768 + h * 96, VM + kc * 512 + h * 64, 4, 768, 512,
                             OE + r0 * 1024 + 512 + h * 64, 1024, 0, 0, nullptr);
        } else { const int id = u - 1024, h = id & 7, b = id >> 3; const size_t kc = (size_t)MLAT + b * CTXL;
            attn_unit<96, 0>(F.lds, F.tid, QM + kc * 768 + h * 96, 768, nullptr, nullptr, 0, KM + kc * 768 + h * 96, VM + kc * 512 + h * 64, 4, 768, 512, OE + kc * 1024 + 512 + h * 64, 1024, 0, 0, nullptr); }
    }
}
__device__ __forceinline__ void phase_odd_mix(Frame& F, const PArgs& A, const HgT& T, int j) {
    const bf16 *QN = (const bf16*)(F.ws + WS_QN), *KN = (const bf16*)(F.ws + WS_KN), *VN = (const bf16*)(F.ws + WS_VN); bf16* OO = (bf16*)(F.ws + WS_OO);
    const float* rpb = A.in[I_RPB] + (size_t)j * 8 * 15 * 31;
#ifndef NO_NA
    for (int u = F.vcu; u < 1024; u += F.G) {
        const int rg = u & 31, h = (u >> 5) & 7, b = u >> 8; const int rlo = min(max(4 * rg - 4, 0), 120), rhi = min(max(4 * rg + 3 - 4, 0), 120) + 8;
        const size_t r0 = (size_t)b * SEQ + (size_t)rg * 256, kl = (size_t)b * SEQ + (size_t)rlo * 64, kc = (size_t)MLAT + b * CTXL;
        attn_unit<64, 1>(F.lds, F.tid, QN + r0 * 512 + h * 64, 512, KN + kl * 512 + h * 64, VN + kl * 512 + h * 64, rhi - rlo, KN + kc * 512 + h * 64, VN + kc * 512 + h * 64, 4, 512, 512,
                         OO + r0 * 1024 + h * 64, 1024, 4 * rg, rlo, rpb + h * 465);
    }
#endif
    for (int u = F.vcu; u < 32; u += F.G) {
        const int h = u & 7, b = u >> 3; const size_t kc = (size_t)MLAT + b * CTXL;
        attn_unit<64, 0>(F.lds, F.tid, QN + kc * 512 + h * 64, 512, nullptr, nullptr, 0, KN + kc * 512 + h * 64, VN + kc * 512 + h * 64, 4, 512, 512, OO + kc * 1024 + h * 64, 1024, 0, 0, nullptr);
    }
#ifndef NO_HA
    for (int u = F.vcu; u < 2112; u += F.G) hg_a_unit(F, T, u / 66, u % 66);
#endif
}
__device__ __forceinline__ void moe_offsets(const gu32* cnt, int (&off)[9]) {
    int a = 0;
#pragma unroll
    for (int e = 0; e < 8; ++e) { off[e] = a; const int c = (int)__hip_atomic_load(cnt + e, __ATOMIC_RELAXED, __HIP_MEMORY_SCOPE_AGENT); a += (c + 255) & ~255; }
    off[8] = a;
}
__device__ __forceinline__ void phase_moe_dispatch(Frame& F, int j) {
    int* topk = (int*)(F.ws + WS_TOPK); const bf16* H = (const bf16*)(F.ws + WS_H); bf16* XG = (bf16*)(F.ws + WS_XG);
    LAS unsigned* lc = (LAS unsigned*)F.lds;
    LAS int* lrow = (LAS int*)(F.lds + 256);
    int off[9]; moe_offsets(F.ctl + CW_CNT + 64 * j, off);
    const int per = MROWS / 256;
    for (int c0 = F.vcu * per; c0 < MROWS; c0 += F.G * per) {
        if (F.tid < 8) lc[F.tid] = 0u;
        __syncthreads();
        int e1 = 0, e2 = 0, li1 = 0, li2 = 0; const bool on = F.tid < per;
        if (on) { e1 = topk[(c0 + F.tid) * 6]; e2 = topk[(c0 + F.tid) * 6 + 1]; li1 = (int)atomicAdd((unsigned*)&lc[e1], 1u); li2 = (int)atomicAdd((unsigned*)&lc[e2], 1u); }
        __syncthreads();
        if (F.tid < 8) lc[8 + F.tid] = __hip_atomic_fetch_add((unsigned*)(F.ctl + CW_CNT2 + 64 * j) + F.tid, lc[F.tid], __ATOMIC_RELAXED, __HIP_MEMORY_SCOPE_AGENT);
        __syncthreads();
        if (on) {
            int o1 = 0, o2 = 0;
#pragma unroll
            for (int e = 0; e < 8; ++e) { o1 = (e == e1) ? off[e] : o1; o2 = (e == e2) ? off[e] : o2; }
            const int r1 = o1 + (int)lc[8 + e1] + li1, r2 = o2 + (int)lc[8 + e2] + li2;
            topk[(c0 + F.tid) * 6 + 4] = r1; topk[(c0 + F.tid) * 6 + 5] = r2; lrow[2 * F.tid] = r1; lrow[2 * F.tid + 1] = r2;
        }
        __syncthreads();
        for (int p = F.wave; p < 2 * per; p += NWAVES) { const int tok = c0 + (p >> 1), dst = lrow[p];
            const GAS v4u* s = (const GAS v4u*)(H + (size_t)tok * 1024) + F.lane; GAS v4u* d = (GAS v4u*)(XG + (size_t)dst * 1024) + F.lane;
            const v4u a = s[0], b2 = s[64]; d[0] = a; d[64] = b2; }
        __syncthreads();
    }
}
constexpr int PH_CV = 0, PH_MOD = 1, PH_E1 = 2, PH_E2 = 3, PH_E3 = 4, PH_E5 = 5, PH_E6 = 6, PH_E7 = 7, PH_E8 = 8, PH_E9 = 9, PH_E10 = 10,
              PH_O1 = 11, PH_O2 = 12, PH_O3 = 13, PH_O4 = 14, PH_O5 = 15, PH_O6 = 16, PH_O7 = 17, PH_O8 = 18, PH_O9 = 19, PH_O10 = 20, PH_PER = 21;
constexpr int NPHASES = 2 * PH_PER;

__global__ void __launch_bounds__(NTHR, 2) mk_fwd(Args args) {
    extern __shared__ __attribute__((aligned(16))) unsigned char lds[];
    Frame F;
    F.lds = (LAS unsigned char*)lds; F.ws = args.ws; F.ctl = (gu32*)(args.ws + WS_CTL);
    F.tid = threadIdx.x; F.lane = F.tid & 63; F.wave = __builtin_amdgcn_readfirstlane(F.tid >> 6);
    F.G = gridDim.x; { const int bx = blockIdx.x; F.vcu = (F.G % 8 == 0) ? (bx % 8) * (F.G / 8) + bx / 8 : bx; }
    volatile LAS unsigned* MISC = (volatile LAS unsigned*)(F.lds + MISC_OFF);
    if (F.tid < 64) MISC[F.tid] = 0u;
    { LAS unsigned long long* tab = (LAS unsigned long long*)(F.lds + MISC_OFF + 256);
      if (F.tid == 0) {
#pragma unroll
          for (int i = 0; i < 30; ++i) tab[i] = (unsigned long long)args.in[i];
          tab[30] = (unsigned long long)args.out; } }
    __syncthreads();
    const int lo = args.ph_lo, hi = args.ph_hi; const int wv0 = F.wave;
    const bool multi = (hi - lo) > 1;
    XcdBarrier bar; bar.bar = (unsigned*)(F.ctl + CW_BAR); bar.x = 0; bar.st = nullptr;
    if (multi) bar = xcd_barrier_post((unsigned*)(F.ctl + CW_BAR), MISC + 8);
#ifndef PHMASK
#define PHMASK 0x1fffff
#endif
#define IN(k) ((((PHMASK) >> ((k) % PH_PER)) & 1) && lo <= (k) && (k) < hi)
#define MKT HgT T; T.Qd = (const bf16*)(ws + WS_QD); T.Vd = (const bf16*)(ws + WS_VD); T.Sg = (const bf16*)(ws + WS_SG); T.Zf = (const float*)(ws + WS_ZF); T.Zb = (const float*)(ws + WS_ZB); \
    T.lb = (const float*)(ws + WS_SMALL + SM_LB) + j * 1024; T.HST = (float*)(ws + WS_HST); T.HDM = (float*)(ws + WS_HDM); T.ong = PA.in[I_ONG] + j * 128; T.OO = (bf16*)(ws + WS_OO);
#define FRESH() int t_; asm volatile("v_mbcnt_lo_u32_b32 %0, -1, 0\n\tv_mbcnt_hi_u32_b32 %0, -1, %0" : "=v"(t_)); t_ += wv0 * 64; F.tid = t_; F.lane = t_ & 63; F.wave = __builtin_amdgcn_readfirstlane(t_ >> 6); \
    unsigned char* ws = ws0; asm volatile("" : "+s"(ws)); F.ws = ws; F.ctl = (gu32*)(ws + WS_CTL); PArgs PA; PA.in.t = (LAS unsigned long long*)(F.lds + MISC_OFF + 256); PA.out = (float*)PA.in[30]; \
    float* mods = (float*)(ws + WS_SMALL + SM_MODS); bf16* W = (bf16*)(ws + WS_W); bf16* WM = (bf16*)(ws + WS_WMOE); bf16* H = (bf16*)(ws + WS_H); float* X = (float*)(ws + WS_X); \
    const float* modE = mods + (size_t)Le * 5 * 6144; const float* modO = mods + (size_t)Lo * 5 * 6144; (void)W; (void)WM; (void)H; (void)X; (void)modE; (void)modO;
#define SEAM(k) do { if (IN(k) && IN((k) + 1)) xcd_barrier(bar); } while (0)
    unsigned char* const ws0 = args.ws;
#pragma unroll 1
    for (int j = 0; j < 2; ++j) {
        const int pb = j * PH_PER, Le = 2 * j, Lo = 2 * j + 1;
        if (IN(pb + PH_CV)) { FRESH(); phase_cv(F, PA, j); } SEAM(pb + PH_CV);
        if (IN(pb + PH_MOD)) { FRESH(); if (j == 0) phase_mod(F, PA); } SEAM(pb + PH_MOD);
        if (IN(pb + PH_E1)) { FRESH();
            pg8::Gemm g{H, W + W_EVIN + (size_t)j * EV_INP * 1024, MROWS, EV_INP, 1024}; pg8::StaticOrder S; S.init(MROWS, EV_INP, F.G, (int)blockIdx.x);
            pg8::EpiRawF32 E{(float*)(ws + WS_RAW), EV_INP};
            pg8::gemm_phase<pg8::EpiRawF32, pg8::StaticOrder, true, true>(F.lds, g, S, E, F.tid);
        } SEAM(pb + PH_E1);
        if (IN(pb + PH_E2)) { FRESH(); phase_even_post(F, PA, j); } SEAM(pb + PH_E2);
        if (IN(pb + PH_E3)) { FRESH();
            { pg8::Gemm g{(const bf16*)(ws + WS_CQN), W + W_UQ + (size_t)j * 768 * 384, MROWS, 768, 384}; pg8::StaticOrder S; S.init(MROWS, 768, F.G, (int)blockIdx.x);
              pg8::EpiMlaQ E{(bf16*)(ws + WS_QM), (const float*)(ws + WS_SMALL + SM_ROPEB)};
              pg8::gemm_phase<pg8::EpiMlaQ, pg8::StaticOrder, true, true>(F.lds, g, S, E, F.tid); }
            { asm volatile("v_mbcnt_lo_u32_b32 %0, -1, 0\n\tv_mbcnt_hi_u32_b32 %0, -1, %0" : "=v"(t_)); t_ += wv0 * 64; F.tid = t_; F.lane = t_ & 63;
              pg8::Gemm g{(const bf16*)(ws + WS_CKVN), W + W_UKV + (size_t)j * 1024 * 256, MROWS, 1024, 256}; pg8::StaticOrder S; S.init(MROWS, 1024, F.G, (int)blockIdx.x);
              pg8::EpiMlaKV E{(bf16*)(ws + WS_KM), (bf16*)(ws + WS_VM)};
              pg8::gemm_phase<pg8::EpiMlaKV, pg8::StaticOrder, true, true>(F.lds, g, S, E, F.tid); }
        } SEAM(pb + PH_E3);
        if (IN(pb + PH_E5)) { FRESH(); phase_even_attn(F); } SEAM(pb + PH_E5);
        if (IN(pb + PH_E6)) { FRESH();
            pg8::Gemm g{(const bf16*)(ws + WS_OE), W + W_EVOUT + (size_t)j * 1024 * 1024, MROWS, 1024, 1024}; pg8::StaticOrder S; S.init(MROWS, 1024, F.G, (int)blockIdx.x);
            pg8::EpiResid E{X, modE + 2 * 1024};
            pg8::gemm_phase<pg8::EpiResid, pg8::StaticOrder, true, true>(F.lds, g, S, E, F.tid);
        } SEAM(pb + PH_E6);
        if (IN(pb + PH_E7)) { FRESH(); phase_ln<false, false>(F, PA, PA.in[I_LN1G] + Le * 1024, PA.in[I_LN1B] + Le * 1024, modE + 3 * 1024, nullptr, nullptr, 0, false); } SEAM(pb + PH_E7);
        if (IN(pb + PH_E8)) { FRESH();
            pg8::Gemm g{H, W + W_FFGU + (size_t)j * 2 * DFF * 1024, MROWS, 2 * DFF, 1024}; pg8::StaticOrder S; S.init(MROWS, 2 * DFF, F.G, (int)blockIdx.x);
            pg8::EpiSwiglu E{(bf16*)(ws + WS_FFH), DFF};
            pg8::gemm_phase<pg8::EpiSwiglu, pg8::StaticOrder, true, true>(F.lds, g, S, E, F.tid);
        } SEAM(pb + PH_E8);
        if (IN(pb + PH_E9)) { FRESH();
            pg8::Gemm g{(const bf16*)(ws + WS_FFH), W + W_FFD + (size_t)j * 1024 * DFF, MROWS, 1024, DFF}; pg8::StaticOrder S; S.init(MROWS, 1024, F.G, (int)blockIdx.x);
            pg8::EpiResid E{X, modE + 5 * 1024};
            pg8::gemm_phase<pg8::EpiResid, pg8::StaticOrder, true, true>(F.lds, g, S, E, F.tid);
        } SEAM(pb + PH_E9);
        if (IN(pb + PH_E10)) { FRESH(); phase_ln<false, false>(F, PA, PA.in[I_LN2G] + Le * 1024, PA.in[I_LN2B] + Le * 1024, modO + 0 * 1024, nullptr, nullptr, 0, false); } SEAM(pb + PH_E10);
        if (IN(pb + PH_O1)) { FRESH();
            pg8::Gemm g{H, W + W_ODIN + (size_t)j * 4096 * 1024, MROWS, 4096, 1024}; pg8::StaticOrder S; S.init(MROWS, 4096, F.G, (int)blockIdx.x);
            pg8::EpiOddIn E{(bf16*)(ws + WS_QN), (bf16*)(ws + WS_KN), (bf16*)(ws + WS_VN), (bf16*)(ws + WS_QD), (bf16*)(ws + WS_VD), (bf16*)(ws + WS_SG), (float*)(ws + WS_ZF), (float*)(ws + WS_ZB)};
            pg8::gemm_phase<pg8::EpiOddIn, pg8::StaticOrder, true, true>(F.lds, g, S, E, F.tid);
        } SEAM(pb + PH_O1);
        if (IN(pb + PH_O2)) { FRESH(); MKT phase_odd_mix(F, PA, T, j); } SEAM(pb + PH_O2);
        if (IN(pb + PH_O3)) { FRESH(); MKT phase_hg_b(F, T); } SEAM(pb + PH_O3);
        if (IN(pb + PH_O4)) { FRESH(); MKT for (int u = F.vcu; u < 16 * 66; u += F.G) hg_c_unit(F, T, u / 264, (u / 66) & 3, u % 66); } SEAM(pb + PH_O4);
        if (IN(pb + PH_O5)) { FRESH();
            pg8::Gemm g{(const bf16*)(ws + WS_OO), W + W_ODOUT + (size_t)j * 1024 * 1024, MROWS, 1024, 1024}; pg8::StaticOrder S; S.init(MROWS, 1024, F.G, (int)blockIdx.x);
            pg8::EpiResid E{X, modO + 2 * 1024};
            pg8::gemm_phase<pg8::EpiResid, pg8::StaticOrder, true, true>(F.lds, g, S, E, F.tid);
        } SEAM(pb + PH_O5);
        if (IN(pb + PH_O6)) { FRESH(); phase_ln<false, true>(F, PA, PA.in[I_LN1G] + Lo * 1024, PA.in[I_LN1B] + Lo * 1024, modO + 3 * 1024, nullptr, PA.in[I_ROUTER] + (size_t)j * 1024 * 8, j, false); } SEAM(pb + PH_O6);
        if (IN(pb + PH_O7)) { FRESH(); phase_moe_dispatch(F, j); } SEAM(pb + PH_O7);
        if (IN(pb + PH_O8)) { FRESH();
            int off[9]; moe_offsets(F.ctl + CW_CNT + 64 * j, off);
            pg8::GroupedOrder S; S.nM = off[8] >> 8; S.nN = 2 * DFFE / 256; S.nwg = S.nM * S.nN; S.G = F.G; S.c = (int)blockIdx.x; S.estride = (long)2 * DFFE * 1024 * 2;
#pragma unroll
            for (int e = 0; e < 9; ++e) S.toff[e] = off[e] >> 8;
            pg8::Gemm g{(const bf16*)(ws + WS_XG), WM + WM_GU, MOE_ROWS, 2 * DFFE, 1024};
            pg8::EpiSwiglu E{(bf16*)(ws + WS_MH), DFFE};
            pg8::gemm_phase<pg8::EpiSwiglu, pg8::GroupedOrder, true, true>(F.lds, g, S, E, F.tid);
        } SEAM(pb + PH_O8);
        if (IN(pb + PH_O9)) { FRESH();
            int off[9]; moe_offsets(F.ctl + CW_CNT + 64 * j, off);
            pg8::GroupedOrder S; S.nM = off[8] >> 8; S.nN = 1024 / 256; S.nwg = S.nM * S.nN; S.G = F.G; S.c = (int)blockIdx.x; S.estride = (long)1024 * DFFE * 2;
#pragma unroll
            for (int e = 0; e < 9; ++e) S.toff[e] = off[e] >> 8;
            pg8::Gemm g{(const bf16*)(ws + WS_MH), WM + WM_D, MOE_ROWS, 1024, DFFE};
            pg8::EpiPlainBf16 E{(bf16*)(ws + WS_XG), 1024};
            pg8::gemm_phase<pg8::EpiPlainBf16, pg8::GroupedOrder, true, true>(F.lds, g, S, E, F.tid);
        } SEAM(pb + PH_O9);
        if (IN(pb + PH_O10)) { FRESH(); phase_ln<true, false>(F, PA, PA.in[I_LN2G] + Lo * 1024, PA.in[I_LN2B] + Lo * 1024, mods + (size_t)(j == 0 ? 2 : 0) * 5 * 6144, modO + 5 * 1024, nullptr, 0, j == 1); }
        if (j == 0) SEAM(pb + PH_O10);
    }
#undef IN
#undef SEAM
}

extern "C" void kernel_launch(void* const* d_in, const int* in_sizes, int n_in, void* d_out, int out_size, void* d_ws, size_t ws_size, hipStream_t stream) {
    static int grid = 0;
    if (grid == 0) {
        if (n_in != 30 || in_sizes[0] != MLAT * DM || out_size != MLAT * DM || ws_size < WS_END) { fprintf(stderr, "kernel_launch: unexpected shapes / workspace (n_in %d, ws %zu)\n", n_in, ws_size); grid = -1; return; }
        int dev = 0, cus = 0, per_cu = 0;
        if (hipGetDevice(&dev) != hipSuccess || hipDeviceGetAttribute(&cus, hipDeviceAttributeMultiprocessorCount, dev) != hipSuccess) { grid = -1; return; }
        if (hipFuncSetAttribute((const void*)mk_fwd, hipFuncAttributeMaxDynamicSharedMemorySize, LDS_BYTES) != hipSuccess) { fprintf(stderr, "kernel_launch: hipFuncSetAttribute failed\n"); grid = -1; return; }
        if (hipOccupancyMaxActiveBlocksPerMultiprocessor(&per_cu, (const void*)mk_fwd, NTHR, LDS_BYTES) != hipSuccess || per_cu < 1) { fprintf(stderr, "kernel_launch: occupancy query says %d\n", per_cu); }
        (void)hipGetLastError();
        grid = cus;
        if (grid != 256) { fprintf(stderr, "kernel_launch: built for 256 CUs, found %d\n", cus); grid = -1; return; }
    }
    if (grid < 0) return;
    if (hipMemsetAsync((char*)d_ws + WS_CTL, 0, CTL_ZERO_BYTES, stream) != hipSuccess) return;
    Args a{};
    for (int i = 0; i < 30; ++i) a.in[i] = (const float*)d_in[i];
    a.out = (float*)d_out; a.ws = (unsigned char*)d_ws;
#if MK_MULTI
    for (int ph = 0; ph < NPHASES; ++ph) {
        if (ph == PH_PER + PH_MOD) continue;
        a.ph_lo = ph; a.ph_hi = ph + 1;
        hipLaunchKernelGGL(mk_fwd, dim3(grid), dim3(NTHR), LDS_BYTES, stream, a);
    }
#else
    a.ph_lo = 0; a.ph_hi = NPHASES;
    hipLaunchKernelGGL(mk_fwd, dim3(grid), dim3(NTHR), LDS_BYTES, stream, a);
#endif
}
```

```cpp
#include <hip/hip_runtime.h>
#include <cstdio>
#include <cstdint>

#ifndef MK_MULTI
#define MK_MULTI 0
#endif

constexpr int DM = 1024, NB = 4, SEQ = 8192, CTXL = 256, GRIDW = 64;
constexpr int MLAT = NB * SEQ, MCTX = NB * CTXL, MROWS = MLAT + MCTX;
constexpr int DEPTH = 4;
constexpr int EV_IN = 1440, EV_INP = 1536;
constexpr int DFF = 2816, DFFE = 3584, NEXP = 8;
constexpr int MOE_ROWS = 2 * MROWS + NEXP * 256;
constexpr float ALPHA = 1.6817928305074290f;
constexpr float LOG2E = 1.4426950408889634f;
constexpr float C2_64 = 0.125f * LOG2E;
constexpr float C2_96 = 0.10206207261596577f * LOG2E;

constexpr size_t MiB = 1u << 20;
constexpr size_t WS_CTL = 0, CTL_ZERO_BYTES = 1 * MiB;
constexpr size_t WS_SMALL = 2 * MiB;
constexpr size_t WS_TOPK = 4 * MiB;
constexpr size_t WS_W = 6 * MiB;
constexpr size_t WS_WMOE = 72 * MiB;
constexpr size_t WS_X = 240 * MiB;
constexpr size_t WS_H = 372 * MiB;
constexpr size_t WS_S = 438 * MiB;
constexpr size_t WS_RAW = WS_S;
constexpr size_t WS_QG = 636 * MiB, WS_KG = 669 * MiB, WS_VG = 678 * MiB, WS_CQN = 687 * MiB, WS_CKVN = 712 * MiB;
constexpr size_t WS_QM = 729 * MiB, WS_KM = 779 * MiB, WS_VM = 829 * MiB, WS_OE = 862 * MiB;
constexpr size_t WS_FFH = WS_S;
constexpr size_t WS_QN = 438 * MiB, WS_KN = 471 * MiB, WS_VN = 504 * MiB, WS_QD = 537 * MiB, WS_VD = 570 * MiB, WS_SG = 603 * MiB;
constexpr size_t WS_ZF = 636 * MiB, WS_ZB = 702 * MiB, WS_OO = 768 * MiB, WS_HST = 834 * MiB, WS_HDM = 966 * MiB;
constexpr size_t WS_MH = 372 * MiB;
constexpr size_t WS_XG = 848 * MiB;
constexpr size_t WS_END = 984 * MiB;
static_assert(WS_QG >= WS_RAW + (size_t)MROWS * EV_INP * 4 && WS_OE + (size_t)MROWS * 2048 <= 984 * MiB, "even map");
static_assert(WS_HST + (size_t)32 * 66 * 65536 <= WS_HDM && WS_HDM + (size_t)32 * 66 * 512 <= WS_END, "odd map");
static_assert(WS_MH + (size_t)MOE_ROWS * DFFE * 2 <= WS_XG && WS_XG + (size_t)MOE_ROWS * 2048 <= WS_END, "moe map");
constexpr size_t SM_MODS = 0;
constexpr size_t SM_ROPEA = 512 * 1024;
constexpr size_t SM_ROPEB = SM_ROPEA + 16384;
constexpr size_t SM_LB = SM_ROPEB + 8192;
constexpr size_t W_EVIN = 0;
constexpr size_t W_UQ = W_EVIN + (size_t)2 * 1536 * 1024;
constexpr size_t W_UKV = W_UQ + (size_t)2 * 768 * 384;
constexpr size_t W_EVOUT = W_UKV + (size_t)2 * 1024 * 256;
constexpr size_t W_FFGU = W_EVOUT + (size_t)2 * 1024 * 1024;
constexpr size_t W_FFD = W_FFGU + (size_t)2 * 5632 * 1024;
constexpr size_t W_ODIN = W_FFD + (size_t)2 * 1024 * 2816;
constexpr size_t W_ODOUT = W_ODIN + (size_t)2 * 4096 * 1024;
constexpr size_t W_ENDE = W_ODOUT + (size_t)2 * 1024 * 1024;
static_assert(W_ENDE * 2 <= 66 * MiB, "weights map");
constexpr size_t WM_GU = 0;
constexpr size_t WM_D = (size_t)8 * 7168 * 1024;
constexpr int CW_BAR = 4096;
constexpr int CW_CNT = 8192;
constexpr int CW_CNT2 = 8192 + 256;
constexpr int LDS_BYTES = 160256;
constexpr int MISC_OFF = LDS_BYTES - 512;
constexpr int NWAVES = 8, NTHR = 512;

#define GAS __attribute__((address_space(1)))
#define LAS __attribute__((address_space(3)))
typedef unsigned short bf16;
typedef unsigned v4u __attribute__((ext_vector_type(4)));
typedef unsigned v2u __attribute__((ext_vector_type(2)));
typedef float f32x4 __attribute__((ext_vector_type(4)));
typedef float f32x16 __attribute__((ext_vector_type(16)));
typedef short bf16x8 __attribute__((ext_vector_type(8)));
typedef short s16x4 __attribute__((ext_vector_type(4)));
typedef GAS unsigned gu32;

typedef float f32x2_t __attribute__((ext_vector_type(2))); typedef __bf16 bf16x2_t __attribute__((ext_vector_type(2)));
__device__ __forceinline__ unsigned pkbf(float lo, float hi) { f32x2_t v = {lo, hi}; bf16x2_t b = __builtin_convertvector(v, bf16x2_t); return __builtin_bit_cast(unsigned, b); }
__device__ __forceinline__ float bf_lo(unsigned u) { return __uint_as_float(u << 16); }
__device__ __forceinline__ float bf_hi(unsigned u) { return __uint_as_float(u & 0xffff0000u); }
__device__ __forceinline__ float bf2f(bf16 h) { return __uint_as_float(((unsigned)h) << 16); }
__device__ __forceinline__ bf16 f2bf(float f) { return (bf16)(pkbf(f, 0.f) & 0xffffu); }
__device__ __forceinline__ float fast_exp2(float x) { return __builtin_amdgcn_exp2f(x); }
__device__ __forceinline__ float sigmoidf_(float x) { return 1.f / (1.f + __expf(-x)); }
__device__ __forceinline__ float siluf_(float x) { return x / (1.f + __expf(-x)); }
__device__ __forceinline__ float shx(float v, int m, int lane) { return __int_as_float(__builtin_amdgcn_ds_bpermute((lane ^ m) << 2, __float_as_int(v))); }
__device__ __forceinline__ float wave_sum(float v, int lane) {
#pragma unroll
    for (int o = 1; o < 64; o <<= 1) v += shx(v, o, lane);
    return v;
}
__device__ __forceinline__ int modrow(int row) { return row < MLAT ? (row >> 13) : 4; }
namespace pg8 {
#define PG8_LAS __attribute__((address_space(3)))
typedef unsigned short bf16_t;
typedef short bf16x8 __attribute__((ext_vector_type(8)));
typedef float f32x4 __attribute__((ext_vector_type(4)));
typedef unsigned u32x4 __attribute__((ext_vector_type(4)));
constexpr int BM = 256, BK = 64, HALF = 128, HTB = HALF * BK * 2  , STAGE_BYTES = 8 * HTB, NXCD = 8, WGM = 8;

__host__ __device__ __forceinline__ int lds_byte(int r, int c) { const int st = (r >> 4) * 2 + (c >> 5), rr = r & 15, cc = c & 31, ob = rr * 64 + cc * 2; return st * 1024 + (ob ^ (((ob >> 9) & 1) << 5)); }
__host__ __device__ __forceinline__ void stage_rc(int b, int& R, int& C) { const int st = b / 1024, sb = b % 1024, swz = sb ^ (((sb >> 9) & 1) << 5); R = (st >> 1) * 16 + swz / 64; C = (st & 1) * 32 + (swz % 64) / 2; }
__host__ __device__ __forceinline__ int perm32(int rho) { const int n = rho >> 4, i = rho & 15; return 8 * (i >> 2) + 4 * n + (i & 3); }

struct Unit { int pm, pn; long boff; };
struct Gemm { const bf16_t* A; const bf16_t* Bt; int M, N, K; };

struct StaticOrder {
    int nM, nN, nwg, G, c;
    __host__ __device__ void init(int M, int N, int G_, int c_) { nM = M / BM; nN = N / BM; nwg = nM * nN; G = G_; c = c_; }
    __host__ __device__ bool next(int i, Unit& u) const {
        const long L = (long)i * G + c; if (L >= nwg) return false;
        int wgid = (int)L; { const int q = nwg / NXCD, r = nwg % NXCD, xcd = wgid % NXCD, off = wgid / NXCD; wgid = (xcd < r ? xcd * (q + 1) : r * (q + 1) + (xcd - r) * q) + off; }
        const int nig = WGM * nN, gid = wgid / nig, fm = gid * WGM, gsz = (nM - fm) < WGM ? (nM - fm) : WGM;
        u.pm = fm + ((wgid % nig) % gsz); u.pn = (wgid % nig) / gsz; u.boff = 0; return true;
    }
    __device__ __forceinline__ void a_ready(const Unit&) const {}
    __device__ __forceinline__ void done(const Unit&) const {}
};

__device__ __forceinline__ unsigned cvt_pk_bf16(float lo, float hi) { return pkbf(lo, hi); }
typedef float f32x2 __attribute__((ext_vector_type(2)));
template <class Epi, class Sched, bool ALIGN_EPI = false, bool SP2 = false>
__device__ __forceinline__ void gemm_phase(PG8_LAS unsigned char* lds, const Gemm g, const Sched& S, const Epi& E, int tid_in) {
    int tid_ = tid_in; asm volatile("" : "+v"(tid_));
    const int tid = tid_, wid = __builtin_amdgcn_readfirstlane(tid >> 6), lane = tid & 63, wr = wid >> 2, wc = wid & 3, fr = lane & 15, fq = lane >> 4;
    const int K = g.K, nt = K / BK;
    unsigned voffA[2], voffB[2];
#pragma unroll
    for (int i = 0; i < 2; ++i) { int R, C; stage_rc(tid * 16 + i * 8192, R, C); const int Rb = Epi::PERM ? ((R & ~31) + perm32(R & 31)) : R;
        voffA[i] = (unsigned)(R * K + C) * 2u; voffB[i] = (unsigned)(Rb * K + C) * 2u; }
    const size_t kstep = (size_t)(BK * 2);
    const size_t hstep = (size_t)HALF * K * 2;
    const size_t tstep = 2 * hstep;
    const unsigned ldsw = (unsigned)wid * 1024u;
    const int aoff = lds_byte(wr * 64 + fr, fq * 8), boff = lds_byte(wc * 32 + fr, fq * 8);
#define PG8_SA(b, h) (((b) * 2 + (h)) * HTB)
#define PG8_SB(b, h) ((4 + (b) * 2 + (h)) * HTB)
#define PG8_STAGE(bufoff, gbase, voff) do { _Pragma("unroll") for (int _i = 0; _i < 2; ++_i) \
        __builtin_amdgcn_global_load_lds((const unsigned*)((const char*)(gbase) + (voff)[_i]), (PG8_LAS unsigned*)(lds + (bufoff) + ldsw + _i * 8192), 16, 0, 0); } while (0)
#define PG8_LDA(dst, b, h) do { _Pragma("unroll") for (int m = 0; m < 4; ++m) _Pragma("unroll") for (int k = 0; k < 2; ++k) dst[m][k] = *(const PG8_LAS bf16x8*)(lds + PG8_SA(b, h) + aoff + m * 2048 + k * 1024); } while (0)
#define PG8_LDB(dst, b, h) do { _Pragma("unroll") for (int n = 0; n < 2; ++n) _Pragma("unroll") for (int k = 0; k < 2; ++k) dst[n][k] = *(const PG8_LAS bf16x8*)(lds + PG8_SB(b, h) + boff + n * 2048 + k * 1024); } while (0)
#define PG8_MMA(ai, bj, At, Bt) do { __builtin_amdgcn_s_setprio(1); _Pragma("unroll") for (int m = 0; m < 4; ++m) _Pragma("unroll") for (int n = 0; n < 2; ++n) _Pragma("unroll") for (int k = 0; k < 2; ++k) \
        acc[ai][bj][m][n] = __builtin_amdgcn_mfma_f32_16x16x32_bf16(Bt[n][k], At[m][k], acc[ai][bj][m][n], 0, 0, 0); __builtin_amdgcn_s_setprio(0); } while (0)
#define PG8_WAIT_V(n) asm volatile("s_waitcnt vmcnt(" #n ")" ::: "memory")
#define PG8_WAIT_L(n) asm volatile("s_waitcnt lgkmcnt(" #n ")" ::: "memory")
#define PG8_BAR __builtin_amdgcn_s_barrier()
#define PG8_SCHED __builtin_amdgcn_sched_barrier(0)
    Unit cur, nxt; int ui = 0;
    if (!S.next(0, cur)) return;
    f32x4 acc[2][2][4][2];
#pragma unroll
    for (int a = 0; a < 2; ++a)
#pragma unroll
        for (int b = 0; b < 2; ++b)
#pragma unroll
            for (int m = 0; m < 4; ++m)
#pragma unroll
                for (int n = 0; n < 2; ++n) acc[a][b][m][n] = (f32x4){0.f, 0.f, 0.f, 0.f};
    bf16x8 At[4][2], B0[2][2], B1[2][2];
    const char* cA = (const char*)g.A + (size_t)cur.pm * tstep; const char* cB = (const char*)g.Bt + (size_t)cur.pn * tstep + cur.boff;
    S.a_ready(cur);
    if constexpr (SP2) {
        PG8_STAGE(PG8_SB(0, 0), cB, voffB); PG8_STAGE(PG8_SB(0, 1), cB + hstep, voffB); PG8_STAGE(PG8_SA(0, 0), cA, voffA); PG8_STAGE(PG8_SA(0, 1), cA + hstep, voffA);
        if (wr == 1) PG8_BAR;
        PG8_WAIT_V(2); PG8_BAR;
        PG8_STAGE(PG8_SB(1, 0), cB + kstep, voffB); PG8_STAGE(PG8_SA(1, 0), cA + kstep, voffA); PG8_STAGE(PG8_SB(1, 1), cB + hstep + kstep, voffB);
        PG8_WAIT_V(6); PG8_BAR;
    } else {
        PG8_STAGE(PG8_SB(0, 0), cB, voffB); PG8_STAGE(PG8_SA(0, 0), cA, voffA); PG8_STAGE(PG8_SB(0, 1), cB + hstep, voffB); PG8_STAGE(PG8_SA(0, 1), cA + hstep, voffA);
        if (wr == 1) PG8_BAR;
        PG8_WAIT_V(4); PG8_BAR;
        PG8_STAGE(PG8_SB(1, 0), cB + kstep, voffB); PG8_STAGE(PG8_SA(1, 0), cA + kstep, voffA); PG8_STAGE(PG8_SB(1, 1), cB + hstep + kstep, voffB);
        PG8_WAIT_V(6); PG8_BAR;
    }
    for (;;) {
        const bool has_next = S.next(ui + 1, nxt);
        const char* nA = has_next ? (const char*)g.A + (size_t)nxt.pm * tstep : cA; const char* nB = has_next ? (const char*)g.Bt + (size_t)nxt.pn * tstep + nxt.boff : cB;
        for (int t = 0; t < nt; t += 2) {
            const bool last = (t == nt - 2);
            const char* a1 = cA + (size_t)(t + 1) * kstep;
            const char* a2 = last ? nA : cA + (size_t)(t + 2) * kstep; const char* b2 = last ? nB : cB + (size_t)(t + 2) * kstep;
            const char* a3 = a2 + kstep; const char* b3 = b2 + kstep;
            if (last && has_next) S.a_ready(nxt);
            if constexpr (SP2) {
            PG8_LDB(B0, 0, 0); PG8_LDB(B1, 0, 1); PG8_SCHED; PG8_LDA(At, 0, 0); PG8_STAGE(PG8_SA(1, 1), a1 + hstep, voffA);
            PG8_WAIT_V(8); PG8_WAIT_L(0); PG8_BAR; PG8_MMA(0, 0, At, B0); PG8_MMA(0, 1, At, B1); PG8_BAR; PG8_SCHED;
            PG8_LDA(At, 0, 1); PG8_STAGE(PG8_SB(0, 0), b2, voffB); PG8_STAGE(PG8_SB(0, 1), b2 + hstep, voffB); PG8_STAGE(PG8_SA(0, 0), a2, voffA);
            PG8_WAIT_V(8); PG8_WAIT_L(0); PG8_BAR; PG8_MMA(1, 0, At, B0); PG8_MMA(1, 1, At, B1); PG8_BAR; PG8_SCHED;
            PG8_LDB(B0, 1, 0); PG8_LDB(B1, 1, 1); PG8_SCHED; PG8_LDA(At, 1, 0); PG8_STAGE(PG8_SA(0, 1), a2 + hstep, voffA);
            PG8_WAIT_V(8); PG8_WAIT_L(0); PG8_BAR; PG8_MMA(0, 0, At, B0); PG8_MMA(0, 1, At, B1); PG8_BAR; PG8_SCHED;
            PG8_LDA(At, 1, 1); PG8_STAGE(PG8_SB(1, 0), b3, voffB); PG8_STAGE(PG8_SB(1, 1), b3 + hstep, voffB); PG8_STAGE(PG8_SA(1, 0), a3, voffA);
            PG8_WAIT_V(8); PG8_WAIT_L(0); PG8_BAR; PG8_MMA(1, 0, At, B0); PG8_MMA(1, 1, At, B1); PG8_BAR; PG8_SCHED;
            } else {
            PG8_LDB(B0, 0, 0); PG8_SCHED; PG8_LDA(At, 0, 0); PG8_STAGE(PG8_SA(1, 1), a1 + hstep, voffA);
            PG8_WAIT_L(8); PG8_BAR; PG8_WAIT_L(0); PG8_MMA(0, 0, At, B0); PG8_BAR; PG8_SCHED;
            PG8_LDB(B1, 0, 1); PG8_STAGE(PG8_SB(0, 0), b2, voffB);
            PG8_BAR; PG8_WAIT_L(0); PG8_MMA(0, 1, At, B1); PG8_BAR;
            PG8_LDA(At, 0, 1); PG8_STAGE(PG8_SA(0, 0), a2, voffA);
            PG8_BAR; PG8_WAIT_L(0); PG8_MMA(1, 0, At, B0); PG8_BAR; PG8_SCHED;
            PG8_STAGE(PG8_SB(0, 1), b2 + hstep, voffB);
            PG8_WAIT_V(6); PG8_BAR; PG8_MMA(1, 1, At, B1); PG8_BAR;
            PG8_LDB(B0, 1, 0); PG8_SCHED; PG8_LDA(At, 1, 0); PG8_STAGE(PG8_SA(0, 1), a2 + hstep, voffA);
            PG8_WAIT_L(8); PG8_BAR; PG8_WAIT_L(0); PG8_MMA(0, 0, At, B0); PG8_BAR; PG8_SCHED;
            PG8_LDB(B1, 1, 1); PG8_STAGE(PG8_SB(1, 0), b3, voffB);
            PG8_BAR; PG8_WAIT_L(0); PG8_MMA(0, 1, At, B1); PG8_BAR;
            PG8_LDA(At, 1, 1); PG8_STAGE(PG8_SA(1, 0), a3, voffA);
            PG8_BAR; PG8_WAIT_L(0); PG8_MMA(1, 0, At, B0); PG8_BAR; PG8_SCHED;
            PG8_STAGE(PG8_SB(1, 1), b3 + hstep, voffB);
            PG8_WAIT_V(6); PG8_BAR; PG8_MMA(1, 1, At, B1); PG8_BAR;
            }
        }
        if constexpr (ALIGN_EPI) { if (wr == 0) PG8_BAR; }
        if constexpr (!Epi::AFTER_DRAIN) { int l2_; asm volatile("v_mbcnt_lo_u32_b32 %0, -1, 0\n\tv_mbcnt_hi_u32_b32 %0, -1, %0" : "=v"(l2_)); const int fr2 = l2_ & 15, fq2 = l2_ >> 4;     E(acc, cur, wr, wc, fr2, fq2); S.done(cur); }
        if (!has_next) break;
#pragma unroll
        for (int a = 0; a < 2; ++a)
#pragma unroll
            for (int b = 0; b < 2; ++b)
#pragma unroll
                for (int m = 0; m < 4; ++m)
#pragma unroll
                    for (int n = 0; n < 2; ++n) acc[a][b][m][n] = (f32x4){0.f, 0.f, 0.f, 0.f};
        cur = nxt; cA = nA; cB = nB; ++ui;
        if constexpr (ALIGN_EPI) { if (wr == 1) PG8_BAR; }
    }
    PG8_WAIT_V(0);
    if constexpr (!ALIGN_EPI) { if (wr == 0) PG8_BAR; }
    PG8_BAR;
    if constexpr (Epi::AFTER_DRAIN) { E.fused(acc, cur, wr, wc, fr, fq, lds, wid, lane); S.done(cur); }
#undef PG8_SA
#undef PG8_SB
#undef PG8_STAGE
#undef PG8_LDA
#undef PG8_LDB
#undef PG8_MMA
#undef PG8_WAIT_V
#undef PG8_WAIT_L
#undef PG8_BAR
#undef PG8_SCHED
}
}
namespace pg8 {
constexpr int NEXP_ = 8;
template <class F> __device__ __forceinline__ void walk8(const f32x4 (&acc)[2][2][4][2], const Unit& u, int wr, int wc, int fr, int fq, const F& f) {
    asm volatile("s_nop 15\n\ts_nop 7" ::: "memory");
    const int row0 = u.pm * BM + wr * 64 + fr, col0 = u.pn * BM + wc * 32 + 8 * fq;
#pragma unroll
    for (int ai = 0; ai < 2; ++ai)
#pragma unroll
        for (int m = 0; m < 4; ++m)
#pragma unroll
            for (int bj = 0; bj < 2; ++bj) {
                const f32x4 a = acc[ai][bj][m][0], b = acc[ai][bj][m][1];
                float v[8] = {a[0], a[1], a[2], a[3], b[0], b[1], b[2], b[3]};
                f.emit(row0 + ai * HALF + m * 16, col0 + bj * HALF, v);
                asm volatile("" ::: "memory");
            }
}
__device__ __forceinline__ u32x4 pack8(const float (&v)[8], float s) {
    u32x4 w; w.x = cvt_pk_bf16(v[0] * s, v[1] * s); w.y = cvt_pk_bf16(v[2] * s, v[3] * s); w.z = cvt_pk_bf16(v[4] * s, v[5] * s); w.w = cvt_pk_bf16(v[6] * s, v[7] * s); return w;
}
struct EpiRawF32 {
    static constexpr bool PERM = true, AFTER_DRAIN = false;
    float* O; int ldc;
    __device__ __forceinline__ void emit(int row, int col, const float (&v)[8]) const {
        float* p = O + (size_t)row * ldc + col; *(f32x4*)p = (f32x4){v[0], v[1], v[2], v[3]}; *(f32x4*)(p + 4) = (f32x4){v[4], v[5], v[6], v[7]};
    }
    __device__ __forceinline__ void operator()(const f32x4 (&acc)[2][2][4][2], const Unit& u, int wr, int wc, int fr, int fq) const { walk8(acc, u, wr, wc, fr, fq, *this); }
};
struct EpiPlainBf16 {
    static constexpr bool PERM = true, AFTER_DRAIN = false;
    bf16_t* O; int ldc;
    __device__ __forceinline__ void emit(int row, int col, const float (&v)[8]) const { *(u32x4*)(O + (size_t)row * ldc + col) = pack8(v, 1.f); }
    __device__ __forceinline__ void operator()(const f32x4 (&acc)[2][2][4][2], const Unit& u, int wr, int wc, int fr, int fq) const { walk8(acc, u, wr, wc, fr, fq, *this); }
};
struct EpiMlaQ {
    static constexpr bool PERM = true, AFTER_DRAIN = false;
    bf16_t* Qm; const float* ropeB;
    __device__ __forceinline__ void emit(int row, int col, const float (&v)[8]) const {
        const int head = col / 96, c = col - head * 96;
        bf16_t* q = Qm + (size_t)row * 768 + head * 96;
        const bool isr = c >= 64;
        const int g = (c - 64) >> 3, axis = g >> 1, base = axis * 16 + (g & 1) * 4;
        f32x4 cs0 = {1.f, 0.f, 1.f, 0.f}, cs1 = {1.f, 0.f, 1.f, 0.f};
        if (isr && row < MLAT) { const int t = row & (SEQ - 1), pos = axis ? (t & 63) : (t >> 6); const float* cs = ropeB + (pos * 8 + (g & 1) * 4) * 2; cs0 = *(const f32x4*)cs; cs1 = *(const f32x4*)(cs + 4); }
        const float o10 = v[0] * cs0[0] - v[4] * cs0[1], o20 = v[4] * cs0[0] + v[0] * cs0[1], o11 = v[1] * cs0[2] - v[5] * cs0[3], o21 = v[5] * cs0[2] + v[1] * cs0[3];
        const float o12 = v[2] * cs1[0] - v[6] * cs1[1], o22 = v[6] * cs1[0] + v[2] * cs1[1], o13 = v[3] * cs1[2] - v[7] * cs1[3], o23 = v[7] * cs1[2] + v[3] * cs1[3];
        typedef unsigned u32x2 __attribute__((ext_vector_type(2)));
        u32x2 w1, w2; w1.x = cvt_pk_bf16(o10 * C2_96, o11 * C2_96); w1.y = cvt_pk_bf16(o12 * C2_96, o13 * C2_96); w2.x = cvt_pk_bf16(o20 * C2_96, o21 * C2_96); w2.y = cvt_pk_bf16(o22 * C2_96, o23 * C2_96);
        bf16_t* p1 = isr ? q + 64 + base : q + c; bf16_t* p2 = isr ? q + 64 + base + 8 : q + c + 4;
        *(u32x2*)p1 = w1; *(u32x2*)p2 = w2;
    }
    __device__ __forceinline__ void operator()(const f32x4 (&acc)[2][2][4][2], const Unit& u, int wr, int wc, int fr, int fq) const { walk8(acc, u, wr, wc, fr, fq, *this); }
};
struct EpiMlaKV {
    static constexpr bool PERM = true, AFTER_DRAIN = false;
    bf16_t* Km; bf16_t* Vm;
    __device__ __forceinline__ void emit(int row, int col, const float (&v)[8]) const {
        const int head = col >> 7, c = col & 127;
        if (c < 64) *(u32x4*)(Km + (size_t)row * 768 + head * 96 + c) = pack8(v, 1.f);
        else        *(u32x4*)(Vm + (size_t)row * 512 + head * 64 + (c - 64)) = pack8(v, 1.f);
    }
    __device__ __forceinline__ void operator()(const f32x4 (&acc)[2][2][4][2], const Unit& u, int wr, int wc, int fr, int fq) const { walk8(acc, u, wr, wc, fr, fq, *this); }
};
struct EpiResid {
    static constexpr bool PERM = true, AFTER_DRAIN = false;
    float* X; const float* gate;
    __device__ __forceinline__ void emit(int row, int col, const float (&v)[8]) const {
        float* p = X + (size_t)row * 1024 + col; const float* g = gate + (size_t)(row < MLAT ? (row >> 13) : 4) * 6144 + col;
        const f32x4 x0 = *(const f32x4*)p, x1 = *(const f32x4*)(p + 4), g0 = *(const f32x4*)g, g1 = *(const f32x4*)(g + 4);
        *(f32x4*)p = x0 * ALPHA + g0 * (f32x4){v[0], v[1], v[2], v[3]}; *(f32x4*)(p + 4) = x1 * ALPHA + g1 * (f32x4){v[4], v[5], v[6], v[7]};
    }
    __device__ __forceinline__ void operator()(const f32x4 (&acc)[2][2][4][2], const Unit& u, int wr, int wc, int fr, int fq) const { walk8(acc, u, wr, wc, fr, fq, *this); }
};
struct EpiSwiglu {
    static constexpr bool PERM = true, AFTER_DRAIN = false;
    bf16_t* Hd; int ldh;
    __device__ __forceinline__ void emit(int row, int col, const float (&v)[8]) const {
        float h[4];
#pragma unroll
        for (int e = 0; e < 4; ++e) h[e] = v[e] / (1.f + __expf(-v[e])) * v[e + 4];
        typedef unsigned u32x2 __attribute__((ext_vector_type(2)));
        u32x2 w; w.x = cvt_pk_bf16(h[0], h[1]); w.y = cvt_pk_bf16(h[2], h[3]);
        *(u32x2*)(Hd + (size_t)row * ldh + (col >> 1)) = w;
    }
    __device__ __forceinline__ void operator()(const f32x4 (&acc)[2][2][4][2], const Unit& u, int wr, int wc, int fr, int fq) const { walk8(acc, u, wr, wc, fr, fq, *this); }
};
struct EpiOddIn {
    static constexpr bool PERM = true, AFTER_DRAIN = false;
    bf16_t *Qn, *Kn, *Vn, *Qd, *Vd, *Sg; float *Zf, *Zb;
    __device__ __forceinline__ void emit(int row, int col, const float (&v)[8]) const {
        const int sec = col >> 9, c = col & 511; const size_t o = (size_t)row * 512 + c;
        if (sec == 0) { *(u32x4*)(Qn + o) = pack8(v, C2_64); }
        else if (sec == 1) { *(u32x4*)(Kn + o) = pack8(v, 1.f); }
        else if (sec == 2) { *(u32x4*)(Vn + o) = pack8(v, 1.f); }
        else if (sec == 4) { *(u32x4*)(Vd + o) = pack8(v, 1.f); }
        else if (sec == 5 || sec == 6) { float* p = (sec == 5 ? Zf : Zb) + o; *(f32x4*)p = (f32x4){v[0], v[1], v[2], v[3]}; *(f32x4*)(p + 4) = (f32x4){v[4], v[5], v[6], v[7]}; }
        else { float s[8];
#pragma unroll
            for (int e = 0; e < 8; ++e) s[e] = v[e] / (1.f + __expf(-v[e]));
            *(u32x4*)((sec == 3 ? Qd : Sg) + o) = pack8(s, 1.f); }
    }
    __device__ __forceinline__ void operator()(const f32x4 (&acc)[2][2][4][2], const Unit& u, int wr, int wc, int fr, int fq) const { walk8(acc, u, wr, wc, fr, fq, *this); }
};
struct GroupedOrder {
    int nM, nN, nwg, G, c; int toff[NEXP_ + 1]; long estride;
    __device__ __forceinline__ bool next(int i, Unit& u) const {
        const long L = (long)i * G + c; if (L >= nwg) return false;
        int wgid = (int)L; { const int q = nwg / NXCD, r = nwg % NXCD, xcd = wgid % NXCD, off = wgid / NXCD; wgid = (xcd < r ? xcd * (q + 1) : r * (q + 1) + (xcd - r) * q) + off; }
        const int nig = WGM * nN, gid = wgid / nig, fm = gid * WGM, gsz = (nM - fm) < WGM ? (nM - fm) : WGM;
        u.pm = fm + ((wgid % nig) % gsz); u.pn = (wgid % nig) / gsz;
        int e = 0;
#pragma unroll
        for (int k = 1; k < NEXP_; ++k) e += (u.pm >= toff[k]) ? 1 : 0;
        u.boff = (long)e * estride; return true;
    }
    __device__ __forceinline__ void a_ready(const Unit&) const {}
    __device__ __forceinline__ void done(const Unit&) const {}
};
}
#define XB_TMO      128
#define XB_XCNT(j)  (256  + 64 * (j))
#define XB_XSUB(j)  (1280 + 64 * (j))
#define XB_XGEN(j)  (2304 + 64 * (j))
#define XB_TOP      3328
#define XB_TOPGEN   3392
#define XCD_BAR_WORDS 3456
#define XB_SPIN_CAP (1u << 18)

__device__ __forceinline__ unsigned xb_ld(unsigned* p)              { return __hip_atomic_load(p, __ATOMIC_RELAXED, __HIP_MEMORY_SCOPE_AGENT); }
__device__ __forceinline__ unsigned xb_add(unsigned* p, unsigned v) { return __hip_atomic_fetch_add(p, v, __ATOMIC_RELAXED, __HIP_MEMORY_SCOPE_AGENT); }
__device__ __forceinline__ unsigned xb_xcc_id() { return (unsigned)__builtin_amdgcn_s_getreg((3 << 11) | 20) & 0xFu; }
#define XB_SPIN(cond, bar) do { unsigned _sp = 0; while (cond) { __builtin_amdgcn_s_sleep(1); \
    if ((++_sp & 255u) == 0u) { if (xb_ld(&(bar)[XB_TMO])) break; if (_sp > XB_SPIN_CAP) { atomicAdd(&(bar)[XB_TMO], 1u); break; } } } } while (0)

struct XcdBarrier {
    unsigned* bar; unsigned x;
    volatile LAS unsigned* st;
};

__device__ __forceinline__ XcdBarrier xcd_barrier_post(unsigned* bar, volatile LAS unsigned* st) {
    XcdBarrier b; b.bar = bar; b.x = xb_xcc_id(); b.st = st;
    if (threadIdx.x == 0) (void)xb_add(&bar[XB_XCNT(b.x)], 1u);
    return b;
}
__device__ __forceinline__ void xcd_barrier_complete(unsigned* bar, unsigned x, unsigned& nloc, unsigned& nx) {
    const unsigned G = gridDim.x * gridDim.y * gridDim.z;
    unsigned sum, cnt, mine, sp = 0u;
    for (;;) {
        sum = 0u; cnt = 0u; mine = 0u;
#pragma unroll
        for (unsigned j = 0; j < 16; ++j) { const unsigned c = xb_ld(&bar[XB_XCNT(j)]); sum += c; cnt += (c > 0u) ? 1u : 0u; mine = (j == x) ? c : mine; }
        if (sum == G) break;
        __builtin_amdgcn_s_sleep(1);
        if ((++sp & 255u) == 0u) { if (xb_ld(&bar[XB_TMO])) break; if (sp > XB_SPIN_CAP) { atomicAdd(&bar[XB_TMO], 1u); break; } }
    }
    nloc = mine > 0u ? mine : 1u; nx = cnt > 0u ? cnt : 1u;
}

__device__ __forceinline__ void xcd_barrier(const XcdBarrier& b) {
    asm volatile("s_waitcnt vmcnt(0)" ::: "memory");
    __syncthreads();
    if (threadIdx.x == 0) {
        unsigned* bar = b.bar;
        __builtin_amdgcn_s_waitcnt(0);
        unsigned nloc = b.st[0], nx = b.st[1];
        if (nloc == 0u) { xcd_barrier_complete(bar, b.x, nloc, nx); b.st[0] = nloc; b.st[1] = nx; }
        const unsigned old = xb_add(&bar[XB_XSUB(b.x)], 1u);
        const unsigned gen = old / nloc;
        if (old + 1u == (gen + 1u) * nloc) {
            __builtin_amdgcn_fence(__ATOMIC_RELEASE, "agent");
            asm volatile("s_waitcnt vmcnt(0)" ::: "memory");
            const unsigned og = xb_add(&bar[XB_TOP], 1u);
            const unsigned tg = og / nx;
            if (og + 1u == (tg + 1u) * nx) xb_add(&bar[XB_TOPGEN], 1u);
            else XB_SPIN(xb_ld(&bar[XB_TOPGEN]) == tg, bar);
            __builtin_amdgcn_fence(__ATOMIC_ACQUIRE, "agent");
            xb_add(&bar[XB_XGEN(b.x)], 1u);
            asm volatile("s_waitcnt vmcnt(0)" ::: "memory");
        } else {
            XB_SPIN(xb_ld(&bar[XB_XGEN(b.x)]) == gen, bar);
            __builtin_amdgcn_fence(__ATOMIC_ACQUIRE, "agent");
            asm volatile("s_waitcnt vmcnt(0)" ::: "memory");
        }
    }
    __syncthreads();
}
struct Frame {
    LAS unsigned char* lds;
    gu32* ctl;
    unsigned char* ws;
    int tid, lane, wave, vcu, G;
};
struct Args { const float* in[30]; float* out; unsigned char* ws; int ph_lo, ph_hi; };
struct InTab { LAS unsigned long long* t;
    __device__ __forceinline__ const float* operator[](int i) const { const unsigned long long v = t[i]; const unsigned lo = __builtin_amdgcn_readfirstlane((unsigned)v), hi = __builtin_amdgcn_readfirstlane((unsigned)(v >> 32)); return (const float*)(((unsigned long long)hi << 32) | lo); } };
struct PArgs { InTab in; float* out; };
#define LDS_WAIT() asm volatile("s_waitcnt lgkmcnt(0)" ::: "memory")
#define VM_WAIT() asm volatile("s_waitcnt vmcnt(0)" ::: "memory")
enum { I_X = 0, I_C, I_CTX, I_CCTX, I_ADAW, I_ADAB, I_LN1G, I_LN1B, I_LN2G, I_LN2B, I_EVWIN, I_QNG, I_KNG, I_CQG, I_CKVG, I_WUQ, I_WUKV, I_EVWOUT,
       I_FFG, I_FFU, I_FFD, I_ODWIN, I_RPB, I_LBL, I_ONG, I_ODWOUT, I_ROUTER, I_MG, I_MU, I_MD };

__device__ __forceinline__ void cvt_item(const float* src0, const float* src1, int K, int N, int Np, bf16* dst, int mode, int item, LAS float* scr, int lane) {
    const int nblk = Np >> 5, kb = item / nblk, nb = item - kb * nblk, k0 = 64 * kb, n0 = 32 * nb;
    const int np = n0 + (lane & 31);
    const float* src = src0; int col = np; bool ok = np < N;
    if (mode == 1) { const int head = np / 96, c = np - head * 96; if (c >= 64) { const int r = c - 64, g = r >> 3, e = r & 7; const int base = (g >> 1) * 16 + (g & 1) * 4; col = head * 96 + 64 + base + (e < 4 ? e : 8 + (e - 4)); } }
    else if (mode == 2) { src = (np & 4) ? src1 : src0; col = ((np >> 3) << 2) + (np & 3); ok = true; }
#pragma unroll 8
    for (int i = 0; i < 32; ++i) { const int kk = 2 * i + (lane >> 5); scr[kk * 33 + (lane & 31)] = ok ? src[(size_t)(k0 + kk) * N + col] : 0.f; }
    LDS_WAIT(); asm volatile("" ::: "memory");
    const int c8 = lane & 7;
#pragma unroll
    for (int j = 0; j < 4; ++j) { const int n = (lane >> 3) + 8 * j; const LAS float* s = scr + (8 * c8) * 33 + n;
        v4u o; o.x = pkbf(s[0 * 33], s[1 * 33]); o.y = pkbf(s[2 * 33], s[3 * 33]); o.z = pkbf(s[4 * 33], s[5 * 33]); o.w = pkbf(s[6 * 33], s[7 * 33]);
        *(GAS v4u*)(dst + (size_t)(n0 + n) * K + k0 + 8 * c8) = o; }
    LDS_WAIT(); asm volatile("" ::: "memory");
}
__device__ __forceinline__ void sincos_red(float ang, float& s, float& c) {
    const float n = __builtin_rintf(ang * 0.636619772367581343f);
    float y = __builtin_fmaf(-n, 1.5703125f, ang); y = __builtin_fmaf(-n, 4.837512969970703125e-4f, y); y = __builtin_fmaf(-n, 7.54978995489188e-8f, y);
    const float z = y * y;
    const float sy = y + y * z * (-1.6666654611e-1f + z * (8.3321608736e-3f + z * (-1.9515295891e-4f)));
    const float cy = 1.0f - 0.5f * z + z * z * (4.166664568298827e-2f + z * (-1.388731625493765e-3f + z * 2.443315711809948e-5f));
    const int q = ((int)n) & 3;
    s = (q == 0) ? sy : (q == 1) ? cy : (q == 2) ? -sy : -cy;
    c = (q == 0) ? cy : (q == 1) ? -sy : (q == 2) ? -cy : sy;
}
__device__ __forceinline__ float inv_freq_pow(double r, int f) { double v = 1.0; for (int i = 0; i < f; ++i) v *= r; return (float)v; }

__device__ __forceinline__ void phase_cv(Frame& F, const PArgs& A, int j) {
    const int gw = F.vcu * NWAVES + F.wave, NGW = F.G * NWAVES;
    float* mods = (float*)(F.ws + WS_SMALL + SM_MODS);
    if (j == 0) {
        LAS float* Ssm = (LAS float*)F.lds;
        LAS float* Psm = (LAS float*)(F.lds + 20480);
        if ((int)blockIdx.x < 192) {
            for (int i = F.tid; i < 5 * 1024; i += NTHR) { const int r = i >> 10, k = i & 1023; const float cv = (r < 4) ? A.in[I_C][r * 1024 + k] : A.in[I_CCTX][k]; Ssm[i] = cv / (1.f + __expf(-cv)); }
            __syncthreads();
            for (int u = blockIdx.x; u < 192; u += F.G) {
                const int l = u / 48, n = (u - l * 48) * 128 + 2 * F.lane;
                float a0[5] = {0.f, 0.f, 0.f, 0.f, 0.f}, a1[5] = {0.f, 0.f, 0.f, 0.f, 0.f};
                const float* wp = A.in[I_ADAW] + ((size_t)l * 1024 + F.wave * 128) * 6144 + n;
#pragma unroll 4
                for (int k = 0; k < 128; ++k) { const float2 w = *(const float2*)(wp + (size_t)k * 6144); const int kk = F.wave * 128 + k;
#pragma unroll
                    for (int r = 0; r < 5; ++r) { const float sv = Ssm[r * 1024 + kk]; a0[r] += sv * w.x; a1[r] += sv * w.y; } }
#pragma unroll
                for (int r = 0; r < 5; ++r) { Psm[(F.wave * 5 + r) * 128 + 2 * F.lane] = a0[r]; Psm[(F.wave * 5 + r) * 128 + 2 * F.lane + 1] = a1[r]; }
                __syncthreads();
                for (int i = F.tid; i < 640; i += NTHR) { const int r = i >> 7, c = i & 127; float s = 0.f;
#pragma unroll
                    for (int w = 0; w < 8; ++w) s += Psm[(w * 5 + r) * 128 + c];
                    const int nn = (u - l * 48) * 128 + c; mods[((size_t)l * 5 + r) * 6144 + nn] = s + A.in[I_ADAB][l * 6144 + nn]; }
                __syncthreads();
            }
        } else if ((int)blockIdx.x == 192) {
            float* ra = (float*)(F.ws + WS_SMALL + SM_ROPEA); float* rb = (float*)(F.ws + WS_SMALL + SM_ROPEB); float* lb = (float*)(F.ws + WS_SMALL + SM_LB);
            for (int i = F.tid; i < 128 * 16; i += NTHR) { const int pos = i >> 4, f = i & 15; const float inv = inv_freq_pow(0.56234132519034908, f); float s, c; sincos_red((float)pos * inv, s, c); ra[2 * i] = c; ra[2 * i + 1] = s; }
            for (int i = F.tid; i < 128 * 8; i += NTHR) { const int pos = i >> 3, f = i & 7; const float inv = inv_freq_pow(0.31622776601683794, f); float s, c; sincos_red((float)pos * inv, s, c); rb[2 * i] = c; rb[2 * i + 1] = s; }
            for (int i = F.tid; i < 2 * 512; i += NTHR) { const int dir = i >> 9, c = i & 511; const float l0 = A.in[I_LBL][(dir * 2 + 0) * 512 + c], l1 = A.in[I_LBL][(dir * 2 + 1) * 512 + c];
                const float mx = fmaxf(l0, l1), e0 = __expf(l0 - mx), e1 = __expf(l1 - mx), p0 = e0 / (e0 + e1), p1 = e1 / (e0 + e1);
                lb[(0 * 2 + dir) * 512 + c] = p0 - p0; lb[(1 * 2 + dir) * 512 + c] = (p0 + p1) - p0; }
        }
        __syncthreads();
    }
    LAS float* scr = (LAS float*)(F.lds + 49152 + F.wave * 8704);
    bf16* W = (bf16*)(F.ws + WS_W); bf16* WM = (bf16*)(F.ws + WS_WMOE);
    constexpr int N1 = 2 * 768, N2 = 2 * 144, N3 = 2 * 128, N4 = 2 * 512, N5 = 2 * 2816, N6 = 2 * 1408, N7 = 2 * 2048, N8 = 2 * 512, N9 = 8 * 3584, N10 = 8 * 1792;
    const int nfix = (j == 0) ? (N1 + N2 + N3 + N4 + N5 + N6 + N7 + N8) : 0;
    const int total = nfix + N9 + N10;
    for (int it = gw; it < total; it += NGW) {
        int r = it; const float* s0; const float* s1 = nullptr; int K, N, Np, mode = 0, item; bf16* d;
        if (r >= nfix) { r -= nfix;
            if (r < N9) { const int e = r / 3584; item = r - e * 3584; const size_t so = ((size_t)(j * 8 + e)) * 1024 * 3584; s0 = A.in[I_MG] + so; s1 = A.in[I_MU] + so; K = 1024; N = 3584; Np = 7168; mode = 2; d = WM + WM_GU + (size_t)e * 7168 * 1024; }
            else { r -= N9; const int e = r / 1792; item = r - e * 1792; s0 = A.in[I_MD] + ((size_t)(j * 8 + e)) * 3584 * 1024; K = 3584; N = 1024; Np = 1024; d = WM + WM_D + (size_t)e * 1024 * 3584; }
        } else if (r < N1) { const int b = r / 768; item = r - b * 768; s0 = A.in[I_EVWIN] + (size_t)b * 1024 * EV_IN; K = 1024; N = EV_IN; Np = EV_INP; d = W + W_EVIN + (size_t)b * EV_INP * 1024; }
        else if ((r -= N1) < N2) { const int b = r / 144; item = r - b * 144; s0 = A.in[I_WUQ] + (size_t)b * 384 * 768; K = 384; N = 768; Np = 768; mode = 1; d = W + W_UQ + (size_t)b * 768 * 384; }
        else if ((r -= N2) < N3) { const int b = r / 128; item = r - b * 128; s0 = A.in[I_WUKV] + (size_t)b * 256 * 1024; K = 256; N = 1024; Np = 1024; d = W + W_UKV + (size_t)b * 1024 * 256; }
        else if ((r -= N3) < N4) { const int b = r / 512; item = r - b * 512; s0 = A.in[I_EVWOUT] + (size_t)b * 1024 * 1024; K = 1024; N = 1024; Np = 1024; d = W + W_EVOUT + (size_t)b * 1024 * 1024; }
        else if ((r -= N4) < N5) { const int b = r / 2816; item = r - b * 2816; s0 = A.in[I_FFG] + (size_t)b * 1024 * DFF; s1 = A.in[I_FFU] + (size_t)b * 1024 * DFF; K = 1024; N = DFF; Np = 2 * DFF; mode = 2; d = W + W_FFGU + (size_t)b * 2 * DFF * 1024; }
        else if ((r -= N5) < N6) { const int b = r / 1408; item = r - b * 1408; s0 = A.in[I_FFD] + (size_t)b * DFF * 1024; K = DFF; N = 1024; Np = 1024; d = W + W_FFD + (size_t)b * 1024 * DFF; }
        else if ((r -= N6) < N7) { const int b = r / 2048; item = r - b * 2048; s0 = A.in[I_ODWIN] + (size_t)b * 1024 * 4096; K = 1024; N = 4096; Np = 4096; d = W + W_ODIN + (size_t)b * 4096 * 1024; }
        else { r -= N7; const int b = r / 512; item = r - b * 512; s0 = A.in[I_ODWOUT] + (size_t)b * 1024 * 1024; K = 1024; N = 1024; Np = 1024; d = W + W_ODOUT + (size_t)b * 1024 * 1024; }
        cvt_item(s0, s1, K, N, Np, d, mode, item, scr, F.lane);
    }
}

__device__ __forceinline__ void store_bf16_row(bf16* orow, int lane, const f32x4 (&v)[4]) {
    GAS unsigned long long* o8 = (GAS unsigned long long*)orow + lane;
#pragma unroll
    for (int j = 0; j < 4; ++j) o8[64 * j] = (unsigned long long)pkbf(v[j].x, v[j].y) | ((unsigned long long)pkbf(v[j].z, v[j].w) << 32);
}
__device__ __forceinline__ void phase_mod(Frame& F, const PArgs& A) {
    const int gw = F.vcu * NWAVES + F.wave, NGW = F.G * NWAVES;
    const float* mods = (const float*)(F.ws + WS_SMALL + SM_MODS);
    float* X = (float*)(F.ws + WS_X); bf16* H = (bf16*)(F.ws + WS_H);
    for (int m = gw; m < MROWS; m += NGW) {
        const float* src = (m < MLAT) ? A.in[I_X] + (size_t)m * 1024 : A.in[I_CTX] + (size_t)(m - MLAT) * 1024;
        const float* md = mods + (size_t)modrow(m) * 6144;
        f32x4 v[4], h[4];
#pragma unroll
        for (int j = 0; j < 4; ++j) { v[j] = *((const f32x4*)src + F.lane + 64 * j); const f32x4 sh = *((const f32x4*)md + F.lane + 64 * j), sc = *((const f32x4*)(md + 1024) + F.lane + 64 * j);
            h[j] = v[j] * (sc + 1.0f) + sh; *((f32x4*)(X + (size_t)m * 1024) + F.lane + 64 * j) = v[j]; }
        store_bf16_row(H + (size_t)m * 1024, F.lane, h);
    }
}
template <bool MOE, bool ROUTER>
__device__ __forceinline__ void phase_ln(Frame& F, const PArgs& A, const float* lng, const float* lnb, const float* mshift  , const float* g5  ,
                                         const float* router, int jodd, bool last) {
    const int gw = F.vcu * NWAVES + F.wave, NGW = F.G * NWAVES;
    float* X = (float*)(F.ws + WS_X); bf16* H = (bf16*)(F.ws + WS_H);
    int* topk = (int*)(F.ws + WS_TOPK);
    const bf16* Y = (const bf16*)(F.ws + WS_XG);
    LAS unsigned* lcnt = (LAS unsigned*)(F.lds);
    if (ROUTER) { if (F.tid < 8) lcnt[F.tid] = 0u; __syncthreads(); }
    f32x4 gv[4], bv[4];
#pragma unroll
    for (int j = 0; j < 4; ++j) { gv[j] = *((const f32x4*)lng + F.lane + 64 * j); bv[j] = *((const f32x4*)lnb + F.lane + 64 * j); }
    for (int m = gw; m < MROWS; m += NGW) {
        float* xr = X + (size_t)m * 1024; const int mr = modrow(m);
        f32x4 v[4];
#pragma unroll
        for (int j = 0; j < 4; ++j) v[j] = *((const f32x4*)xr + F.lane + 64 * j);
        if (MOE) {
            const int r1 = topk[m * 6 + 4], r2 = topk[m * 6 + 5]; const float w1 = __int_as_float(topk[m * 6 + 2]), w2 = __int_as_float(topk[m * 6 + 3]);
            const float* gg = g5 + (size_t)mr * 6144;
#pragma unroll
            for (int j = 0; j < 4; ++j) { const v2u y1 = *((const v2u*)(Y + (size_t)r1 * 1024) + F.lane + 64 * j), y2 = *((const v2u*)(Y + (size_t)r2 * 1024) + F.lane + 64 * j);
                const f32x4 gq = *((const f32x4*)gg + F.lane + 64 * j);
                f32x4 yy; yy.x = w1 * bf_lo(y1.x) + w2 * bf_lo(y2.x); yy.y = w1 * bf_hi(y1.x) + w2 * bf_hi(y2.x); yy.z = w1 * bf_lo(y1.y) + w2 * bf_lo(y2.y); yy.w = w1 * bf_hi(y1.y) + w2 * bf_hi(y2.y);
                v[j] = v[j] * ALPHA + gq * yy; }
        }
        float s = 0.f;
#pragma unroll
        for (int j = 0; j < 4; ++j) s += (v[j].x + v[j].y) + (v[j].z + v[j].w);
        const float mean = wave_sum(s, F.lane) * (1.f / 1024.f); float s2 = 0.f;
#pragma unroll
        for (int j = 0; j < 4; ++j) { v[j] = v[j] - mean; s2 += (v[j].x * v[j].x + v[j].y * v[j].y) + (v[j].z * v[j].z + v[j].w * v[j].w); }
        const float rstd = 1.f / sqrtf(wave_sum(s2, F.lane) * (1.f / 1024.f) + 1e-6f);
#pragma unroll
        for (int j = 0; j < 4; ++j) { v[j] = v[j] * rstd * gv[j] + bv[j]; *((f32x4*)xr + F.lane + 64 * j) = v[j]; }
#if defined(SELFCHK)
        if (last) { const float cn = __hip_atomic_load((const float*)(F.ctl + 12288), __ATOMIC_RELAXED, __HIP_MEMORY_SCOPE_AGENT), cd = __hip_atomic_load((const float*)(F.ctl + 12288) + 1, __ATOMIC_RELAXED, __HIP_MEMORY_SCOPE_AGENT);
            const float cscale = 1.f + sqrtf(cn / fmaxf(cd, 1e-30f));
#pragma unroll
            for (int j = 0; j < 4; ++j) v[j] = v[j] * cscale; }
#endif
        if (last) { if (m < MLAT) {
#pragma unroll
                for (int j = 0; j < 4; ++j) *((f32x4*)(A.out + (size_t)m * 1024) + F.lane + 64 * j) = v[j]; }
            continue; }
        const float* md = mshift + (size_t)mr * 6144;
#pragma unroll
        for (int j = 0; j < 4; ++j) { const f32x4 sh = *((const f32x4*)md + F.lane + 64 * j), sc = *((const f32x4*)(md + 1024) + F.lane + 64 * j); v[j] = v[j] * (sc + 1.0f) + sh; }
        store_bf16_row(H + (size_t)m * 1024, F.lane, v);
        if (ROUTER) {
            float lg[8] = {0.f, 0.f, 0.f, 0.f, 0.f, 0.f, 0.f, 0.f};
#pragma unroll
            for (int j = 0; j < 4; ++j) { const float* rp = router + (size_t)(4 * F.lane + 256 * j) * 8;
#pragma unroll
                for (int i = 0; i < 4; ++i) { const f32x4 ra = *(const f32x4*)(rp + 8 * i), rb = *(const f32x4*)(rp + 8 * i + 4); const float hv = v[j][i];
                    lg[0] += hv * ra.x; lg[1] += hv * ra.y; lg[2] += hv * ra.z; lg[3] += hv * ra.w; lg[4] += hv * rb.x; lg[5] += hv * rb.y; lg[6] += hv * rb.z; lg[7] += hv * rb.w; } }
#pragma unroll
            for (int e = 0; e < 8; ++e) lg[e] = wave_sum(lg[e], F.lane);
            int e1 = 0; float v1 = lg[0];
#pragma unroll
            for (int e = 1; e < 8; ++e) if (lg[e] > v1) { v1 = lg[e]; e1 = e; }
            int e2 = -1; float v2 = -INFINITY;
#pragma unroll
            for (int e = 0; e < 8; ++e) if (e != e1 && lg[e] > v2) { v2 = lg[e]; e2 = e; }
            const float w1 = 1.f / (1.f + __expf(v2 - v1)), w2 = 1.f - w1;
            if (F.lane == 0) { topk[m * 6 + 0] = e1; topk[m * 6 + 1] = e2; topk[m * 6 + 2] = __float_as_int(w1); topk[m * 6 + 3] = __float_as_int(w2);
                atomicAdd((unsigned*)&lcnt[e1], 1u); atomicAdd((unsigned*)&lcnt[e2], 1u); }
        }
    }
    if (ROUTER) { LDS_WAIT(); __syncthreads(); if (F.tid < 8) __hip_atomic_fetch_add((unsigned*)(F.ctl + CW_CNT + 64 * jodd) + F.tid, lcnt[F.tid], __ATOMIC_RELAXED, __HIP_MEMORY_SCOPE_AGENT); }
}
typedef short v4i16_t __attribute__((ext_vector_type(4)));
__device__ __forceinline__ int crow(int r, int hi) { return (r & 3) + 8 * (r >> 2) + 4 * hi; }
__device__ __forceinline__ float swap_max(float m) { auto rr = __builtin_amdgcn_permlane32_swap(__float_as_uint(m), __float_as_uint(m), false, false); return fmaxf(__uint_as_float(rr[0]), __uint_as_float(rr[1])); }
__device__ __forceinline__ float swap_sum(float m) { auto rr = __builtin_amdgcn_permlane32_swap(__float_as_uint(m), __float_as_uint(m), false, false); return __uint_as_float(rr[0]) + __uint_as_float(rr[1]); }

template <int DK, int MODE>
__device__ __forceinline__ void attn_unit(LAS unsigned char* lds, int tid, const bf16* Q, int qp, const bf16* K1, const bf16* V1, int nt1, const bf16* K2, const bf16* V2, int nt2,
                                          int kp, int vp, bf16* O, int op, int rq0, int kr0, const float* rpbh) {
    constexpr int KROW = DK * 2 + 16, KSZ = 64 * KROW, CPK = DK / 8  , NPK = 64 * CPK;
    constexpr int VB = 2 * KSZ, SCR = VB + 16384, BIAS = SCR + 2048;
    const int lane = tid & 63, r32 = lane & 31, hi = lane >> 5; const int wid = __builtin_amdgcn_readfirstlane(tid >> 6);
    const int NT = nt1 + nt2;
    LAS float* wsf = (LAS float*)(lds + SCR) + wid * 64;
    const int kkey0 = tid / CPK, kch0 = tid - kkey0 * CPK;
    const int kkey1 = (tid + 512) / CPK, kch1 = (tid + 512) - kkey1 * CPK;
    const bool two = (NPK > 512) && (tid + 512 < NPK);
    const int vkey = tid >> 3, vch = tid & 7;
    const int vdst = ((vkey >> 3) * 2 + (vch >> 2)) * 512 + (vkey & 7) * 64 + (vch & 3) * 16;
    v4u kreg0, kreg1 = {0u, 0u, 0u, 0u}, vreg;
#define ATT_LOAD(t) do { const int t_ = (t); const bf16* kb_ = (t_ < nt1) ? K1 + (size_t)t_ * 64 * kp : K2 + (size_t)(t_ - nt1) * 64 * kp; \
        const bf16* vb_ = (t_ < nt1) ? V1 + (size_t)t_ * 64 * vp : V2 + (size_t)(t_ - nt1) * 64 * vp; \
        kreg0 = *(const GAS v4u*)(kb_ + (size_t)kkey0 * kp + kch0 * 8); if (two) kreg1 = *(const GAS v4u*)(kb_ + (size_t)kkey1 * kp + kch1 * 8); \
        vreg = *(const GAS v4u*)(vb_ + (size_t)vkey * vp + vch * 8); } while (0)
#define ATT_STORE(buf) do { LAS unsigned char* kd_ = lds + (buf) * KSZ; *(LAS v4u*)(kd_ + kkey0 * KROW + kch0 * 16) = kreg0; if (two) *(LAS v4u*)(kd_ + kkey1 * KROW + kch1 * 16) = kreg1; \
        *(LAS v4u*)(lds + VB + (buf) * 8192 + vdst) = vreg; } while (0)
    ATT_LOAD(0);
    if (MODE == 1) { LAS float* bs = (LAS float*)(lds + BIAS); for (int i = tid; i < 15 * 31; i += NTHR) bs[i] = rpbh[i] * LOG2E; }
    bf16x8 qr[DK / 16];
#pragma unroll
    for (int d0 = 0; d0 < DK / 16; ++d0) qr[d0] = *(const GAS bf16x8*)(Q + (size_t)(wid * 32 + r32) * qp + d0 * 16 + hi * 8);
    ATT_STORE(0);
    __syncthreads();
    float m_run = -INFINITY, l_run = 0.f; f32x16 o0 = {}, o1 = {};
    const int rq = rq0 + (wid >> 1), rsq = min(max(rq - 4, 0), 120), qc = (wid & 1) * 32 + r32, cs = min(max(qc - 8, 0), 48);
    const int koff = r32 * KROW + hi * 16;
    const int vlane = (4 * hi + ((lane & 15) >> 2)) * 64 + ((lane >> 4) & 1) * 32 + (lane & 3) * 8;
    for (int t = 0; t < NT; ++t) {
        const int buf = t & 1;
        if (t + 1 < NT) ATT_LOAD(t + 1);
        bool act = true; int kr = 0;
        if (MODE == 1) { kr = kr0 + t; act = (t >= nt1) || (kr >= rsq && kr < rsq + 8); }
        if (act) {
            const LAS unsigned char* kb = lds + buf * KSZ + koff;
            f32x16 s0 = {}, s1 = {};
#pragma unroll
            for (int d0 = 0; d0 < DK / 16; ++d0) {
                const bf16x8 a0 = *(const LAS bf16x8*)(kb + d0 * 32), a1 = *(const LAS bf16x8*)(kb + 32 * KROW + d0 * 32);
                s0 = __builtin_amdgcn_mfma_f32_32x32x16_bf16(a0, qr[d0], s0, 0, 0, 0);
                s1 = __builtin_amdgcn_mfma_f32_32x32x16_bf16(a1, qr[d0], s1, 0, 0, 0);
            }
            if (MODE == 1) { if (t < nt1) {
                const LAS float* bs = (const LAS float*)(lds + BIAS) + (kr - rq + 7) * 31 - qc + 15;
#pragma unroll
                for (int r = 0; r < 16; ++r) { const int kc0 = crow(r, hi), kc1 = kc0 + 32;
                    const bool v0 = (kc0 >= cs) && (kc0 < cs + 16), v1 = (kc1 >= cs) && (kc1 < cs + 16);
                    s0[r] = v0 ? s0[r] + bs[v0 ? kc0 : cs] : -INFINITY; s1[r] = v1 ? s1[r] + bs[v1 ? kc1 : cs] : -INFINITY; } } }
            float mx = fmaxf(s0[0], s1[0]);
#pragma unroll
            for (int r = 1; r < 16; ++r) mx = fmaxf(mx, fmaxf(s0[r], s1[r]));
            mx = swap_max(mx);
            const float mnew = fmaxf(m_run, mx);
            if (__any(mnew > m_run)) {
                const float f = fast_exp2(m_run - mnew); l_run *= f; if (hi == 0) wsf[r32] = f; LDS_WAIT();
#pragma unroll
                for (int r = 0; r < 16; ++r) { const float fr_ = wsf[crow(r, hi)]; o0[r] *= fr_; o1[r] *= fr_; }
                m_run = mnew;
            }
            float ls = 0.f;
#pragma unroll
            for (int r = 0; r < 16; ++r) { s0[r] = fast_exp2(s0[r] - m_run); s1[r] = fast_exp2(s1[r] - m_run); ls += s0[r] + s1[r]; }
            l_run += ls;
            v4u pw[4];
            pw[0] = (v4u){pkbf(s0[0], s0[1]), pkbf(s0[2], s0[3]), pkbf(s0[4], s0[5]), pkbf(s0[6], s0[7])};
            pw[1] = (v4u){pkbf(s0[8], s0[9]), pkbf(s0[10], s0[11]), pkbf(s0[12], s0[13]), pkbf(s0[14], s0[15])};
            pw[2] = (v4u){pkbf(s1[0], s1[1]), pkbf(s1[2], s1[3]), pkbf(s1[4], s1[5]), pkbf(s1[6], s1[7])};
            pw[3] = (v4u){pkbf(s1[8], s1[9]), pkbf(s1[10], s1[11]), pkbf(s1[12], s1[13]), pkbf(s1[14], s1[15])};
            const LAS unsigned char* vb = lds + VB + buf * 8192 + vlane;
#pragma unroll
            for (int ks = 0; ks < 4; ++ks) {
                const bf16x8 pa = __builtin_bit_cast(bf16x8, pw[ks]);
#pragma unroll
                for (int db = 0; db < 2; ++db) {
                    const v4i16_t lo = __builtin_amdgcn_ds_read_tr16_b64_v4i16((LAS v4i16_t*)(vb + ((ks * 2 + 0) * 2 + db) * 512));
                    const v4i16_t hh = __builtin_amdgcn_ds_read_tr16_b64_v4i16((LAS v4i16_t*)(vb + ((ks * 2 + 1) * 2 + db) * 512));
                    const bf16x8 vf = (bf16x8){lo[0], lo[1], lo[2], lo[3], hh[0], hh[1], hh[2], hh[3]};
                    if (db == 0) o0 = __builtin_amdgcn_mfma_f32_32x32x16_bf16(pa, vf, o0, 0, 0, 0);
                    else         o1 = __builtin_amdgcn_mfma_f32_32x32x16_bf16(pa, vf, o1, 0, 0, 0);
                }
            }
        }
        if (t + 1 < NT) ATT_STORE(buf ^ 1);
        __syncthreads();
    }
    const float lt = swap_sum(l_run);
    if (hi == 0) wsf[32 + r32] = 1.f / lt;
    LDS_WAIT();
#pragma unroll
    for (int r = 0; r < 16; ++r) { const int q = crow(r, hi); const float il = wsf[32 + q]; bf16* orow = O + (size_t)(wid * 32 + q) * op;
        orow[r32] = f2bf(o0[r] * il); orow[32 + r32] = f2bf(o1[r] * il); }
    __syncthreads();
#undef ATT_LOAD
#undef ATT_STORE
}
__device__ __forceinline__ int hg_blk_row(int b, int blk) { return blk < 2 ? MLAT + b * CTXL + 128 * blk : b * SEQ + 128 * (blk - 2); }
__device__ __forceinline__ int hg_mc_of_blk(int dir, int blk) { return dir ? (blk < 2 ? 1 - blk : 67 - blk) : blk; }
template <int KT> __device__ __forceinline__ f32x16 mma_nt(f32x16 acc, const LAS bf16* A, int lda, const LAS bf16* Bt, int ldb, int r32, int hi) {
    const LAS bf16* ap = A + r32 * lda + 8 * hi; const LAS bf16* bp = Bt + r32 * ldb + 8 * hi;
#pragma unroll
    for (int k0 = 0; k0 < KT; k0 += 16) acc = __builtin_amdgcn_mfma_f32_32x32x16_bf16(*(const LAS bf16x8*)(ap + k0), *(const LAS bf16x8*)(bp + k0), acc, 0, 0, 0);
    return acc;
}
__device__ __forceinline__ void ldq16(const bf16* p, float (&o)[16]) {
    const v4u a = *(const GAS v4u*)p, b = *(const GAS v4u*)(p + 8);
    o[0] = bf_lo(a.x); o[1] = bf_hi(a.x); o[2] = bf_lo(a.y); o[3] = bf_hi(a.y); o[4] = bf_lo(a.z); o[5] = bf_hi(a.z); o[6] = bf_lo(a.w); o[7] = bf_hi(a.w);
    o[8] = bf_lo(b.x); o[9] = bf_hi(b.x); o[10] = bf_lo(b.y); o[11] = bf_hi(b.y); o[12] = bf_lo(b.z); o[13] = bf_hi(b.z); o[14] = bf_lo(b.w); o[15] = bf_hi(b.w);
}
__device__ __forceinline__ void ldf16(const float* p, float (&o)[16]) {
#pragma unroll
    for (int k = 0; k < 4; ++k) { const f32x4 a = *((const GAS f32x4*)p + k); o[4 * k] = a.x; o[4 * k + 1] = a.y; o[4 * k + 2] = a.z; o[4 * k + 3] = a.w; }
}
__device__ __forceinline__ void st16(LAS bf16* p, const float (&v)[16]) {
    *(LAS v4u*)p = (v4u){pkbf(v[0], v[1]), pkbf(v[2], v[3]), pkbf(v[4], v[5]), pkbf(v[6], v[7])};
    *(LAS v4u*)(p + 8) = (v4u){pkbf(v[8], v[9]), pkbf(v[10], v[11]), pkbf(v[12], v[13]), pkbf(v[14], v[15])};
}

__device__ __forceinline__ void ldq8(const bf16* p, float (&o)[8]) { const v4u a = *(const GAS v4u*)p;
    o[0] = bf_lo(a.x); o[1] = bf_hi(a.x); o[2] = bf_lo(a.y); o[3] = bf_hi(a.y); o[4] = bf_lo(a.z); o[5] = bf_hi(a.z); o[6] = bf_lo(a.w); o[7] = bf_hi(a.w); }
__device__ __forceinline__ void ldf8(const float* p, float (&o)[8]) { const f32x4 a = *(const GAS f32x4*)p, b = *((const GAS f32x4*)p + 1); o[0] = a.x; o[1] = a.y; o[2] = a.z; o[3] = a.w; o[4] = b.x; o[5] = b.y; o[6] = b.z; o[7] = b.w; }
__device__ __forceinline__ void st8(LAS bf16* p, const float (&v)[8]) { *(LAS v4u*)p = (v4u){pkbf(v[0], v[1]), pkbf(v[2], v[3]), pkbf(v[4], v[5]), pkbf(v[6], v[7])}; }

struct HgT { const bf16 *Qd, *Vd, *Sg; const float *Zf, *Zb; const float* lb  ; float* HST; float* HDM; const float* ong; bf16* OO; };

__device__ __forceinline__ void hg_a_unit(Frame& F, const HgT& T, int chain, int mc) {
    const int dir = chain & 1, h = (chain >> 1) & 3, b = chain >> 3, hoff = h * 128;
    const int row0 = hg_blk_row(b, hg_mc_of_blk(dir, mc));
    const float* Z = dir ? T.Zb : T.Zf;
    LAS float* Lf = (LAS float*)F.lds;
    LAS float* PT = (LAS float*)(F.lds + 65536);
    LAS bf16* KET = (LAS bf16*)(F.lds + 67584);
    LAS bf16* VT = (LAS bf16*)(F.lds + 67584 + 34816);
    const int tid = F.tid, lane = F.lane, r32 = lane & 31, hi = lane >> 5, wid = F.wave;
    const int ti = tid >> 2, cg = tid & 3;
#pragma unroll 1
    for (int q8 = 0; q8 < 4; ++q8) { const int e0 = 32 * cg + 8 * q8; float z[8]; ldf8(Z + (size_t)(row0 + ti) * 512 + hoff + e0, z); float lbv[8]; ldf8(T.lb + dir * 512 + hoff + e0, lbv);
#pragma unroll
        for (int k = 0; k < 8; ++k) Lf[ti * 128 + e0 + k] = __logf(lbv[k] + (1.f - lbv[k]) * sigmoidf_(z[k])); }
    __syncthreads();
    { const int e = tid & 127, p = tid >> 7; float run = 0.f;
      if (dir == 0) { for (int i = 32 * p + 31; i >= 32 * p; --i) { const float tmp = Lf[i * 128 + e]; Lf[i * 128 + e] = run; run += tmp; } }
      else          { for (int i = 32 * p; i < 32 * p + 32; ++i) { const float tmp = Lf[i * 128 + e]; Lf[i * 128 + e] = run; run += tmp; } }
      PT[p * 128 + e] = run; }
    __syncthreads();
    { const int p = ti >> 5;
#pragma unroll 1
      for (int q8 = 0; q8 < 4; ++q8) { const int e0 = 32 * cg + 8 * q8; float z[8], v[8], lbv[8]; ldf8(Z + (size_t)(row0 + ti) * 512 + hoff + e0, z); ldq8(T.Vd + (size_t)(row0 + ti) * 512 + hoff + e0, v); ldf8(T.lb + dir * 512 + hoff + e0, lbv);
#pragma unroll
        for (int k = 0; k < 8; ++k) { const int e = e0 + k; const float kk = (1.f - lbv[k]) * sigmoidf_(-z[k]);
            const float p0 = PT[e], p1 = PT[128 + e], p2 = PT[256 + e], p3 = PT[384 + e];
            float w = Lf[ti * 128 + e];
            if (dir == 0) w += (p < 3 ? p3 : 0.f) + (p < 2 ? p2 : 0.f) + (p < 1 ? p1 : 0.f); else w += (p > 0 ? p0 : 0.f) + (p > 1 ? p1 : 0.f) + (p > 2 ? p2 : 0.f);
            KET[e * 136 + ti] = f2bf(kk * __expf(w)); VT[e * 136 + ti] = f2bf(v[k]); } } }
    if (tid < 128) { const float tot = PT[tid] + PT[128 + tid] + PT[256 + tid] + PT[384 + tid]; T.HDM[((size_t)chain * 66 + mc) * 128 + tid] = __expf(tot); }
    __syncthreads();
    { const int ei = wid & 3, fp = wid >> 2; float* dst = T.HST + ((size_t)chain * 66 + mc) * 16384;
#pragma unroll
      for (int k = 0; k < 2; ++k) { const int fi = 2 * fp + k; f32x16 acc = {}; acc = mma_nt<128>(acc, KET + 32 * ei * 136, 136, VT + 32 * fi * 136, 136, r32, hi);
#pragma unroll
          for (int r = 0; r < 16; ++r) dst[(32 * ei + crow(r, hi)) * 128 + 32 * fi + r32] = acc[r]; } }
    __syncthreads();
}
__device__ __forceinline__ void phase_hg_b(Frame& F, const HgT& T) {
    const int g = F.vcu * NTHR + F.tid;
    for (int gi = g; gi < 32 * 4096; gi += F.G * NTHR) {
        const int chain = gi >> 12, idx = gi & 4095, e = idx >> 5, f4 = idx & 31;
        f32x4* base = (f32x4*)(T.HST + (size_t)chain * 66 * 16384 + e * 128) + f4; const float* dmp = T.HDM + (size_t)chain * 66 * 128 + e;
        f32x4 S = {0.f, 0.f, 0.f, 0.f};
#pragma unroll 6
        for (int mc = 0; mc < 66; ++mc) { const f32x4 kv = base[(size_t)mc * 4096]; const float d = dmp[mc * 128]; base[(size_t)mc * 4096] = S; S = S * d + kv; }
    }
}
__device__ __forceinline__ void hg_c_unit(Frame& F, const HgT& T, int b, int h, int blk) {
    const int hoff = h * 128, row0 = hg_blk_row(b, blk);
    const int tid = F.tid, lane = F.lane, r32 = lane & 31, hi = lane >> 5, wid = F.wave;
    LAS float* Lf = (LAS float*)F.lds;
    LAS bf16* P = (LAS bf16*)F.lds;
    LAS float* PT = (LAS float*)(F.lds + 32768);
    LAS float* DE = (LAS float*)(F.lds + 34816);
    LAS float* BR = (LAS float*)(F.lds + 35328);
    LAS bf16* QB = (LAS bf16*)(F.lds + 35840);
    LAS bf16* QS = (LAS bf16*)(F.lds + 53248);
    LAS bf16* KS = (LAS bf16*)(F.lds + 70656);
    LAS bf16* KET = (LAS bf16*)(F.lds + 88064);
    LAS bf16* VT = (LAS bf16*)(F.lds + 106496);
    LAS bf16* ST = (LAS bf16*)(F.lds + 124928);
    LAS float* OUT = (LAS float*)(F.lds + 35840);
    const int ti = wid & 1, fi = wid >> 1;
    const int ei = wid & 3, fp = wid >> 2;
    f32x16 oacc0 = {}, oacc1 = {};
    const int si_ = tid >> 3, e0 = 16 * (tid & 7);
#ifndef HGDIR_LO
#define HGDIR_LO 0
#define HGDIR_HI 2
#endif
#pragma unroll 1
    for (int dir = HGDIR_LO; dir < HGDIR_HI; ++dir) {
        const int chain = (b * 4 + h) * 2 + dir; const float* Z = dir ? T.Zb : T.Zf;
        const float* Sin = T.HST + ((size_t)chain * 66 + hg_mc_of_blk(dir, blk)) * 16384;
        f32x16 S[2];
#pragma unroll
        for (int k = 0; k < 2; ++k)
#pragma unroll
            for (int r = 0; r < 16; ++r) S[k][r] = Sin[(32 * ei + crow(r, hi)) * 128 + 32 * (2 * fp + k) + r32];
#pragma unroll
        for (int k = 0; k < 2; ++k)
#pragma unroll
            for (int g = 0; g < 4; ++g) *(LAS v2u*)(ST + (32 * (2 * fp + k) + r32) * 136 + 32 * ei + 8 * g + 4 * hi) = (v2u){pkbf(S[k][4 * g], S[k][4 * g + 1]), pkbf(S[k][4 * g + 2], S[k][4 * g + 3])};
#pragma unroll 1
        for (int cc = 0; cc < 2; ++cc) {
            const int ci = dir ? 1 - cc : cc; const int rowc = row0 + 64 * ci;
#pragma unroll 1
            for (int hh = 0; hh < 2; ++hh) { const int e8 = e0 + 8 * hh; float z[8], lbv[8]; ldf8(Z + (size_t)(rowc + si_) * 512 + hoff + e8, z); ldf8(T.lb + dir * 512 + hoff + e8, lbv);
#pragma unroll
              for (int k = 0; k < 8; ++k) Lf[si_ * 128 + e8 + k] = __logf(lbv[k] + (1.f - lbv[k]) * sigmoidf_(z[k])); }
            __syncthreads();
            { const int e = tid & 127, p = tid >> 7; float run = 0.f;
              if (dir == 0) { for (int i = 16 * p; i < 16 * p + 16; ++i) { run += Lf[i * 128 + e]; Lf[i * 128 + e] = run; } }
              else          { for (int i = 16 * p + 15; i >= 16 * p; --i) { run += Lf[i * 128 + e]; Lf[i * 128 + e] = run; } }
              PT[p * 128 + e] = run; }
            __syncthreads();
            if (tid < 128) { const float p0 = PT[tid], p1 = PT[128 + tid], p2 = PT[256 + tid], p3 = PT[384 + tid];
                DE[tid] = __expf(p0 + p1 + p2 + p3);
                BR[tid] = dir ? (Lf[32 * 128 + tid] + p3) : (Lf[31 * 128 + tid] + p0); }
            __syncthreads();
            { const int p = si_ >> 4;
#pragma unroll 1
              for (int hh = 0; hh < 2; ++hh) { const int e8 = e0 + 8 * hh; float z[8], q[8], v[8], lbv[8], t1[8], t2[8], t3[8];
                ldf8(Z + (size_t)(rowc + si_) * 512 + hoff + e8, z); ldq8(T.Qd + (size_t)(rowc + si_) * 512 + hoff + e8, q); ldq8(T.Vd + (size_t)(rowc + si_) * 512 + hoff + e8, v); ldf8(T.lb + dir * 512 + hoff + e8, lbv);
#pragma unroll
                for (int k = 0; k < 8; ++k) { const int e = e8 + k; const float kk = (1.f - lbv[k]) * sigmoidf_(-z[k]);
                    const float p0 = PT[e], p1 = PT[128 + e], p2 = PT[256 + e], p3 = PT[384 + e];
                    float bb = Lf[si_ * 128 + e];
                    if (dir == 0) bb += (p > 0 ? p0 : 0.f) + (p > 1 ? p1 : 0.f) + (p > 2 ? p2 : 0.f); else bb += (p < 3 ? p3 : 0.f) + (p < 2 ? p2 : 0.f) + (p < 1 ? p1 : 0.f);
                    const float bend = (p0 + p1) + (p2 + p3), br = BR[e];
                    t1[k] = q[k] * __expf(bb); t2[k] = q[k] * __expf(bb - br); t3[k] = kk * __expf(br - bb);
                    KET[e * 72 + si_] = f2bf(kk * __expf(bend - bb)); VT[e * 72 + si_] = f2bf(v[k]); }
                st8(QB + si_ * 136 + e8, t1); st8(QS + si_ * 136 + e8, t2); st8(KS + si_ * 136 + e8, t3); } }
            __syncthreads();
            if (wid < 4) { const int tb = wid & 1, sb = wid >> 1; f32x16 sc = {}; sc = mma_nt<128>(sc, QS + 32 * tb * 136, 136, KS + 32 * sb * 136, 136, r32, hi);
#pragma unroll
                for (int r = 0; r < 16; ++r) { const int t = 32 * tb + crow(r, hi), s = 32 * sb + r32; const bool keep = dir ? (s >= t) : (s <= t); P[t * 72 + s] = f2bf(keep ? sc[r] : 0.f); } }
            __syncthreads();
            { f32x16 a = ci ? oacc1 : oacc0; a = mma_nt<64>(a, P + 32 * ti * 72, 72, VT + 32 * fi * 72, 72, r32, hi); a = mma_nt<128>(a, QB + 32 * ti * 136, 136, ST + 32 * fi * 136, 136, r32, hi); if (ci) oacc1 = a; else oacc0 = a; }
            __syncthreads();
#pragma unroll
            for (int k = 0; k < 2; ++k) {
#pragma unroll
                for (int r = 0; r < 16; ++r) S[k][r] *= DE[32 * ei + crow(r, hi)];
                S[k] = mma_nt<64>(S[k], KET + 32 * ei * 72, 72, VT + 32 * (2 * fp + k) * 72, 72, r32, hi);
                asm volatile("s_nop 15\n\ts_nop 7" : "+v"(S[k]));
#pragma unroll
                for (int g = 0; g < 4; ++g) *(LAS v2u*)(ST + (32 * (2 * fp + k) + r32) * 136 + 32 * ei + 8 * g + 4 * hi) = (v2u){pkbf(S[k][4 * g], S[k][4 * g + 1]), pkbf(S[k][4 * g + 2], S[k][4 * g + 3])};
            }
            __syncthreads();
        }
#if defined(SELFCHK) && SELFCHK == 6
        { const int pair = (b == 1 && h == 2) ? 0 : (b == 3 && h == 0) ? 1 : -1;
          if (pair >= 0) {
#pragma unroll
            for (int r = 0; r < 16; ++r) { OUT[(32 * ti + crow(r, hi)) * 132 + 32 * fi + r32] = oacc0[r]; OUT[(64 + 32 * ti + crow(r, hi)) * 132 + 32 * fi + r32] = oacc1[r]; }
            __syncthreads();
            float* D = (float*)(F.ws + 1002 * MiB) + ((size_t)(dir * 2 + pair) * 8448 + (blk < 2 ? 128 * blk : 256 + 128 * (blk - 2))) * 128;
            for (int i = tid; i < 128 * 128; i += NTHR) D[i] = OUT[(i >> 7) * 132 + (i & 127)];
            __syncthreads(); } }
#endif
    }
#pragma unroll
    for (int r = 0; r < 16; ++r) { OUT[(32 * ti + crow(r, hi)) * 132 + 32 * fi + r32] = oacc0[r]; OUT[(64 + 32 * ti + crow(r, hi)) * 132 + 32 * fi + r32] = oacc1[r]; }
    __syncthreads();
    for (int k = 0; k < 16; ++k) { const int t = 16 * wid + k; const float a0 = OUT[t * 132 + lane], a1 = OUT[t * 132 + 64 + lane];
        const float ms = wave_sum(a0 * a0 + a1 * a1, lane) * (1.f / 128.f); const float rs = 1.f / sqrtf(ms + 1e-6f);
        const size_t ro = (size_t)(row0 + t) * 512 + hoff; bf16* orow = T.OO + (size_t)(row0 + t) * 1024 + 512 + hoff;
        orow[lane] = f2bf(a0 * rs * T.ong[lane] * bf2f(T.Sg[ro + lane])); orow[64 + lane] = f2bf(a1 * rs * T.ong[64 + lane] * bf2f(T.Sg[ro + 64 + lane])); }
    __syncthreads();
}
__device__ __forceinline__ void ld8(const float* p, float (&v)[8]) { const f32x4 a = *(const GAS f32x4*)p, b = *(const GAS f32x4*)(p + 4); v[0] = a.x; v[1] = a.y; v[2] = a.z; v[3] = a.w; v[4] = b.x; v[5] = b.y; v[6] = b.z; v[7] = b.w; }
__device__ __forceinline__ v4u pk8(const float (&v)[8], float s) { return (v4u){pkbf(v[0] * s, v[1] * s), pkbf(v[2] * s, v[3] * s), pkbf(v[4] * s, v[5] * s), pkbf(v[6] * s, v[7] * s)}; }
__device__ __forceinline__ void head_norm_rope(float (&v)[8], const float* g64, int l8  , bool rope, int trow, int tcol, const float* ropeA, int lane) {
    float ss = 0.f;
#pragma unroll
    for (int e = 0; e < 8; ++e) ss += v[e] * v[e];
    ss += shx(ss, 1, lane); ss += shx(ss, 2, lane); ss += shx(ss, 4, lane);
    const float rs = 1.f / sqrtf(ss * (1.f / 64.f) + 1e-6f);
#pragma unroll
    for (int e = 0; e < 8; ++e) v[e] = v[e] * rs * g64[8 * l8 + e];
    float pr[8];
#pragma unroll
    for (int e = 0; e < 8; ++e) pr[e] = shx(v[e], 2, lane);
    if (rope) { const int axis = l8 >> 2, pos = axis ? tcol : trow; const float* cs = ropeA + (pos * 16 + 8 * (l8 & 1)) * 2; const bool second = (l8 & 2) != 0;
#pragma unroll
        for (int e = 0; e < 8; ++e) { const float c_ = cs[2 * e], s_ = cs[2 * e + 1]; v[e] = second ? (v[e] * c_ + pr[e] * s_) : (v[e] * c_ - pr[e] * s_); } }
}
__device__ __forceinline__ void phase_even_post(Frame& F, const PArgs& A, int j) {
    const int gw = F.vcu * NWAVES + F.wave, NGW = F.G * NWAVES, lane = F.lane;
    const float* RAW = (const float*)(F.ws + WS_RAW);
    bf16 *QG = (bf16*)(F.ws + WS_QG), *KG = (bf16*)(F.ws + WS_KG), *VG = (bf16*)(F.ws + WS_VG), *CQN = (bf16*)(F.ws + WS_CQN), *CKVN = (bf16*)(F.ws + WS_CKVN), *KM = (bf16*)(F.ws + WS_KM);
    const float* ropeA = (const float*)(F.ws + WS_SMALL + SM_ROPEA); const float* ropeB = (const float*)(F.ws + WS_SMALL + SM_ROPEB);
    const float *qng = A.in[I_QNG] + j * 64, *kng = A.in[I_KNG] + j * 64, *cqg = A.in[I_CQG] + j * 384, *ckvg = A.in[I_CKVG] + j * 256;
    for (int m = gw; m < MROWS; m += NGW) {
        const float* r = RAW + (size_t)m * EV_INP; const bool lat = m < MLAT; const int t = m & (SEQ - 1), trow = t >> 6, tcol = t & 63;
        float v[8];
        ld8(r + 8 * lane, v); head_norm_rope(v, qng, lane & 7, lat, trow, tcol, ropeA, lane); *(GAS v4u*)(QG + (size_t)m * 512 + 8 * lane) = pk8(v, C2_64);
        { const int l = lane & 31; ld8(r + 512 + 8 * l, v); float w[8];
#pragma unroll
          for (int e = 0; e < 8; ++e) w[e] = v[e];
          head_norm_rope(w, kng, l & 7, lat, trow, tcol, ropeA, lane);
          if (lane < 16) *(GAS v4u*)(KG + (size_t)m * 128 + 8 * lane) = pk8(w, 1.f);
          else if (lane < 32) *(GAS v4u*)(VG + (size_t)m * 128 + 8 * (lane - 16)) = pk8(v, 1.f); }
        { const bool on = lane < 48; if (on) ld8(r + 768 + 8 * lane, v); float ss = 0.f;
          if (on) {
#pragma unroll
              for (int e = 0; e < 8; ++e) ss += v[e] * v[e]; }
          const float rs = 1.f / sqrtf(wave_sum(ss, lane) * (1.f / 384.f) + 1e-6f);
          if (on) {
#pragma unroll
              for (int e = 0; e < 8; ++e) v[e] = v[e] * rs * cqg[8 * lane + e];
              *(GAS v4u*)(CQN + (size_t)m * 384 + 8 * lane) = pk8(v, 1.f); } }
        { const bool on = lane < 32; if (on) ld8(r + 1152 + 8 * lane, v); float ss = 0.f;
          if (on) {
#pragma unroll
              for (int e = 0; e < 8; ++e) ss += v[e] * v[e]; }
          const float rs = 1.f / sqrtf(wave_sum(ss, lane) * (1.f / 256.f) + 1e-6f);
          if (on) {
#pragma unroll
              for (int e = 0; e < 8; ++e) v[e] = v[e] * rs * ckvg[8 * lane + e];
              *(GAS v4u*)(CKVN + (size_t)m * 256 + 8 * lane) = pk8(v, 1.f); } }
        { const int l4 = lane & 3; ld8(r + 1408 + 8 * l4, v); float pr[8];
#pragma unroll
          for (int e = 0; e < 8; ++e) pr[e] = shx(v[e], 1, lane);
          if (lat) { const int axis = l4 >> 1, pos = axis ? tcol : trow; const float* cs = ropeB + pos * 16; const bool second = (l4 & 1) != 0;
#pragma unroll
              for (int e = 0; e < 8; ++e) { const float c_ = cs[2 * e], s_ = cs[2 * e + 1]; v[e] = second ? (v[e] * c_ + pr[e] * s_) : (v[e] * c_ - pr[e] * s_); } }
          if (lane < 32) { const int head = lane >> 2; *(GAS v4u*)(KM + (size_t)m * 768 + head * 96 + 64 + 8 * l4) = pk8(v, 1.f); } }
    }
}
__device__ __forceinline__ void phase_even_attn(Frame& F) {
    const bf16 *QG = (const bf16*)(F.ws + WS_QG), *KG = (const bf16*)(F.ws + WS_KG), *VG = (const bf16*)(F.ws + WS_VG);
    const bf16 *QM = (const bf16*)(F.ws + WS_QM), *KM = (const bf16*)(F.ws + WS_KM), *VM = (const bf16*)(F.ws + WS_VM); bf16* OE = (bf16*)(F.ws + WS_OE);
    for (int u = F.vcu; u < 1024 + 32; u += F.G) {
        if (u < 1024) {
            const int qb = u & 31, hq = (u >> 5) & 3, kvh = (u >> 7) & 1, b = u >> 8, h = kvh * 4 + hq; const size_t r0 = (size_t)b * SEQ + qb * 256, kl = (size_t)b * SEQ, kc = (size_t)MLAT + b * CTXL;
            attn_unit<64, 0>(F.lds, F.tid, QG + r0 * 512 + h * 64, 512, KG + kl * 128 + kvh * 64, VG + kl * 128 + kvh * 64, 128, KG + kc * 128 + kvh * 64, VG + kc * 128 + kvh * 64, 4, 128, 128,
                             OE + r0 * 1024 + h * 64, 1024, 0, 0, nullptr);
        } else { const int id = u - 1024, h = id & 7, b = id >> 3, kvh = h >> 2; const size_t kc = (size_t)MLAT + b * CTXL;
            attn_unit<64, 0>(F.lds, F.tid, QG + kc * 512 + h * 64, 512, nullptr, nullptr, 0, KG + kc * 128 + kvh * 64, VG + kc * 128 + kvh * 64, 4, 128, 128, OE + kc * 1024 + h * 64, 1024, 0, 0, nullptr); }
    }
    for (int u = F.vcu; u < 1024 + 32; u += F.G) {
        if (u < 1024) {
            const int qb = u & 31, h = (u >> 5) & 7, b = u >> 8; const size_t r0 = (size_t)b * SEQ + qb * 256, kl = (size_t)b * SEQ, kc = (size_t)MLAT + b * CTXL;
            attn_unit<96, 0>(F.lds, F.tid, QM + r0 * 768 + h * 96, 768, KM + kl * 768 + h * 96, VM + kl * 512 + h * 64, 128, KM + kc * 768 + h * 96, VM + kc * 512 + h * 64, 4, 768, 512,
                             OE + r0 * 1024 + 512 + h * 64, 1024, 0, 0, nullptr);
        } else { const int id = u - 1024, h = id & 7, b = id >> 3; const size_t kc = (size_t)MLAT + b * CTXL;
            attn_unit<96, 0>(F.lds, F.tid, QM + kc * 768 + h * 96, 768, nullptr, nullptr, 0, KM + kc * 768 + h * 96, VM + kc * 512 + h * 64, 4, 768, 512, OE + kc * 1024 + 512 + h * 64, 1024, 0, 0, nullptr); }
    }
}
__device__ __forceinline__ void phase_odd_mix(Frame& F, const PArgs& A, const HgT& T, int j) {
    const bf16 *QN = (const bf16*)(F.ws + WS_QN), *KN = (const bf16*)(F.ws + WS_KN), *VN = (const bf16*)(F.ws + WS_VN); bf16* OO = (bf16*)(F.ws + WS_OO);
    const float* rpb = A.in[I_RPB] + (size_t)j * 8 * 15 * 31;
#ifndef NO_NA
    for (int u = F.vcu; u < 1024; u += F.G) {
        const int rg = u & 31, h = (u >> 5) & 7, b = u >> 8; const int rlo = min(max(4 * rg - 4, 0), 120), rhi = min(max(4 * rg + 3 - 4, 0), 120) + 8;
        const size_t r0 = (size_t)b * SEQ + (size_t)rg * 256, kl = (size_t)b * SEQ + (size_t)rlo * 64, kc = (size_t)MLAT + b * CTXL;
        attn_unit<64, 1>(F.lds, F.tid, QN + r0 * 512 + h * 64, 512, KN + kl * 512 + h * 64, VN + kl * 512 + h * 64, rhi - rlo, KN + kc * 512 + h * 64, VN + kc * 512 + h * 64, 4, 512, 512,
                         OO + r0 * 1024 + h * 64, 1024, 4 * rg, rlo, rpb + h * 465);
    }
#endif
    for (int u = F.vcu; u < 32; u += F.G) {
        const int h = u & 7, b = u >> 3; const size_t kc = (size_t)MLAT + b * CTXL;
        attn_unit<64, 0>(F.lds, F.tid, QN + kc * 512 + h * 64, 512, nullptr, nullptr, 0, KN + kc * 512 + h * 64, VN + kc * 512 + h * 64, 4, 512, 512, OO + kc * 1024 + h * 64, 1024, 0, 0, nullptr);
    }
#ifndef NO_HA
    for (int u = F.vcu; u < 2112; u += F.G) hg_a_unit(F, T, u / 66, u % 66);
#endif
}
__device__ __forceinline__ void moe_offsets(const gu32* cnt, int (&off)[9]) {
    int a = 0;
#pragma unroll
    for (int e = 0; e < 8; ++e) { off[e] = a; const int c = (int)__hip_atomic_load(cnt + e, __ATOMIC_RELAXED, __HIP_MEMORY_SCOPE_AGENT); a += (c + 255) & ~255; }
    off[8] = a;
}
__device__ __forceinline__ void phase_moe_dispatch(Frame& F, int j) {
    int* topk = (int*)(F.ws + WS_TOPK); const bf16* H = (const bf16*)(F.ws + WS_H); bf16* XG = (bf16*)(F.ws + WS_XG);
    LAS unsigned* lc = (LAS unsigned*)F.lds;
    LAS int* lrow = (LAS int*)(F.lds + 256);
    int off[9]; moe_offsets(F.ctl + CW_CNT + 64 * j, off);
    const int per = MROWS / 256;
    for (int c0 = F.vcu * per; c0 < MROWS; c0 += F.G * per) {
        if (F.tid < 8) lc[F.tid] = 0u;
        __syncthreads();
        int e1 = 0, e2 = 0, li1 = 0, li2 = 0; const bool on = F.tid < per;
        if (on) { e1 = topk[(c0 + F.tid) * 6]; e2 = topk[(c0 + F.tid) * 6 + 1]; li1 = (int)atomicAdd((unsigned*)&lc[e1], 1u); li2 = (int)atomicAdd((unsigned*)&lc[e2], 1u); }
        __syncthreads();
        if (F.tid < 8) lc[8 + F.tid] = __hip_atomic_fetch_add((unsigned*)(F.ctl + CW_CNT2 + 64 * j) + F.tid, lc[F.tid], __ATOMIC_RELAXED, __HIP_MEMORY_SCOPE_AGENT);
        __syncthreads();
        if (on) {
            int o1 = 0, o2 = 0;
#pragma unroll
            for (int e = 0; e < 8; ++e) { o1 = (e == e1) ? off[e] : o1; o2 = (e == e2) ? off[e] : o2; }
            const int r1 = o1 + (int)lc[8 + e1] + li1, r2 = o2 + (int)lc[8 + e2] + li2;
            topk[(c0 + F.tid) * 6 + 4] = r1; topk[(c0 + F.tid) * 6 + 5] = r2; lrow[2 * F.tid] = r1; lrow[2 * F.tid + 1] = r2;
        }
        __syncthreads();
        for (int p = F.wave; p < 2 * per; p += NWAVES) { const int tok = c0 + (p >> 1), dst = lrow[p];
            const GAS v4u* s = (const GAS v4u*)(H + (size_t)tok * 1024) + F.lane; GAS v4u* d = (GAS v4u*)(XG + (size_t)dst * 1024) + F.lane;
            const v4u a = s[0], b2 = s[64]; d[0] = a; d[64] = b2; }
        __syncthreads();
    }
}
#if defined(SELFCHK)
constexpr int CW_CHK = 12288;
__device__ __forceinline__ int chk_row(int s) {
    if (s >= 48) return MLAT + ((s - 48) * 61) % MCTX;
    const int b = s & 3; int t = (s * 683 + 17 * (s >> 2) * 97) & (SEQ - 1);
    if (s < 4) t = 0; else if (s < 8) t = SEQ - 1; else if (s < 12) t = 63; else if (s < 16) t = 64;
    return b * SEQ + t;
}
__device__ __forceinline__ void chk_accum(Frame& F, float num, float den) {
    LAS float* red = (LAS float*)(F.lds + 150000);
    __syncthreads();
    num = wave_sum(num, F.lane); den = wave_sum(den, F.lane);
    if (F.lane == 0) { red[F.wave * 2] = num; red[F.wave * 2 + 1] = den; }
    __syncthreads();
    if (F.tid == 0) { float a = 0.f, b = 0.f; for (int w = 0; w < 8; ++w) { a += red[2 * w]; b += red[2 * w + 1]; }
        atomicAdd((float*)(F.ctl + CW_CHK), a); atomicAdd((float*)(F.ctl + CW_CHK) + 1, b); }
    __syncthreads();
}
__device__ __forceinline__ float chk_rope(const LAS float* x, int d, int rot_dim, int t) {
    const int axis_dim = rot_dim / 2, half = axis_dim / 2, axis = d / axis_dim, i = d % axis_dim;
    const float pos = (float)(axis == 0 ? t / GRIDW : t % GRIDW);
    const float inv = powf(10000.f, -(float)(2 * (i % half)) / (float)axis_dim);
    const float ang = pos * inv; float sn, cs; sincos_red(ang, sn, cs);
    const float rot = (i < half) ? -x[axis * axis_dim + i + half] : x[axis * axis_dim + i - half];
    return x[d] * cs + rot * sn;
}
__device__ __forceinline__ void phase_selfcheck_even(Frame& F, const PArgs& A, int j) {
    const bf16* H = (const bf16*)(F.ws + WS_H);
    const bf16 *QG = (const bf16*)(F.ws + WS_QG), *KG = (const bf16*)(F.ws + WS_KG), *VG = (const bf16*)(F.ws + WS_VG), *CQN = (const bf16*)(F.ws + WS_CQN), *CKVN = (const bf16*)(F.ws + WS_CKVN);
    const bf16 *QM = (const bf16*)(F.ws + WS_QM), *KM = (const bf16*)(F.ws + WS_KM), *VM = (const bf16*)(F.ws + WS_VM), *OE = (const bf16*)(F.ws + WS_OE);
    LAS float* raw = (LAS float*)F.lds;
    LAS float* xn = (LAS float*)(F.lds + 8192);
    LAS float* sc = (LAS float*)(F.lds + 16384);
    LAS float* red = (LAS float*)(F.lds + 65536);
    const int tid = F.tid;
#if SELFCHK >= 5
#elif SELFCHK == 1 || SELFCHK == 2
    for (int s = F.vcu; s < 64; s += F.G) {
        const int row = chk_row(s); const bool lat = row < MLAT; const int t = row & (SEQ - 1);
        float num = 0.f, den = 0.f;
#if SELFCHK == 1
        const float* W = A.in[I_EVWIN] + (size_t)j * 1024 * EV_IN;
        for (int c = tid; c < EV_IN; c += NTHR) { float a = 0.f; for (int k = 0; k < 1024; ++k) a += bf2f(H[(size_t)row * 1024 + k]) * W[(size_t)k * EV_IN + c]; raw[c] = a; }
        __syncthreads();
        for (int c = tid; c < 640; c += NTHR) { const int hb = (c / 64) * 64, d = c % 64; float ss = 0.f; for (int k = 0; k < 64; ++k) ss += raw[hb + k] * raw[hb + k];
            const float g = (c < 512) ? A.in[I_QNG][j * 64 + d] : A.in[I_KNG][j * 64 + d]; xn[c] = raw[c] * (1.f / sqrtf(ss / 64.f + 1e-6f)) * g; }
        __syncthreads();
        for (int c = tid; c < 640; c += NTHR) { const int hb = (c / 64) * 64, d = c % 64; const float ref = lat ? chk_rope(xn + hb, d, 64, t) : xn[c];
            const float got = (c < 512) ? bf2f(QG[(size_t)row * 512 + c]) / C2_64 : bf2f(KG[(size_t)row * 128 + (c - 512)]); num += (got - ref) * (got - ref); den += ref * ref; }
        for (int c = tid; c < 128; c += NTHR) { const float ref = raw[640 + c], got = bf2f(VG[(size_t)row * 128 + c]); num += (got - ref) * (got - ref); den += ref * ref; }
        { float ss = 0.f; for (int k = 0; k < 384; ++k) ss += raw[768 + k] * raw[768 + k]; const float rs = 1.f / sqrtf(ss / 384.f + 1e-6f);
          for (int c = tid; c < 384; c += NTHR) { const float ref = raw[768 + c] * rs * A.in[I_CQG][j * 384 + c], got = bf2f(CQN[(size_t)row * 384 + c]); num += (got - ref) * (got - ref); den += ref * ref; } }
        { float ss = 0.f; for (int k = 0; k < 256; ++k) ss += raw[1152 + k] * raw[1152 + k]; const float rs = 1.f / sqrtf(ss / 256.f + 1e-6f);
          for (int c = tid; c < 256; c += NTHR) { const float ref = raw[1152 + c] * rs * A.in[I_CKVG][j * 256 + c], got = bf2f(CKVN[(size_t)row * 256 + c]); num += (got - ref) * (got - ref); den += ref * ref; } }
        for (int c = tid; c < 256; c += NTHR) { const int head = c / 32, d = c % 32; const float ref = lat ? chk_rope(raw + 1408, d, 32, t) : raw[1408 + d];
            const float got = bf2f(KM[(size_t)row * 768 + head * 96 + 64 + d]); num += (got - ref) * (got - ref); den += ref * ref; }
#else
        const float* Wq = A.in[I_WUQ] + (size_t)j * 384 * 768; const float* Wkv = A.in[I_WUKV] + (size_t)j * 256 * 1024;
        for (int c = tid; c < 768; c += NTHR) { float a = 0.f; for (int k = 0; k < 384; ++k) a += bf2f(CQN[(size_t)row * 384 + k]) * Wq[(size_t)k * 768 + c]; raw[c] = a; }
        __syncthreads();
        for (int c = tid; c < 768; c += NTHR) { const int head = c / 96, d = c % 96; const float ref = (d >= 64 && lat) ? chk_rope(raw + head * 96 + 64, d - 64, 32, t) : raw[c];
            const float got = bf2f(QM[(size_t)row * 768 + c]) / C2_96; num += (got - ref) * (got - ref); den += ref * ref; }
        for (int c = tid; c < 1024; c += NTHR) { float a = 0.f; for (int k = 0; k < 256; ++k) a += bf2f(CKVN[(size_t)row * 256 + k]) * Wkv[(size_t)k * 1024 + c];
            const int head = c / 128, d = c % 128; const float got = (d < 64) ? bf2f(KM[(size_t)row * 768 + head * 96 + d]) : bf2f(VM[(size_t)row * 512 + head * 64 + (d - 64)]); num += (got - a) * (got - a); den += a * a; }
#endif
        chk_accum(F, num, den);
    }
#elif SELFCHK == 3 || SELFCHK == 4
    for (int u = F.vcu; u < 64 * 8; u += F.G) {
        const int s = u >> 3, h = u & 7; const int row = chk_row(s); const bool lat = row < MLAT; const int b = lat ? row / SEQ : (row - MLAT) / CTXL;
        const int nk = lat ? SEQ + CTXL : CTXL;
#if SELFCHK == 3
        constexpr int DKK = 64; const bf16* qp = QG + (size_t)row * 512 + h * 64; const int kvh = h / 4;
#define CHK_K(key) (KG + (size_t)(key) * 128 + kvh * 64)
#define CHK_V(key) (VG + (size_t)(key) * 128 + kvh * 64)
        const bf16* op = OE + (size_t)row * 1024 + h * 64;
#else
        constexpr int DKK = 96; const bf16* qp = QM + (size_t)row * 768 + h * 96;
#define CHK_K(key) (KM + (size_t)(key) * 768 + h * 96)
#define CHK_V(key) (VM + (size_t)(key) * 512 + h * 64)
        const bf16* op = OE + (size_t)row * 1024 + 512 + h * 64;
#endif
        float mx = -INFINITY;
        for (int kk = tid; kk < nk; kk += NTHR) { const int key = lat ? (kk < SEQ ? b * SEQ + kk : MLAT + b * CTXL + (kk - SEQ)) : MLAT + b * CTXL + kk;
            float a = 0.f; for (int d = 0; d < DKK; ++d) a += bf2f(qp[d]) * bf2f(CHK_K(key)[d]); sc[kk] = a; mx = fmaxf(mx, a); }
#pragma unroll
        for (int o = 1; o < 64; o <<= 1) mx = fmaxf(mx, shx(mx, o, F.lane));
        if (F.lane == 0) red[F.wave] = mx;
        __syncthreads();
        mx = red[0]; for (int w = 1; w < 8; ++w) mx = fmaxf(mx, red[w]);
        float ls = 0.f;
        for (int kk = tid; kk < nk; kk += NTHR) { const float p = exp2f(sc[kk] - mx); sc[kk] = p; ls += p; }
        ls = wave_sum(ls, F.lane);
        __syncthreads();
        if (F.lane == 0) red[8 + F.wave] = ls;
        __syncthreads();
        ls = 0.f; for (int w = 0; w < 8; ++w) ls += red[8 + w];
        { const int d = tid & 63, part = tid >> 6; float a = 0.f;
          for (int kk = part; kk < nk; kk += 8) { const int key = lat ? (kk < SEQ ? b * SEQ + kk : MLAT + b * CTXL + (kk - SEQ)) : MLAT + b * CTXL + kk; a += sc[kk] * bf2f(CHK_V(key)[d]); }
          red[64 + part * 64 + d] = a; }
        __syncthreads();
        float num = 0.f, den = 0.f;
        if (tid < 64) { float a = 0.f; for (int p = 0; p < 8; ++p) a += red[64 + p * 64 + tid]; const float ref = a / ls, got = bf2f(op[tid]); num = (got - ref) * (got - ref); den = ref * ref; }
        chk_accum(F, num, den);
#undef CHK_K
#undef CHK_V
    }
#endif
}
#endif

#if defined(SELFCHK) && (SELFCHK == 5 || SELFCHK == 6 || SELFCHK == 7)
__device__ __forceinline__ void phase_selfcheck_na(Frame& F, const PArgs& A, int j) {
    const bf16 *QN = (const bf16*)(F.ws + WS_QN), *KN = (const bf16*)(F.ws + WS_KN), *VN = (const bf16*)(F.ws + WS_VN), *OO = (const bf16*)(F.ws + WS_OO);
    LAS float* sc = (LAS float*)(F.lds + 16384); LAS float* red = (LAS float*)(F.lds + 65536); LAS int* kid = (LAS int*)(F.lds + 32768);
    const int tid = F.tid;
    for (int u = F.vcu; u < 64 * 8; u += F.G) {
        const int s = u >> 3, h = u & 7; const int row = chk_row(s); const bool lat = row < MLAT; const int b = lat ? row / SEQ : (row - MLAT) / CTXL;
        const bf16* qp = QN + (size_t)row * 512 + h * 64; const float* rpb = A.in[I_RPB] + ((size_t)j * 8 + h) * 15 * 31;
        int nk = CTXL;
        if (lat) { nk = 128 + CTXL; const int t = row % SEQ, r = t / GRIDW, cc = t % GRIDW;
            const int rs = min(max(r - 4, 0), 128 - 8), cs = min(max(cc - 8, 0), GRIDW - 16);
            for (int w = tid; w < 128; w += NTHR) { const int i = w / 16, jj = w % 16; const int kr = rs + i, kc = cs + jj; kid[w] = b * SEQ + kr * GRIDW + kc;
                sc[1024 + w] = rpb[(kr - r + 7) * 31 + (kc - cc + 15)] * LOG2E; }
            for (int w = tid; w < CTXL; w += NTHR) { kid[128 + w] = MLAT + b * CTXL + w; sc[1024 + 128 + w] = 0.f; }
        } else { for (int w = tid; w < CTXL; w += NTHR) { kid[w] = MLAT + b * CTXL + w; sc[1024 + w] = 0.f; } }
        __syncthreads();
        float mx = -INFINITY;
        for (int kk = tid; kk < nk; kk += NTHR) { const bf16* kp = KN + (size_t)kid[kk] * 512 + h * 64; float a = 0.f; for (int d = 0; d < 64; ++d) a += bf2f(qp[d]) * bf2f(kp[d]); a += sc[1024 + kk]; sc[kk] = a; mx = fmaxf(mx, a); }
#pragma unroll
        for (int o = 1; o < 64; o <<= 1) mx = fmaxf(mx, shx(mx, o, F.lane));
        if (F.lane == 0) red[F.wave] = mx;
        __syncthreads();
        mx = red[0]; for (int w = 1; w < 8; ++w) mx = fmaxf(mx, red[w]);
        float ls = 0.f;
        for (int kk = tid; kk < nk; kk += NTHR) { const float p = exp2f(sc[kk] - mx); sc[kk] = p; ls += p; }
        ls = wave_sum(ls, F.lane);
        __syncthreads();
        if (F.lane == 0) red[8 + F.wave] = ls;
        __syncthreads();
        ls = 0.f; for (int w = 0; w < 8; ++w) ls += red[8 + w];
        { const int d = tid & 63, part = tid >> 6; float a = 0.f;
          for (int kk = part; kk < nk; kk += 8) a += sc[kk] * bf2f(VN[(size_t)kid[kk] * 512 + h * 64 + d]);
          red[64 + part * 64 + d] = a; }
        __syncthreads();
        float num = 0.f, den = 0.f;
        if (tid < 64) { float a = 0.f; for (int p = 0; p < 8; ++p) a += red[64 + p * 64 + tid]; const float ref = a / ls, got = bf2f(OO[(size_t)row * 1024 + h * 64 + tid]); num = (got - ref) * (got - ref); den = ref * ref; }
        chk_accum(F, num, den);
    }
}
constexpr size_t WS_CHKO = WS_END;
__device__ __forceinline__ int chk_seq_row(int b, int dir, int sq) { if (sq < CTXL) return MLAT + b * CTXL + (dir ? CTXL - 1 - sq : sq); const int jq = sq - CTXL; return b * SEQ + (dir ? SEQ - 1 - jq : jq); }
__device__ __forceinline__ void phase_selfcheck_hg_scan(Frame& F, const PArgs& A, int j) {
    if (F.vcu >= 4) return;
    const int c = F.vcu, dir = c & 1, pair = c >> 1; const int b = pair ? 3 : 1, h = pair ? 0 : 2, hoff = h * 128;
    const bf16 *Qd = (const bf16*)(F.ws + WS_QD), *Vd = (const bf16*)(F.ws + WS_VD); const float* Z = (const float*)(F.ws + (dir ? WS_ZB : WS_ZF));
    float* OF = (float*)(F.ws + WS_CHKO) + (size_t)c * 8448 * 128;
    LAS float* vec = (LAS float*)F.lds;
    LAS float* part = (LAS float*)(F.lds + 4096);
    const int tid = F.tid, f = tid & 127, eq = tid >> 7;
    float S[32];
#pragma unroll
    for (int i = 0; i < 32; ++i) S[i] = 0.f;
    for (int sq = 0; sq < CTXL + SEQ; ++sq) {
        const int row = chk_seq_row(b, dir, sq);
        if (tid < 128) { const int ch = hoff + tid; const float l0 = A.in[I_LBL][(dir * 2 + 0) * 512 + ch], l1 = A.in[I_LBL][(dir * 2 + 1) * 512 + ch];
            const float m = fmaxf(l0, l1), p0 = expf(l0 - m) / (expf(l0 - m) + expf(l1 - m)), p1 = expf(l1 - m) / (expf(l0 - m) + expf(l1 - m)); const float lb = (j == 0) ? 0.f : (p0 + p1) - p0;
            const float z = Z[(size_t)row * 512 + ch]; const float sg = 1.f / (1.f + expf(-z));
            vec[tid] = bf2f(Qd[(size_t)row * 512 + ch]); vec[128 + tid] = (1.f - lb) * (1.f / (1.f + expf(z))); vec[256 + tid] = bf2f(Vd[(size_t)row * 512 + ch]); vec[384 + tid] = lb + (1.f - lb) * sg; }
        __syncthreads();
        float o = 0.f; const float vf = vec[256 + f];
#pragma unroll
        for (int i = 0; i < 32; ++i) { const int e = eq * 32 + i; S[i] = vec[384 + e] * S[i] + vec[128 + e] * vf; o += S[i] * vec[e]; }
        part[eq * 128 + f] = o;
        __syncthreads();
        if (tid < 128) OF[(size_t)sq * 128 + tid] = part[tid] + part[128 + tid] + part[256 + tid] + part[384 + tid];
    }
}
__device__ __forceinline__ void phase_selfcheck_hg_cmp(Frame& F, const PArgs& A, int j) {
    const bf16 *Sg = (const bf16*)(F.ws + WS_SG), *OO = (const bf16*)(F.ws + WS_OO); const float* OF = (const float*)(F.ws + WS_CHKO);
    const int gw = F.vcu * NWAVES + F.wave, NGW = F.G * NWAVES;
    float num = 0.f, den = 0.f;
    for (int it = gw; it < 2 * 8448; it += NGW) { const int pair = it / 8448, sq = it % 8448; const int b = pair ? 3 : 1, h = pair ? 0 : 2, hoff = h * 128;
        const int row = chk_seq_row(b, 0, sq);
        const int sqb = (sq < CTXL) ? (CTXL - 1 - sq) : (CTXL + (SEQ - 1 - (sq - CTXL)));
        const float* of = OF + ((size_t)(pair * 2 + 0) * 8448 + sq) * 128; const float* ob = OF + ((size_t)(pair * 2 + 1) * 8448 + sqb) * 128;
        const float* D0 = (const float*)(F.ws + 1002 * MiB) + ((size_t)(0 * 2 + pair) * 8448 + sq) * 128; const float* D1 = (const float*)(F.ws + 1002 * MiB) + ((size_t)(1 * 2 + pair) * 8448 + sq) * 128;
#ifndef CHKSEL
#define CHKSEL 0
#endif
        (void)row; (void)Sg; (void)OO;
#pragma unroll
        for (int q2 = 0; q2 < 2; ++q2) { const int ff = F.lane + 64 * q2;
            const float ref = (CHKSEL != 1) ? of[ff] : ob[ff]; const float got = (CHKSEL != 1) ? D0[ff] : (D1[ff] - D0[ff]);
            const bool use = (CHKSEL == 10) ? (sq < 64) : (CHKSEL == 11) ? (sq >= 64 && sq < 128) : (CHKSEL == 12) ? (sq >= 128 && sq < 256) : (CHKSEL == 13) ? (sq >= 256 && ((sq & 127) < 64)) : (CHKSEL == 14) ? (sq >= 256 && ((sq & 127) >= 64)) : true;
            if (use) { num += (got - ref) * (got - ref); den += ref * ref; } } }
    chk_accum(F, num, den);
}
#endif
constexpr int PH_CV = 0, PH_MOD = 1, PH_E1 = 2, PH_E2 = 3, PH_E3 = 4, PH_E5 = 5, PH_E6 = 6, PH_E7 = 7, PH_E8 = 8, PH_E9 = 9, PH_E10 = 10,
              PH_O1 = 11, PH_O2 = 12, PH_O3 = 13, PH_O4 = 14, PH_O5 = 15, PH_O6 = 16, PH_O7 = 17, PH_O8 = 18, PH_O9 = 19, PH_O10 = 20, PH_PER = 21;
constexpr int NPHASES = 2 * PH_PER;

__global__ void __launch_bounds__(NTHR, 2) mk_fwd(Args args) {
    extern __shared__ __attribute__((aligned(16))) unsigned char lds[];
    Frame F;
    F.lds = (LAS unsigned char*)lds; F.ws = args.ws; F.ctl = (gu32*)(args.ws + WS_CTL);
    F.tid = threadIdx.x; F.lane = F.tid & 63; F.wave = __builtin_amdgcn_readfirstlane(F.tid >> 6);
    F.G = gridDim.x; { const int bx = blockIdx.x; F.vcu = (F.G % 8 == 0) ? (bx % 8) * (F.G / 8) + bx / 8 : bx; }
    volatile LAS unsigned* MISC = (volatile LAS unsigned*)(F.lds + MISC_OFF);
    if (F.tid < 64) MISC[F.tid] = 0u;
    { LAS unsigned long long* tab = (LAS unsigned long long*)(F.lds + MISC_OFF + 256);
      if (F.tid == 0) {
#pragma unroll
          for (int i = 0; i < 30; ++i) tab[i] = (unsigned long long)args.in[i];
          tab[30] = (unsigned long long)args.out; } }
    __syncthreads();
    const int lo = args.ph_lo, hi = args.ph_hi; const int wv0 = F.wave;
    const bool multi = (hi - lo) > 1;
    XcdBarrier bar; bar.bar = (unsigned*)(F.ctl + CW_BAR); bar.x = 0; bar.st = nullptr;
    if (multi) bar = xcd_barrier_post((unsigned*)(F.ctl + CW_BAR), MISC + 8);
#ifndef PHMASK
#define PHMASK 0x1fffff
#endif
#define IN(k) ((((PHMASK) >> ((k) % PH_PER)) & 1) && lo <= (k) && (k) < hi)
#define MKT HgT T; T.Qd = (const bf16*)(ws + WS_QD); T.Vd = (const bf16*)(ws + WS_VD); T.Sg = (const bf16*)(ws + WS_SG); T.Zf = (const float*)(ws + WS_ZF); T.Zb = (const float*)(ws + WS_ZB); \
    T.lb = (const float*)(ws + WS_SMALL + SM_LB) + j * 1024; T.HST = (float*)(ws + WS_HST); T.HDM = (float*)(ws + WS_HDM); T.ong = PA.in[I_ONG] + j * 128; T.OO = (bf16*)(ws + WS_OO);
#define FRESH() int t_; asm volatile("v_mbcnt_lo_u32_b32 %0, -1, 0\n\tv_mbcnt_hi_u32_b32 %0, -1, %0" : "=v"(t_)); t_ += wv0 * 64; F.tid = t_; F.lane = t_ & 63; F.wave = __builtin_amdgcn_readfirstlane(t_ >> 6); \
    unsigned char* ws = ws0; asm volatile("" : "+s"(ws)); F.ws = ws; F.ctl = (gu32*)(ws + WS_CTL); PArgs PA; PA.in.t = (LAS unsigned long long*)(F.lds + MISC_OFF + 256); PA.out = (float*)PA.in[30]; \
    float* mods = (float*)(ws + WS_SMALL + SM_MODS); bf16* W = (bf16*)(ws + WS_W); bf16* WM = (bf16*)(ws + WS_WMOE); bf16* H = (bf16*)(ws + WS_H); float* X = (float*)(ws + WS_X); \
    const float* modE = mods + (size_t)Le * 5 * 6144; const float* modO = mods + (size_t)Lo * 5 * 6144; (void)W; (void)WM; (void)H; (void)X; (void)modE; (void)modO;
#define SEAM(k) do { if (IN(k) && IN((k) + 1)) xcd_barrier(bar); } while (0)
    unsigned char* const ws0 = args.ws;
#pragma unroll 1
    for (int j = 0; j < 2; ++j) {
        const int pb = j * PH_PER, Le = 2 * j, Lo = 2 * j + 1;
        if (IN(pb + PH_CV)) { FRESH(); phase_cv(F, PA, j); } SEAM(pb + PH_CV);
        if (IN(pb + PH_MOD)) { FRESH(); if (j == 0) phase_mod(F, PA); } SEAM(pb + PH_MOD);
        if (IN(pb + PH_E1)) { FRESH();
            pg8::Gemm g{H, W + W_EVIN + (size_t)j * EV_INP * 1024, MROWS, EV_INP, 1024}; pg8::StaticOrder S; S.init(MROWS, EV_INP, F.G, (int)blockIdx.x);
            pg8::EpiRawF32 E{(float*)(ws + WS_RAW), EV_INP};
            pg8::gemm_phase<pg8::EpiRawF32, pg8::StaticOrder, true, true>(F.lds, g, S, E, F.tid);
        } SEAM(pb + PH_E1);
        if (IN(pb + PH_E2)) { FRESH(); phase_even_post(F, PA, j); } SEAM(pb + PH_E2);
        if (IN(pb + PH_E3)) { FRESH();
            { pg8::Gemm g{(const bf16*)(ws + WS_CQN), W + W_UQ + (size_t)j * 768 * 384, MROWS, 768, 384}; pg8::StaticOrder S; S.init(MROWS, 768, F.G, (int)blockIdx.x);
              pg8::EpiMlaQ E{(bf16*)(ws + WS_QM), (const float*)(ws + WS_SMALL + SM_ROPEB)};
              pg8::gemm_phase<pg8::EpiMlaQ, pg8::StaticOrder, true, true>(F.lds, g, S, E, F.tid); }
            { asm volatile("v_mbcnt_lo_u32_b32 %0, -1, 0\n\tv_mbcnt_hi_u32_b32 %0, -1, %0" : "=v"(t_)); t_ += wv0 * 64; F.tid = t_; F.lane = t_ & 63;
              pg8::Gemm g{(const bf16*)(ws + WS_CKVN), W + W_UKV + (size_t)j * 1024 * 256, MROWS, 1024, 256}; pg8::StaticOrder S; S.init(MROWS, 1024, F.G, (int)blockIdx.x);
              pg8::EpiMlaKV E{(bf16*)(ws + WS_KM), (bf16*)(ws + WS_VM)};
              pg8::gemm_phase<pg8::EpiMlaKV, pg8::StaticOrder, true, true>(F.lds, g, S, E, F.tid); }
        } SEAM(pb + PH_E3);
        if (IN(pb + PH_E5)) { FRESH(); phase_even_attn(F); } SEAM(pb + PH_E5);
#if defined(SELFCHK)
        if (IN(pb + PH_E6)) { FRESH(); phase_selfcheck_even(F, PA, j); }
#endif
        if (IN(pb + PH_E6)) { FRESH();
            pg8::Gemm g{(const bf16*)(ws + WS_OE), W + W_EVOUT + (size_t)j * 1024 * 1024, MROWS, 1024, 1024}; pg8::StaticOrder S; S.init(MROWS, 1024, F.G, (int)blockIdx.x);
            pg8::EpiResid E{X, modE + 2 * 1024};
            pg8::gemm_phase<pg8::EpiResid, pg8::StaticOrder, true, true>(F.lds, g, S, E, F.tid);
        } SEAM(pb + PH_E6);
        if (IN(pb + PH_E7)) { FRESH(); phase_ln<false, false>(F, PA, PA.in[I_LN1G] + Le * 1024, PA.in[I_LN1B] + Le * 1024, modE + 3 * 1024, nullptr, nullptr, 0, false); } SEAM(pb + PH_E7);
        if (IN(pb + PH_E8)) { FRESH();
            pg8::Gemm g{H, W + W_FFGU + (size_t)j * 2 * DFF * 1024, MROWS, 2 * DFF, 1024}; pg8::StaticOrder S; S.init(MROWS, 2 * DFF, F.G, (int)blockIdx.x);
            pg8::EpiSwiglu E{(bf16*)(ws + WS_FFH), DFF};
            pg8::gemm_phase<pg8::EpiSwiglu, pg8::StaticOrder, true, true>(F.lds, g, S, E, F.tid);
        } SEAM(pb + PH_E8);
        if (IN(pb + PH_E9)) { FRESH();
            pg8::Gemm g{(const bf16*)(ws + WS_FFH), W + W_FFD + (size_t)j * 1024 * DFF, MROWS, 1024, DFF}; pg8::StaticOrder S; S.init(MROWS, 1024, F.G, (int)blockIdx.x);
            pg8::EpiResid E{X, modE + 5 * 1024};
            pg8::gemm_phase<pg8::EpiResid, pg8::StaticOrder, true, true>(F.lds, g, S, E, F.tid);
        } SEAM(pb + PH_E9);
        if (IN(pb + PH_E10)) { FRESH(); phase_ln<false, false>(F, PA, PA.in[I_LN2G] + Le * 1024, PA.in[I_LN2B] + Le * 1024, modO + 0 * 1024, nullptr, nullptr, 0, false); } SEAM(pb + PH_E10);
        if (IN(pb + PH_O1)) { FRESH();
            pg8::Gemm g{H, W + W_ODIN + (size_t)j * 4096 * 1024, MROWS, 4096, 1024}; pg8::StaticOrder S; S.init(MROWS, 4096, F.G, (int)blockIdx.x);
            pg8::EpiOddIn E{(bf16*)(ws + WS_QN), (bf16*)(ws + WS_KN), (bf16*)(ws + WS_VN), (bf16*)(ws + WS_QD), (bf16*)(ws + WS_VD), (bf16*)(ws + WS_SG), (float*)(ws + WS_ZF), (float*)(ws + WS_ZB)};
            pg8::gemm_phase<pg8::EpiOddIn, pg8::StaticOrder, true, true>(F.lds, g, S, E, F.tid);
        } SEAM(pb + PH_O1);
        if (IN(pb + PH_O2)) { FRESH(); MKT phase_odd_mix(F, PA, T, j); } SEAM(pb + PH_O2);
        if (IN(pb + PH_O3)) { FRESH(); MKT phase_hg_b(F, T); } SEAM(pb + PH_O3);
        if (IN(pb + PH_O4)) { FRESH(); MKT for (int u = F.vcu; u < 16 * 66; u += F.G) hg_c_unit(F, T, u / 264, (u / 66) & 3, u % 66); } SEAM(pb + PH_O4);
#if defined(SELFCHK) && SELFCHK == 5
        if (IN(pb + PH_O5)) { FRESH(); phase_selfcheck_na(F, PA, j); }
#endif
#if defined(SELFCHK) && SELFCHK == 6
#ifndef CHKJ
#define CHKJ j
#endif
        if (IN(pb + PH_O5) && j == (CHKJ)) { { FRESH(); phase_selfcheck_hg_scan(F, PA, j); } xcd_barrier(bar); { FRESH(); phase_selfcheck_hg_cmp(F, PA, j); } }
#endif
        if (IN(pb + PH_O5)) { FRESH();
            pg8::Gemm g{(const bf16*)(ws + WS_OO), W + W_ODOUT + (size_t)j * 1024 * 1024, MROWS, 1024, 1024}; pg8::StaticOrder S; S.init(MROWS, 1024, F.G, (int)blockIdx.x);
            pg8::EpiResid E{X, modO + 2 * 1024};
            pg8::gemm_phase<pg8::EpiResid, pg8::StaticOrder, true, true>(F.lds, g, S, E, F.tid);
        } SEAM(pb + PH_O5);
        if (IN(pb + PH_O6)) { FRESH(); phase_ln<false, true>(F, PA, PA.in[I_LN1G] + Lo * 1024, PA.in[I_LN1B] + Lo * 1024, modO + 3 * 1024, nullptr, PA.in[I_ROUTER] + (size_t)j * 1024 * 8, j, false); } SEAM(pb + PH_O6);
        if (IN(pb + PH_O7)) { FRESH(); phase_moe_dispatch(F, j); } SEAM(pb + PH_O7);
        if (IN(pb + PH_O8)) { FRESH();
            int off[9]; moe_offsets(F.ctl + CW_CNT + 64 * j, off);
            pg8::GroupedOrder S; S.nM = off[8] >> 8; S.nN = 2 * DFFE / 256; S.nwg = S.nM * S.nN; S.G = F.G; S.c = (int)blockIdx.x; S.estride = (long)2 * DFFE * 1024 * 2;
#pragma unroll
            for (int e = 0; e < 9; ++e) S.toff[e] = off[e] >> 8;
            pg8::Gemm g{(const bf16*)(ws + WS_XG), WM + WM_GU, MOE_ROWS, 2 * DFFE, 1024};
            pg8::EpiSwiglu E{(bf16*)(ws + WS_MH), DFFE};
            pg8::gemm_phase<pg8::EpiSwiglu, pg8::GroupedOrder, true, true>(F.lds, g, S, E, F.tid);
        } SEAM(pb + PH_O8);
        if (IN(pb + PH_O9)) { FRESH();
            int off[9]; moe_offsets(F.ctl + CW_CNT + 64 * j, off);
            pg8::GroupedOrder S; S.nM = off[8] >> 8; S.nN = 1024 / 256; S.nwg = S.nM * S.nN; S.G = F.G; S.c = (int)blockIdx.x; S.estride = (long)1024 * DFFE * 2;
#pragma unroll
            for (int e = 0; e < 9; ++e) S.toff[e] = off[e] >> 8;
            pg8::Gemm g{(const bf16*)(ws + WS_MH), WM + WM_D, MOE_ROWS, 1024, DFFE};
            pg8::EpiPlainBf16 E{(bf16*)(ws + WS_XG), 1024};
            pg8::gemm_phase<pg8::EpiPlainBf16, pg8::GroupedOrder, true, true>(F.lds, g, S, E, F.tid);
        } SEAM(pb + PH_O9);
        if (IN(pb + PH_O10)) { FRESH(); phase_ln<true, false>(F, PA, PA.in[I_LN2G] + Lo * 1024, PA.in[I_LN2B] + Lo * 1024, mods + (size_t)(j == 0 ? 2 : 0) * 5 * 6144, modO + 5 * 1024, nullptr, 0, j == 1); }
        if (j == 0) SEAM(pb + PH_O10);
    }
#undef IN
#undef SEAM
}

extern "C" void kernel_launch(void* const* d_in, const int* in_sizes, int n_in, void* d_out, int out_size, void* d_ws, size_t ws_size, hipStream_t stream) {
    static int grid = 0;
    if (grid == 0) {
        if (n_in != 30 || in_sizes[0] != MLAT * DM || out_size != MLAT * DM || ws_size < WS_END) { fprintf(stderr, "kernel_launch: unexpected shapes / workspace (n_in %d, ws %zu)\n", n_in, ws_size); grid = -1; return; }
        int dev = 0, cus = 0, per_cu = 0;
        if (hipGetDevice(&dev) != hipSuccess || hipDeviceGetAttribute(&cus, hipDeviceAttributeMultiprocessorCount, dev) != hipSuccess) { grid = -1; return; }
        if (hipFuncSetAttribute((const void*)mk_fwd, hipFuncAttributeMaxDynamicSharedMemorySize, LDS_BYTES) != hipSuccess) { fprintf(stderr, "kernel_launch: hipFuncSetAttribute failed\n"); grid = -1; return; }
        if (hipOccupancyMaxActiveBlocksPerMultiprocessor(&per_cu, (const void*)mk_fwd, NTHR, LDS_BYTES) != hipSuccess || per_cu < 1) { fprintf(stderr, "kernel_launch: occupancy query says %d\n", per_cu); }
        (void)hipGetLastError();
        grid = cus;
        if (grid != 256) { fprintf(stderr, "kernel_launch: built for 256 CUs, found %d\n", cus); grid = -1; return; }
    }
    if (grid < 0) return;
    if (hipMemsetAsync((char*)d_ws + WS_CTL, 0, CTL_ZERO_BYTES, stream) != hipSuccess) return;
    Args a{};
    for (int i = 0; i < 30; ++i) a.in[i] = (const float*)d_in[i];
    a.out = (float*)d_out; a.ws = (unsigned char*)d_ws;
#if MK_MULTI
    for (int ph = 0; ph < NPHASES; ++ph) {
        if (ph == PH_PER + PH_MOD) continue;
        a.ph_lo = ph; a.ph_hi = ph + 1;
        hipLaunchKernelGGL(mk_fwd, dim3(grid), dim3(NTHR), LDS_BYTES, stream, a);
    }
#else
    a.ph_lo = 0; a.ph_hi = NPHASES;
    hipLaunchKernelGGL(mk_fwd, dim3(grid), dim3(NTHR), LDS_BYTES, stream, a);
#endif
}
```

```cpp
#include <hip/hip_runtime.h>
#include <cstdio>
#include <cstdint>

#ifndef MK_MULTI
#define MK_MULTI 0
#endif

constexpr int DM = 1024, NB = 4, SEQ = 8192, CTXL = 256, GRIDW = 64;
constexpr int MLAT = NB * SEQ, MCTX = NB * CTXL, MROWS = MLAT + MCTX;
constexpr int DEPTH = 4;
constexpr int EV_IN = 1440, EV_INP = 1536;
constexpr int DFF = 2816, DFFE = 3584, NEXP = 8;
constexpr int MOE_ROWS = 2 * MROWS + NEXP * 256;
constexpr float ALPHA = 1.6817928305074290f;
constexpr float LOG2E = 1.4426950408889634f;
constexpr float C2_64 = 0.125f * LOG2E;
constexpr float C2_96 = 0.10206207261596577f * LOG2E;

constexpr size_t MiB = 1u << 20;
constexpr size_t WS_CTL = 0, CTL_ZERO_BYTES = 1 * MiB;
constexpr size_t WS_SMALL = 2 * MiB;
constexpr size_t WS_TOPK = 4 * MiB;
constexpr size_t WS_W = 6 * MiB;
constexpr size_t WS_WMOE = 72 * MiB;
constexpr size_t WS_X = 240 * MiB;
constexpr size_t WS_H = 372 * MiB;
constexpr size_t WS_S = 438 * MiB;
constexpr size_t WS_RAW = WS_S;
constexpr size_t WS_QG = 636 * MiB, WS_KG = 669 * MiB, WS_VG = 678 * MiB, WS_CQN = 687 * MiB, WS_CKVN = 712 * MiB;
constexpr size_t WS_QM = 729 * MiB, WS_KM = 779 * MiB, WS_VM = 829 * MiB, WS_OE = 862 * MiB;
constexpr size_t WS_FFH = WS_S;
constexpr size_t WS_QN = 438 * MiB, WS_KN = 471 * MiB, WS_VN = 504 * MiB, WS_QD = 537 * MiB, WS_VD = 570 * MiB, WS_SG = 603 * MiB;
constexpr size_t WS_ZF = 636 * MiB, WS_ZB = 702 * MiB, WS_OO = 768 * MiB, WS_HST = 834 * MiB, WS_HDM = 966 * MiB;
constexpr size_t WS_MH = 372 * MiB;
constexpr size_t WS_XG = 848 * MiB;
constexpr size_t WS_XG8 = 612 * MiB;
constexpr size_t WS_ZR = 700 * MiB;
constexpr size_t WS_END = 984 * MiB;
static_assert(WS_QG >= WS_RAW + (size_t)MROWS * EV_INP * 4 && WS_OE + (size_t)MROWS * 2048 <= 984 * MiB, "even map");
static_assert(WS_HST + (size_t)32 * 66 * 65536 <= WS_HDM && WS_HDM + (size_t)32 * 66 * 512 <= WS_END, "odd map");
static_assert(WS_MH + (size_t)MOE_ROWS * DFFE <= WS_XG8 && WS_XG8 + (size_t)MOE_ROWS * 1024 <= WS_XG && WS_XG + (size_t)MOE_ROWS * 2048 <= WS_END, "moe map");
constexpr size_t SM_MODS = 0;
constexpr size_t SM_ROPEA = 512 * 1024;
constexpr size_t SM_ROPEB = SM_ROPEA + 16384;
constexpr size_t SM_LB = SM_ROPEB + 8192;
constexpr size_t W_EVIN = 0;
constexpr size_t W_UQ = W_EVIN + (size_t)2 * 1536 * 1024;
constexpr size_t W_UKV = W_UQ + (size_t)2 * 768 * 384;
constexpr size_t W_EVOUT = W_UKV + (size_t)2 * 1024 * 256;
constexpr size_t W_FFGU = W_EVOUT + (size_t)2 * 1024 * 1024;
constexpr size_t W_FFD = W_FFGU + (size_t)2 * 5632 * 1024;
constexpr size_t W_ODIN = W_FFD + (size_t)2 * 1024 * 2816;
constexpr size_t W_ODOUT = W_ODIN + (size_t)2 * 4096 * 1024;
constexpr size_t W_ENDE = W_ODOUT + (size_t)2 * 1024 * 1024;
static_assert(W_ENDE * 2 <= 66 * MiB, "weights map");
constexpr size_t WM_GU = 0;
constexpr size_t WM_D = (size_t)8 * 7168 * 1024;
#ifndef FFN_F8
#define FFN_F8 true
#endif
constexpr float MOE_WSCALE = 64.f;
constexpr int CW_BAR = 4096;
constexpr int CW_CNT = 8192;
constexpr int CW_CNT2 = 8192 + 256;
constexpr int LDS_BYTES = 160256;
constexpr int MISC_OFF = LDS_BYTES - 512;
constexpr int NWAVES = 8, NTHR = 512;

#define GAS __attribute__((address_space(1)))
#define LAS __attribute__((address_space(3)))
typedef unsigned short bf16;
typedef unsigned v4u __attribute__((ext_vector_type(4)));
typedef unsigned v2u __attribute__((ext_vector_type(2)));
typedef float f32x4 __attribute__((ext_vector_type(4)));
typedef float f32x16 __attribute__((ext_vector_type(16)));
typedef short bf16x8 __attribute__((ext_vector_type(8)));
typedef short s16x4 __attribute__((ext_vector_type(4)));
typedef GAS unsigned gu32;

typedef float f32x2_t __attribute__((ext_vector_type(2))); typedef __bf16 bf16x2_t __attribute__((ext_vector_type(2)));
__device__ __forceinline__ unsigned pkbf(float lo, float hi) { f32x2_t v = {lo, hi}; bf16x2_t b = __builtin_convertvector(v, bf16x2_t); return __builtin_bit_cast(unsigned, b); }
typedef _Float16 h16x2 __attribute__((ext_vector_type(2)));
typedef _Float16 h16x4 __attribute__((ext_vector_type(4)));
typedef float f32x2v __attribute__((ext_vector_type(2)));
__device__ __forceinline__ unsigned pkh(float a, float b) { return __builtin_bit_cast(unsigned, __builtin_convertvector((f32x2v){a, b}, h16x2)); }
__device__ __forceinline__ float bf_lo(unsigned u) { return __uint_as_float(u << 16); }
__device__ __forceinline__ float bf_hi(unsigned u) { return __uint_as_float(u & 0xffff0000u); }
__device__ __forceinline__ float bf2f(bf16 h) { return __uint_as_float(((unsigned)h) << 16); }
__device__ __forceinline__ bf16 f2bf(float f) { return (bf16)(pkbf(f, 0.f) & 0xffffu); }
__device__ __forceinline__ float fast_exp2(float x) { return __builtin_amdgcn_exp2f(x); }
__device__ __forceinline__ float frcp(float x) { return __builtin_amdgcn_rcpf(x); }
__device__ __forceinline__ float sigmoidf_(float x) { return frcp(1.f + __expf(-x)); }
__device__ __forceinline__ float siluf_(float x) { return x * frcp(1.f + __expf(-x)); }
__device__ __forceinline__ float shx(float v, int m, int lane) { return __int_as_float(__builtin_amdgcn_ds_bpermute((lane ^ m) << 2, __float_as_int(v))); }
__device__ __forceinline__ float wave_sum(float v, int lane) {
#pragma unroll
    for (int o = 1; o < 64; o <<= 1) v += shx(v, o, lane);
    return v;
}
__device__ __forceinline__ int modrow(int row) { return row < MLAT ? (row >> 13) : 4; }
namespace pg8 {
#define PG8_LAS __attribute__((address_space(3)))
typedef unsigned short bf16_t;
typedef short bf16x8 __attribute__((ext_vector_type(8)));
typedef float f32x4 __attribute__((ext_vector_type(4)));
typedef unsigned u32x4 __attribute__((ext_vector_type(4)));
constexpr int BM = 256, BK = 64, HALF = 128, HTB = HALF * BK * 2  , STAGE_BYTES = 8 * HTB, NXCD = 8, WGM = 8;

__host__ __device__ __forceinline__ int lds_byte(int r, int c) { const int st = (r >> 4) * 2 + (c >> 5), rr = r & 15, cc = c & 31, ob = rr * 64 + cc * 2; return st * 1024 + (ob ^ (((ob >> 9) & 1) << 5)); }
__host__ __device__ __forceinline__ void stage_rc(int b, int& R, int& C) { const int st = b / 1024, sb = b % 1024, swz = sb ^ (((sb >> 9) & 1) << 5); R = (st >> 1) * 16 + swz / 64; C = (st & 1) * 32 + (swz % 64) / 2; }
__host__ __device__ __forceinline__ int perm32(int rho) { const int n = rho >> 4, i = rho & 15; return 8 * (i >> 2) + 4 * n + (i & 3); }

struct Unit { int pm, pn; long boff; };
struct Gemm { const bf16_t* A; const bf16_t* Bt; int M, N, K; };

struct StaticOrder {
    int nM, nN, nwg, G, c;
    __host__ __device__ void init(int M, int N, int G_, int c_) { nM = M / BM; nN = N / BM; nwg = nM * nN; G = G_; c = c_; }
    __host__ __device__ bool next(int i, Unit& u) const {
        const long L = (long)i * G + c; if (L >= nwg) return false;
        int wgid = (int)L; { const int q = nwg / NXCD, r = nwg % NXCD, xcd = wgid % NXCD, off = wgid / NXCD; wgid = (xcd < r ? xcd * (q + 1) : r * (q + 1) + (xcd - r) * q) + off; }
        const int nig = WGM * nN, gid = wgid / nig, fm = gid * WGM, gsz = (nM - fm) < WGM ? (nM - fm) : WGM;
        u.pm = fm + ((wgid % nig) % gsz); u.pn = (wgid % nig) / gsz; u.boff = 0; return true;
    }
    __device__ __forceinline__ void a_ready(const Unit&) const {}
    __device__ __forceinline__ void done(const Unit&) const {}
};

__device__ __forceinline__ unsigned cvt_pk_bf16(float lo, float hi) { return pkbf(lo, hi); }
typedef float f32x2 __attribute__((ext_vector_type(2)));
template <class Epi, class Sched, bool ALIGN_EPI = false, bool SP2 = false, bool F8 = false>
__device__ __forceinline__ void gemm_phase(PG8_LAS unsigned char* lds, const Gemm g, const Sched& S, const Epi& E, int tid_in) {
    int tid_ = tid_in; asm volatile("" : "+v"(tid_));
    const int tid = tid_, wid = __builtin_amdgcn_readfirstlane(tid >> 6), lane = tid & 63, wr = wid >> 2, wc = wid & 3, fr = lane & 15, fq = lane >> 4;
    const int K = g.K, nt = K / BK;
    unsigned voffA[2], voffB[2];
#pragma unroll
    for (int i = 0; i < 2; ++i) { int R, C; stage_rc(tid * 16 + i * 8192, R, C); const int Rb = Epi::PERM ? ((R & ~31) + perm32(R & 31)) : R;
        voffA[i] = (unsigned)(R * K + C) * 2u; voffB[i] = (unsigned)(Rb * K + C) * 2u; }
    const size_t kstep = (size_t)(BK * 2);
    const size_t hstep = (size_t)HALF * K * 2;
    const size_t tstep = 2 * hstep;
    const unsigned ldsw = (unsigned)wid * 1024u;
    const int aoff = lds_byte(wr * 64 + fr, fq * 8), boff = lds_byte(wc * 32 + fr, fq * 8);
#define PG8_SA(b, h) (((b) * 2 + (h)) * HTB)
#define PG8_SB(b, h) ((4 + (b) * 2 + (h)) * HTB)
#define PG8_STAGE(bufoff, gbase, voff) do { _Pragma("unroll") for (int _i = 0; _i < 2; ++_i) \
        __builtin_amdgcn_global_load_lds((const unsigned*)((const char*)(gbase) + (voff)[_i]), (PG8_LAS unsigned*)(lds + (bufoff) + ldsw + _i * 8192), 16, 0, 0); } while (0)
#define PG8_LDA(dst, b, h) do { if constexpr (F8) { _Pragma("unroll") for (int m = 0; m < 4; ++m) dst##8[m] = __builtin_shufflevector(*(const PG8_LAS v4i_*)(lds + PG8_SA(b, h) + aoff + m * 2048), *(const PG8_LAS v4i_*)(lds + PG8_SA(b, h) + aoff + m * 2048 + 1024), 0, 1, 2, 3, 4, 5, 6, 7); } \
        else { _Pragma("unroll") for (int m = 0; m < 4; ++m) _Pragma("unroll") for (int k = 0; k < 2; ++k) dst[m][k] = *(const PG8_LAS bf16x8*)(lds + PG8_SA(b, h) + aoff + m * 2048 + k * 1024); } } while (0)
#define PG8_LDB(dst, b, h) do { if constexpr (F8) { _Pragma("unroll") for (int n = 0; n < 2; ++n) dst##8[n] = __builtin_shufflevector(*(const PG8_LAS v4i_*)(lds + PG8_SB(b, h) + boff + n * 2048), *(const PG8_LAS v4i_*)(lds + PG8_SB(b, h) + boff + n * 2048 + 1024), 0, 1, 2, 3, 4, 5, 6, 7); } \
        else { _Pragma("unroll") for (int n = 0; n < 2; ++n) _Pragma("unroll") for (int k = 0; k < 2; ++k) dst[n][k] = *(const PG8_LAS bf16x8*)(lds + PG8_SB(b, h) + boff + n * 2048 + k * 1024); } } while (0)
#define PG8_MMA(ai, bj, At, Bt) do { __builtin_amdgcn_s_setprio(1); _Pragma("unroll") for (int m = 0; m < 4; ++m) _Pragma("unroll") for (int n = 0; n < 2; ++n) { \
        if constexpr (F8) { asm volatile("v_mfma_f32_16x16x128_f8f6f4 %0, %1, %2, %0" : "+v"(acc[ai][bj][m][n]) : "v"(Bt##8[n]), "v"(At##8[m])); } \
        else { _Pragma("unroll") for (int k = 0; k < 2; ++k) acc[ai][bj][m][n] = __builtin_amdgcn_mfma_f32_16x16x32_bf16(Bt[n][k], At[m][k], acc[ai][bj][m][n], 0, 0, 0); } } \
        __builtin_amdgcn_s_setprio(0); } while (0)
#define PG8_WAIT_V(n) asm volatile("s_waitcnt vmcnt(" #n ")" ::: "memory")
#define PG8_WAIT_L(n) asm volatile("s_waitcnt lgkmcnt(" #n ")" ::: "memory")
#define PG8_BAR __builtin_amdgcn_s_barrier()
#define PG8_SCHED __builtin_amdgcn_sched_barrier(0)
    Unit cur, nxt; int ui = 0;
    if (!S.next(0, cur)) return;
    f32x4 acc[2][2][4][2];
#pragma unroll
    for (int a = 0; a < 2; ++a)
#pragma unroll
        for (int b = 0; b < 2; ++b)
#pragma unroll
            for (int m = 0; m < 4; ++m)
#pragma unroll
                for (int n = 0; n < 2; ++n) acc[a][b][m][n] = (f32x4){0.f, 0.f, 0.f, 0.f};
    typedef int v4i_ __attribute__((ext_vector_type(4))); typedef int v8i_ __attribute__((ext_vector_type(8)));
    bf16x8 At[4][2], B0[2][2], B1[2][2]; v8i_ At8[4], B08[2], B18[2];
    const char* cA = (const char*)g.A + (size_t)cur.pm * tstep; const char* cB = (const char*)g.Bt + (size_t)cur.pn * tstep + cur.boff;
    S.a_ready(cur);
    if constexpr (SP2) {
        PG8_STAGE(PG8_SB(0, 0), cB, voffB); PG8_STAGE(PG8_SB(0, 1), cB + hstep, voffB); PG8_STAGE(PG8_SA(0, 0), cA, voffA); PG8_STAGE(PG8_SA(0, 1), cA + hstep, voffA);
        if (wr == 1) PG8_BAR;
        PG8_WAIT_V(2); PG8_BAR;
        PG8_STAGE(PG8_SB(1, 0), cB + kstep, voffB); PG8_STAGE(PG8_SA(1, 0), cA + kstep, voffA); PG8_STAGE(PG8_SB(1, 1), cB + hstep + kstep, voffB);
        PG8_WAIT_V(6); PG8_BAR;
    } else {
        PG8_STAGE(PG8_SB(0, 0), cB, voffB); PG8_STAGE(PG8_SA(0, 0), cA, voffA); PG8_STAGE(PG8_SB(0, 1), cB + hstep, voffB); PG8_STAGE(PG8_SA(0, 1), cA + hstep, voffA);
        if (wr == 1) PG8_BAR;
        PG8_WAIT_V(4); PG8_BAR;
        PG8_STAGE(PG8_SB(1, 0), cB + kstep, voffB); PG8_STAGE(PG8_SA(1, 0), cA + kstep, voffA); PG8_STAGE(PG8_SB(1, 1), cB + hstep + kstep, voffB);
        PG8_WAIT_V(6); PG8_BAR;
    }
    for (;;) {
        const bool has_next = S.next(ui + 1, nxt);
        const char* nA = has_next ? (const char*)g.A + (size_t)nxt.pm * tstep : cA; const char* nB = has_next ? (const char*)g.Bt + (size_t)nxt.pn * tstep + nxt.boff : cB;
        for (int t = 0; t < nt; t += 2) {
            const bool last = (t == nt - 2);
            const char* a1 = cA + (size_t)(t + 1) * kstep;
            const char* a2 = last ? nA : cA + (size_t)(t + 2) * kstep; const char* b2 = last ? nB : cB + (size_t)(t + 2) * kstep;
            const char* a3 = a2 + kstep; const char* b3 = b2 + kstep;
            if (last && has_next) S.a_ready(nxt);
            if constexpr (SP2) {
            PG8_LDB(B0, 0, 0); PG8_LDB(B1, 0, 1); PG8_SCHED; PG8_LDA(At, 0, 0); PG8_STAGE(PG8_SA(1, 1), a1 + hstep, voffA);
            PG8_WAIT_V(8); PG8_WAIT_L(0); PG8_BAR; PG8_MMA(0, 0, At, B0); PG8_MMA(0, 1, At, B1); PG8_BAR; PG8_SCHED;
            PG8_LDA(At, 0, 1); PG8_STAGE(PG8_SB(0, 0), b2, voffB); PG8_STAGE(PG8_SB(0, 1), b2 + hstep, voffB); PG8_STAGE(PG8_SA(0, 0), a2, voffA);
            PG8_WAIT_V(8); PG8_WAIT_L(0); PG8_BAR; PG8_MMA(1, 0, At, B0); PG8_MMA(1, 1, At, B1); PG8_BAR; PG8_SCHED;
            PG8_LDB(B0, 1, 0); PG8_LDB(B1, 1, 1); PG8_SCHED; PG8_LDA(At, 1, 0); PG8_STAGE(PG8_SA(0, 1), a2 + hstep, voffA);
            PG8_WAIT_V(8); PG8_WAIT_L(0); PG8_BAR; PG8_MMA(0, 0, At, B0); PG8_MMA(0, 1, At, B1); PG8_BAR; PG8_SCHED;
            PG8_LDA(At, 1, 1); PG8_STAGE(PG8_SB(1, 0), b3, voffB); PG8_STAGE(PG8_SB(1, 1), b3 + hstep, voffB); PG8_STAGE(PG8_SA(1, 0), a3, voffA);
            PG8_WAIT_V(8); PG8_WAIT_L(0); PG8_BAR; PG8_MMA(1, 0, At, B0); PG8_MMA(1, 1, At, B1); PG8_BAR; PG8_SCHED;
            } else {
            PG8_LDB(B0, 0, 0); PG8_SCHED; PG8_LDA(At, 0, 0); PG8_STAGE(PG8_SA(1, 1), a1 + hstep, voffA);
            PG8_WAIT_L(8); PG8_BAR; PG8_WAIT_L(0); PG8_MMA(0, 0, At, B0); PG8_BAR; PG8_SCHED;
            PG8_LDB(B1, 0, 1); PG8_STAGE(PG8_SB(0, 0), b2, voffB);
            PG8_BAR; PG8_WAIT_L(0); PG8_MMA(0, 1, At, B1); PG8_BAR;
            PG8_LDA(At, 0, 1); PG8_STAGE(PG8_SA(0, 0), a2, voffA);
            PG8_BAR; PG8_WAIT_L(0); PG8_MMA(1, 0, At, B0); PG8_BAR; PG8_SCHED;
            PG8_STAGE(PG8_SB(0, 1), b2 + hstep, voffB);
            PG8_WAIT_V(6); PG8_BAR; PG8_MMA(1, 1, At, B1); PG8_BAR;
            PG8_LDB(B0, 1, 0); PG8_SCHED; PG8_LDA(At, 1, 0); PG8_STAGE(PG8_SA(0, 1), a2 + hstep, voffA);
            PG8_WAIT_L(8); PG8_BAR; PG8_WAIT_L(0); PG8_MMA(0, 0, At, B0); PG8_BAR; PG8_SCHED;
            PG8_LDB(B1, 1, 1); PG8_STAGE(PG8_SB(1, 0), b3, voffB);
            PG8_BAR; PG8_WAIT_L(0); PG8_MMA(0, 1, At, B1); PG8_BAR;
            PG8_LDA(At, 1, 1); PG8_STAGE(PG8_SA(1, 0), a3, voffA);
            PG8_BAR; PG8_WAIT_L(0); PG8_MMA(1, 0, At, B0); PG8_BAR; PG8_SCHED;
            PG8_STAGE(PG8_SB(1, 1), b3 + hstep, voffB);
            PG8_WAIT_V(6); PG8_BAR; PG8_MMA(1, 1, At, B1); PG8_BAR;
            }
        }
        if constexpr (ALIGN_EPI) { if (wr == 0) PG8_BAR; }
        if constexpr (!Epi::AFTER_DRAIN) { int l2_; asm volatile("v_mbcnt_lo_u32_b32 %0, -1, 0\n\tv_mbcnt_hi_u32_b32 %0, -1, %0" : "=v"(l2_)); const int fr2 = l2_ & 15, fq2 = l2_ >> 4;     E(acc, cur, wr, wc, fr2, fq2); S.done(cur); }
        if (!has_next) break;
#pragma unroll
        for (int a = 0; a < 2; ++a)
#pragma unroll
            for (int b = 0; b < 2; ++b)
#pragma unroll
                for (int m = 0; m < 4; ++m)
#pragma unroll
                    for (int n = 0; n < 2; ++n) acc[a][b][m][n] = (f32x4){0.f, 0.f, 0.f, 0.f};
        cur = nxt; cA = nA; cB = nB; ++ui;
        if constexpr (ALIGN_EPI) { if (wr == 1) PG8_BAR; }
    }
    PG8_WAIT_V(0);
    if constexpr (!ALIGN_EPI) { if (wr == 0) PG8_BAR; }
    PG8_BAR;
    if constexpr (Epi::AFTER_DRAIN) { E.fused(acc, cur, wr, wc, fr, fq, lds, wid, lane); S.done(cur); }
#undef PG8_SA
#undef PG8_SB
#undef PG8_STAGE
#undef PG8_LDA
#undef PG8_LDB
#undef PG8_MMA
#undef PG8_WAIT_V
#undef PG8_WAIT_L
#undef PG8_BAR
#undef PG8_SCHED
}
}
namespace pg8 {
constexpr int NEXP_ = 8;
template <class F> __device__ __forceinline__ void walk8(const f32x4 (&acc)[2][2][4][2], const Unit& u, int wr, int wc, int fr, int fq, const F& f) {
    asm volatile("s_nop 15\n\ts_nop 15\n\ts_nop 15\n\ts_nop 7" ::: "memory");
    const int row0 = u.pm * BM + wr * 64 + fr, col0 = u.pn * BM + wc * 32 + 8 * fq;
#pragma unroll
    for (int ai = 0; ai < 2; ++ai)
#pragma unroll
        for (int m = 0; m < 4; ++m)
#pragma unroll
            for (int bj = 0; bj < 2; ++bj) {
                const f32x4 a = acc[ai][bj][m][0], b = acc[ai][bj][m][1];
                float v[8] = {a[0], a[1], a[2], a[3], b[0], b[1], b[2], b[3]};
                f.emit(row0 + ai * HALF + m * 16, col0 + bj * HALF, v);
                asm volatile("" ::: "memory");
            }
}
__device__ __forceinline__ u32x4 pack8(const float (&v)[8], float s) {
    u32x4 w; w.x = cvt_pk_bf16(v[0] * s, v[1] * s); w.y = cvt_pk_bf16(v[2] * s, v[3] * s); w.z = cvt_pk_bf16(v[4] * s, v[5] * s); w.w = cvt_pk_bf16(v[6] * s, v[7] * s); return w;
}
struct EpiRawF32 {
    static constexpr bool PERM = true, AFTER_DRAIN = false;
    float* O; int ldc;
    __device__ __forceinline__ void emit(int row, int col, const float (&v)[8]) const {
        float* p = O + (size_t)row * ldc + col; *(f32x4*)p = (f32x4){v[0], v[1], v[2], v[3]}; *(f32x4*)(p + 4) = (f32x4){v[4], v[5], v[6], v[7]};
    }
    __device__ __forceinline__ void operator()(const f32x4 (&acc)[2][2][4][2], const Unit& u, int wr, int wc, int fr, int fq) const { walk8(acc, u, wr, wc, fr, fq, *this); }
};
struct EpiPlainBf16 {
    static constexpr bool PERM = true, AFTER_DRAIN = false;
    bf16_t* O; int ldc;
    __device__ __forceinline__ void emit(int row, int col, const float (&v)[8]) const { *(u32x4*)(O + (size_t)row * ldc + col) = pack8(v, 1.f); }
    __device__ __forceinline__ void operator()(const f32x4 (&acc)[2][2][4][2], const Unit& u, int wr, int wc, int fr, int fq) const { walk8(acc, u, wr, wc, fr, fq, *this); }
};
struct EpiMlaQ {
    static constexpr bool PERM = true, AFTER_DRAIN = false;
    bf16_t* Qm; const float* ropeB;
    __device__ __forceinline__ void emit(int row, int col, const float (&v)[8]) const {
        const int head = col / 96, c = col - head * 96;
        bf16_t* q = Qm + (size_t)row * 768 + head * 96;
        const bool isr = c >= 64;
        const int g = (c - 64) >> 3, axis = g >> 1, base = axis * 16 + (g & 1) * 4;
        f32x4 cs0 = {1.f, 0.f, 1.f, 0.f}, cs1 = {1.f, 0.f, 1.f, 0.f};
        if (isr && row < MLAT) { const int t = row & (SEQ - 1), pos = axis ? (t & 63) : (t >> 6); const float* cs = ropeB + (pos * 8 + (g & 1) * 4) * 2; cs0 = *(const f32x4*)cs; cs1 = *(const f32x4*)(cs + 4); }
        const float o10 = v[0] * cs0[0] - v[4] * cs0[1], o20 = v[4] * cs0[0] + v[0] * cs0[1], o11 = v[1] * cs0[2] - v[5] * cs0[3], o21 = v[5] * cs0[2] + v[1] * cs0[3];
        const float o12 = v[2] * cs1[0] - v[6] * cs1[1], o22 = v[6] * cs1[0] + v[2] * cs1[1], o13 = v[3] * cs1[2] - v[7] * cs1[3], o23 = v[7] * cs1[2] + v[3] * cs1[3];
        typedef unsigned u32x2 __attribute__((ext_vector_type(2)));
        u32x2 w1, w2; w1.x = cvt_pk_bf16(o10 * C2_96, o11 * C2_96); w1.y = cvt_pk_bf16(o12 * C2_96, o13 * C2_96); w2.x = cvt_pk_bf16(o20 * C2_96, o21 * C2_96); w2.y = cvt_pk_bf16(o22 * C2_96, o23 * C2_96);
        bf16_t* p1 = isr ? q + 64 + base : q + c; bf16_t* p2 = isr ? q + 64 + base + 8 : q + c + 4;
        *(u32x2*)p1 = w1; *(u32x2*)p2 = w2;
    }
    __device__ __forceinline__ void operator()(const f32x4 (&acc)[2][2][4][2], const Unit& u, int wr, int wc, int fr, int fq) const { walk8(acc, u, wr, wc, fr, fq, *this); }
};
struct EpiMlaKV {
    static constexpr bool PERM = true, AFTER_DRAIN = false;
    bf16_t* Km; bf16_t* Vm;
    __device__ __forceinline__ void emit(int row, int col, const float (&v)[8]) const {
        const int head = col >> 7, c = col & 127;
        if (c < 64) *(u32x4*)(Km + (size_t)row * 768 + head * 96 + c) = pack8(v, 1.f);
        else        *(u32x4*)(Vm + (size_t)row * 512 + head * 64 + (c - 64)) = pack8(v, 1.f);
    }
    __device__ __forceinline__ void operator()(const f32x4 (&acc)[2][2][4][2], const Unit& u, int wr, int wc, int fr, int fq) const { walk8(acc, u, wr, wc, fr, fq, *this); }
};
struct EpiResid {
    static constexpr bool PERM = true, AFTER_DRAIN = false;
    bf16_t* Z; const float* gate; const void* bl; const void* bc; bool src16;
    __device__ __forceinline__ void emit(int row, int col, const float (&v)[8]) const {
        const float* g = gate + (size_t)(row < MLAT ? (row >> 13) : 4) * 6144 + col;
        const size_t qo = (row < MLAT ? (size_t)row * 1024 : (size_t)(row - MLAT) * 1024) + col; const void* qb = row < MLAT ? bl : bc;
        f32x4 x0, x1;
        if (src16) { const u32x4 r = *(const u32x4*)((const bf16_t*)qb + qo); typedef _Float16 h16x8_ __attribute__((ext_vector_type(8))); typedef float f32x8_ __attribute__((ext_vector_type(8)));
            const f32x8_ xf = __builtin_convertvector(__builtin_bit_cast(h16x8_, r), f32x8_); x0 = (f32x4){xf[0], xf[1], xf[2], xf[3]}; x1 = (f32x4){xf[4], xf[5], xf[6], xf[7]}; }
        else { const float* q = (const float*)qb + qo; x0 = *(const f32x4*)q; x1 = *(const f32x4*)(q + 4); }
        const f32x4 g0 = *(const f32x4*)g, g1 = *(const f32x4*)(g + 4);
        const f32x4 z0 = x0 * ALPHA + g0 * (f32x4){v[0], v[1], v[2], v[3]}, z1 = x1 * ALPHA + g1 * (f32x4){v[4], v[5], v[6], v[7]};
        *(u32x4*)(Z + (size_t)row * 1024 + col) = (u32x4){pkh(z0[0], z0[1]), pkh(z0[2], z0[3]), pkh(z1[0], z1[1]), pkh(z1[2], z1[3])};
    }
    __device__ __forceinline__ void operator()(const f32x4 (&acc)[2][2][4][2], const Unit& u, int wr, int wc, int fr, int fq) const { walk8(acc, u, wr, wc, fr, fq, *this); }
};
struct EpiSwiglu {
    static constexpr bool PERM = true, AFTER_DRAIN = false;
    bf16_t* Hd; int ldh;
    __device__ __forceinline__ void emit(int row, int col, const float (&v)[8]) const {
        float h[4];
#pragma unroll
        for (int e = 0; e < 4; ++e) h[e] = v[e] * __builtin_amdgcn_rcpf(1.f + __expf(-v[e])) * v[e + 4];
        typedef unsigned u32x2 __attribute__((ext_vector_type(2)));
        u32x2 w; w.x = cvt_pk_bf16(h[0], h[1]); w.y = cvt_pk_bf16(h[2], h[3]);
        *(u32x2*)(Hd + (size_t)row * ldh + (col >> 1)) = w;
    }
    __device__ __forceinline__ void operator()(const f32x4 (&acc)[2][2][4][2], const Unit& u, int wr, int wc, int fr, int fq) const { walk8(acc, u, wr, wc, fr, fq, *this); }
};
struct EpiOddIn {
    static constexpr bool PERM = true, AFTER_DRAIN = false;
    bf16_t *Qn, *Kn, *Vn, *Qd, *Vd, *Sg; float *Zf, *Zb;
    __device__ __forceinline__ void emit(int row, int col, const float (&v)[8]) const {
        const int sec = col >> 9, c = col & 511; const size_t o = (size_t)row * 512 + c;
        if (sec == 0) { *(u32x4*)(Qn + o) = pack8(v, C2_64); }
        else if (sec == 1) { *(u32x4*)(Kn + o) = pack8(v, 1.f); }
        else if (sec == 2) { *(u32x4*)(Vn + o) = pack8(v, 1.f); }
        else if (sec == 4) { *(u32x4*)(Vd + o) = pack8(v, 1.f); }
        else if (sec == 5 || sec == 6) { float* p = (sec == 5 ? Zf : Zb) + o; *(f32x4*)p = (f32x4){v[0], v[1], v[2], v[3]}; *(f32x4*)(p + 4) = (f32x4){v[4], v[5], v[6], v[7]}; }
        else { float s[8];
#pragma unroll
            for (int e = 0; e < 8; ++e) s[e] = v[e] * __builtin_amdgcn_rcpf(1.f + __expf(-v[e]));
            *(u32x4*)((sec == 3 ? Qd : Sg) + o) = pack8(s, 1.f); }
    }
    __device__ __forceinline__ void operator()(const f32x4 (&acc)[2][2][4][2], const Unit& u, int wr, int wc, int fr, int fq) const { walk8(acc, u, wr, wc, fr, fq, *this); }
};
struct EpiSwigluS {
    static constexpr bool PERM = true, AFTER_DRAIN = false;
    bf16_t* Hd; int ldh; float s;
    __device__ __forceinline__ void emit(int row, int col, const float (&v)[8]) const {
        float h[4]; const float c1 = -s * 1.4426950408889634f, k2 = 1.f / (s * s);
#pragma unroll
        for (int e = 0; e < 4; ++e) h[e] = (v[e] * v[e + 4]) * __builtin_amdgcn_rcpf(__builtin_fmaf(__builtin_amdgcn_exp2f(v[e] * c1), k2, k2));
        typedef unsigned u32x2 __attribute__((ext_vector_type(2)));
        u32x2 w; w.x = cvt_pk_bf16(h[0], h[1]); w.y = cvt_pk_bf16(h[2], h[3]);
        *(u32x2*)(Hd + (size_t)row * ldh + (col >> 1)) = w;
    }
    __device__ __forceinline__ void operator()(const f32x4 (&acc)[2][2][4][2], const Unit& u, int wr, int wc, int fr, int fq) const { walk8(acc, u, wr, wc, fr, fq, *this); }
};
struct EpiSwigluF8 {
    static constexpr bool PERM = true, AFTER_DRAIN = false;
    unsigned char* Hd; int ldh; float s;
    __device__ __forceinline__ void emit(int row, int col, const float (&v)[8]) const {
        float h[4]; const float c1 = -s * 1.4426950408889634f, k2 = 1.f / (s * s);
#pragma unroll
        for (int e = 0; e < 4; ++e) h[e] = (v[e] * v[e + 4]) * __builtin_amdgcn_rcpf(__builtin_fmaf(__builtin_amdgcn_exp2f(v[e] * c1), k2, k2));
        unsigned w = 0u; w = __builtin_amdgcn_cvt_pk_fp8_f32(h[0], h[1], w, false); w = __builtin_amdgcn_cvt_pk_fp8_f32(h[2], h[3], w, true);
        *(unsigned*)(Hd + (size_t)row * ldh + (col >> 1)) = w;
    }
    __device__ __forceinline__ void operator()(const f32x4 (&acc)[2][2][4][2], const Unit& u, int wr, int wc, int fr, int fq) const { walk8(acc, u, wr, wc, fr, fq, *this); }
};
struct EpiScaledBf16 {
    static constexpr bool PERM = true, AFTER_DRAIN = false;
    bf16_t* O; int ldc; float s;
    __device__ __forceinline__ void emit(int row, int col, const float (&v)[8]) const { *(u32x4*)(O + (size_t)row * ldc + col) = pack8(v, s); }
    __device__ __forceinline__ void operator()(const f32x4 (&acc)[2][2][4][2], const Unit& u, int wr, int wc, int fr, int fq) const { walk8(acc, u, wr, wc, fr, fq, *this); }
};
struct GroupedOrder {
    int nM, nN, nwg, G, c; int toff[NEXP_ + 1]; long estride;
    __device__ __forceinline__ bool next(int i, Unit& u) const {
        const long L = (long)i * G + c; if (L >= nwg) return false;
        int wgid = (int)L; { const int q = nwg / NXCD, r = nwg % NXCD, xcd = wgid % NXCD, off = wgid / NXCD; wgid = (xcd < r ? xcd * (q + 1) : r * (q + 1) + (xcd - r) * q) + off; }
        const int nig = WGM * nN, gid = wgid / nig, fm = gid * WGM, gsz = (nM - fm) < WGM ? (nM - fm) : WGM;
        u.pm = fm + ((wgid % nig) % gsz); u.pn = (wgid % nig) / gsz;
        int e = 0;
#pragma unroll
        for (int k = 1; k < NEXP_; ++k) e += (u.pm >= toff[k]) ? 1 : 0;
        u.boff = (long)e * estride; return true;
    }
    __device__ __forceinline__ void a_ready(const Unit&) const {}
    __device__ __forceinline__ void done(const Unit&) const {}
};
}
#define XB_TMO      128
#define XB_XCNT(j)  (256  + 64 * (j))
#define XB_XSUB(j)  (1280 + 64 * (j))
#define XB_XGEN(j)  (2304 + 64 * (j))
#define XB_TOP      3328
#define XB_TOPGEN   3392
#define XCD_BAR_WORDS 3456
#define XB_SPIN_CAP (1u << 18)

__device__ __forceinline__ unsigned xb_ld(unsigned* p)              { return __hip_atomic_load(p, __ATOMIC_RELAXED, __HIP_MEMORY_SCOPE_AGENT); }
__device__ __forceinline__ unsigned xb_add(unsigned* p, unsigned v) { return __hip_atomic_fetch_add(p, v, __ATOMIC_RELAXED, __HIP_MEMORY_SCOPE_AGENT); }
__device__ __forceinline__ unsigned xb_xcc_id() { return (unsigned)__builtin_amdgcn_s_getreg((3 << 11) | 20) & 0xFu; }
#define XB_SPIN(cond, bar) do { unsigned _sp = 0; while (cond) { __builtin_amdgcn_s_sleep(1); \
    if ((++_sp & 255u) == 0u) { if (xb_ld(&(bar)[XB_TMO])) break; if (_sp > XB_SPIN_CAP) { atomicAdd(&(bar)[XB_TMO], 1u); break; } } } } while (0)

struct XcdBarrier {
    unsigned* bar; unsigned x;
    volatile LAS unsigned* st;
};

__device__ __forceinline__ XcdBarrier xcd_barrier_post(unsigned* bar, volatile LAS unsigned* st) {
    XcdBarrier b; b.bar = bar; b.x = xb_xcc_id(); b.st = st;
    if (threadIdx.x == 0) (void)xb_add(&bar[XB_XCNT(b.x)], 1u);
    return b;
}
__device__ __forceinline__ void xcd_barrier_complete(unsigned* bar, unsigned x, unsigned& nloc, unsigned& nx) {
    const unsigned G = gridDim.x * gridDim.y * gridDim.z;
    unsigned sum, cnt, mine, sp = 0u;
    for (;;) {
        sum = 0u; cnt = 0u; mine = 0u;
#pragma unroll
        for (unsigned j = 0; j < 16; ++j) { const unsigned c = xb_ld(&bar[XB_XCNT(j)]); sum += c; cnt += (c > 0u) ? 1u : 0u; mine = (j == x) ? c : mine; }
        if (sum == G) break;
        __builtin_amdgcn_s_sleep(1);
        if ((++sp & 255u) == 0u) { if (xb_ld(&bar[XB_TMO])) break; if (sp > XB_SPIN_CAP) { atomicAdd(&bar[XB_TMO], 1u); break; } }
    }
    nloc = mine > 0u ? mine : 1u; nx = cnt > 0u ? cnt : 1u;
}

__device__ __forceinline__ void xcd_barrier(const XcdBarrier& b) {
    asm volatile("s_waitcnt vmcnt(0)" ::: "memory");
    __syncthreads();
    if (threadIdx.x == 0) {
        unsigned* bar = b.bar;
        __builtin_amdgcn_s_waitcnt(0);
        unsigned nloc = b.st[0], nx = b.st[1];
        if (nloc == 0u) { xcd_barrier_complete(bar, b.x, nloc, nx); b.st[0] = nloc; b.st[1] = nx; }
        const unsigned old = xb_add(&bar[XB_XSUB(b.x)], 1u);
        const unsigned gen = old / nloc;
        if (old + 1u == (gen + 1u) * nloc) {
            __builtin_amdgcn_fence(__ATOMIC_RELEASE, "agent");
            asm volatile("s_waitcnt vmcnt(0)" ::: "memory");
            const unsigned og = xb_add(&bar[XB_TOP], 1u);
            const unsigned tg = og / nx;
            if (og + 1u == (tg + 1u) * nx) xb_add(&bar[XB_TOPGEN], 1u);
            else XB_SPIN(xb_ld(&bar[XB_TOPGEN]) == tg, bar);
            __builtin_amdgcn_fence(__ATOMIC_ACQUIRE, "agent");
            xb_add(&bar[XB_XGEN(b.x)], 1u);
            asm volatile("s_waitcnt vmcnt(0)" ::: "memory");
        } else {
            XB_SPIN(xb_ld(&bar[XB_XGEN(b.x)]) == gen, bar);
            __builtin_amdgcn_fence(__ATOMIC_ACQUIRE, "agent");
            asm volatile("s_waitcnt vmcnt(0)" ::: "memory");
        }
    }
    __syncthreads();
}
struct Frame {
    LAS unsigned char* lds;
    gu32* ctl;
    unsigned char* ws;
    int tid, lane, wave, vcu, G;
};
struct Args { const float* in[30]; float* out; unsigned char* ws; int ph_lo, ph_hi; };
struct InTab { LAS unsigned long long* t;
    __device__ __forceinline__ const float* operator[](int i) const { const unsigned long long v = t[i]; const unsigned lo = __builtin_amdgcn_readfirstlane((unsigned)v), hi = __builtin_amdgcn_readfirstlane((unsigned)(v >> 32)); return (const float*)(((unsigned long long)hi << 32) | lo); } };
struct PArgs { InTab in; float* out; };
#define LDS_WAIT() asm volatile("s_waitcnt lgkmcnt(0)" ::: "memory")
#define VM_WAIT() asm volatile("s_waitcnt vmcnt(0)" ::: "memory")
enum { I_X = 0, I_C, I_CTX, I_CCTX, I_ADAW, I_ADAB, I_LN1G, I_LN1B, I_LN2G, I_LN2B, I_EVWIN, I_QNG, I_KNG, I_CQG, I_CKVG, I_WUQ, I_WUKV, I_EVWOUT,
       I_FFG, I_FFU, I_FFD, I_ODWIN, I_RPB, I_LBL, I_ONG, I_ODWOUT, I_ROUTER, I_MG, I_MU, I_MD };

__device__ __forceinline__ void cvt_item(const float* src0, const float* src1, int K, int N, int Np, bf16* dst, int mode, int item, LAS float* scr, int lane, bool f8 = false) {
    const int nblk = Np >> 5, kb = item / nblk, nb = item - kb * nblk, k0 = 64 * kb, n0 = 32 * nb;
    const int np = n0 + (lane & 31);
    const float* src = src0; int col = np; bool ok = np < N;
    if (mode == 1) { const int head = np / 96, c = np - head * 96; if (c >= 64) { const int r = c - 64, g = r >> 3, e = r & 7; const int base = (g >> 1) * 16 + (g & 1) * 4; col = head * 96 + 64 + base + (e < 4 ? e : 8 + (e - 4)); } }
    else if (mode == 2) { src = (np & 4) ? src1 : src0; col = ((np >> 3) << 2) + (np & 3); ok = true; }
    float rr[32];
    { const GAS float* sp_ = (const GAS float*)src + (size_t)(k0 + (lane >> 5)) * N + col;
#pragma unroll
      for (int i = 0; i < 32; ++i) rr[i] = ok ? sp_[(size_t)(2 * i) * N] : 0.f; }
#pragma unroll
    for (int i = 0; i < 32; ++i) { const int kk = 2 * i + (lane >> 5); scr[kk * 33 + (lane & 31)] = rr[i]; }
    LDS_WAIT(); asm volatile("" ::: "memory");
    const int c8 = lane & 7;
    if (f8) {
        unsigned char* d8 = (unsigned char*)dst;
#pragma unroll
        for (int j = 0; j < 4; ++j) { const int n = (lane >> 3) + 8 * j; const LAS float* s = scr + (8 * c8) * 33 + n;
            unsigned w0 = 0u, w1 = 0u;
            w0 = __builtin_amdgcn_cvt_pk_fp8_f32(s[0 * 33] * MOE_WSCALE, s[1 * 33] * MOE_WSCALE, w0, false); w0 = __builtin_amdgcn_cvt_pk_fp8_f32(s[2 * 33] * MOE_WSCALE, s[3 * 33] * MOE_WSCALE, w0, true);
            w1 = __builtin_amdgcn_cvt_pk_fp8_f32(s[4 * 33] * MOE_WSCALE, s[5 * 33] * MOE_WSCALE, w1, false); w1 = __builtin_amdgcn_cvt_pk_fp8_f32(s[6 * 33] * MOE_WSCALE, s[7 * 33] * MOE_WSCALE, w1, true);
            *(GAS v2u*)(d8 + (size_t)(n0 + n) * K + k0 + 8 * c8) = (v2u){w0, w1}; }
    } else {
#pragma unroll
        for (int j = 0; j < 4; ++j) { const int n = (lane >> 3) + 8 * j; const LAS float* s = scr + (8 * c8) * 33 + n;
            v4u o; o.x = pkbf(s[0 * 33], s[1 * 33]); o.y = pkbf(s[2 * 33], s[3 * 33]); o.z = pkbf(s[4 * 33], s[5 * 33]); o.w = pkbf(s[6 * 33], s[7 * 33]);
            *(GAS v4u*)(dst + (size_t)(n0 + n) * K + k0 + 8 * c8) = o; }
    }
    LDS_WAIT(); asm volatile("" ::: "memory");
}
__device__ __forceinline__ void sincos_red(float ang, float& s, float& c) {
    const float n = __builtin_rintf(ang * 0.636619772367581343f);
    float y = __builtin_fmaf(-n, 1.5703125f, ang); y = __builtin_fmaf(-n, 4.837512969970703125e-4f, y); y = __builtin_fmaf(-n, 7.54978995489188e-8f, y);
    const float z = y * y;
    const float sy = y + y * z * (-1.6666654611e-1f + z * (8.3321608736e-3f + z * (-1.9515295891e-4f)));
    const float cy = 1.0f - 0.5f * z + z * z * (4.166664568298827e-2f + z * (-1.388731625493765e-3f + z * 2.443315711809948e-5f));
    const int q = ((int)n) & 3;
    s = (q == 0) ? sy : (q == 1) ? cy : (q == 2) ? -sy : -cy;
    c = (q == 0) ? cy : (q == 1) ? -sy : (q == 2) ? -cy : sy;
}
__device__ __forceinline__ float inv_freq_pow(double r, int f) { double v = 1.0; for (int i = 0; i < f; ++i) v *= r; return (float)v; }

__device__ __forceinline__ void phase_cv(Frame& F, const PArgs& A, int j) {
    const int gw = F.vcu * NWAVES + F.wave, NGW = F.G * NWAVES;
    float* mods = (float*)(F.ws + WS_SMALL + SM_MODS);
    if (j == 0) {
        LAS float* Ssm = (LAS float*)F.lds;
        LAS float* Psm = (LAS float*)(F.lds + 20480);
        if ((int)blockIdx.x < 192) {
            for (int i = F.tid; i < 5 * 1024; i += NTHR) { const int r = i >> 10, k = i & 1023; const float cv = (r < 4) ? A.in[I_C][r * 1024 + k] : A.in[I_CCTX][k]; Ssm[i] = cv * frcp(1.f + __expf(-cv)); }
            __syncthreads();
            for (int u = blockIdx.x; u < 192; u += F.G) {
                const int l = u / 48, n = (u - l * 48) * 128 + 2 * F.lane;
                float a0[5] = {0.f, 0.f, 0.f, 0.f, 0.f}, a1[5] = {0.f, 0.f, 0.f, 0.f, 0.f};
                const float* wp = A.in[I_ADAW] + ((size_t)l * 1024 + F.wave * 128) * 6144 + n;
#pragma unroll 16
                for (int k = 0; k < 128; ++k) { const f32x2_t w = *(const GAS f32x2_t*)(wp + (size_t)k * 6144); const int kk = F.wave * 128 + k;
#pragma unroll
                    for (int r = 0; r < 5; ++r) { const float sv = Ssm[r * 1024 + kk]; a0[r] += sv * w.x; a1[r] += sv * w.y; } }
#pragma unroll
                for (int r = 0; r < 5; ++r) { Psm[(F.wave * 5 + r) * 128 + 2 * F.lane] = a0[r]; Psm[(F.wave * 5 + r) * 128 + 2 * F.lane + 1] = a1[r]; }
                __syncthreads();
                for (int i = F.tid; i < 640; i += NTHR) { const int r = i >> 7, c = i & 127; float s = 0.f;
#pragma unroll
                    for (int w = 0; w < 8; ++w) s += Psm[(w * 5 + r) * 128 + c];
                    const int nn = (u - l * 48) * 128 + c; mods[((size_t)l * 5 + r) * 6144 + nn] = s + A.in[I_ADAB][l * 6144 + nn]; }
                __syncthreads();
            }
        } else if ((int)blockIdx.x == 192) {
            float* ra = (float*)(F.ws + WS_SMALL + SM_ROPEA); float* rb = (float*)(F.ws + WS_SMALL + SM_ROPEB); float* lb = (float*)(F.ws + WS_SMALL + SM_LB);
            for (int i = F.tid; i < 128 * 16; i += NTHR) { const int pos = i >> 4, f = i & 15; const float inv = inv_freq_pow(0.56234132519034908, f); float s, c; sincos_red((float)pos * inv, s, c); ra[2 * i] = c; ra[2 * i + 1] = s; }
            for (int i = F.tid; i < 128 * 8; i += NTHR) { const int pos = i >> 3, f = i & 7; const float inv = inv_freq_pow(0.31622776601683794, f); float s, c; sincos_red((float)pos * inv, s, c); rb[2 * i] = c; rb[2 * i + 1] = s; }
            for (int i = F.tid; i < 2 * 512; i += NTHR) { const int dir = i >> 9, c = i & 511; const float l0 = A.in[I_LBL][(dir * 2 + 0) * 512 + c], l1 = A.in[I_LBL][(dir * 2 + 1) * 512 + c];
                const float mx = fmaxf(l0, l1), e0 = __expf(l0 - mx), e1 = __expf(l1 - mx), p0 = e0 / (e0 + e1), p1 = e1 / (e0 + e1);
                lb[(0 * 2 + dir) * 512 + c] = p0 - p0; lb[(1 * 2 + dir) * 512 + c] = (p0 + p1) - p0; }
        }
        __syncthreads();
    }
    LAS float* scr = (LAS float*)(F.lds + 49152 + F.wave * 8704);
    bf16* W = (bf16*)(F.ws + WS_W); bf16* WM = (bf16*)(F.ws + WS_WMOE);
    constexpr int N1 = 2 * 768, N2 = 2 * 144, N3 = 2 * 128, N4 = 2 * 512, N5 = 2 * 2816, N6 = 2 * 1408, N7 = 2 * 2048, N8 = 2 * 512, N9 = 8 * 3584, N10 = 8 * 1792;
    const int nfix = (j == 0) ? (N1 + N2 + N3 + N4 + N5 + N6 + N7 + N8) : 0;
    const int total = nfix + N9 + N10;
    for (int it = gw; it < total; it += NGW) {
        int r = it; const float* s0; const float* s1 = nullptr; int K, N, Np, mode = 0, item; bf16* d; bool f8 = false;
        if (r >= nfix) { r -= nfix;
            if (r < N9) { const int e = r / 3584; item = r - e * 3584; const size_t so = ((size_t)(j * 8 + e)) * 1024 * 3584; s0 = A.in[I_MG] + so; s1 = A.in[I_MU] + so; K = 1024; N = 3584; Np = 7168; mode = 2; f8 = true; d = (bf16*)((unsigned char*)WM + WM_GU + (size_t)e * 7168 * 1024); }
            else { r -= N9; const int e = r / 1792; item = r - e * 1792; s0 = A.in[I_MD] + ((size_t)(j * 8 + e)) * 3584 * 1024; K = 3584; N = 1024; Np = 1024; f8 = true; d = (bf16*)((unsigned char*)WM + WM_D + (size_t)e * 1024 * 3584); }
        } else if (r < N1) { const int b = r / 768; item = r - b * 768; s0 = A.in[I_EVWIN] + (size_t)b * 1024 * EV_IN; K = 1024; N = EV_IN; Np = EV_INP; d = W + W_EVIN + (size_t)b * EV_INP * 1024; }
        else if ((r -= N1) < N2) { const int b = r / 144; item = r - b * 144; s0 = A.in[I_WUQ] + (size_t)b * 384 * 768; K = 384; N = 768; Np = 768; mode = 1; d = W + W_UQ + (size_t)b * 768 * 384; }
        else if ((r -= N2) < N3) { const int b = r / 128; item = r - b * 128; s0 = A.in[I_WUKV] + (size_t)b * 256 * 1024; K = 256; N = 1024; Np = 1024; d = W + W_UKV + (size_t)b * 1024 * 256; }
        else if ((r -= N3) < N4) { const int b = r / 512; item = r - b * 512; s0 = A.in[I_EVWOUT] + (size_t)b * 1024 * 1024; K = 1024; N = 1024; Np = 1024; d = W + W_EVOUT + (size_t)b * 1024 * 1024; }
        else if ((r -= N4) < N5) { const int b = r / 2816; item = r - b * 2816; s0 = A.in[I_FFG] + (size_t)b * 1024 * DFF; s1 = A.in[I_FFU] + (size_t)b * 1024 * DFF; K = 1024; N = DFF; Np = 2 * DFF; mode = 2; f8 = FFN_F8; d = FFN_F8 ? (bf16*)((unsigned char*)(W + W_FFGU) + (size_t)b * 2 * DFF * 1024) : W + W_FFGU + (size_t)b * 2 * DFF * 1024; }
        else if ((r -= N5) < N6) { const int b = r / 1408; item = r - b * 1408; s0 = A.in[I_FFD] + (size_t)b * DFF * 1024; K = DFF; N = 1024; Np = 1024; d = W + W_FFD + (size_t)b * 1024 * DFF; }
        else if ((r -= N6) < N7) { const int b = r / 2048; item = r - b * 2048; s0 = A.in[I_ODWIN] + (size_t)b * 1024 * 4096; K = 1024; N = 4096; Np = 4096; d = W + W_ODIN + (size_t)b * 4096 * 1024; }
        else { r -= N7; const int b = r / 512; item = r - b * 512; s0 = A.in[I_ODWOUT] + (size_t)b * 1024 * 1024; K = 1024; N = 1024; Np = 1024; d = W + W_ODOUT + (size_t)b * 1024 * 1024; }
        cvt_item(s0, s1, K, N, Np, d, mode, item, scr, F.lane, f8);
    }
}

__device__ __forceinline__ void store_bf16_row(bf16* orow, int lane, const f32x4 (&v)[4]) {
    GAS unsigned long long* o8 = (GAS unsigned long long*)orow + lane;
#pragma unroll
    for (int j = 0; j < 4; ++j) o8[64 * j] = (unsigned long long)pkbf(v[j].x, v[j].y) | ((unsigned long long)pkbf(v[j].z, v[j].w) << 32);
}
__device__ __forceinline__ void phase_mod(Frame& F, const PArgs& A) {
    const int gw = F.vcu * NWAVES + F.wave, NGW = F.G * NWAVES;
    const float* mods = (const float*)(F.ws + WS_SMALL + SM_MODS);
    bf16* H = (bf16*)(F.ws + WS_H);
    for (int m = gw; m < MROWS; m += NGW) {
        const float* src = (m < MLAT) ? A.in[I_X] + (size_t)m * 1024 : A.in[I_CTX] + (size_t)(m - MLAT) * 1024;
        const float* md = mods + (size_t)modrow(m) * 6144;
        f32x4 v[4], h[4];
#pragma unroll
        for (int j = 0; j < 4; ++j) { v[j] = *((const f32x4*)src + F.lane + 64 * j); const f32x4 sh = *((const f32x4*)md + F.lane + 64 * j), sc = *((const f32x4*)(md + 1024) + F.lane + 64 * j);
            h[j] = v[j] * (sc + 1.0f) + sh; }
        store_bf16_row(H + (size_t)m * 1024, F.lane, h);
    }
}
template <bool MOE, bool ROUTER, bool H8 = false>
__device__ __forceinline__ void phase_ln(Frame& F, const PArgs& A, const float* lng, const float* lnb, const float* mshift  , const float* g5  ,
                                         const float* router, int jodd, bool last, int nrows = MROWS) {
    const int gw = F.vcu * NWAVES + F.wave, NGW = F.G * NWAVES;
    bf16* X = (bf16*)(F.ws + WS_X); bf16* H = (bf16*)(F.ws + WS_H);
    int* topk = (int*)(F.ws + WS_TOPK);
    const bf16* Y = (const bf16*)(F.ws + WS_XG);
    LAS unsigned* lcnt = (LAS unsigned*)(F.lds);
    if (ROUTER) { if (F.tid < 8) lcnt[F.tid] = 0u; __syncthreads(); }
    f32x4 gv[4], bv[4];
#pragma unroll
    for (int j = 0; j < 4; ++j) { gv[j] = *((const f32x4*)lng + F.lane + 64 * j); bv[j] = *((const f32x4*)lnb + F.lane + 64 * j); }
    f32x4 rwa[4][4], rwb[4][4];
    if (ROUTER) {
#pragma unroll
        for (int j = 0; j < 4; ++j)
#pragma unroll
            for (int i = 0; i < 4; ++i) { const float* rp = router + (size_t)(4 * F.lane + 256 * j + i) * 8; rwa[j][i] = *(const GAS f32x4*)rp; rwb[j][i] = *(const GAS f32x4*)(rp + 4); }
    }
    for (int m = gw; m < nrows; m += NGW) {
        bf16* xr = X + (size_t)m * 1024; const int mr = modrow(m);
        f32x4 v[4];
        if (MOE) {
#pragma unroll
            for (int j = 0; j < 4; ++j) { const v2u xx = *((const GAS v2u*)xr + F.lane + 64 * j); v[j] = __builtin_convertvector(__builtin_bit_cast(h16x4, xx), f32x4); }
        } else {
            const bf16* zr = (const bf16*)(F.ws + WS_ZR) + (size_t)m * 1024;
#pragma unroll
            for (int j = 0; j < 4; ++j) { const v2u z = *((const GAS v2u*)zr + F.lane + 64 * j); v[j] = __builtin_convertvector(__builtin_bit_cast(h16x4, z), f32x4); }
        }
        if (MOE) {
            const int r1 = topk[m * 6 + 4], r2 = topk[m * 6 + 5]; const float w1 = __int_as_float(topk[m * 6 + 2]), w2 = __int_as_float(topk[m * 6 + 3]);
            const float* gg = g5 + (size_t)mr * 6144;
#pragma unroll
            for (int j = 0; j < 4; ++j) { const v2u y1 = *((const v2u*)(Y + (size_t)r1 * 1024) + F.lane + 64 * j), y2 = *((const v2u*)(Y + (size_t)r2 * 1024) + F.lane + 64 * j);
                const f32x4 gq = *((const f32x4*)gg + F.lane + 64 * j);
                f32x4 yy; yy.x = w1 * bf_lo(y1.x) + w2 * bf_lo(y2.x); yy.y = w1 * bf_hi(y1.x) + w2 * bf_hi(y2.x); yy.z = w1 * bf_lo(y1.y) + w2 * bf_lo(y2.y); yy.w = w1 * bf_hi(y1.y) + w2 * bf_hi(y2.y);
                v[j] = v[j] * ALPHA + gq * yy; }
        }
        float s = 0.f;
#pragma unroll
        for (int j = 0; j < 4; ++j) s += (v[j].x + v[j].y) + (v[j].z + v[j].w);
        const float mean = wave_sum(s, F.lane) * (1.f / 1024.f); float s2 = 0.f;
#pragma unroll
        for (int j = 0; j < 4; ++j) { v[j] = v[j] - mean; s2 += (v[j].x * v[j].x + v[j].y * v[j].y) + (v[j].z * v[j].z + v[j].w * v[j].w); }
        const float rstd = __builtin_amdgcn_rsqf(wave_sum(s2, F.lane) * (1.f / 1024.f) + 1e-6f);
#pragma unroll
        for (int j = 0; j < 4; ++j) { v[j] = v[j] * rstd * gv[j] + bv[j]; if (!last) *((GAS v2u*)xr + F.lane + 64 * j) = (v2u){pkh(v[j].x, v[j].y), pkh(v[j].z, v[j].w)}; }
#if defined(SELFCHK)
        if (last) { const float cn = __hip_atomic_load((const float*)(F.ctl + 12288), __ATOMIC_RELAXED, __HIP_MEMORY_SCOPE_AGENT), cd = __hip_atomic_load((const float*)(F.ctl + 12288) + 1, __ATOMIC_RELAXED, __HIP_MEMORY_SCOPE_AGENT);
            const float cscale = 1.f + sqrtf(cn / fmaxf(cd, 1e-30f));
#pragma unroll
            for (int j = 0; j < 4; ++j) v[j] = v[j] * cscale; }
#endif
        if (last) { if (m < MLAT) {
#pragma unroll
                for (int j = 0; j < 4; ++j) *((f32x4*)(A.out + (size_t)m * 1024) + F.lane + 64 * j) = v[j]; }
            continue; }
        const float* md = mshift + (size_t)mr * 6144;
#pragma unroll
        for (int j = 0; j < 4; ++j) { const f32x4 sh = *((const f32x4*)md + F.lane + 64 * j), sc = *((const f32x4*)(md + 1024) + F.lane + 64 * j); v[j] = v[j] * (sc + 1.0f) + sh; }
        if (H8) {
#pragma unroll
            for (int j = 0; j < 4; ++j) { unsigned w = 0u; w = __builtin_amdgcn_cvt_pk_fp8_f32(v[j].x, v[j].y, w, false); w = __builtin_amdgcn_cvt_pk_fp8_f32(v[j].z, v[j].w, w, true);
                *((GAS unsigned*)((unsigned char*)H + (size_t)m * 1024) + F.lane + 64 * j) = w; }
        } else store_bf16_row(H + (size_t)m * 1024, F.lane, v);
        if (ROUTER) {
            float pa[8] = {0.f, 0.f, 0.f, 0.f, 0.f, 0.f, 0.f, 0.f};
#pragma unroll
            for (int j = 0; j < 4; ++j)
#pragma unroll
                for (int i = 0; i < 4; ++i) { const float hv = v[j][i]; const f32x4 ra = rwa[j][i], rb = rwb[j][i];
                    pa[0] += hv * ra.x; pa[1] += hv * ra.y; pa[2] += hv * ra.z; pa[3] += hv * ra.w; pa[4] += hv * rb.x; pa[5] += hv * rb.y; pa[6] += hv * rb.z; pa[7] += hv * rb.w; }
            float lg[8];
            { const bool b5 = (F.lane & 32) != 0, b4 = (F.lane & 16) != 0, b3 = (F.lane & 8) != 0; float q4[4], q2[2];
#pragma unroll
              for (int k = 0; k < 4; ++k) { const float snd = b5 ? pa[k] : pa[k + 4], own = b5 ? pa[k + 4] : pa[k]; q4[k] = own + shx(snd, 32, F.lane); }
#pragma unroll
              for (int k = 0; k < 2; ++k) { const float snd = b4 ? q4[k] : q4[k + 2], own = b4 ? q4[k + 2] : q4[k]; q2[k] = own + shx(snd, 16, F.lane); }
              float q1 = (b3 ? q2[1] : q2[0]) + shx(b3 ? q2[0] : q2[1], 8, F.lane);
              q1 += shx(q1, 4, F.lane); q1 += shx(q1, 2, F.lane); q1 += shx(q1, 1, F.lane);
#pragma unroll
              for (int e = 0; e < 8; ++e) lg[e] = __builtin_bit_cast(float, __builtin_amdgcn_readlane(__builtin_bit_cast(int, q1), 32 * (e >> 2) + 16 * ((e >> 1) & 1) + 8 * (e & 1))); }
            int e1 = 0; float v1 = lg[0];
#pragma unroll
            for (int e = 1; e < 8; ++e) if (lg[e] > v1) { v1 = lg[e]; e1 = e; }
            int e2 = -1; float v2 = -INFINITY;
#pragma unroll
            for (int e = 0; e < 8; ++e) if (e != e1 && lg[e] > v2) { v2 = lg[e]; e2 = e; }
            const float w1 = frcp(1.f + __expf(v2 - v1)), w2 = 1.f - w1;
            if (F.lane == 0) { topk[m * 6 + 0] = e1; topk[m * 6 + 1] = e2; topk[m * 6 + 2] = __float_as_int(w1); topk[m * 6 + 3] = __float_as_int(w2);
                atomicAdd((unsigned*)&lcnt[e1], 1u); atomicAdd((unsigned*)&lcnt[e2], 1u); }
        }
    }
    if (ROUTER) { LDS_WAIT(); __syncthreads(); if (F.tid < 8) __hip_atomic_fetch_add((unsigned*)(F.ctl + CW_CNT + 64 * jodd) + F.tid, lcnt[F.tid], __ATOMIC_RELAXED, __HIP_MEMORY_SCOPE_AGENT); }
}
typedef short v4i16_t __attribute__((ext_vector_type(4)));
__device__ __forceinline__ int crow(int r, int hi) { return (r & 3) + 8 * (r >> 2) + 4 * hi; }
__device__ __forceinline__ float swap_max(float m) { auto rr = __builtin_amdgcn_permlane32_swap(__float_as_uint(m), __float_as_uint(m), false, false); return fmaxf(__uint_as_float(rr[0]), __uint_as_float(rr[1])); }
__device__ __forceinline__ float swap_sum(float m) { auto rr = __builtin_amdgcn_permlane32_swap(__float_as_uint(m), __float_as_uint(m), false, false); return __uint_as_float(rr[0]) + __uint_as_float(rr[1]); }

#ifndef ATT_THR
#define ATT_THR 6.f
#endif
template <int DK, int MODE>
__device__ __forceinline__ void attn_unit(LAS unsigned char* lds, int tid, const bf16* Q, int qp, const bf16* K1, const bf16* V1, int nt1, const bf16* K2, const bf16* V2, int nt2,
                                          int kp, int vp, bf16* O, int op, int rq0, int kr0, const float* rpbh) {
    constexpr int KROW = DK * 2 + 16, KSZ = 64 * KROW, CPK = DK / 8  , NPK = 64 * CPK;
    constexpr int VB = 4 * KSZ, SCR = VB + 4 * 8192, BIAS = SCR + 2048;
    const int lane = tid & 63, r32 = lane & 31, hi = lane >> 5; const int wid = __builtin_amdgcn_readfirstlane(tid >> 6);
    const int NT = nt1 + nt2;
    LAS float* wsf = (LAS float*)(lds + SCR) + wid * 64;
    const int kkey0 = tid / CPK, kch0 = tid - kkey0 * CPK;
    const int kkey1 = (tid + 512) / CPK, kch1 = (tid + 512) - kkey1 * CPK;
    const bool two = (NPK > 512) && (tid + 512 < NPK);
    const int vkey = tid >> 3, vch = tid & 7;
    const int vdst = ((vkey >> 3) * 2 + (vch >> 2)) * 512 + (vkey & 7) * 64 + (vch & 3) * 16;
    v4u kA0, kA1 = {0u, 0u, 0u, 0u}, vA, kB0, kB1 = {0u, 0u, 0u, 0u}, vB;
#define ATT_LOAD(t, K0_, K1_, V_) do { const int t_ = (t); const bf16* kb_ = (t_ < nt1) ? K1 + (size_t)t_ * 64 * kp : K2 + (size_t)(t_ - nt1) * 64 * kp; \
        const bf16* vb_ = (t_ < nt1) ? V1 + (size_t)t_ * 64 * vp : V2 + (size_t)(t_ - nt1) * 64 * vp; \
        K0_ = *(const GAS v4u*)(kb_ + (size_t)kkey0 * kp + kch0 * 8); if (two) K1_ = *(const GAS v4u*)(kb_ + (size_t)kkey1 * kp + kch1 * 8); \
        V_ = *(const GAS v4u*)(vb_ + (size_t)vkey * vp + vch * 8); } while (0)
#define ATT_STORE(buf, K0_, K1_, V_) do { LAS unsigned char* kd_ = lds + (buf) * KSZ; *(LAS v4u*)(kd_ + kkey0 * KROW + kch0 * 16) = K0_; if (two) *(LAS v4u*)(kd_ + kkey1 * KROW + kch1 * 16) = K1_; \
        *(LAS v4u*)(lds + VB + (buf) * 8192 + vdst) = V_; } while (0)
    ATT_LOAD(0, kA0, kA1, vA); if (NT > 1) ATT_LOAD(1, kB0, kB1, vB);
    if (MODE == 1) { LAS float* bs = (LAS float*)(lds + BIAS); for (int i = tid; i < 15 * 31; i += NTHR) bs[i] = rpbh[i] * LOG2E; }
    bf16x8 qr[DK / 16];
#pragma unroll
    for (int d0 = 0; d0 < DK / 16; ++d0) qr[d0] = *(const GAS bf16x8*)(Q + (size_t)(wid * 32 + r32) * qp + d0 * 16 + hi * 8);
    ATT_STORE(0, kA0, kA1, vA); if (NT > 1) ATT_STORE(1, kB0, kB1, vB);
    __syncthreads();
    float m_run = 0.f, l_run = 0.f; f32x16 o0, o1, negm;
    { float zz; asm volatile("v_mov_b32 %0, 0" : "=v"(zz));
#pragma unroll
      for (int r = 0; r < 16; ++r) { o0[r] = zz; o1[r] = zz; negm[r] = zz; } }
    const int rq = rq0 + (wid >> 1), rsq = min(max(rq - 4, 0), 120), qc = (wid & 1) * 32 + r32, cs = min(max(qc - 8, 0), 48);
    unsigned nmask0 = 0u, nmask1 = 0u;
    if (MODE == 1) {
#pragma unroll
        for (int r = 0; r < 16; ++r) { const int kc0 = crow(r, hi), kc1 = kc0 + 32; nmask0 |= ((kc0 >= cs) && (kc0 < cs + 16)) ? (1u << r) : 0u; nmask1 |= ((kc1 >= cs) && (kc1 < cs + 16)) ? (1u << r) : 0u; } }
    const int koff = r32 * KROW + hi * 16;
    const int vlane = (4 * hi + ((lane & 15) >> 2)) * 64 + ((lane >> 4) & 1) * 32 + (lane & 3) * 8;
#define ATT_TILE(tt) do { const int t_c = (tt); const int buf = t_c & 3; \
        bool act = true; int kr = 0; \
        if (MODE == 1) { kr = kr0 + t_c; act = (t_c >= nt1) || (kr >= rsq && kr < rsq + 8); } \
        if (act) { \
            const LAS unsigned char* kb = lds + buf * KSZ + koff; \
            f32x16 s0, s1; bf16x8 ka0[DK / 16], ka1[DK / 16]; \
            _Pragma("unroll") for (int d0 = 0; d0 < DK / 16; ++d0) { ka0[d0] = *(const LAS bf16x8*)(kb + d0 * 32); ka1[d0] = *(const LAS bf16x8*)(kb + 32 * KROW + d0 * 32); } \
            __builtin_amdgcn_sched_barrier(0);            \
            _Pragma("unroll") for (int d0 = 0; d0 < DK / 16; ++d0) { \
                if (d0 == 0) { s0 = __builtin_amdgcn_mfma_f32_32x32x16_bf16(ka0[0], qr[0], negm, 0, 0, 0); s1 = __builtin_amdgcn_mfma_f32_32x32x16_bf16(ka1[0], qr[0], negm, 0, 0, 0); } \
                else { s0 = __builtin_amdgcn_mfma_f32_32x32x16_bf16(ka0[d0], qr[d0], s0, 0, 0, 0); s1 = __builtin_amdgcn_mfma_f32_32x32x16_bf16(ka1[d0], qr[d0], s1, 0, 0, 0); } } \
            const LAS unsigned char* vb = lds + VB + buf * 8192 + vlane; \
            v4i16_t vlo[8], vhh[8]; \
            _Pragma("unroll") for (int i = 0; i < 8; ++i) { const int ks = i >> 1, db = i & 1; \
                vlo[i] = __builtin_amdgcn_ds_read_tr16_b64_v4i16((LAS v4i16_t*)(vb + ((ks * 2 + 0) * 2 + db) * 512)); \
                vhh[i] = __builtin_amdgcn_ds_read_tr16_b64_v4i16((LAS v4i16_t*)(vb + ((ks * 2 + 1) * 2 + db) * 512)); } \
            __builtin_amdgcn_sched_barrier(0);            \
            if (MODE == 1) { if (t_c < nt1) { \
                unsigned bo_ = (unsigned)(size_t)((const LAS float*)(lds + BIAS) + (kr - rq + 7) * 31 - qc + 15 + 4 * hi); asm volatile("" : "+v"(bo_)); \
                const LAS float* bs = (const LAS float*)(size_t)bo_;        \
                _Pragma("unroll") for (int r = 0; r < 16; ++r) { const int kk_ = (r & 3) + 8 * (r >> 2); \
                    const float b0 = bs[kk_], b1 = bs[kk_ + 32]; \
                    s0[r] = ((nmask0 >> r) & 1u) ? s0[r] + b0 : -INFINITY; s1[r] = ((nmask1 >> r) & 1u) ? s1[r] + b1 : -INFINITY; } } } \
            float ma = __builtin_fmaxf(__builtin_fmaxf(s0[0], s0[1]), s1[0]), mb = __builtin_fmaxf(__builtin_fmaxf(s0[2], s0[3]), s1[1]); \
            ma = __builtin_fmaxf(__builtin_fmaxf(ma, s1[2]), s1[3]); \
            _Pragma("unroll") for (int r = 4; r < 16; r += 4) { ma = __builtin_fmaxf(__builtin_fmaxf(ma, s0[r]), s0[r + 1]); mb = __builtin_fmaxf(__builtin_fmaxf(mb, s0[r + 2]), s0[r + 3]); \
                ma = __builtin_fmaxf(__builtin_fmaxf(ma, s1[r]), s1[r + 1]); mb = __builtin_fmaxf(__builtin_fmaxf(mb, s1[r + 2]), s1[r + 3]); } \
            const float mx = swap_max(__builtin_fmaxf(ma, mb)); \
            if (__any(mx > ATT_THR)) {        \
                const float dl = __builtin_fmaxf(mx, 0.f); m_run += dl; const float f = fast_exp2(-dl); l_run *= f; if (hi == 0) wsf[r32] = f; LDS_WAIT(); \
                _Pragma("unroll") for (int r = 0; r < 16; ++r) { const float fr_ = wsf[crow(r, hi)]; o0[r] *= fr_; o1[r] *= fr_; s0[r] -= dl; s1[r] -= dl; } \
                _Pragma("unroll") for (int r = 0; r < 16; ++r) negm[r] = -m_run; \
                asm volatile("" : "+v"(negm)); \
            } \
            float ls = 0.f; \
            _Pragma("unroll") for (int r = 0; r < 16; ++r) { s0[r] = fast_exp2(s0[r]); s1[r] = fast_exp2(s1[r]); ls += s0[r] + s1[r]; } \
            l_run += ls; \
            v4u pw[4]; \
            pw[0] = (v4u){pkbf(s0[0], s0[1]), pkbf(s0[2], s0[3]), pkbf(s0[4], s0[5]), pkbf(s0[6], s0[7])}; \
            pw[1] = (v4u){pkbf(s0[8], s0[9]), pkbf(s0[10], s0[11]), pkbf(s0[12], s0[13]), pkbf(s0[14], s0[15])}; \
            pw[2] = (v4u){pkbf(s1[0], s1[1]), pkbf(s1[2], s1[3]), pkbf(s1[4], s1[5]), pkbf(s1[6], s1[7])}; \
            pw[3] = (v4u){pkbf(s1[8], s1[9]), pkbf(s1[10], s1[11]), pkbf(s1[12], s1[13]), pkbf(s1[14], s1[15])}; \
            __builtin_amdgcn_sched_barrier(0); \
            _Pragma("unroll") for (int ks = 0; ks < 4; ++ks) { \
                const bf16x8 pa = __builtin_bit_cast(bf16x8, pw[ks]); \
                _Pragma("unroll") for (int db = 0; db < 2; ++db) { \
                    const v4i16_t lo = vlo[ks * 2 + db], hh = vhh[ks * 2 + db]; \
                    const bf16x8 vf = (bf16x8){lo[0], lo[1], lo[2], lo[3], hh[0], hh[1], hh[2], hh[3]}; \
                    if (db == 0) o0 = __builtin_amdgcn_mfma_f32_32x32x16_bf16(pa, vf, o0, 0, 0, 0); \
                    else         o1 = __builtin_amdgcn_mfma_f32_32x32x16_bf16(pa, vf, o1, 0, 0, 0); } } \
        } } while (0)
    for (int t = 0; t < NT; t += 2) {
        if (t + 2 < NT) ATT_LOAD(t + 2, kA0, kA1, vA);
        if (t + 3 < NT) ATT_LOAD(t + 3, kB0, kB1, vB);
        ATT_TILE(t);
        if (t + 1 < NT) ATT_TILE(t + 1);
        if (t + 2 < NT) ATT_STORE((t + 2) & 3, kA0, kA1, vA);
        if (t + 3 < NT) ATT_STORE((t + 3) & 3, kB0, kB1, vB);
        __syncthreads();
    }
    const float lt = swap_sum(l_run);
    if (hi == 0) wsf[32 + r32] = frcp(lt);
    LDS_WAIT();
#pragma unroll
    for (int r = 0; r < 16; ++r) { const int q = crow(r, hi); const float il = wsf[32 + q]; bf16* orow = O + (size_t)(wid * 32 + q) * op;
        orow[r32] = f2bf(o0[r] * il); orow[32 + r32] = f2bf(o1[r] * il); }
    __syncthreads();
#undef ATT_LOAD
#undef ATT_STORE
#undef ATT_TILE
}
#define PINF(x_) asm volatile("" : "+v"(x_))
#if defined(PROBE_EXP2X)
#define PROBE_XEXP(x_) do { float dd_; asm volatile("v_exp_f32 %0, %1" : "=v"(dd_) : "v"(x_)); } while (0)
#else
#define PROBE_XEXP(x_) do {} while (0)
#endif
#if defined(PROBE_ACC)
#define PACC_T0(id_) do { if ((id_) == PROBE_ACC && blockIdx.x == 0 && tid == 0) { volatile LAS unsigned* pm_ = (volatile LAS unsigned*)(lds + MISC_OFF); pm_[16] = (unsigned)__builtin_amdgcn_s_memrealtime(); } } while (0)
#define PACC_T1(id_) do { if ((id_) == PROBE_ACC && blockIdx.x == 0 && tid == 0) { volatile LAS unsigned* pm_ = (volatile LAS unsigned*)(lds + MISC_OFF); pm_[18] += (unsigned)__builtin_amdgcn_s_memrealtime() - pm_[16]; } } while (0)
#else
#define PACC_T0(id_) do {} while (0)
#define PACC_T1(id_) do {} while (0)
#endif
template <int DK>
__device__ __forceinline__ void attn_unit_p(LAS unsigned char* lds, int tid, const bf16* Q, int qp, const bf16* K1, const bf16* V1, int nt1, const bf16* K2, const bf16* V2, int nt2,
                                            int kp, int vp, bf16* O, int op) {
    constexpr int NK = DK / 16, G = 2 * NK, PRE = 4;
    constexpr int KROW = DK * 2 + 16, KSZ = 64 * KROW, CPK = DK / 8, NPK = 64 * CPK;
    constexpr int VB = 4 * KSZ, SCR = VB + 4 * 8192;
    const int lane = tid & 63, r32 = lane & 31, hi = lane >> 5; const int wid = __builtin_amdgcn_readfirstlane(tid >> 6);
    const int NT = nt1 + nt2;
    LAS float* wsf = (LAS float*)(lds + SCR) + wid * 64;
    const int kkey0 = tid / CPK, kch0 = tid - kkey0 * CPK;
    const int kkey1 = (tid + 512) / CPK, kch1 = (tid + 512) - kkey1 * CPK;
    const bool two = (NPK > 512) && (tid + 512 < NPK);
    const int vkey = tid >> 3, vch = tid & 7;
    const int vdst = ((vkey >> 3) * 2 + (vch >> 2)) * 512 + (vkey & 7) * 64 + (vch & 3) * 16;
    v4u kA0, kA1 = {0u, 0u, 0u, 0u}, vA, kB0, kB1 = {0u, 0u, 0u, 0u}, vB;
#define ATT_LOADK(t, K0_, K1_) do { const int t_ = (t); const bf16* kb_ = (t_ < nt1) ? K1 + (size_t)t_ * 64 * kp : K2 + (size_t)(t_ - nt1) * 64 * kp; \
        K0_ = *(const GAS v4u*)(kb_ + (size_t)kkey0 * kp + kch0 * 8); if (two) K1_ = *(const GAS v4u*)(kb_ + (size_t)kkey1 * kp + kch1 * 8); } while (0)
#define ATT_LOADV(t, V_) do { const int t_ = (t); const bf16* vb_ = (t_ < nt1) ? V1 + (size_t)t_ * 64 * vp : V2 + (size_t)(t_ - nt1) * 64 * vp; \
        V_ = *(const GAS v4u*)(vb_ + (size_t)vkey * vp + vch * 8); } while (0)
#define ATT_STOREK(buf, K0_, K1_) do { LAS unsigned char* kd_ = lds + (buf) * KSZ; *(LAS v4u*)(kd_ + kkey0 * KROW + kch0 * 16) = K0_; if (two) *(LAS v4u*)(kd_ + kkey1 * KROW + kch1 * 16) = K1_; } while (0)
#define ATT_STOREV(buf, V_) do { *(LAS v4u*)(lds + VB + (buf) * 8192 + vdst) = V_; } while (0)
    { v4u kT0, kT1 = {0u, 0u, 0u, 0u};
      ATT_LOADK(0, kA0, kA1); ATT_LOADV(0, vA); ATT_LOADK(1, kB0, kB1); ATT_LOADV(1, vB); ATT_LOADK(2, kT0, kT1);
      ATT_STOREK(0, kA0, kA1); ATT_STOREV(0, vA); ATT_STOREK(1, kB0, kB1); ATT_STOREV(1, vB); ATT_STOREK(2, kT0, kT1); }
    bf16x8 qr[NK];
#pragma unroll
    for (int d0 = 0; d0 < NK; ++d0) qr[d0] = *(const GAS bf16x8*)(Q + (size_t)(wid * 32 + r32) * qp + d0 * 16 + hi * 8);
    __syncthreads();
    float m_run = 0.f, l4[4]; f32x16 o0, o1, negm;
    { float zz; asm volatile("v_mov_b32 %0, 0" : "=v"(zz));
#pragma unroll
      for (int r = 0; r < 16; ++r) { o0[r] = zz; o1[r] = zz; negm[r] = zz; }
      l4[0] = zz; l4[1] = zz; l4[2] = zz; l4[3] = zz; }
    const int koff = r32 * KROW + hi * 16;
    const int vlane = (4 * hi + ((lane & 15) >> 2)) * 64 + ((lane >> 4) & 1) * 32 + (lane & 3) * 8;
#define KREAD(i_) (*(const LAS bf16x8*)(kb + ((i_) & 1) * 32 * KROW + ((i_) >> 1) * 32))
#define VREADLO(g_) __builtin_amdgcn_ds_read_tr16_b64_v4i16((LAS v4i16_t*)(vb + ((((g_) >> 1) * 2 + 0) * 2 + ((g_) & 1)) * 512))
#define VREADHI(g_) __builtin_amdgcn_ds_read_tr16_b64_v4i16((LAS v4i16_t*)(vb + ((((g_) >> 1) * 2 + 1) * 2 + ((g_) & 1)) * 512))
#define MAX3(a_, b_, c_) __builtin_fmaxf(__builtin_fmaxf(a_, b_), c_)
#define ATT_DECIDE(N0, N1, ma_, mb_) do { const float mloc = __builtin_fmaxf(ma_, mb_);        \
        if (__any(mloc > ATT_THR)) { const float mx = swap_max(mloc); \
            const float dl = __builtin_fmaxf(mx, 0.f); m_run += dl; const float f = fast_exp2(-dl); l4[0] *= f; l4[1] *= f; l4[2] *= f; l4[3] *= f; if (hi == 0) wsf[r32] = f; LDS_WAIT(); \
            _Pragma("unroll") for (int r = 0; r < 16; ++r) { const float fr_ = wsf[crow(r, hi)]; o0[r] *= fr_; o1[r] *= fr_; N0[r] -= dl; N1[r] -= dl; } \
            _Pragma("unroll") for (int r = 0; r < 16; ++r) negm[r] = -m_run; \
            asm volatile("" : "+v"(negm)); \
        } } while (0)
#define CE(C0, C1, e_) (((e_) < 16) ? C0[(e_) & 15] : C1[(e_) & 15])
#define EOF_(g_) (PRE + (32 - PRE) * (g_) / G)
#define MS_(g_) ((g_) < 2 ? 0 : (g_) == 2 ? 3 : 2 * (g_) - 1)
#define ATT_STEP(C0, C1, N0, N1, T) do { const int t_s = (T); \
        if ((t_s & 1) != 0) { if (wid >= 4) __builtin_amdgcn_s_setprio(0); else __builtin_amdgcn_s_setprio(1); } else { if (wid >= 4) __builtin_amdgcn_s_setprio(1); else __builtin_amdgcn_s_setprio(0); }        \
        PACC_T0(5); PACC_T0(2); \
        const LAS unsigned char* kb = lds + ((t_s + 1) & 3) * KSZ + koff; \
        const LAS unsigned char* vb = lds + VB + (t_s & 3) * 8192 + vlane; \
        bf16x8 kf[G]; float x[32]; unsigned pwv[16]; v4i16_t vlo[8], vhh[8]; float ma, mb; \
        kf[0] = KREAD(0); kf[1] = KREAD(1); kf[2] = KREAD(2); \
        _Pragma("unroll") for (int e = 0; e < PRE; ++e) { x[e] = fast_exp2(CE(C0, C1, e)); PINF(x[e]); } \
        __builtin_amdgcn_sched_barrier(0); \
        _Pragma("unroll") for (int g = 0; g < G; ++g) { \
            if (g + 3 < G) kf[g + 3] = KREAD(g + 3); \
            if (g >= G - 4) { vlo[g - (G - 4)] = VREADLO(g - (G - 4)); vhh[g - (G - 4)] = VREADHI(g - (G - 4)); } \
            if (g == 0) N0 = __builtin_amdgcn_mfma_f32_32x32x16_bf16(kf[0], qr[0], negm, 0, 0, 0); \
            else if (g == 1) N1 = __builtin_amdgcn_mfma_f32_32x32x16_bf16(kf[1], qr[0], negm, 0, 0, 0); \
            else if (g & 1) N1 = __builtin_amdgcn_mfma_f32_32x32x16_bf16(kf[g], qr[g >> 1], N1, 0, 0, 0); \
            else N0 = __builtin_amdgcn_mfma_f32_32x32x16_bf16(kf[g], qr[g >> 1], N0, 0, 0, 0); \
            if (g & 1) PINF(N1); else PINF(N0);            \
            _Pragma("unroll") for (int e = EOF_(g); e < EOF_(g + 1); ++e) { x[e] = fast_exp2(CE(C0, C1, e)); PINF(x[e]); PROBE_XEXP(x[e]); } \
            _Pragma("unroll") for (int k = (g == 0 ? 0 : EOF_(g - 1) / 2); k < EOF_(g) / 2; ++k) { pwv[k] = pkbf(x[2 * k], x[2 * k + 1]); PINF(pwv[k]); } \
            __builtin_amdgcn_sched_barrier(0); } \
        PACC_T1(2); PACC_T0(3); \
        _Pragma("unroll") for (int g = 0; g < 8; ++g) { \
            if (g < 4) { vlo[g + 4] = VREADLO(g + 4); vhh[g + 4] = VREADHI(g + 4); } \
            if (g == 0) { _Pragma("unroll") for (int k = EOF_(G - 1) / 2; k < 16; ++k) { pwv[k] = pkbf(x[2 * k], x[2 * k + 1]); PINF(pwv[k]); } } \
            { const int ks = g >> 1; const bf16x8 pa = __builtin_bit_cast(bf16x8, ((v4u){pwv[4 * ks], pwv[4 * ks + 1], pwv[4 * ks + 2], pwv[4 * ks + 3]})); \
              const bf16x8 vf = (bf16x8){vlo[g][0], vlo[g][1], vlo[g][2], vlo[g][3], vhh[g][0], vhh[g][1], vhh[g][2], vhh[g][3]}; \
              if (g & 1) { o1 = __builtin_amdgcn_mfma_f32_32x32x16_bf16(pa, vf, o1, 0, 0, 0); PINF(o1); } else { o0 = __builtin_amdgcn_mfma_f32_32x32x16_bf16(pa, vf, o0, 0, 0, 0); PINF(o0); } } \
            _Pragma("unroll") for (int jj = 0; jj < 4; ++jj) { l4[jj] += x[4 * g + jj]; PINF(l4[jj]); } \
            { _Pragma("unroll") for (int i = MS_(g); i < MS_(g + 1); ++i) { \
                  if (i == 0) ma = MAX3(CE(N0, N1, 0), CE(N0, N1, 1), CE(N0, N1, 2)); else if (i == 1) mb = MAX3(CE(N0, N1, 3), CE(N0, N1, 4), CE(N0, N1, 5)); \
                  else if (i & 1) mb = MAX3(mb, CE(N0, N1, 2 * i + 2), CE(N0, N1, 2 * i + 3)); else ma = MAX3(ma, CE(N0, N1, 2 * i + 2), CE(N0, N1, 2 * i + 3)); \
                  if (i & 1) PINF(mb); else PINF(ma); } } \
            __builtin_amdgcn_sched_barrier(0); } \
        PACC_T1(3); PACC_T0(4); \
        ATT_DECIDE(N0, N1, ma, mb); \
        PACC_T1(4); PACC_T1(5); \
    } while (0)
    if (wid >= 4) __builtin_amdgcn_s_setprio(1);
    f32x16 a0, a1, b0, b1;
    {
        const LAS unsigned char* kb = lds + koff; bf16x8 kf[G];
#pragma unroll
        for (int g = 0; g < G; ++g) kf[g] = KREAD(g);
        __builtin_amdgcn_sched_barrier(0);
#pragma unroll
        for (int g = 0; g < G; ++g) {
            if (g == 0) a0 = __builtin_amdgcn_mfma_f32_32x32x16_bf16(kf[0], qr[0], negm, 0, 0, 0);
            else if (g == 1) a1 = __builtin_amdgcn_mfma_f32_32x32x16_bf16(kf[1], qr[0], negm, 0, 0, 0);
            else if (g & 1) a1 = __builtin_amdgcn_mfma_f32_32x32x16_bf16(kf[g], qr[g >> 1], a1, 0, 0, 0);
            else a0 = __builtin_amdgcn_mfma_f32_32x32x16_bf16(kf[g], qr[g >> 1], a0, 0, 0, 0); }
        float ma = __builtin_fmaxf(a0[0], a0[1]), mb = __builtin_fmaxf(a0[2], a0[3]);
#pragma unroll
        for (int i = 2; i < 16; ++i) { if (i & 1) mb = MAX3(mb, CE(a0, a1, 2 * i), CE(a0, a1, 2 * i + 1)); else ma = MAX3(ma, CE(a0, a1, 2 * i), CE(a0, a1, 2 * i + 1)); }
        m_run = swap_max(__builtin_fmaxf(ma, mb));
#pragma unroll
        for (int r = 0; r < 16; ++r) { a0[r] -= m_run; a1[r] -= m_run; negm[r] = -m_run; }
        asm volatile("" : "+v"(negm));
    }
    for (int t = 0; t + 2 < NT; t += 2) {
        ATT_LOADK(t + 3, kA0, kA1); ATT_LOADV(t + 2, vA); ATT_LOADV(t + 3, vB); if (t + 4 < NT) ATT_LOADK(t + 4, kB0, kB1);
        ATT_STEP(a0, a1, b0, b1, t); ATT_STEP(b0, b1, a0, a1, t + 1);
        ATT_STOREK((t + 3) & 3, kA0, kA1); ATT_STOREV((t + 2) & 3, vA); ATT_STOREV((t + 3) & 3, vB); if (t + 4 < NT) ATT_STOREK((t + 4) & 3, kB0, kB1);
        PACC_T0(1);
        __syncthreads();
        PACC_T1(1);
    }
    ATT_STEP(a0, a1, b0, b1, NT - 2);
    {
        const LAS unsigned char* vb = lds + VB + ((NT - 1) & 3) * 8192 + vlane; v4i16_t vlo[8], vhh[8];
#pragma unroll
        for (int g = 0; g < 8; ++g) { vlo[g] = VREADLO(g); vhh[g] = VREADHI(g); }
        __builtin_amdgcn_sched_barrier(0);
        float ls = 0.f;
#pragma unroll
        for (int r = 0; r < 16; ++r) { b0[r] = fast_exp2(b0[r]); b1[r] = fast_exp2(b1[r]); ls += b0[r] + b1[r]; }
        l4[0] += ls;
        v4u pw[4];
        pw[0] = (v4u){pkbf(b0[0], b0[1]), pkbf(b0[2], b0[3]), pkbf(b0[4], b0[5]), pkbf(b0[6], b0[7])};
        pw[1] = (v4u){pkbf(b0[8], b0[9]), pkbf(b0[10], b0[11]), pkbf(b0[12], b0[13]), pkbf(b0[14], b0[15])};
        pw[2] = (v4u){pkbf(b1[0], b1[1]), pkbf(b1[2], b1[3]), pkbf(b1[4], b1[5]), pkbf(b1[6], b1[7])};
        pw[3] = (v4u){pkbf(b1[8], b1[9]), pkbf(b1[10], b1[11]), pkbf(b1[12], b1[13]), pkbf(b1[14], b1[15])};
#pragma unroll
        for (int g = 0; g < 8; ++g) { const bf16x8 pa = __builtin_bit_cast(bf16x8, pw[g >> 1]);
            const bf16x8 vf = (bf16x8){vlo[g][0], vlo[g][1], vlo[g][2], vlo[g][3], vhh[g][0], vhh[g][1], vhh[g][2], vhh[g][3]};
            if (g & 1) o1 = __builtin_amdgcn_mfma_f32_32x32x16_bf16(pa, vf, o1, 0, 0, 0); else o0 = __builtin_amdgcn_mfma_f32_32x32x16_bf16(pa, vf, o0, 0, 0, 0); }
    }
    __builtin_amdgcn_s_setprio(0);
    const float lt = swap_sum((l4[0] + l4[1]) + (l4[2] + l4[3]));
    if (hi == 0) wsf[32 + r32] = frcp(lt);
    LDS_WAIT();
#pragma unroll
    for (int r = 0; r < 16; ++r) { const int q = crow(r, hi); const float il = wsf[32 + q]; bf16* orow = O + (size_t)(wid * 32 + q) * op;
        orow[r32] = f2bf(o0[r] * il); orow[32 + r32] = f2bf(o1[r] * il); }
    __syncthreads();
#undef ATT_LOADK
#undef ATT_LOADV
#undef ATT_STOREK
#undef ATT_STOREV
#undef ATT_STEP
#undef ATT_DECIDE
#undef KREAD
#undef VREADLO
#undef VREADHI
#undef CE
#undef EOF_
#undef MS_
}
__device__ __forceinline__ int hg_blk_row(int b, int blk) { return blk < 2 ? MLAT + b * CTXL + 128 * blk : b * SEQ + 128 * (blk - 2); }
__device__ __forceinline__ int hg_mc_of_blk(int dir, int blk) { return dir ? (blk < 2 ? 1 - blk : 67 - blk) : blk; }
template <int KT> __device__ __forceinline__ f32x16 mma_nt(f32x16 acc, const LAS bf16* A, int lda, const LAS bf16* Bt, int ldb, int r32, int hi) {
    const LAS bf16* ap = A + r32 * lda + 8 * hi; const LAS bf16* bp = Bt + r32 * ldb + 8 * hi;
#pragma unroll
    for (int k0 = 0; k0 < KT; k0 += 16) acc = __builtin_amdgcn_mfma_f32_32x32x16_bf16(*(const LAS bf16x8*)(ap + k0), *(const LAS bf16x8*)(bp + k0), acc, 0, 0, 0);
    return acc;
}
__device__ __forceinline__ void ldq16(const bf16* p, float (&o)[16]) {
    const v4u a = *(const GAS v4u*)p, b = *(const GAS v4u*)(p + 8);
    o[0] = bf_lo(a.x); o[1] = bf_hi(a.x); o[2] = bf_lo(a.y); o[3] = bf_hi(a.y); o[4] = bf_lo(a.z); o[5] = bf_hi(a.z); o[6] = bf_lo(a.w); o[7] = bf_hi(a.w);
    o[8] = bf_lo(b.x); o[9] = bf_hi(b.x); o[10] = bf_lo(b.y); o[11] = bf_hi(b.y); o[12] = bf_lo(b.z); o[13] = bf_hi(b.z); o[14] = bf_lo(b.w); o[15] = bf_hi(b.w);
}
__device__ __forceinline__ void ldf16(const float* p, float (&o)[16]) {
#pragma unroll
    for (int k = 0; k < 4; ++k) { const f32x4 a = *((const GAS f32x4*)p + k); o[4 * k] = a.x; o[4 * k + 1] = a.y; o[4 * k + 2] = a.z; o[4 * k + 3] = a.w; }
}
__device__ __forceinline__ void st16(LAS bf16* p, const float (&v)[16]) {
    *(LAS v4u*)p = (v4u){pkbf(v[0], v[1]), pkbf(v[2], v[3]), pkbf(v[4], v[5]), pkbf(v[6], v[7])};
    *(LAS v4u*)(p + 8) = (v4u){pkbf(v[8], v[9]), pkbf(v[10], v[11]), pkbf(v[12], v[13]), pkbf(v[14], v[15])};
}

__device__ __forceinline__ void ldq8(const bf16* p, float (&o)[8]) { const v4u a = *(const GAS v4u*)p;
    o[0] = bf_lo(a.x); o[1] = bf_hi(a.x); o[2] = bf_lo(a.y); o[3] = bf_hi(a.y); o[4] = bf_lo(a.z); o[5] = bf_hi(a.z); o[6] = bf_lo(a.w); o[7] = bf_hi(a.w); }
__device__ __forceinline__ void ldf8(const float* p, float (&o)[8]) { const f32x4 a = *(const GAS f32x4*)p, b = *((const GAS f32x4*)p + 1); o[0] = a.x; o[1] = a.y; o[2] = a.z; o[3] = a.w; o[4] = b.x; o[5] = b.y; o[6] = b.z; o[7] = b.w; }
__device__ __forceinline__ void st8(LAS bf16* p, const float (&v)[8]) { *(LAS v4u*)p = (v4u){pkbf(v[0], v[1]), pkbf(v[2], v[3]), pkbf(v[4], v[5]), pkbf(v[6], v[7])}; }

struct HgT { const bf16 *Qd, *Vd, *Sg; const float *Zf, *Zb; const float* lb  ; bf16* HST  ; float* HDM; const float* ong; bf16* OO; };

__device__ __forceinline__ void hg_a_unit(Frame& F, const HgT& T, int chain, int mc) {
    const int dir = chain & 1, h = (chain >> 1) & 3, b = chain >> 3, hoff = h * 128;
    const int row0 = hg_blk_row(b, hg_mc_of_blk(dir, mc));
    const float* Z = dir ? T.Zb : T.Zf;
    LAS float* PT = (LAS float*)F.lds;
    LAS bf16* KET = (LAS bf16*)(F.lds + 2048);
    LAS bf16* VT = (LAS bf16*)(F.lds + 2048 + 34816);
    const int tid = F.tid, lane = F.lane, r32 = lane & 31, hi = lane >> 5, wid = F.wave;
    const int e = tid & 127, p = __builtin_amdgcn_readfirstlane(tid >> 7);
    const float lbv = T.lb[dir * 512 + hoff + e];
    const float* zp = Z + (size_t)(row0 + 32 * p) * 512 + hoff; const bf16* vp = T.Vd + (size_t)(row0 + 32 * p) * 512 + hoff;
    float w[32], kk[32]; unsigned vv[16];
#pragma unroll
    for (int i = 0; i < 32; ++i) { const float z = ((const GAS float*)(zp + (size_t)i * 512))[e]; const float sg = sigmoidf_(z); w[i] = __logf(lbv + (1.f - lbv) * sg); kk[i] = (1.f - lbv) * (1.f - sg); }
#pragma unroll
    for (int i = 0; i < 16; ++i) vv[i] = (unsigned)((const GAS bf16*)(vp + (size_t)(2 * i) * 512))[e] | ((unsigned)((const GAS bf16*)(vp + (size_t)(2 * i + 1) * 512))[e] << 16);
    float run = 0.f;
    if (dir == 0) {
#pragma unroll
        for (int i = 31; i >= 0; --i) { const float tmp = w[i]; w[i] = run; run += tmp; }
    } else {
#pragma unroll
        for (int i = 0; i < 32; ++i) { const float tmp = w[i]; w[i] = run; run += tmp; }
    }
    PT[p * 128 + e] = run;
    __syncthreads();
    { const float p0 = PT[e], p1 = PT[128 + e], p2 = PT[256 + e], p3 = PT[384 + e];
      const float offs = dir == 0 ? ((p < 3 ? p3 : 0.f) + (p < 2 ? p2 : 0.f) + (p < 1 ? p1 : 0.f)) : ((p > 0 ? p0 : 0.f) + (p > 1 ? p1 : 0.f) + (p > 2 ? p2 : 0.f));
      if (p == 0) T.HDM[((size_t)chain * 66 + mc) * 128 + e] = __expf((p0 + p1) + (p2 + p3));
#pragma unroll
      for (int g = 0; g < 4; ++g) { unsigned pk[4];
#pragma unroll
          for (int c = 0; c < 4; ++c) { const int i = 8 * g + 2 * c; pk[c] = pkbf(kk[i] * __expf(w[i] + offs), kk[i + 1] * __expf(w[i + 1] + offs)); }
          *(LAS v4u*)(KET + e * 136 + 32 * p + 8 * g) = (v4u){pk[0], pk[1], pk[2], pk[3]};
          *(LAS v4u*)(VT + e * 136 + 32 * p + 8 * g) = (v4u){vv[4 * g], vv[4 * g + 1], vv[4 * g + 2], vv[4 * g + 3]}; } }
    __syncthreads();
    { const int ei = wid & 3, fp = wid >> 2; bf16* dst = T.HST + ((size_t)chain * 66 + mc) * 16384;
#pragma unroll
      for (int k = 0; k < 2; ++k) { const int fi = 2 * fp + k; f32x16 acc = {}; acc = mma_nt<128>(acc, KET + 32 * ei * 136, 136, VT + 32 * fi * 136, 136, r32, hi);
#pragma unroll
          for (int r = 0; r < 16; ++r) dst[(32 * ei + crow(r, hi)) * 128 + 32 * fi + r32] = (bf16)(pkh(acc[r], 0.f) & 0xffffu); } }
    __syncthreads();
}
__device__ __forceinline__ void phase_hg_b(Frame& F, const HgT& T) {
    const int g = F.vcu * NTHR + F.tid;
    for (int gi = g; gi < 32 * 4096; gi += F.G * NTHR) {
        const int chain = gi >> 12, idx = gi & 4095, e = idx >> 5, f4 = idx & 31;
        v2u* base = (v2u*)(T.HST + (size_t)chain * 66 * 16384 + e * 128) + f4; const float* dmp = T.HDM + (size_t)chain * 66 * 128 + e;
        f32x4 S = {0.f, 0.f, 0.f, 0.f};
#pragma unroll 6
        for (int mc = 0; mc < 66; ++mc) { const f32x4 kv = __builtin_convertvector(__builtin_bit_cast(h16x4, base[(size_t)mc * 4096]), f32x4); const float d = dmp[mc * 128];
            base[(size_t)mc * 4096] = (v2u){pkh(S.x, S.y), pkh(S.z, S.w)}; S = S * d + kv; }
    }
}
__device__ __forceinline__ void hg_c_unit(Frame& F, const HgT& T, int b, int h, int blk) {
    const int hoff = h * 128, row0 = hg_blk_row(b, blk);
    const int tid = F.tid, lane = F.lane, r32 = lane & 31, hi = lane >> 5, wid = F.wave;
    LAS bf16* P = (LAS bf16*)F.lds;
    LAS float* PT = (LAS float*)(F.lds + 32768);
    LAS float* DE = (LAS float*)(F.lds + 34816);
    LAS float* BR = (LAS float*)(F.lds + 35328);
    LAS bf16* QB = (LAS bf16*)(F.lds + 35840);
    LAS bf16* QS = (LAS bf16*)(F.lds + 53248);
    LAS bf16* KS = (LAS bf16*)(F.lds + 70656);
    LAS bf16* KET = (LAS bf16*)(F.lds + 88064);
    LAS bf16* VT = (LAS bf16*)(F.lds + 106496);
    LAS bf16* ST = (LAS bf16*)(F.lds + 124928);
    LAS float* OUT = (LAS float*)(F.lds + 35840);
    const int ti = wid & 1, fi = wid >> 1;
    const int ei = wid & 3, fp = wid >> 2;
    f32x16 oacc0 = {}, oacc1 = {};
    const int se = tid & 127, sp = __builtin_amdgcn_readfirstlane(tid >> 7);
#ifndef HGDIR_LO
#define HGDIR_LO 0
#define HGDIR_HI 2
#endif
    float zraw[16]; unsigned qraw[16], vraw[16];
#define HC_LOAD(dir_, cc_) do { const int ci_ = (dir_) ? 1 - (cc_) : (cc_); const int rowc_ = row0 + 64 * ci_; const float* Z_ = (dir_) ? T.Zb : T.Zf; \
        const float* zp_ = Z_ + (size_t)(rowc_ + 16 * sp) * 512 + hoff; const bf16* qp_ = T.Qd + (size_t)(rowc_ + 16 * sp) * 512 + hoff; const bf16* vp_ = T.Vd + (size_t)(rowc_ + 16 * sp) * 512 + hoff; \
        _Pragma("unroll") for (int i = 0; i < 16; ++i) { zraw[i] = ((const GAS float*)(zp_ + (size_t)i * 512))[se]; qraw[i] = ((const GAS bf16*)(qp_ + (size_t)i * 512))[se]; vraw[i] = ((const GAS bf16*)(vp_ + (size_t)i * 512))[se]; } } while (0)
    HC_LOAD(HGDIR_LO, 0);
#pragma unroll 1
    for (int dir = HGDIR_LO; dir < HGDIR_HI; ++dir) {
        const int chain = (b * 4 + h) * 2 + dir; const float* Z = dir ? T.Zb : T.Zf;
        const bf16* Sin = T.HST + ((size_t)chain * 66 + hg_mc_of_blk(dir, blk)) * 16384;
        f32x16 S[2];
#pragma unroll
        for (int k = 0; k < 2; ++k)
#pragma unroll
            for (int r = 0; r < 16; ++r) S[k][r] = (float)__builtin_bit_cast(_Float16, ((const GAS bf16*)(Sin + (32 * ei + (r & 3) + 8 * (r >> 2)) * 128 + 32 * (2 * fp + k)))[4 * hi * 128 + r32]);
#pragma unroll
        for (int k = 0; k < 2; ++k)
#pragma unroll
            for (int g = 0; g < 4; ++g) *(LAS v2u*)(ST + (32 * (2 * fp + k) + r32) * 136 + 32 * ei + 8 * g + 4 * hi) = (v2u){pkbf(S[k][4 * g], S[k][4 * g + 1]), pkbf(S[k][4 * g + 2], S[k][4 * g + 3])};
#pragma unroll 1
        for (int cc = 0; cc < 2; ++cc) {
            const int ci = dir ? 1 - cc : cc; const int rowc = row0 + 64 * ci;
            { const float lbv = T.lb[dir * 512 + hoff + se];
              float bq[16], kk[16], qv[16]; unsigned vv[8];
#pragma unroll
              for (int i = 0; i < 16; ++i) { const float z = zraw[i]; const float sg = sigmoidf_(z); bq[i] = __logf(lbv + (1.f - lbv) * sg); kk[i] = (1.f - lbv) * (1.f - sg); qv[i] = __uint_as_float(qraw[i] << 16); }
#pragma unroll
              for (int i = 0; i < 8; ++i) vv[i] = vraw[2 * i] | (vraw[2 * i + 1] << 16);
              float run = 0.f;
              if (dir == 0) {
#pragma unroll
                  for (int i = 0; i < 16; ++i) { run += bq[i]; bq[i] = run; }
              } else {
#pragma unroll
                  for (int i = 15; i >= 0; --i) { run += bq[i]; bq[i] = run; }
              }
              PT[sp * 128 + se] = run;
              if (dir == 0) { if (sp == 1) BR[se] = bq[15]; } else { if (sp == 2) BR[se] = bq[0]; }
              __syncthreads();
              const float p0 = PT[se], p1 = PT[128 + se], p2 = PT[256 + se], p3 = PT[384 + se];
              const float offs = dir == 0 ? ((sp > 0 ? p0 : 0.f) + (sp > 1 ? p1 : 0.f) + (sp > 2 ? p2 : 0.f)) : ((sp < 3 ? p3 : 0.f) + (sp < 2 ? p2 : 0.f) + (sp < 1 ? p1 : 0.f));
              const float bend = (p0 + p1) + (p2 + p3), br = BR[se] + (dir == 0 ? p0 : p3);
              if (sp == 0) DE[se] = __expf(bend);
              unsigned ke[8];
#pragma unroll
              for (int c = 0; c < 8; ++c) { const float b0 = bq[2 * c] + offs, b1 = bq[2 * c + 1] + offs; ke[c] = pkbf(kk[2 * c] * __expf(bend - b0), kk[2 * c + 1] * __expf(bend - b1)); }
              *(LAS v4u*)(KET + se * 72 + 16 * sp) = (v4u){ke[0], ke[1], ke[2], ke[3]}; *(LAS v4u*)(KET + se * 72 + 16 * sp + 8) = (v4u){ke[4], ke[5], ke[6], ke[7]};
              *(LAS v4u*)(VT + se * 72 + 16 * sp) = (v4u){vv[0], vv[1], vv[2], vv[3]}; *(LAS v4u*)(VT + se * 72 + 16 * sp + 8) = (v4u){vv[4], vv[5], vv[6], vv[7]};
#pragma unroll
              for (int i = 0; i < 16; ++i) { const float bb = bq[i] + offs; const int tok = 16 * sp + i;
                  QB[tok * 136 + se] = f2bf(qv[i] * __expf(bb)); QS[tok * 136 + se] = f2bf(qv[i] * __expf(bb - br)); KS[tok * 136 + se] = f2bf(kk[i] * __expf(br - bb)); } }
            __syncthreads();
            if (cc == 0) HC_LOAD(dir, 1); else if (dir + 1 < HGDIR_HI) HC_LOAD(dir + 1, 0);
            if (wid < 4) { const int tb = wid & 1, sb = wid >> 1; f32x16 sc = {}; sc = mma_nt<128>(sc, QS + 32 * tb * 136, 136, KS + 32 * sb * 136, 136, r32, hi);
#pragma unroll
                for (int r = 0; r < 16; ++r) { const int t = 32 * tb + crow(r, hi), s = 32 * sb + r32; const bool keep = dir ? (s >= t) : (s <= t); P[t * 72 + s] = f2bf(keep ? sc[r] : 0.f); } }
            __syncthreads();
            { f32x16 a = ci ? oacc1 : oacc0; a = mma_nt<64>(a, P + 32 * ti * 72, 72, VT + 32 * fi * 72, 72, r32, hi); a = mma_nt<128>(a, QB + 32 * ti * 136, 136, ST + 32 * fi * 136, 136, r32, hi); if (ci) oacc1 = a; else oacc0 = a; }
            __syncthreads();
#pragma unroll
            for (int k = 0; k < 2; ++k) {
#pragma unroll
                for (int r = 0; r < 16; ++r) S[k][r] *= DE[32 * ei + crow(r, hi)];
                S[k] = mma_nt<64>(S[k], KET + 32 * ei * 72, 72, VT + 32 * (2 * fp + k) * 72, 72, r32, hi);
                asm volatile("s_nop 15\n\ts_nop 7" : "+v"(S[k]));
#pragma unroll
                for (int g = 0; g < 4; ++g) *(LAS v2u*)(ST + (32 * (2 * fp + k) + r32) * 136 + 32 * ei + 8 * g + 4 * hi) = (v2u){pkbf(S[k][4 * g], S[k][4 * g + 1]), pkbf(S[k][4 * g + 2], S[k][4 * g + 3])};
            }
            __syncthreads();
        }
#if defined(SELFCHK) && SELFCHK == 6
        { const int pair = (b == 1 && h == 2) ? 0 : (b == 3 && h == 0) ? 1 : -1;
          if (pair >= 0) {
#pragma unroll
            for (int r = 0; r < 16; ++r) { OUT[(32 * ti + crow(r, hi)) * 132 + 32 * fi + r32] = oacc0[r]; OUT[(64 + 32 * ti + crow(r, hi)) * 132 + 32 * fi + r32] = oacc1[r]; }
            __syncthreads();
            float* D = (float*)(F.ws + 1002 * MiB) + ((size_t)(dir * 2 + pair) * 8448 + (blk < 2 ? 128 * blk : 256 + 128 * (blk - 2))) * 128;
            for (int i = tid; i < 128 * 128; i += NTHR) D[i] = OUT[(i >> 7) * 132 + (i & 127)];
            __syncthreads(); } }
#endif
    }
#undef HC_LOAD
    { int l2; asm volatile("v_mbcnt_lo_u32_b32 %0, -1, 0\n\tv_mbcnt_hi_u32_b32 %0, -1, %0" : "=v"(l2)); const int r32b = l2 & 31, hib = l2 >> 5;
#pragma unroll
      for (int r = 0; r < 16; ++r) { OUT[(32 * ti + crow(r, hib)) * 132 + 32 * fi + r32b] = oacc0[r]; OUT[(64 + 32 * ti + crow(r, hib)) * 132 + 32 * fi + r32b] = oacc1[r]; }
      __syncthreads();
      for (int k = 0; k < 16; ++k) { const int t = 16 * wid + k; const float a0 = OUT[t * 132 + l2], a1 = OUT[t * 132 + 64 + l2];
        const float ms = wave_sum(a0 * a0 + a1 * a1, l2) * (1.f / 128.f); const float rs = __builtin_amdgcn_rsqf(ms + 1e-6f);
        const bf16* sgr = T.Sg + (size_t)(row0 + t) * 512 + hoff; bf16* orow = T.OO + (size_t)(row0 + t) * 1024 + 512 + hoff;
        ((GAS bf16*)orow)[l2] = f2bf(a0 * rs * ((const GAS float*)T.ong)[l2] * bf2f(((const GAS bf16*)sgr)[l2])); ((GAS bf16*)orow)[64 + l2] = f2bf(a1 * rs * ((const GAS float*)T.ong)[64 + l2] * bf2f(((const GAS bf16*)sgr)[64 + l2])); } }
    __syncthreads();
}
__device__ __forceinline__ void ld8(const float* p, float (&v)[8]) { const f32x4 a = *(const GAS f32x4*)p, b = *(const GAS f32x4*)(p + 4); v[0] = a.x; v[1] = a.y; v[2] = a.z; v[3] = a.w; v[4] = b.x; v[5] = b.y; v[6] = b.z; v[7] = b.w; }
__device__ __forceinline__ void ld8(const bf16* p, float (&v)[8]) { const v4u a = *(const GAS v4u*)p;
    v[0] = __uint_as_float(a.x << 16); v[1] = __uint_as_float(a.x & 0xffff0000u); v[2] = __uint_as_float(a.y << 16); v[3] = __uint_as_float(a.y & 0xffff0000u);
    v[4] = __uint_as_float(a.z << 16); v[5] = __uint_as_float(a.z & 0xffff0000u); v[6] = __uint_as_float(a.w << 16); v[7] = __uint_as_float(a.w & 0xffff0000u); }
__device__ __forceinline__ v4u pk8(const float (&v)[8], float s) { return (v4u){pkbf(v[0] * s, v[1] * s), pkbf(v[2] * s, v[3] * s), pkbf(v[4] * s, v[5] * s), pkbf(v[6] * s, v[7] * s)}; }
template <int R>
__device__ __forceinline__ void head_norm_rope(float (&v)[R][8], const float (&g8)[8], int l8  , const bool (&rope)[R], const int (&trow)[R], const int (&tcol)[R], const float* ropeA, int lane) {
    float ss[R];
#pragma unroll
    for (int q = 0; q < R; ++q) { ss[q] = 0.f;
#pragma unroll
        for (int e = 0; e < 8; ++e) ss[q] += v[q][e] * v[q][e]; }
#pragma unroll
    for (int q = 0; q < R; ++q) ss[q] += shx(ss[q], 1, lane);
#pragma unroll
    for (int q = 0; q < R; ++q) ss[q] += shx(ss[q], 2, lane);
#pragma unroll
    for (int q = 0; q < R; ++q) ss[q] += shx(ss[q], 4, lane);
    float pr[R][8];
#pragma unroll
    for (int q = 0; q < R; ++q) { const float rs = __builtin_amdgcn_rsqf(ss[q] * (1.f / 64.f) + 1e-6f);
#pragma unroll
        for (int e = 0; e < 8; ++e) v[q][e] = v[q][e] * rs * g8[e]; }
#pragma unroll
    for (int q = 0; q < R; ++q)
#pragma unroll
        for (int e = 0; e < 8; ++e) pr[q][e] = shx(v[q][e], 2, lane);
#pragma unroll
    for (int q = 0; q < R; ++q) if (rope[q]) { const int axis = l8 >> 2, pos = axis ? tcol[q] : trow[q]; const float* cs = ropeA + (pos * 16 + 8 * (l8 & 1)) * 2; const bool second = (l8 & 2) != 0;
        float cc[16];
#pragma unroll
        for (int k = 0; k < 4; ++k) { const f32x4 c4 = *((const GAS f32x4*)cs + k); cc[4 * k] = c4.x; cc[4 * k + 1] = c4.y; cc[4 * k + 2] = c4.z; cc[4 * k + 3] = c4.w; }
#pragma unroll
        for (int e = 0; e < 8; ++e) { const float c_ = cc[2 * e], s_ = cc[2 * e + 1]; v[q][e] = second ? (v[q][e] * c_ + pr[q][e] * s_) : (v[q][e] * c_ - pr[q][e] * s_); } }
}
__device__ __forceinline__ void phase_even_post(Frame& F, const PArgs& A, int j) {
    constexpr int R = 2;
    const int gw = F.vcu * NWAVES + F.wave, NGW = F.G * NWAVES, lane = F.lane;
    const bf16* RAW = (const bf16*)(F.ws + WS_RAW);
    bf16 *QG = (bf16*)(F.ws + WS_QG), *KG = (bf16*)(F.ws + WS_KG), *VG = (bf16*)(F.ws + WS_VG), *CQN = (bf16*)(F.ws + WS_CQN), *CKVN = (bf16*)(F.ws + WS_CKVN), *KM = (bf16*)(F.ws + WS_KM);
    const float* ropeA = (const float*)(F.ws + WS_SMALL + SM_ROPEA); const float* ropeB = (const float*)(F.ws + WS_SMALL + SM_ROPEB);
    float gq[8], gk[8], gcq[8], gckv[8];
    ld8(A.in[I_QNG] + j * 64 + 8 * (lane & 7), gq); ld8(A.in[I_KNG] + j * 64 + 8 * (lane & 7), gk); ld8(A.in[I_CQG] + j * 384 + 8 * (lane < 48 ? lane : 0), gcq); ld8(A.in[I_CKVG] + j * 256 + 8 * (lane & 31), gckv);
    constexpr int NR = (MROWS + R - 1) / R;
    for (int g = gw; g < NR; g += NGW) {
        const bf16* r[R]; bool lat[R]; int trow[R], tcol[R], m[R];
#pragma unroll
        for (int q = 0; q < R; ++q) { m[q] = R * g + q; r[q] = RAW + (size_t)m[q] * EV_INP; lat[q] = m[q] < MLAT; const int t = m[q] & (SEQ - 1); trow[q] = t >> 6; tcol[q] = t & 63; }
        float v[R][8], w[R][8];
#pragma unroll
        for (int q = 0; q < R; ++q) ld8(r[q] + 8 * lane, v[q]);
        head_norm_rope<R>(v, gq, lane & 7, lat, trow, tcol, ropeA, lane);
#pragma unroll
        for (int q = 0; q < R; ++q) *(GAS v4u*)(QG + (size_t)m[q] * 512 + 8 * lane) = pk8(v[q], C2_64);
        { const int l = lane & 31;
#pragma unroll
          for (int q = 0; q < R; ++q) { ld8(r[q] + 512 + 8 * l, v[q]);
#pragma unroll
              for (int e = 0; e < 8; ++e) w[q][e] = v[q][e]; }
          head_norm_rope<R>(w, gk, l & 7, lat, trow, tcol, ropeA, lane);
#pragma unroll
          for (int q = 0; q < R; ++q) { if (lane < 16) *(GAS v4u*)(KG + (size_t)m[q] * 128 + 8 * lane) = pk8(w[q], 1.f);
              else if (lane < 32) *(GAS v4u*)(VG + (size_t)m[q] * 128 + 8 * (lane - 16)) = pk8(v[q], 1.f); } }
        { const bool on1 = lane < 48, on2 = lane < 32; float s1[R], s2[R];
#pragma unroll
          for (int q = 0; q < R; ++q) { ld8(r[q] + 768 + 8 * (on1 ? lane : 0), v[q]); ld8(r[q] + 1152 + 8 * (lane & 31), w[q]); s1[q] = 0.f; s2[q] = 0.f;
#pragma unroll
              for (int e = 0; e < 8; ++e) { s1[q] += on1 ? v[q][e] * v[q][e] : 0.f; s2[q] += on2 ? w[q][e] * w[q][e] : 0.f; } }
#pragma unroll
          for (int o = 1; o < 64; o <<= 1) {
#pragma unroll
              for (int q = 0; q < R; ++q) { s1[q] += shx(s1[q], o, lane); s2[q] += shx(s2[q], o, lane); } }
#pragma unroll
          for (int q = 0; q < R; ++q) { const float rs1 = __builtin_amdgcn_rsqf(s1[q] * (1.f / 384.f) + 1e-6f), rs2 = __builtin_amdgcn_rsqf(s2[q] * (1.f / 256.f) + 1e-6f);
#pragma unroll
              for (int e = 0; e < 8; ++e) { v[q][e] = v[q][e] * rs1 * gcq[e]; w[q][e] = w[q][e] * rs2 * gckv[e]; }
              if (on1) *(GAS v4u*)(CQN + (size_t)m[q] * 384 + 8 * lane) = pk8(v[q], 1.f);
              if (on2) *(GAS v4u*)(CKVN + (size_t)m[q] * 256 + 8 * lane) = pk8(w[q], 1.f); } }
        { const int l4 = lane & 3;
#pragma unroll
          for (int q = 0; q < R; ++q) ld8(r[q] + 1408 + 8 * l4, v[q]);
#pragma unroll
          for (int q = 0; q < R; ++q)
#pragma unroll
              for (int e = 0; e < 8; ++e) w[q][e] = shx(v[q][e], 1, lane);
#pragma unroll
          for (int q = 0; q < R; ++q) { if (lat[q]) { const int axis = l4 >> 1, pos = axis ? tcol[q] : trow[q]; const float* cs = ropeB + pos * 16; const bool second = (l4 & 1) != 0;
                  float cc[16];
#pragma unroll
                  for (int k = 0; k < 4; ++k) { const f32x4 c4 = *((const GAS f32x4*)cs + k); cc[4 * k] = c4.x; cc[4 * k + 1] = c4.y; cc[4 * k + 2] = c4.z; cc[4 * k + 3] = c4.w; }
#pragma unroll
                  for (int e = 0; e < 8; ++e) { const float c_ = cc[2 * e], s_ = cc[2 * e + 1]; v[q][e] = second ? (v[q][e] * c_ + w[q][e] * s_) : (v[q][e] * c_ - w[q][e] * s_); } }
              if (lane < 32) { const int head = lane >> 2; *(GAS v4u*)(KM + (size_t)m[q] * 768 + head * 96 + 64 + 8 * l4) = pk8(v[q], 1.f); } } }
    }
}
__device__ __forceinline__ void phase_even_attn(Frame& F) {
    const bf16 *QG = (const bf16*)(F.ws + WS_QG), *KG = (const bf16*)(F.ws + WS_KG), *VG = (const bf16*)(F.ws + WS_VG);
    const bf16 *QM = (const bf16*)(F.ws + WS_QM), *KM = (const bf16*)(F.ws + WS_KM), *VM = (const bf16*)(F.ws + WS_VM); bf16* OE = (bf16*)(F.ws + WS_OE);
    for (int u = F.vcu; u < 1024 + 32; u += F.G) {
        if (u < 1024) {
            const int qb = u & 31, hq = (u >> 5) & 3, kvh = (u >> 7) & 1, b = u >> 8, h = kvh * 4 + hq; const size_t r0 = (size_t)b * SEQ + qb * 256, kl = (size_t)b * SEQ, kc = (size_t)MLAT + b * CTXL;
            attn_unit_p<64>(F.lds, F.tid, QG + r0 * 512 + h * 64, 512, KG + kl * 128 + kvh * 64, VG + kl * 128 + kvh * 64, 128, KG + kc * 128 + kvh * 64, VG + kc * 128 + kvh * 64, 4, 128, 128,
                             OE + r0 * 1024 + h * 64, 1024);
        } else { const int id = u - 1024, h = id & 7, b = id >> 3, kvh = h >> 2; const size_t kc = (size_t)MLAT + b * CTXL;
            attn_unit_p<64>(F.lds, F.tid, QG + kc * 512 + h * 64, 512, nullptr, nullptr, 0, KG + kc * 128 + kvh * 64, VG + kc * 128 + kvh * 64, 4, 128, 128, OE + kc * 1024 + h * 64, 1024); }
    }
    for (int u = F.vcu; u < 1024 + 32; u += F.G) {
        if (u < 1024) {
            const int qb = u & 31, h = (u >> 5) & 7, b = u >> 8; const size_t r0 = (size_t)b * SEQ + qb * 256, kl = (size_t)b * SEQ, kc = (size_t)MLAT + b * CTXL;
            attn_unit_p<96>(F.lds, F.tid, QM + r0 * 768 + h * 96, 768, KM + kl * 768 + h * 96, VM + kl * 512 + h * 64, 128, KM + kc * 768 + h * 96, VM + kc * 512 + h * 64, 4, 768, 512,
                             OE + r0 * 1024 + 512 + h * 64, 1024);
        } else { const int id = u - 1024, h = id & 7, b = id >> 3; const size_t kc = (size_t)MLAT + b * CTXL;
            attn_unit_p<96>(F.lds, F.tid, QM + kc * 768 + h * 96, 768, nullptr, nullptr, 0, KM + kc * 768 + h * 96, VM + kc * 512 + h * 64, 4, 768, 512, OE + kc * 1024 + 512 + h * 64, 1024); }
    }
}
__device__ __forceinline__ void phase_odd_mix(Frame& F, const PArgs& A, const HgT& T, int j) {
    const bf16 *QN = (const bf16*)(F.ws + WS_QN), *KN = (const bf16*)(F.ws + WS_KN), *VN = (const bf16*)(F.ws + WS_VN); bf16* OO = (bf16*)(F.ws + WS_OO);
    const float* rpb = A.in[I_RPB] + (size_t)j * 8 * 15 * 31;
#ifndef NO_NA
#if defined(NA_TWICE)
    for (int rep = 0; rep < 2; ++rep)
#endif
    for (int u = F.vcu; u < 1024; u += F.G) {
        const int rg = u & 31, h = (u >> 5) & 7, b = u >> 8; const int rlo = min(max(4 * rg - 4, 0), 120), rhi = min(max(4 * rg + 3 - 4, 0), 120) + 8;
        const size_t r0 = (size_t)b * SEQ + (size_t)rg * 256, kl = (size_t)b * SEQ + (size_t)rlo * 64, kc = (size_t)MLAT + b * CTXL;
        attn_unit<64, 1>(F.lds, F.tid, QN + r0 * 512 + h * 64, 512, KN + kl * 512 + h * 64, VN + kl * 512 + h * 64, rhi - rlo, KN + kc * 512 + h * 64, VN + kc * 512 + h * 64, 4, 512, 512,
                         OO + r0 * 1024 + h * 64, 1024, 4 * rg, rlo, rpb + h * 465);
    }
#endif
    for (int u = F.vcu; u < (j == 1 ? 0 : 32); u += F.G) {
        const int h = u & 7, b = u >> 3; const size_t kc = (size_t)MLAT + b * CTXL;
        attn_unit<64, 0>(F.lds, F.tid, QN + kc * 512 + h * 64, 512, nullptr, nullptr, 0, KN + kc * 512 + h * 64, VN + kc * 512 + h * 64, 4, 512, 512, OO + kc * 1024 + h * 64, 1024, 0, 0, nullptr);
    }
#ifndef NO_HA
    for (int u = F.vcu; u < 2112; u += F.G) hg_a_unit(F, T, u / 66, u % 66);
#if defined(HA_TWICE)
    for (int u = F.vcu; u < 2112; u += F.G) hg_a_unit(F, T, u / 66, u % 66);
#endif
#endif
}
__device__ __forceinline__ void ctx_resid_gemm(Frame& F, const bf16* A  , const bf16* Bt  , int K, bf16* Z, const float* gate, const void* base, bool src16  ) {
    const int tid = F.tid, lane = F.lane, r32 = lane & 31, hi = lane >> 5, wid = F.wave;
    LAS float* part = (LAS float*)F.lds;
    for (int u = F.vcu; u < 256; u += F.G) {
        const int tm = u >> 4, tn = u & 15;
        const int ks = K / 8, k0 = wid * ks;
        const bf16* a0 = A + (size_t)(MLAT + 64 * tm + r32) * K + k0 + 8 * hi; const bf16* b0 = Bt + (size_t)(64 * tn + r32) * K + k0 + 8 * hi;
        f32x16 c00, c01, c10, c11;
#pragma unroll
        for (int r = 0; r < 16; ++r) { c00[r] = 0.f; c01[r] = 0.f; c10[r] = 0.f; c11[r] = 0.f; }
#pragma unroll 2
        for (int k = 0; k < ks; k += 16) {
            const bf16x8 fa0 = *(const GAS bf16x8*)(a0 + k), fa1 = *(const GAS bf16x8*)(a0 + (size_t)32 * K + k), fb0 = *(const GAS bf16x8*)(b0 + k), fb1 = *(const GAS bf16x8*)(b0 + (size_t)32 * K + k);
            c00 = __builtin_amdgcn_mfma_f32_32x32x16_bf16(fa0, fb0, c00, 0, 0, 0); c01 = __builtin_amdgcn_mfma_f32_32x32x16_bf16(fa0, fb1, c01, 0, 0, 0);
            c10 = __builtin_amdgcn_mfma_f32_32x32x16_bf16(fa1, fb0, c10, 0, 0, 0); c11 = __builtin_amdgcn_mfma_f32_32x32x16_bf16(fa1, fb1, c11, 0, 0, 0);
        }
        LAS float* pw = part + wid * (64 * 65);
#pragma unroll
        for (int r = 0; r < 16; ++r) { const int i = crow(r, hi); pw[i * 65 + r32] = c00[r]; pw[i * 65 + 32 + r32] = c01[r]; pw[(32 + i) * 65 + r32] = c10[r]; pw[(32 + i) * 65 + 32 + r32] = c11[r]; }
        __syncthreads();
        for (int e = tid; e < 64 * 64; e += NTHR) { const int i = e >> 6, jc = e & 63; float s = 0.f;
#pragma unroll
            for (int w = 0; w < 8; ++w) s += part[w * (64 * 65) + i * 65 + jc];
            const size_t xo = (size_t)(MLAT + 64 * tm + i) * 1024 + 64 * tn + jc; const int col = 64 * tn + jc;
            const size_t bo = (size_t)(64 * tm + i) * 1024 + col;
            const float xb = src16 ? (float)__builtin_bit_cast(_Float16, ((const bf16*)base)[bo]) : ((const float*)base)[bo];
            Z[xo] = (bf16)(pkh(ALPHA * xb + gate[4 * 6144 + col] * s, 0.f) & 0xffffu); }
        __syncthreads();
    }
}
__device__ __forceinline__ void moe_offsets(const gu32* cnt, int (&off)[9]) {
    int a = 0;
#pragma unroll
    for (int e = 0; e < 8; ++e) { off[e] = a; const int c = __builtin_amdgcn_readfirstlane((int)__hip_atomic_load(cnt + e, __ATOMIC_RELAXED, __HIP_MEMORY_SCOPE_AGENT)); a += (c + 255) & ~255; }
    off[8] = a;
}
__device__ __forceinline__ void phase_moe_dispatch(Frame& F, int j, int nrows) {
    int* topk = (int*)(F.ws + WS_TOPK); const bf16* H = (const bf16*)(F.ws + WS_H); unsigned char* XG8 = F.ws + WS_XG8;
    LAS unsigned* lc = (LAS unsigned*)F.lds;
    LAS int* lrow = (LAS int*)(F.lds + 256);
    int off[9]; moe_offsets(F.ctl + CW_CNT + 64 * j, off);
    const int per = nrows / 256;
    for (int c0 = F.vcu * per; c0 < nrows; c0 += F.G * per) {
        if (F.tid < 8) lc[F.tid] = 0u;
        __syncthreads();
        int e1 = 0, e2 = 0, li1 = 0, li2 = 0; const bool on = F.tid < per;
        if (on) { e1 = topk[(c0 + F.tid) * 6]; e2 = topk[(c0 + F.tid) * 6 + 1]; li1 = (int)atomicAdd((unsigned*)&lc[e1], 1u); li2 = (int)atomicAdd((unsigned*)&lc[e2], 1u); }
        __syncthreads();
        if (F.tid < 8) lc[8 + F.tid] = __hip_atomic_fetch_add((unsigned*)(F.ctl + CW_CNT2 + 64 * j) + F.tid, lc[F.tid], __ATOMIC_RELAXED, __HIP_MEMORY_SCOPE_AGENT);
        __syncthreads();
        if (on) {
            int o1 = 0, o2 = 0;
#pragma unroll
            for (int e = 0; e < 8; ++e) { o1 = (e == e1) ? off[e] : o1; o2 = (e == e2) ? off[e] : o2; }
            const int r1 = o1 + (int)lc[8 + e1] + li1, r2 = o2 + (int)lc[8 + e2] + li2;
            topk[(c0 + F.tid) * 6 + 4] = r1; topk[(c0 + F.tid) * 6 + 5] = r2; lrow[2 * F.tid] = r1; lrow[2 * F.tid + 1] = r2;
        }
        __syncthreads();
        for (int p = F.wave; p < 2 * per; p += NWAVES) { const int tok = c0 + (p >> 1), dst = lrow[p];
            const GAS v4u* s = (const GAS v4u*)(H + (size_t)tok * 1024) + 2 * F.lane; const v4u a = s[0], b2 = s[1];
            unsigned w0 = 0u, w1 = 0u, w2 = 0u, w3 = 0u;
            w0 = __builtin_amdgcn_cvt_pk_fp8_f32(bf_lo(a.x), bf_hi(a.x), w0, false); w0 = __builtin_amdgcn_cvt_pk_fp8_f32(bf_lo(a.y), bf_hi(a.y), w0, true);
            w1 = __builtin_amdgcn_cvt_pk_fp8_f32(bf_lo(a.z), bf_hi(a.z), w1, false); w1 = __builtin_amdgcn_cvt_pk_fp8_f32(bf_lo(a.w), bf_hi(a.w), w1, true);
            w2 = __builtin_amdgcn_cvt_pk_fp8_f32(bf_lo(b2.x), bf_hi(b2.x), w2, false); w2 = __builtin_amdgcn_cvt_pk_fp8_f32(bf_lo(b2.y), bf_hi(b2.y), w2, true);
            w3 = __builtin_amdgcn_cvt_pk_fp8_f32(bf_lo(b2.z), bf_hi(b2.z), w3, false); w3 = __builtin_amdgcn_cvt_pk_fp8_f32(bf_lo(b2.w), bf_hi(b2.w), w3, true);
            *((GAS v4u*)((unsigned char*)XG8 + (size_t)dst * 1024) + F.lane) = (v4u){w0, w1, w2, w3}; }
        __syncthreads();
    }
}
#if defined(SELFCHK)
constexpr int CW_CHK = 12288;
__device__ __forceinline__ int chk_row(int s) {
    if (s >= 48) return MLAT + ((s - 48) * 61) % MCTX;
    const int b = s & 3; int t = (s * 683 + 17 * (s >> 2) * 97) & (SEQ - 1);
    if (s < 4) t = 0; else if (s < 8) t = SEQ - 1; else if (s < 12) t = 63; else if (s < 16) t = 64;
    return b * SEQ + t;
}
__device__ __forceinline__ void chk_accum(Frame& F, float num, float den) {
    LAS float* red = (LAS float*)(F.lds + 150000);
    __syncthreads();
    num = wave_sum(num, F.lane); den = wave_sum(den, F.lane);
    if (F.lane == 0) { red[F.wave * 2] = num; red[F.wave * 2 + 1] = den; }
    __syncthreads();
    if (F.tid == 0) { float a = 0.f, b = 0.f; for (int w = 0; w < 8; ++w) { a += red[2 * w]; b += red[2 * w + 1]; }
        atomicAdd((float*)(F.ctl + CW_CHK), a); atomicAdd((float*)(F.ctl + CW_CHK) + 1, b); }
    __syncthreads();
}
__device__ __forceinline__ float chk_rope(const LAS float* x, int d, int rot_dim, int t) {
    const int axis_dim = rot_dim / 2, half = axis_dim / 2, axis = d / axis_dim, i = d % axis_dim;
    const float pos = (float)(axis == 0 ? t / GRIDW : t % GRIDW);
    const float inv = powf(10000.f, -(float)(2 * (i % half)) / (float)axis_dim);
    const float ang = pos * inv; float sn, cs; sincos_red(ang, sn, cs);
    const float rot = (i < half) ? -x[axis * axis_dim + i + half] : x[axis * axis_dim + i - half];
    return x[d] * cs + rot * sn;
}
__device__ __forceinline__ void phase_selfcheck_even(Frame& F, const PArgs& A, int j) {
    const bf16* H = (const bf16*)(F.ws + WS_H);
    const bf16 *QG = (const bf16*)(F.ws + WS_QG), *KG = (const bf16*)(F.ws + WS_KG), *VG = (const bf16*)(F.ws + WS_VG), *CQN = (const bf16*)(F.ws + WS_CQN), *CKVN = (const bf16*)(F.ws + WS_CKVN);
    const bf16 *QM = (const bf16*)(F.ws + WS_QM), *KM = (const bf16*)(F.ws + WS_KM), *VM = (const bf16*)(F.ws + WS_VM), *OE = (const bf16*)(F.ws + WS_OE);
    LAS float* raw = (LAS float*)F.lds;
    LAS float* xn = (LAS float*)(F.lds + 8192);
    LAS float* sc = (LAS float*)(F.lds + 16384);
    LAS float* red = (LAS float*)(F.lds + 65536);
    const int tid = F.tid;
#if SELFCHK >= 5
#elif SELFCHK == 1 || SELFCHK == 2
    for (int s = F.vcu; s < 64; s += F.G) {
        const int row = chk_row(s); const bool lat = row < MLAT; const int t = row & (SEQ - 1);
        float num = 0.f, den = 0.f;
#if SELFCHK == 1
        const float* W = A.in[I_EVWIN] + (size_t)j * 1024 * EV_IN;
        for (int c = tid; c < EV_IN; c += NTHR) { float a = 0.f; for (int k = 0; k < 1024; ++k) a += bf2f(H[(size_t)row * 1024 + k]) * W[(size_t)k * EV_IN + c]; raw[c] = a; }
        __syncthreads();
        for (int c = tid; c < 640; c += NTHR) { const int hb = (c / 64) * 64, d = c % 64; float ss = 0.f; for (int k = 0; k < 64; ++k) ss += raw[hb + k] * raw[hb + k];
            const float g = (c < 512) ? A.in[I_QNG][j * 64 + d] : A.in[I_KNG][j * 64 + d]; xn[c] = raw[c] * (1.f / sqrtf(ss / 64.f + 1e-6f)) * g; }
        __syncthreads();
        for (int c = tid; c < 640; c += NTHR) { const int hb = (c / 64) * 64, d = c % 64; const float ref = lat ? chk_rope(xn + hb, d, 64, t) : xn[c];
            const float got = (c < 512) ? bf2f(QG[(size_t)row * 512 + c]) / C2_64 : bf2f(KG[(size_t)row * 128 + (c - 512)]); num += (got - ref) * (got - ref); den += ref * ref; }
        for (int c = tid; c < 128; c += NTHR) { const float ref = raw[640 + c], got = bf2f(VG[(size_t)row * 128 + c]); num += (got - ref) * (got - ref); den += ref * ref; }
        { float ss = 0.f; for (int k = 0; k < 384; ++k) ss += raw[768 + k] * raw[768 + k]; const float rs = 1.f / sqrtf(ss / 384.f + 1e-6f);
          for (int c = tid; c < 384; c += NTHR) { const float ref = raw[768 + c] * rs * A.in[I_CQG][j * 384 + c], got = bf2f(CQN[(size_t)row * 384 + c]); num += (got - ref) * (got - ref); den += ref * ref; } }
        { float ss = 0.f; for (int k = 0; k < 256; ++k) ss += raw[1152 + k] * raw[1152 + k]; const float rs = 1.f / sqrtf(ss / 256.f + 1e-6f);
          for (int c = tid; c < 256; c += NTHR) { const float ref = raw[1152 + c] * rs * A.in[I_CKVG][j * 256 + c], got = bf2f(CKVN[(size_t)row * 256 + c]); num += (got - ref) * (got - ref); den += ref * ref; } }
        for (int c = tid; c < 256; c += NTHR) { const int head = c / 32, d = c % 32; const float ref = lat ? chk_rope(raw + 1408, d, 32, t) : raw[1408 + d];
            const float got = bf2f(KM[(size_t)row * 768 + head * 96 + 64 + d]); num += (got - ref) * (got - ref); den += ref * ref; }
#else
        const float* Wq = A.in[I_WUQ] + (size_t)j * 384 * 768; const float* Wkv = A.in[I_WUKV] + (size_t)j * 256 * 1024;
        for (int c = tid; c < 768; c += NTHR) { float a = 0.f; for (int k = 0; k < 384; ++k) a += bf2f(CQN[(size_t)row * 384 + k]) * Wq[(size_t)k * 768 + c]; raw[c] = a; }
        __syncthreads();
        for (int c = tid; c < 768; c += NTHR) { const int head = c / 96, d = c % 96; const float ref = (d >= 64 && lat) ? chk_rope(raw + head * 96 + 64, d - 64, 32, t) : raw[c];
            const float got = bf2f(QM[(size_t)row * 768 + c]) / C2_96; num += (got - ref) * (got - ref); den += ref * ref; }
        for (int c = tid; c < 1024; c += NTHR) { float a = 0.f; for (int k = 0; k < 256; ++k) a += bf2f(CKVN[(size_t)row * 256 + k]) * Wkv[(size_t)k * 1024 + c];
            const int head = c / 128, d = c % 128; const float got = (d < 64) ? bf2f(KM[(size_t)row * 768 + head * 96 + d]) : bf2f(VM[(size_t)row * 512 + head * 64 + (d - 64)]); num += (got - a) * (got - a); den += a * a; }
#endif
        chk_accum(F, num, den);
    }
#elif SELFCHK == 3 || SELFCHK == 4
    for (int u = F.vcu; u < 64 * 8; u += F.G) {
        const int s = u >> 3, h = u & 7; const int row = chk_row(s); const bool lat = row < MLAT; const int b = lat ? row / SEQ : (row - MLAT) / CTXL;
        const int nk = lat ? SEQ + CTXL : CTXL;
#if SELFCHK == 3
        constexpr int DKK = 64; const bf16* qp = QG + (size_t)row * 512 + h * 64; const int kvh = h / 4;
#define CHK_K(key) (KG + (size_t)(key) * 128 + kvh * 64)
#define CHK_V(key) (VG + (size_t)(key) * 128 + kvh * 64)
        const bf16* op = OE + (size_t)row * 1024 + h * 64;
#else
        constexpr int DKK = 96; const bf16* qp = QM + (size_t)row * 768 + h * 96;
#define CHK_K(key) (KM + (size_t)(key) * 768 + h * 96)
#define CHK_V(key) (VM + (size_t)(key) * 512 + h * 64)
        const bf16* op = OE + (size_t)row * 1024 + 512 + h * 64;
#endif
        float mx = -INFINITY;
        for (int kk = tid; kk < nk; kk += NTHR) { const int key = lat ? (kk < SEQ ? b * SEQ + kk : MLAT + b * CTXL + (kk - SEQ)) : MLAT + b * CTXL + kk;
            float a = 0.f; for (int d = 0; d < DKK; ++d) a += bf2f(qp[d]) * bf2f(CHK_K(key)[d]); sc[kk] = a; mx = fmaxf(mx, a); }
#pragma unroll
        for (int o = 1; o < 64; o <<= 1) mx = fmaxf(mx, shx(mx, o, F.lane));
        if (F.lane == 0) red[F.wave] = mx;
        __syncthreads();
        mx = red[0]; for (int w = 1; w < 8; ++w) mx = fmaxf(mx, red[w]);
        float ls = 0.f;
        for (int kk = tid; kk < nk; kk += NTHR) { const float p = exp2f(sc[kk] - mx); sc[kk] = p; ls += p; }
        ls = wave_sum(ls, F.lane);
        __syncthreads();
        if (F.lane == 0) red[8 + F.wave] = ls;
        __syncthreads();
        ls = 0.f; for (int w = 0; w < 8; ++w) ls += red[8 + w];
        { const int d = tid & 63, part = tid >> 6; float a = 0.f;
          for (int kk = part; kk < nk; kk += 8) { const int key = lat ? (kk < SEQ ? b * SEQ + kk : MLAT + b * CTXL + (kk - SEQ)) : MLAT + b * CTXL + kk; a += sc[kk] * bf2f(CHK_V(key)[d]); }
          red[64 + part * 64 + d] = a; }
        __syncthreads();
        float num = 0.f, den = 0.f;
        if (tid < 64) { float a = 0.f; for (int p = 0; p < 8; ++p) a += red[64 + p * 64 + tid]; const float ref = a / ls, got = bf2f(op[tid]); num = (got - ref) * (got - ref); den = ref * ref; }
        chk_accum(F, num, den);
#undef CHK_K
#undef CHK_V
    }
#endif
}
#endif

#if defined(SELFCHK) && (SELFCHK == 5 || SELFCHK == 6 || SELFCHK == 7)
__device__ __forceinline__ void phase_selfcheck_na(Frame& F, const PArgs& A, int j) {
    const bf16 *QN = (const bf16*)(F.ws + WS_QN), *KN = (const bf16*)(F.ws + WS_KN), *VN = (const bf16*)(F.ws + WS_VN), *OO = (const bf16*)(F.ws + WS_OO);
    LAS float* sc = (LAS float*)(F.lds + 16384); LAS float* red = (LAS float*)(F.lds + 65536); LAS int* kid = (LAS int*)(F.lds + 32768);
    const int tid = F.tid;
    for (int u = F.vcu; u < 64 * 8; u += F.G) {
        const int s = u >> 3, h = u & 7; const int row = chk_row(s); const bool lat = row < MLAT; const int b = lat ? row / SEQ : (row - MLAT) / CTXL;
        if (!lat && j == 1) continue;
        const bf16* qp = QN + (size_t)row * 512 + h * 64; const float* rpb = A.in[I_RPB] + ((size_t)j * 8 + h) * 15 * 31;
        int nk = CTXL;
        if (lat) { nk = 128 + CTXL; const int t = row % SEQ, r = t / GRIDW, cc = t % GRIDW;
            const int rs = min(max(r - 4, 0), 128 - 8), cs = min(max(cc - 8, 0), GRIDW - 16);
            for (int w = tid; w < 128; w += NTHR) { const int i = w / 16, jj = w % 16; const int kr = rs + i, kc = cs + jj; kid[w] = b * SEQ + kr * GRIDW + kc;
                sc[1024 + w] = rpb[(kr - r + 7) * 31 + (kc - cc + 15)] * LOG2E; }
            for (int w = tid; w < CTXL; w += NTHR) { kid[128 + w] = MLAT + b * CTXL + w; sc[1024 + 128 + w] = 0.f; }
        } else { for (int w = tid; w < CTXL; w += NTHR) { kid[w] = MLAT + b * CTXL + w; sc[1024 + w] = 0.f; } }
        __syncthreads();
        float mx = -INFINITY;
        for (int kk = tid; kk < nk; kk += NTHR) { const bf16* kp = KN + (size_t)kid[kk] * 512 + h * 64; float a = 0.f; for (int d = 0; d < 64; ++d) a += bf2f(qp[d]) * bf2f(kp[d]); a += sc[1024 + kk]; sc[kk] = a; mx = fmaxf(mx, a); }
#pragma unroll
        for (int o = 1; o < 64; o <<= 1) mx = fmaxf(mx, shx(mx, o, F.lane));
        if (F.lane == 0) red[F.wave] = mx;
        __syncthreads();
        mx = red[0]; for (int w = 1; w < 8; ++w) mx = fmaxf(mx, red[w]);
        float ls = 0.f;
        for (int kk = tid; kk < nk; kk += NTHR) { const float p = exp2f(sc[kk] - mx); sc[kk] = p; ls += p; }
        ls = wave_sum(ls, F.lane);
        __syncthreads();
        if (F.lane == 0) red[8 + F.wave] = ls;
        __syncthreads();
        ls = 0.f; for (int w = 0; w < 8; ++w) ls += red[8 + w];
        { const int d = tid & 63, part = tid >> 6; float a = 0.f;
          for (int kk = part; kk < nk; kk += 8) a += sc[kk] * bf2f(VN[(size_t)kid[kk] * 512 + h * 64 + d]);
          red[64 + part * 64 + d] = a; }
        __syncthreads();
        float num = 0.f, den = 0.f;
        if (tid < 64) { float a = 0.f; for (int p = 0; p < 8; ++p) a += red[64 + p * 64 + tid]; const float ref = a / ls, got = bf2f(OO[(size_t)row * 1024 + h * 64 + tid]); num = (got - ref) * (got - ref); den = ref * ref; }
        chk_accum(F, num, den);
    }
}
constexpr size_t WS_CHKO = WS_END;
__device__ __forceinline__ int chk_seq_row(int b, int dir, int sq) { if (sq < CTXL) return MLAT + b * CTXL + (dir ? CTXL - 1 - sq : sq); const int jq = sq - CTXL; return b * SEQ + (dir ? SEQ - 1 - jq : jq); }
__device__ __forceinline__ void phase_selfcheck_hg_scan(Frame& F, const PArgs& A, int j) {
    if (F.vcu >= 4) return;
    const int c = F.vcu, dir = c & 1, pair = c >> 1; const int b = pair ? 3 : 1, h = pair ? 0 : 2, hoff = h * 128;
    const bf16 *Qd = (const bf16*)(F.ws + WS_QD), *Vd = (const bf16*)(F.ws + WS_VD); const float* Z = (const float*)(F.ws + (dir ? WS_ZB : WS_ZF));
    float* OF = (float*)(F.ws + WS_CHKO) + (size_t)c * 8448 * 128;
    LAS float* vec = (LAS float*)F.lds;
    LAS float* part = (LAS float*)(F.lds + 4096);
    const int tid = F.tid, f = tid & 127, eq = tid >> 7;
    float S[32];
#pragma unroll
    for (int i = 0; i < 32; ++i) S[i] = 0.f;
    for (int sq = 0; sq < CTXL + SEQ; ++sq) {
        const int row = chk_seq_row(b, dir, sq);
        if (tid < 128) { const int ch = hoff + tid; const float l0 = A.in[I_LBL][(dir * 2 + 0) * 512 + ch], l1 = A.in[I_LBL][(dir * 2 + 1) * 512 + ch];
            const float m = fmaxf(l0, l1), p0 = expf(l0 - m) / (expf(l0 - m) + expf(l1 - m)), p1 = expf(l1 - m) / (expf(l0 - m) + expf(l1 - m)); const float lb = (j == 0) ? 0.f : (p0 + p1) - p0;
            const float z = Z[(size_t)row * 512 + ch]; const float sg = 1.f / (1.f + expf(-z));
            vec[tid] = bf2f(Qd[(size_t)row * 512 + ch]); vec[128 + tid] = (1.f - lb) * (1.f / (1.f + expf(z))); vec[256 + tid] = bf2f(Vd[(size_t)row * 512 + ch]); vec[384 + tid] = lb + (1.f - lb) * sg; }
        __syncthreads();
        float o = 0.f; const float vf = vec[256 + f];
#pragma unroll
        for (int i = 0; i < 32; ++i) { const int e = eq * 32 + i; S[i] = vec[384 + e] * S[i] + vec[128 + e] * vf; o += S[i] * vec[e]; }
        part[eq * 128 + f] = o;
        __syncthreads();
        if (tid < 128) OF[(size_t)sq * 128 + tid] = part[tid] + part[128 + tid] + part[256 + tid] + part[384 + tid];
    }
}
__device__ __forceinline__ void phase_selfcheck_hg_cmp(Frame& F, const PArgs& A, int j) {
    const bf16 *Sg = (const bf16*)(F.ws + WS_SG), *OO = (const bf16*)(F.ws + WS_OO); const float* OF = (const float*)(F.ws + WS_CHKO);
    const int gw = F.vcu * NWAVES + F.wave, NGW = F.G * NWAVES;
    float num = 0.f, den = 0.f;
    for (int it = gw; it < 2 * 8448; it += NGW) { const int pair = it / 8448, sq = it % 8448; const int b = pair ? 3 : 1, h = pair ? 0 : 2, hoff = h * 128;
        const int row = chk_seq_row(b, 0, sq);
        const int sqb = (sq < CTXL) ? (CTXL - 1 - sq) : (CTXL + (SEQ - 1 - (sq - CTXL)));
        const float* of = OF + ((size_t)(pair * 2 + 0) * 8448 + sq) * 128; const float* ob = OF + ((size_t)(pair * 2 + 1) * 8448 + sqb) * 128;
        const float* D0 = (const float*)(F.ws + 1002 * MiB) + ((size_t)(0 * 2 + pair) * 8448 + sq) * 128; const float* D1 = (const float*)(F.ws + 1002 * MiB) + ((size_t)(1 * 2 + pair) * 8448 + sq) * 128;
#ifndef CHKSEL
#define CHKSEL 0
#endif
        (void)row; (void)Sg; (void)OO;
#pragma unroll
        for (int q2 = 0; q2 < 2; ++q2) { const int ff = F.lane + 64 * q2;
            const float ref = (CHKSEL != 1) ? of[ff] : ob[ff]; const float got = (CHKSEL != 1) ? D0[ff] : (D1[ff] - D0[ff]);
            const bool use = (CHKSEL == 10) ? (sq < 64) : (CHKSEL == 11) ? (sq >= 64 && sq < 128) : (CHKSEL == 12) ? (sq >= 128 && sq < 256) : (CHKSEL == 13) ? (sq >= 256 && ((sq & 127) < 64)) : (CHKSEL == 14) ? (sq >= 256 && ((sq & 127) >= 64)) : true;
            if (use && (j == 0 || sq >= CTXL)) { num += (got - ref) * (got - ref); den += ref * ref; } } }
    chk_accum(F, num, den);
}
#endif
constexpr int PH_CV = 0, PH_MOD = 1, PH_E1 = 2, PH_E2 = 3, PH_E3 = 4, PH_E5 = 5, PH_E6 = 6, PH_E7 = 7, PH_E8 = 8, PH_E9 = 9, PH_E10 = 10,
              PH_O1 = 11, PH_O2 = 12, PH_O3 = 13, PH_O4 = 14, PH_O5 = 15, PH_O6 = 16, PH_O7 = 17, PH_O8 = 18, PH_O9 = 19, PH_O10 = 20, PH_PER = 21;
constexpr int NPHASES = 2 * PH_PER;

__global__ void __launch_bounds__(NTHR, 2) mk_fwd(Args args) {
    extern __shared__ __attribute__((aligned(16))) unsigned char lds[];
    Frame F;
    F.lds = (LAS unsigned char*)lds; F.ws = args.ws; F.ctl = (gu32*)(args.ws + WS_CTL);
    F.tid = threadIdx.x; F.lane = F.tid & 63; F.wave = __builtin_amdgcn_readfirstlane(F.tid >> 6);
    F.G = gridDim.x; { const int bx = blockIdx.x; F.vcu = (F.G % 8 == 0) ? (bx % 8) * (F.G / 8) + bx / 8 : bx; }
    volatile LAS unsigned* MISC = (volatile LAS unsigned*)(F.lds + MISC_OFF);
    if (F.tid < 64) MISC[F.tid] = 0u;
    { LAS unsigned long long* tab = (LAS unsigned long long*)(F.lds + MISC_OFF + 256);
      if (F.tid == 0) {
#pragma unroll
          for (int i = 0; i < 30; ++i) tab[i] = (unsigned long long)args.in[i];
          tab[30] = (unsigned long long)args.out; } }
    __syncthreads();
    const int lo = args.ph_lo, hi = args.ph_hi; const int wv0 = F.wave;
    const bool multi = (hi - lo) > 1;
    XcdBarrier bar; bar.bar = (unsigned*)(F.ctl + CW_BAR); bar.x = 0; bar.st = nullptr;
    if (multi) bar = xcd_barrier_post((unsigned*)(F.ctl + CW_BAR), MISC + 8);
#ifndef PHMASK
#define PHMASK 0x1fffff
#endif
#define IN(k) ((((PHMASK) >> ((k) % PH_PER)) & 1) && lo <= (k) && (k) < hi)
#if defined(PROBE_PH)
    if (PROBE_PH == 0 && blockIdx.x == 0 && threadIdx.x == 0) MISC[16] = (unsigned)__builtin_amdgcn_s_memrealtime();
#endif
#define MKT HgT T; T.Qd = (const bf16*)(ws + WS_QD); T.Vd = (const bf16*)(ws + WS_VD); T.Sg = (const bf16*)(ws + WS_SG); T.Zf = (const float*)(ws + WS_ZF); T.Zb = (const float*)(ws + WS_ZB); \
    T.lb = (const float*)(ws + WS_SMALL + SM_LB) + j * 1024; T.HST = (bf16*)(ws + WS_HST); T.HDM = (float*)(ws + WS_HDM); T.ong = PA.in[I_ONG] + j * 128; T.OO = (bf16*)(ws + WS_OO);
#define FRESH() int t_; asm volatile("v_mbcnt_lo_u32_b32 %0, -1, 0\n\tv_mbcnt_hi_u32_b32 %0, -1, %0" : "=v"(t_)); t_ += wv0 * 64; F.tid = t_; F.lane = t_ & 63; F.wave = __builtin_amdgcn_readfirstlane(t_ >> 6); \
    unsigned char* ws = ws0; asm volatile("" : "+s"(ws)); F.ws = ws; F.ctl = (gu32*)(ws + WS_CTL); PArgs PA; PA.in.t = (LAS unsigned long long*)(F.lds + MISC_OFF + 256); PA.out = (float*)PA.in[30]; \
    float* mods = (float*)(ws + WS_SMALL + SM_MODS); bf16* W = (bf16*)(ws + WS_W); bf16* WM = (bf16*)(ws + WS_WMOE); bf16* H = (bf16*)(ws + WS_H); bf16* X = (bf16*)(ws + WS_X); \
    const float* modE = mods + (size_t)Le * 5 * 6144; const float* modO = mods + (size_t)Lo * 5 * 6144; (void)W; (void)WM; (void)H; (void)X; (void)modE; (void)modO;
#if defined(PROBE_PH)
#define IS_T0() ({ int l_; asm volatile("v_mbcnt_lo_u32_b32 %0, -1, 0\n\tv_mbcnt_hi_u32_b32 %0, -1, %0" : "=v"(l_)); (wv0 == 0 && l_ == 0); })
#if defined(PROBE_CLK)
#define PROBE_NOW() ((unsigned)__builtin_amdgcn_s_memtime())
#else
#define PROBE_NOW() ((unsigned)__builtin_amdgcn_s_memrealtime())
#endif
#define PROBE_T0(k) do { if ((k) == PROBE_PH && blockIdx.x == 0 && IS_T0()) { MISC[16] = PROBE_NOW(); } } while (0)
#define PROBE_T1(k) do { if ((k) == PROBE_PH && blockIdx.x == 0 && IS_T0()) { MISC[18] = PROBE_NOW() - MISC[16]; } } while (0)
#else
#define PROBE_T0(k) do {} while (0)
#define PROBE_T1(k) do {} while (0)
#endif
#if defined(PROBE_WALL)
#define SEAM(k) do { if (IN(k) && IN((k) + 1)) xcd_barrier(bar); PROBE_T1(k); PROBE_T0((k) + 1); } while (0)
#else
#define SEAM(k) do { PROBE_T1(k); if (IN(k) && IN((k) + 1)) xcd_barrier(bar); PROBE_T0((k) + 1); } while (0)
#endif
    unsigned char* const ws0 = args.ws;
#pragma unroll 1
    for (int j = 0; j < 2; ++j) {
        const int pb = j * PH_PER, Le = 2 * j, Lo = 2 * j + 1;
        if (j == 0) { if (IN(pb + PH_CV)) { FRESH(); phase_cv(F, PA, 0); } SEAM(pb + PH_CV);
                      if (IN(pb + PH_MOD)) { FRESH(); phase_mod(F, PA); } SEAM(pb + PH_MOD); }
        if (IN(pb + PH_E1)) { FRESH();
            pg8::Gemm g{H, W + W_EVIN + (size_t)j * EV_INP * 1024, MROWS, EV_INP, 1024}; pg8::StaticOrder S; S.init(MROWS, EV_INP, F.G, (int)blockIdx.x);
            pg8::EpiPlainBf16 E{(pg8::bf16_t*)(ws + WS_RAW), EV_INP};
            pg8::gemm_phase<pg8::EpiPlainBf16, pg8::StaticOrder, true, true>(F.lds, g, S, E, F.tid);
        } SEAM(pb + PH_E1);
        if (IN(pb + PH_E2)) { FRESH(); phase_even_post(F, PA, j); } SEAM(pb + PH_E2);
        if (IN(pb + PH_E3)) { FRESH();
            { pg8::Gemm g{(const bf16*)(ws + WS_CQN), W + W_UQ + (size_t)j * 768 * 384, MROWS, 768, 384}; pg8::StaticOrder S; S.init(MROWS, 768, F.G, (int)blockIdx.x);
              pg8::EpiMlaQ E{(bf16*)(ws + WS_QM), (const float*)(ws + WS_SMALL + SM_ROPEB)};
              pg8::gemm_phase<pg8::EpiMlaQ, pg8::StaticOrder, true, true>(F.lds, g, S, E, F.tid); }
            { asm volatile("v_mbcnt_lo_u32_b32 %0, -1, 0\n\tv_mbcnt_hi_u32_b32 %0, -1, %0" : "=v"(t_)); t_ += wv0 * 64; F.tid = t_; F.lane = t_ & 63;
              pg8::Gemm g{(const bf16*)(ws + WS_CKVN), W + W_UKV + (size_t)j * 1024 * 256, MROWS, 1024, 256}; pg8::StaticOrder S; S.init(MROWS, 1024, F.G, (int)blockIdx.x);
              pg8::EpiMlaKV E{(bf16*)(ws + WS_KM), (bf16*)(ws + WS_VM)};
              pg8::gemm_phase<pg8::EpiMlaKV, pg8::StaticOrder, true, true>(F.lds, g, S, E, F.tid); }
        } SEAM(pb + PH_E3);
        if (IN(pb + PH_E5)) { FRESH(); phase_even_attn(F); } SEAM(pb + PH_E5);
#if defined(SELFCHK)
        if (IN(pb + PH_E6)) { FRESH(); phase_selfcheck_even(F, PA, j); }
#endif
        if (IN(pb + PH_E6)) { FRESH();
            { pg8::Gemm g{(const bf16*)(ws + WS_OE), W + W_EVOUT + (size_t)j * 1024 * 1024, MLAT, 1024, 1024}; pg8::StaticOrder S; S.init(MLAT, 1024, F.G, (int)blockIdx.x);
              pg8::EpiResid E{(pg8::bf16_t*)(ws + WS_ZR), modE + 2 * 1024, j == 0 ? (const void*)PA.in[I_X] : (const void*)X, j == 0 ? (const void*)PA.in[I_CTX] : (const void*)(X + (size_t)MLAT * 1024), j != 0};
              pg8::gemm_phase<pg8::EpiResid, pg8::StaticOrder, true, true>(F.lds, g, S, E, F.tid); }
            ctx_resid_gemm(F, (const bf16*)(ws + WS_OE), W + W_EVOUT + (size_t)j * 1024 * 1024, 1024, (bf16*)(ws + WS_ZR), modE + 2 * 1024, j == 0 ? (const void*)PA.in[I_CTX] : (const void*)(X + (size_t)MLAT * 1024), j != 0);
        } SEAM(pb + PH_E6);
        if (IN(pb + PH_E7)) { FRESH(); phase_ln<false, false, FFN_F8>(F, PA, PA.in[I_LN1G] + Le * 1024, PA.in[I_LN1B] + Le * 1024, modE + 3 * 1024, nullptr, nullptr, 0, false); } SEAM(pb + PH_E7);
        if (IN(pb + PH_E8)) { FRESH();
            if constexpr (FFN_F8) {
                pg8::Gemm g{H, (const bf16*)((unsigned char*)(W + W_FFGU) + (size_t)j * 2 * DFF * 1024), MROWS, 2 * DFF, 1024 / 2}; pg8::StaticOrder S; S.init(MROWS, 2 * DFF, F.G, (int)blockIdx.x);
                pg8::EpiSwigluS E{(bf16*)(ws + WS_FFH), DFF, 1.f / MOE_WSCALE};
                pg8::gemm_phase<pg8::EpiSwigluS, pg8::StaticOrder, true, true, true>(F.lds, g, S, E, F.tid);
            } else {
                pg8::Gemm g{H, W + W_FFGU + (size_t)j * 2 * DFF * 1024, MROWS, 2 * DFF, 1024}; pg8::StaticOrder S; S.init(MROWS, 2 * DFF, F.G, (int)blockIdx.x);
                pg8::EpiSwiglu E{(bf16*)(ws + WS_FFH), DFF};
                pg8::gemm_phase<pg8::EpiSwiglu, pg8::StaticOrder, true, true>(F.lds, g, S, E, F.tid);
            }
        } SEAM(pb + PH_E8);
        if (IN(pb + PH_E9)) { FRESH();
            { pg8::Gemm g{(const bf16*)(ws + WS_FFH), W + W_FFD + (size_t)j * 1024 * DFF, MLAT, 1024, DFF}; pg8::StaticOrder S; S.init(MLAT, 1024, F.G, (int)blockIdx.x);
              pg8::EpiResid E{(pg8::bf16_t*)(ws + WS_ZR), modE + 5 * 1024, X, X + (size_t)MLAT * 1024, true};
              pg8::gemm_phase<pg8::EpiResid, pg8::StaticOrder, true, true>(F.lds, g, S, E, F.tid); }
            ctx_resid_gemm(F, (const bf16*)(ws + WS_FFH), W + W_FFD + (size_t)j * 1024 * DFF, DFF, (bf16*)(ws + WS_ZR), modE + 5 * 1024, X + (size_t)MLAT * 1024, true);
        } SEAM(pb + PH_E9);
        if (IN(pb + PH_E10)) { FRESH(); phase_ln<false, false>(F, PA, PA.in[I_LN2G] + Le * 1024, PA.in[I_LN2B] + Le * 1024, modO + 0 * 1024, nullptr, nullptr, 0, false); } SEAM(pb + PH_E10);
        if (IN(pb + PH_O1)) { FRESH();
            pg8::Gemm g{H, W + W_ODIN + (size_t)j * 4096 * 1024, MROWS, 4096, 1024}; pg8::StaticOrder S; S.init(MROWS, 4096, F.G, (int)blockIdx.x);
            pg8::EpiOddIn E{(bf16*)(ws + WS_QN), (bf16*)(ws + WS_KN), (bf16*)(ws + WS_VN), (bf16*)(ws + WS_QD), (bf16*)(ws + WS_VD), (bf16*)(ws + WS_SG), (float*)(ws + WS_ZF), (float*)(ws + WS_ZB)};
            pg8::gemm_phase<pg8::EpiOddIn, pg8::StaticOrder, true, true>(F.lds, g, S, E, F.tid);
        } SEAM(pb + PH_O1);
        if (IN(pb + PH_O2)) { FRESH(); MKT phase_odd_mix(F, PA, T, j); } SEAM(pb + PH_O2);
        if (IN(pb + PH_O3)) { FRESH(); MKT phase_hg_b(F, T); } SEAM(pb + PH_O3);
        if (IN(pb + PH_O4)) { FRESH(); MKT if (j == 1) { for (int u = F.vcu; u < 16 * 64; u += F.G) hg_c_unit(F, T, u >> 8, (u >> 6) & 3, 2 + (u & 63)); }
            else { for (int u = F.vcu; u < 16 * 66; u += F.G) hg_c_unit(F, T, u / 264, (u / 66) & 3, u % 66); } } SEAM(pb + PH_O4);
#if defined(SELFCHK) && SELFCHK == 5
        if (IN(pb + PH_O5)) { FRESH(); phase_selfcheck_na(F, PA, j); }
#endif
#if defined(SELFCHK) && SELFCHK == 6
#ifndef CHKJ
#define CHKJ j
#endif
        if (IN(pb + PH_O5) && j == (CHKJ)) { { FRESH(); phase_selfcheck_hg_scan(F, PA, j); } xcd_barrier(bar); { FRESH(); phase_selfcheck_hg_cmp(F, PA, j); } }
#endif
        if (IN(pb + PH_O5)) { FRESH();
            { pg8::Gemm g{(const bf16*)(ws + WS_OO), W + W_ODOUT + (size_t)j * 1024 * 1024, MLAT, 1024, 1024}; pg8::StaticOrder S; S.init(MLAT, 1024, F.G, (int)blockIdx.x);
              pg8::EpiResid E{(pg8::bf16_t*)(ws + WS_ZR), modO + 2 * 1024, X, X + (size_t)MLAT * 1024, true};
              pg8::gemm_phase<pg8::EpiResid, pg8::StaticOrder, true, true>(F.lds, g, S, E, F.tid); }
            if (j == 0) ctx_resid_gemm(F, (const bf16*)(ws + WS_OO), W + W_ODOUT + (size_t)j * 1024 * 1024, 1024, (bf16*)(ws + WS_ZR), modO + 2 * 1024, X + (size_t)MLAT * 1024, true);
        } SEAM(pb + PH_O5);
        if (IN(pb + PH_O6)) { FRESH(); phase_ln<false, true>(F, PA, PA.in[I_LN1G] + Lo * 1024, PA.in[I_LN1B] + Lo * 1024, modO + 3 * 1024, nullptr, PA.in[I_ROUTER] + (size_t)j * 1024 * 8, j, false, (j == 1) ? MLAT : MROWS); } SEAM(pb + PH_O6);
        if (IN(pb + PH_O7)) { FRESH(); phase_moe_dispatch(F, j, (j == 1) ? MLAT : MROWS); } SEAM(pb + PH_O7);
        if (IN(pb + PH_O8)) { FRESH();
            int off[9]; moe_offsets(F.ctl + CW_CNT + 64 * j, off);
            pg8::GroupedOrder S; S.nM = off[8] >> 8; S.nN = 2 * DFFE / 256; S.nwg = S.nM * S.nN; S.G = F.G; S.c = (int)blockIdx.x; S.estride = (long)2 * DFFE * 1024;
#pragma unroll
            for (int e = 0; e < 9; ++e) S.toff[e] = off[e] >> 8;
            pg8::Gemm g{(const bf16*)(ws + WS_XG8), (const bf16*)((unsigned char*)WM + WM_GU), MOE_ROWS, 2 * DFFE, 1024 / 2};
            pg8::EpiSwigluF8 E{ws + WS_MH, DFFE, 1.f / MOE_WSCALE};
            pg8::gemm_phase<pg8::EpiSwigluF8, pg8::GroupedOrder, true, true, true>(F.lds, g, S, E, F.tid);
        } SEAM(pb + PH_O8);
        if (IN(pb + PH_O9)) { FRESH();
            int off[9]; moe_offsets(F.ctl + CW_CNT + 64 * j, off);
            pg8::GroupedOrder S; S.nM = off[8] >> 8; S.nN = 1024 / 256; S.nwg = S.nM * S.nN; S.G = F.G; S.c = (int)blockIdx.x; S.estride = (long)1024 * DFFE;
#pragma unroll
            for (int e = 0; e < 9; ++e) S.toff[e] = off[e] >> 8;
            pg8::Gemm g{(const bf16*)(ws + WS_MH), (const bf16*)((unsigned char*)WM + WM_D), MOE_ROWS, 1024, DFFE / 2};
            pg8::EpiScaledBf16 E{(bf16*)(ws + WS_XG), 1024, 1.f / MOE_WSCALE};
            pg8::gemm_phase<pg8::EpiScaledBf16, pg8::GroupedOrder, true, true, true>(F.lds, g, S, E, F.tid);
        } SEAM(pb + PH_O9);
        if (IN(pb + PH_O10)) { FRESH(); phase_ln<true, false>(F, PA, PA.in[I_LN2G] + Lo * 1024, PA.in[I_LN2B] + Lo * 1024, mods + (size_t)(j == 0 ? 2 : 0) * 5 * 6144, modO + 5 * 1024, nullptr, 0, j == 1, (j == 1) ? MLAT : MROWS); }
        if (j == 0) { if (IN(pb + PH_O10)) { FRESH(); phase_cv(F, PA, 1); }
                      if (IN(pb + PH_O10) && IN(PH_PER + PH_E1)) xcd_barrier(bar); }
    }
#if defined(PROBE_BARRIERS)
    for (int i = 0; i < PROBE_BARRIERS; ++i) xcd_barrier(bar);
#endif
#if defined(PROBE_ACC)
    if (blockIdx.x == 0 && ({ int l_; asm volatile("v_mbcnt_lo_u32_b32 %0, -1, 0\n\tv_mbcnt_hi_u32_b32 %0, -1, %0" : "=v"(l_)); (wv0 == 0 && l_ == 0); })) { const unsigned d = MISC[18]; const unsigned t0 = (unsigned)__builtin_amdgcn_s_memrealtime(); while ((unsigned)__builtin_amdgcn_s_memrealtime() - t0 < 9u * d) __builtin_amdgcn_s_sleep(8); }
#endif
#if defined(PROBE_PH)
#if defined(PROBE_CLK)
    if (blockIdx.x == 0 && IS_T0()) { const unsigned d = MISC[18] / 20u; const unsigned t0 = (unsigned)__builtin_amdgcn_s_memrealtime(); while ((unsigned)__builtin_amdgcn_s_memrealtime() - t0 < 9u * d) __builtin_amdgcn_s_sleep(8); }
#else
    if (blockIdx.x == 0 && IS_T0()) { const unsigned d = MISC[18]; const unsigned t0 = (unsigned)__builtin_amdgcn_s_memrealtime(); while ((unsigned)__builtin_amdgcn_s_memrealtime() - t0 < 9u * d) __builtin_amdgcn_s_sleep(8); }
#endif
#endif
#undef IN
#undef SEAM
}

extern "C" void kernel_launch(void* const* d_in, const int* in_sizes, int n_in, void* d_out, int out_size, void* d_ws, size_t ws_size, hipStream_t stream) {
    static int grid = 0;
    if (grid == 0) {
        if (n_in != 30 || in_sizes[0] != MLAT * DM || out_size != MLAT * DM || ws_size < WS_END) { fprintf(stderr, "kernel_launch: unexpected shapes / workspace (n_in %d, ws %zu)\n", n_in, ws_size); grid = -1; return; }
        int dev = 0, cus = 0, per_cu = 0;
        if (hipGetDevice(&dev) != hipSuccess || hipDeviceGetAttribute(&cus, hipDeviceAttributeMultiprocessorCount, dev) != hipSuccess) { grid = -1; return; }
        if (hipFuncSetAttribute((const void*)mk_fwd, hipFuncAttributeMaxDynamicSharedMemorySize, LDS_BYTES) != hipSuccess) { fprintf(stderr, "kernel_launch: hipFuncSetAttribute failed\n"); grid = -1; return; }
        if (hipOccupancyMaxActiveBlocksPerMultiprocessor(&per_cu, (const void*)mk_fwd, NTHR, LDS_BYTES) != hipSuccess || per_cu < 1) { fprintf(stderr, "kernel_launch: occupancy query says %d\n", per_cu); }
        (void)hipGetLastError();
        grid = cus;
        if (grid != 256) { fprintf(stderr, "kernel_launch: built for 256 CUs, found %d\n", cus); grid = -1; return; }
    }
    if (grid < 0) return;
    if (hipMemsetAsync((char*)d_ws + WS_CTL, 0, CTL_ZERO_BYTES, stream) != hipSuccess) return;
    Args a{};
    for (int i = 0; i < 30; ++i) a.in[i] = (const float*)d_in[i];
    a.out = (float*)d_out; a.ws = (unsigned char*)d_ws;
#if MK_MULTI
    for (int ph = 0; ph < NPHASES; ++ph) {
        if (ph == PH_PER + PH_MOD || ph == PH_PER + PH_CV) continue;
        a.ph_lo = ph; a.ph_hi = ph + 1;
        hipLaunchKernelGGL(mk_fwd, dim3(grid), dim3(NTHR), LDS_BYTES, stream, a);
    }
#else
    a.ph_lo = 0; a.ph_hi = NPHASES;
    hipLaunchKernelGGL(mk_fwd, dim3(grid), dim3(NTHR), LDS_BYTES, stream, a);
#endif
}
```

```cpp
#include <hip/hip_runtime.h>
#include <cstdio>
#include <cstdint>

#ifndef MK_MULTI
#define MK_MULTI 0
#endif

constexpr int DM = 1024, NB = 4, SEQ = 8192, CTXL = 256, GRIDW = 64;
constexpr int MLAT = NB * SEQ, MCTX = NB * CTXL, MROWS = MLAT + MCTX;
constexpr int DEPTH = 4;
constexpr int EV_IN = 1440, EV_INP = 1536;
constexpr int DFF = 2816, DFFE = 3584, NEXP = 8;
constexpr int MOE_ROWS = 2 * MROWS + NEXP * 256;
constexpr float ALPHA = 1.6817928305074290f;
constexpr float LOG2E = 1.4426950408889634f;
constexpr float C2_64 = 0.125f * LOG2E;
constexpr float C2_96 = 0.10206207261596577f * LOG2E;

constexpr size_t MiB = 1u << 20;
constexpr size_t WS_CTL = 0, CTL_ZERO_BYTES = 1 * MiB;
constexpr size_t WS_SMALL = 2 * MiB;
constexpr size_t WS_TOPK = 4 * MiB;
constexpr size_t WS_W = 6 * MiB;
constexpr size_t WS_WMOE = 72 * MiB;
constexpr size_t WS_X = 240 * MiB;
constexpr size_t WS_H = 372 * MiB;
constexpr size_t WS_S = 438 * MiB;
constexpr size_t WS_RAW = WS_S;
constexpr size_t WS_QG = 636 * MiB, WS_KG = 669 * MiB, WS_VG = 678 * MiB, WS_CQN = 687 * MiB, WS_CKVN = 712 * MiB;
constexpr size_t WS_QM = 729 * MiB, WS_KM = 779 * MiB, WS_VM = 829 * MiB, WS_OE = 862 * MiB;
constexpr size_t WS_FFH = WS_S;
constexpr size_t WS_QN = 438 * MiB, WS_KN = 471 * MiB, WS_VN = 504 * MiB, WS_QD = 537 * MiB, WS_VD = 570 * MiB, WS_SG = 603 * MiB;
constexpr size_t WS_ZF = 636 * MiB, WS_ZB = 702 * MiB, WS_OO = 768 * MiB, WS_HST = 834 * MiB, WS_HDM = 966 * MiB;
constexpr size_t WS_MH = 372 * MiB;
constexpr size_t WS_XG = 848 * MiB;
constexpr size_t WS_XG8 = 612 * MiB;
constexpr size_t WS_ZR = 700 * MiB;
constexpr size_t WS_END = 984 * MiB;
static_assert(WS_QG >= WS_RAW + (size_t)MROWS * EV_INP * 4 && WS_OE + (size_t)MROWS * 2048 <= 984 * MiB, "even map");
static_assert(WS_HST + (size_t)32 * 66 * 65536 <= WS_HDM && WS_HDM + (size_t)32 * 66 * 512 <= WS_END, "odd map");
static_assert(WS_MH + (size_t)MOE_ROWS * DFFE <= WS_XG8 && WS_XG8 + (size_t)MOE_ROWS * 1024 <= WS_XG && WS_XG + (size_t)MOE_ROWS * 2048 <= WS_END, "moe map");
constexpr size_t SM_MODS = 0;
constexpr size_t SM_ROPEA = 512 * 1024;
constexpr size_t SM_ROPEB = SM_ROPEA + 16384;
constexpr size_t SM_LB = SM_ROPEB + 8192;
constexpr size_t W_EVIN = 0;
constexpr size_t W_UQ = W_EVIN + (size_t)2 * 1536 * 1024;
constexpr size_t W_UKV = W_UQ + (size_t)2 * 768 * 384;
constexpr size_t W_EVOUT = W_UKV + (size_t)2 * 1024 * 256;
constexpr size_t W_FFGU = W_EVOUT + (size_t)2 * 1024 * 1024;
constexpr size_t W_FFD = W_FFGU + (size_t)2 * 5632 * 1024;
constexpr size_t W_ODIN = W_FFD + (size_t)2 * 1024 * 2816;
constexpr size_t W_ODOUT = W_ODIN + (size_t)2 * 4096 * 1024;
constexpr size_t W_ENDE = W_ODOUT + (size_t)2 * 1024 * 1024;
static_assert(W_ENDE * 2 <= 66 * MiB, "weights map");
constexpr size_t WM_GU = 0;
constexpr size_t WM_D = (size_t)8 * 7168 * 1024;
#ifndef FFN_F8
#define FFN_F8 true
#endif
constexpr float MOE_WSCALE = 64.f;
constexpr int CW_BAR = 4096;
constexpr int CW_CNT = 8192;
constexpr int CW_CNT2 = 8192 + 256;
constexpr int LDS_BYTES = 160256;
constexpr int MISC_OFF = LDS_BYTES - 512;
constexpr int NWAVES = 8, NTHR = 512;

#define GAS __attribute__((address_space(1)))
#define LAS __attribute__((address_space(3)))
typedef unsigned short bf16;
typedef unsigned v4u __attribute__((ext_vector_type(4)));
typedef unsigned v2u __attribute__((ext_vector_type(2)));
typedef float f32x4 __attribute__((ext_vector_type(4)));
typedef float f32x16 __attribute__((ext_vector_type(16)));
typedef short bf16x8 __attribute__((ext_vector_type(8)));
typedef short s16x4 __attribute__((ext_vector_type(4)));
typedef GAS unsigned gu32;

typedef float f32x2_t __attribute__((ext_vector_type(2))); typedef __bf16 bf16x2_t __attribute__((ext_vector_type(2)));
__device__ __forceinline__ unsigned pkbf(float lo, float hi) { f32x2_t v = {lo, hi}; bf16x2_t b = __builtin_convertvector(v, bf16x2_t); return __builtin_bit_cast(unsigned, b); }
typedef _Float16 h16x2 __attribute__((ext_vector_type(2)));
typedef _Float16 h16x4 __attribute__((ext_vector_type(4)));
typedef float f32x2v __attribute__((ext_vector_type(2)));
__device__ __forceinline__ unsigned pkh(float a, float b) { return __builtin_bit_cast(unsigned, __builtin_convertvector((f32x2v){a, b}, h16x2)); }
__device__ __forceinline__ float bf_lo(unsigned u) { return __uint_as_float(u << 16); }
__device__ __forceinline__ float bf_hi(unsigned u) { return __uint_as_float(u & 0xffff0000u); }
__device__ __forceinline__ float bf2f(bf16 h) { return __uint_as_float(((unsigned)h) << 16); }
__device__ __forceinline__ bf16 f2bf(float f) { return (bf16)(pkbf(f, 0.f) & 0xffffu); }
__device__ __forceinline__ float fast_exp2(float x) { return __builtin_amdgcn_exp2f(x); }
__device__ __forceinline__ float frcp(float x) { return __builtin_amdgcn_rcpf(x); }
__device__ __forceinline__ float sigmoidf_(float x) { return frcp(1.f + __expf(-x)); }
__device__ __forceinline__ float siluf_(float x) { return x * frcp(1.f + __expf(-x)); }
__device__ __forceinline__ float shx(float v, int m, int lane) { return __int_as_float(__builtin_amdgcn_ds_bpermute((lane ^ m) << 2, __float_as_int(v))); }
__device__ __forceinline__ float wave_sum(float v, int lane) {
#pragma unroll
    for (int o = 1; o < 64; o <<= 1) v += shx(v, o, lane);
    return v;
}
__device__ __forceinline__ int modrow(int row) { return row < MLAT ? (row >> 13) : 4; }
namespace pg8 {
#define PG8_LAS __attribute__((address_space(3)))
typedef unsigned short bf16_t;
typedef short bf16x8 __attribute__((ext_vector_type(8)));
typedef float f32x4 __attribute__((ext_vector_type(4)));
typedef unsigned u32x4 __attribute__((ext_vector_type(4)));
constexpr int BM = 256, BK = 64, HALF = 128, HTB = HALF * BK * 2  , STAGE_BYTES = 8 * HTB, NXCD = 8, WGM = 8;

__host__ __device__ __forceinline__ int lds_byte(int r, int c) { const int st = (r >> 4) * 2 + (c >> 5), rr = r & 15, cc = c & 31, ob = rr * 64 + cc * 2; return st * 1024 + (ob ^ (((ob >> 9) & 1) << 5)); }
__host__ __device__ __forceinline__ void stage_rc(int b, int& R, int& C) { const int st = b / 1024, sb = b % 1024, swz = sb ^ (((sb >> 9) & 1) << 5); R = (st >> 1) * 16 + swz / 64; C = (st & 1) * 32 + (swz % 64) / 2; }
__host__ __device__ __forceinline__ int perm32(int rho) { const int n = rho >> 4, i = rho & 15; return 8 * (i >> 2) + 4 * n + (i & 3); }

struct Unit { int pm, pn; long boff; };
struct Gemm { const bf16_t* A; const bf16_t* Bt; int M, N, K; };

struct StaticOrder {
    int nM, nN, nwg, G, c;
    __host__ __device__ void init(int M, int N, int G_, int c_) { nM = M / BM; nN = N / BM; nwg = nM * nN; G = G_; c = c_; }
    __host__ __device__ bool next(int i, Unit& u) const {
        const long L = (long)i * G + c; if (L >= nwg) return false;
        int wgid = (int)L; { const int q = nwg / NXCD, r = nwg % NXCD, xcd = wgid % NXCD, off = wgid / NXCD; wgid = (xcd < r ? xcd * (q + 1) : r * (q + 1) + (xcd - r) * q) + off; }
        const int nig = WGM * nN, gid = wgid / nig, fm = gid * WGM, gsz = (nM - fm) < WGM ? (nM - fm) : WGM;
        u.pm = fm + ((wgid % nig) % gsz); u.pn = (wgid % nig) / gsz; u.boff = 0; return true;
    }
    __device__ __forceinline__ void a_ready(const Unit&) const {}
    __device__ __forceinline__ void done(const Unit&) const {}
};

__device__ __forceinline__ unsigned cvt_pk_bf16(float lo, float hi) { return pkbf(lo, hi); }
typedef float f32x2 __attribute__((ext_vector_type(2)));
template <class Epi, class Sched, bool ALIGN_EPI = false, bool SP2 = false, bool F8 = false>
__device__ __forceinline__ void gemm_phase(PG8_LAS unsigned char* lds, const Gemm g, const Sched& S, const Epi& E, int tid_in) {
    int tid_ = tid_in; asm volatile("" : "+v"(tid_));
    const int tid = tid_, wid = __builtin_amdgcn_readfirstlane(tid >> 6), lane = tid & 63, wr = wid >> 2, wc = wid & 3, fr = lane & 15, fq = lane >> 4;
    const int K = g.K, nt = K / BK;
    unsigned voffA[2], voffB[2];
#pragma unroll
    for (int i = 0; i < 2; ++i) { int R, C; stage_rc(tid * 16 + i * 8192, R, C); const int Rb = Epi::PERM ? ((R & ~31) + perm32(R & 31)) : R;
        voffA[i] = (unsigned)(R * K + C) * 2u; voffB[i] = (unsigned)(Rb * K + C) * 2u; }
    const size_t kstep = (size_t)(BK * 2);
    const size_t hstep = (size_t)HALF * K * 2;
    const size_t tstep = 2 * hstep;
    const unsigned ldsw = (unsigned)wid * 1024u;
    const int aoff = lds_byte(wr * 64 + fr, fq * 8), boff = lds_byte(wc * 32 + fr, fq * 8);
#define PG8_SA(b, h) (((b) * 2 + (h)) * HTB)
#define PG8_SB(b, h) ((4 + (b) * 2 + (h)) * HTB)
#define PG8_STAGE(bufoff, gbase, voff) do { _Pragma("unroll") for (int _i = 0; _i < 2; ++_i) \
        __builtin_amdgcn_global_load_lds((const unsigned*)((const char*)(gbase) + (voff)[_i]), (PG8_LAS unsigned*)(lds + (bufoff) + ldsw + _i * 8192), 16, 0, 0); } while (0)
#define PG8_LDA(dst, b, h) do { if constexpr (F8) { _Pragma("unroll") for (int m = 0; m < 4; ++m) dst##8[m] = __builtin_shufflevector(*(const PG8_LAS v4i_*)(lds + PG8_SA(b, h) + aoff + m * 2048), *(const PG8_LAS v4i_*)(lds + PG8_SA(b, h) + aoff + m * 2048 + 1024), 0, 1, 2, 3, 4, 5, 6, 7); } \
        else { _Pragma("unroll") for (int m = 0; m < 4; ++m) _Pragma("unroll") for (int k = 0; k < 2; ++k) dst[m][k] = *(const PG8_LAS bf16x8*)(lds + PG8_SA(b, h) + aoff + m * 2048 + k * 1024); } } while (0)
#define PG8_LDB(dst, b, h) do { if constexpr (F8) { _Pragma("unroll") for (int n = 0; n < 2; ++n) dst##8[n] = __builtin_shufflevector(*(const PG8_LAS v4i_*)(lds + PG8_SB(b, h) + boff + n * 2048), *(const PG8_LAS v4i_*)(lds + PG8_SB(b, h) + boff + n * 2048 + 1024), 0, 1, 2, 3, 4, 5, 6, 7); } \
        else { _Pragma("unroll") for (int n = 0; n < 2; ++n) _Pragma("unroll") for (int k = 0; k < 2; ++k) dst[n][k] = *(const PG8_LAS bf16x8*)(lds + PG8_SB(b, h) + boff + n * 2048 + k * 1024); } } while (0)
#define PG8_MMA(ai, bj, At, Bt) do { __builtin_amdgcn_s_setprio(1); _Pragma("unroll") for (int m = 0; m < 4; ++m) _Pragma("unroll") for (int n = 0; n < 2; ++n) { \
        if constexpr (F8) { asm volatile("v_mfma_f32_16x16x128_f8f6f4 %0, %1, %2, %0" : "+v"(acc[ai][bj][m][n]) : "v"(Bt##8[n]), "v"(At##8[m])); } \
        else { _Pragma("unroll") for (int k = 0; k < 2; ++k) acc[ai][bj][m][n] = __builtin_amdgcn_mfma_f32_16x16x32_bf16(Bt[n][k], At[m][k], acc[ai][bj][m][n], 0, 0, 0); } } \
        __builtin_amdgcn_s_setprio(0); } while (0)
#define PG8_WAIT_V(n) asm volatile("s_waitcnt vmcnt(" #n ")" ::: "memory")
#define PG8_WAIT_L(n) asm volatile("s_waitcnt lgkmcnt(" #n ")" ::: "memory")
#define PG8_BAR __builtin_amdgcn_s_barrier()
#define PG8_SCHED __builtin_amdgcn_sched_barrier(0)
    Unit cur, nxt; int ui = 0;
    if (!S.next(0, cur)) return;
    f32x4 acc[2][2][4][2];
#pragma unroll
    for (int a = 0; a < 2; ++a)
#pragma unroll
        for (int b = 0; b < 2; ++b)
#pragma unroll
            for (int m = 0; m < 4; ++m)
#pragma unroll
                for (int n = 0; n < 2; ++n) acc[a][b][m][n] = (f32x4){0.f, 0.f, 0.f, 0.f};
    typedef int v4i_ __attribute__((ext_vector_type(4))); typedef int v8i_ __attribute__((ext_vector_type(8)));
    bf16x8 At[4][2], B0[2][2], B1[2][2]; v8i_ At8[4], B08[2], B18[2];
    const char* cA = (const char*)g.A + (size_t)cur.pm * tstep; const char* cB = (const char*)g.Bt + (size_t)cur.pn * tstep + cur.boff;
    S.a_ready(cur);
    if constexpr (SP2) {
        PG8_STAGE(PG8_SB(0, 0), cB, voffB); PG8_STAGE(PG8_SB(0, 1), cB + hstep, voffB); PG8_STAGE(PG8_SA(0, 0), cA, voffA); PG8_STAGE(PG8_SA(0, 1), cA + hstep, voffA);
        if (wr == 1) PG8_BAR;
        PG8_WAIT_V(2); PG8_BAR;
        PG8_STAGE(PG8_SB(1, 0), cB + kstep, voffB); PG8_STAGE(PG8_SA(1, 0), cA + kstep, voffA); PG8_STAGE(PG8_SB(1, 1), cB + hstep + kstep, voffB);
        PG8_WAIT_V(6); PG8_BAR;
    } else {
        PG8_STAGE(PG8_SB(0, 0), cB, voffB); PG8_STAGE(PG8_SA(0, 0), cA, voffA); PG8_STAGE(PG8_SB(0, 1), cB + hstep, voffB); PG8_STAGE(PG8_SA(0, 1), cA + hstep, voffA);
        if (wr == 1) PG8_BAR;
        PG8_WAIT_V(4); PG8_BAR;
        PG8_STAGE(PG8_SB(1, 0), cB + kstep, voffB); PG8_STAGE(PG8_SA(1, 0), cA + kstep, voffA); PG8_STAGE(PG8_SB(1, 1), cB + hstep + kstep, voffB);
        PG8_WAIT_V(6); PG8_BAR;
    }
    for (;;) {
        const bool has_next = S.next(ui + 1, nxt);
        const char* nA = has_next ? (const char*)g.A + (size_t)nxt.pm * tstep : cA; const char* nB = has_next ? (const char*)g.Bt + (size_t)nxt.pn * tstep + nxt.boff : cB;
        for (int t = 0; t < nt; t += 2) {
            const bool last = (t == nt - 2);
            const char* a1 = cA + (size_t)(t + 1) * kstep;
            const char* a2 = last ? nA : cA + (size_t)(t + 2) * kstep; const char* b2 = last ? nB : cB + (size_t)(t + 2) * kstep;
            const char* a3 = a2 + kstep; const char* b3 = b2 + kstep;
            if (last && has_next) S.a_ready(nxt);
            if constexpr (SP2) {
            PG8_LDB(B0, 0, 0); PG8_LDB(B1, 0, 1); PG8_SCHED; PG8_LDA(At, 0, 0); PG8_STAGE(PG8_SA(1, 1), a1 + hstep, voffA);
            PG8_WAIT_V(8); PG8_WAIT_L(0); PG8_BAR; PG8_MMA(0, 0, At, B0); PG8_MMA(0, 1, At, B1); PG8_BAR; PG8_SCHED;
            PG8_LDA(At, 0, 1); PG8_STAGE(PG8_SB(0, 0), b2, voffB); PG8_STAGE(PG8_SB(0, 1), b2 + hstep, voffB); PG8_STAGE(PG8_SA(0, 0), a2, voffA);
            PG8_WAIT_V(8); PG8_WAIT_L(0); PG8_BAR; PG8_MMA(1, 0, At, B0); PG8_MMA(1, 1, At, B1); PG8_BAR; PG8_SCHED;
            PG8_LDB(B0, 1, 0); PG8_LDB(B1, 1, 1); PG8_SCHED; PG8_LDA(At, 1, 0); PG8_STAGE(PG8_SA(0, 1), a2 + hstep, voffA);
            PG8_WAIT_V(8); PG8_WAIT_L(0); PG8_BAR; PG8_MMA(0, 0, At, B0); PG8_MMA(0, 1, At, B1); PG8_BAR; PG8_SCHED;
            PG8_LDA(At, 1, 1); PG8_STAGE(PG8_SB(1, 0), b3, voffB); PG8_STAGE(PG8_SB(1, 1), b3 + hstep, voffB); PG8_STAGE(PG8_SA(1, 0), a3, voffA);
            PG8_WAIT_V(8); PG8_WAIT_L(0); PG8_BAR; PG8_MMA(1, 0, At, B0); PG8_MMA(1, 1, At, B1); PG8_BAR; PG8_SCHED;
            } else {
            PG8_LDB(B0, 0, 0); PG8_SCHED; PG8_LDA(At, 0, 0); PG8_STAGE(PG8_SA(1, 1), a1 + hstep, voffA);
            PG8_WAIT_L(8); PG8_BAR; PG8_WAIT_L(0); PG8_MMA(0, 0, At, B0); PG8_BAR; PG8_SCHED;
            PG8_LDB(B1, 0, 1); PG8_STAGE(PG8_SB(0, 0), b2, voffB);
            PG8_BAR; PG8_WAIT_L(0); PG8_MMA(0, 1, At, B1); PG8_BAR;
            PG8_LDA(At, 0, 1); PG8_STAGE(PG8_SA(0, 0), a2, voffA);
            PG8_BAR; PG8_WAIT_L(0); PG8_MMA(1, 0, At, B0); PG8_BAR; PG8_SCHED;
            PG8_STAGE(PG8_SB(0, 1), b2 + hstep, voffB);
            PG8_WAIT_V(6); PG8_BAR; PG8_MMA(1, 1, At, B1); PG8_BAR;
            PG8_LDB(B0, 1, 0); PG8_SCHED; PG8_LDA(At, 1, 0); PG8_STAGE(PG8_SA(0, 1), a2 + hstep, voffA);
            PG8_WAIT_L(8); PG8_BAR; PG8_WAIT_L(0); PG8_MMA(0, 0, At, B0); PG8_BAR; PG8_SCHED;
            PG8_LDB(B1, 1, 1); PG8_STAGE(PG8_SB(1, 0), b3, voffB);
            PG8_BAR; PG8_WAIT_L(0); PG8_MMA(0, 1, At, B1); PG8_BAR;
            PG8_LDA(At, 1, 1); PG8_STAGE(PG8_SA(1, 0), a3, voffA);
            PG8_BAR; PG8_WAIT_L(0); PG8_MMA(1, 0, At, B0); PG8_BAR; PG8_SCHED;
            PG8_STAGE(PG8_SB(1, 1), b3 + hstep, voffB);
            PG8_WAIT_V(6); PG8_BAR; PG8_MMA(1, 1, At, B1); PG8_BAR;
            }
        }
        if constexpr (ALIGN_EPI) { if (wr == 0) PG8_BAR; }
        if constexpr (!Epi::AFTER_DRAIN) { int l2_; asm volatile("v_mbcnt_lo_u32_b32 %0, -1, 0\n\tv_mbcnt_hi_u32_b32 %0, -1, %0" : "=v"(l2_)); const int fr2 = l2_ & 15, fq2 = l2_ >> 4;     E(acc, cur, wr, wc, fr2, fq2); S.done(cur); }
        if (!has_next) break;
#pragma unroll
        for (int a = 0; a < 2; ++a)
#pragma unroll
            for (int b = 0; b < 2; ++b)
#pragma unroll
                for (int m = 0; m < 4; ++m)
#pragma unroll
                    for (int n = 0; n < 2; ++n) acc[a][b][m][n] = (f32x4){0.f, 0.f, 0.f, 0.f};
        cur = nxt; cA = nA; cB = nB; ++ui;
        if constexpr (ALIGN_EPI) { if (wr == 1) PG8_BAR; }
    }
    PG8_WAIT_V(0);
    if constexpr (!ALIGN_EPI) { if (wr == 0) PG8_BAR; }
    PG8_BAR;
    if constexpr (Epi::AFTER_DRAIN) { E.fused(acc, cur, wr, wc, fr, fq, lds, wid, lane); S.done(cur); }
#undef PG8_SA
#undef PG8_SB
#undef PG8_STAGE
#undef PG8_LDA
#undef PG8_LDB
#undef PG8_MMA
#undef PG8_WAIT_V
#undef PG8_WAIT_L
#undef PG8_BAR
#undef PG8_SCHED
}
}
namespace pg8 {
constexpr int NEXP_ = 8;
template <class F> __device__ __forceinline__ void walk8(const f32x4 (&acc)[2][2][4][2], const Unit& u, int wr, int wc, int fr, int fq, const F& f) {
    asm volatile("s_nop 15\n\ts_nop 15\n\ts_nop 15\n\ts_nop 7" ::: "memory");
    const int row0 = u.pm * BM + wr * 64 + fr, col0 = u.pn * BM + wc * 32 + 8 * fq;
#pragma unroll
    for (int ai = 0; ai < 2; ++ai)
#pragma unroll
        for (int m = 0; m < 4; ++m)
#pragma unroll
            for (int bj = 0; bj < 2; ++bj) {
                const f32x4 a = acc[ai][bj][m][0], b = acc[ai][bj][m][1];
                float v[8] = {a[0], a[1], a[2], a[3], b[0], b[1], b[2], b[3]};
                f.emit(row0 + ai * HALF + m * 16, col0 + bj * HALF, v);
                asm volatile("" ::: "memory");
            }
}
__device__ __forceinline__ u32x4 pack8(const float (&v)[8], float s) {
    u32x4 w; w.x = cvt_pk_bf16(v[0] * s, v[1] * s); w.y = cvt_pk_bf16(v[2] * s, v[3] * s); w.z = cvt_pk_bf16(v[4] * s, v[5] * s); w.w = cvt_pk_bf16(v[6] * s, v[7] * s); return w;
}
struct EpiRawF32 {
    static constexpr bool PERM = true, AFTER_DRAIN = false;
    float* O; int ldc;
    __device__ __forceinline__ void emit(int row, int col, const float (&v)[8]) const {
        float* p = O + (size_t)row * ldc + col; *(f32x4*)p = (f32x4){v[0], v[1], v[2], v[3]}; *(f32x4*)(p + 4) = (f32x4){v[4], v[5], v[6], v[7]};
    }
    __device__ __forceinline__ void operator()(const f32x4 (&acc)[2][2][4][2], const Unit& u, int wr, int wc, int fr, int fq) const { walk8(acc, u, wr, wc, fr, fq, *this); }
};
struct EpiPlainBf16 {
    static constexpr bool PERM = true, AFTER_DRAIN = false;
    bf16_t* O; int ldc;
    __device__ __forceinline__ void emit(int row, int col, const float (&v)[8]) const { *(u32x4*)(O + (size_t)row * ldc + col) = pack8(v, 1.f); }
    __device__ __forceinline__ void operator()(const f32x4 (&acc)[2][2][4][2], const Unit& u, int wr, int wc, int fr, int fq) const { walk8(acc, u, wr, wc, fr, fq, *this); }
};
struct EpiMlaQ {
    static constexpr bool PERM = true, AFTER_DRAIN = false;
    bf16_t* Qm; const float* ropeB;
    __device__ __forceinline__ void emit(int row, int col, const float (&v)[8]) const {
        const int head = col / 96, c = col - head * 96;
        bf16_t* q = Qm + (size_t)row * 768 + head * 96;
        const bool isr = c >= 64;
        const int g = (c - 64) >> 3, axis = g >> 1, base = axis * 16 + (g & 1) * 4;
        f32x4 cs0 = {1.f, 0.f, 1.f, 0.f}, cs1 = {1.f, 0.f, 1.f, 0.f};
        if (isr && row < MLAT) { const int t = row & (SEQ - 1), pos = axis ? (t & 63) : (t >> 6); const float* cs = ropeB + (pos * 8 + (g & 1) * 4) * 2; cs0 = *(const f32x4*)cs; cs1 = *(const f32x4*)(cs + 4); }
        const float o10 = v[0] * cs0[0] - v[4] * cs0[1], o20 = v[4] * cs0[0] + v[0] * cs0[1], o11 = v[1] * cs0[2] - v[5] * cs0[3], o21 = v[5] * cs0[2] + v[1] * cs0[3];
        const float o12 = v[2] * cs1[0] - v[6] * cs1[1], o22 = v[6] * cs1[0] + v[2] * cs1[1], o13 = v[3] * cs1[2] - v[7] * cs1[3], o23 = v[7] * cs1[2] + v[3] * cs1[3];
        typedef unsigned u32x2 __attribute__((ext_vector_type(2)));
        u32x2 w1, w2; w1.x = cvt_pk_bf16(o10 * C2_96, o11 * C2_96); w1.y = cvt_pk_bf16(o12 * C2_96, o13 * C2_96); w2.x = cvt_pk_bf16(o20 * C2_96, o21 * C2_96); w2.y = cvt_pk_bf16(o22 * C2_96, o23 * C2_96);
        bf16_t* p1 = isr ? q + 64 + base : q + c; bf16_t* p2 = isr ? q + 64 + base + 8 : q + c + 4;
        *(u32x2*)p1 = w1; *(u32x2*)p2 = w2;
    }
    __device__ __forceinline__ void operator()(const f32x4 (&acc)[2][2][4][2], const Unit& u, int wr, int wc, int fr, int fq) const { walk8(acc, u, wr, wc, fr, fq, *this); }
};
struct EpiMlaKV {
    static constexpr bool PERM = true, AFTER_DRAIN = false;
    bf16_t* Km; bf16_t* Vm;
    __device__ __forceinline__ void emit(int row, int col, const float (&v)[8]) const {
        const int head = col >> 7, c = col & 127;
        if (c < 64) *(u32x4*)(Km + (size_t)row * 768 + head * 96 + c) = pack8(v, 1.f);
        else        *(u32x4*)(Vm + (size_t)row * 512 + head * 64 + (c - 64)) = pack8(v, 1.f);
    }
    __device__ __forceinline__ void operator()(const f32x4 (&acc)[2][2][4][2], const Unit& u, int wr, int wc, int fr, int fq) const { walk8(acc, u, wr, wc, fr, fq, *this); }
};
struct EpiResid {
    static constexpr bool PERM = true, AFTER_DRAIN = false;
    bf16_t* Z; const float* gate; const void* bl; const void* bc; bool src16;
    __device__ __forceinline__ void emit(int row, int col, const float (&v)[8]) const {
        const float* g = gate + (size_t)(row < MLAT ? (row >> 13) : 4) * 6144 + col;
        const size_t qo = (row < MLAT ? (size_t)row * 1024 : (size_t)(row - MLAT) * 1024) + col; const void* qb = row < MLAT ? bl : bc;
        f32x4 x0, x1;
        if (src16) { const u32x4 r = *(const u32x4*)((const bf16_t*)qb + qo); typedef _Float16 h16x8_ __attribute__((ext_vector_type(8))); typedef float f32x8_ __attribute__((ext_vector_type(8)));
            const f32x8_ xf = __builtin_convertvector(__builtin_bit_cast(h16x8_, r), f32x8_); x0 = (f32x4){xf[0], xf[1], xf[2], xf[3]}; x1 = (f32x4){xf[4], xf[5], xf[6], xf[7]}; }
        else { const float* q = (const float*)qb + qo; x0 = *(const f32x4*)q; x1 = *(const f32x4*)(q + 4); }
        const f32x4 g0 = *(const f32x4*)g, g1 = *(const f32x4*)(g + 4);
        const f32x4 z0 = x0 * ALPHA + g0 * (f32x4){v[0], v[1], v[2], v[3]}, z1 = x1 * ALPHA + g1 * (f32x4){v[4], v[5], v[6], v[7]};
        *(u32x4*)(Z + (size_t)row * 1024 + col) = (u32x4){pkh(z0[0], z0[1]), pkh(z0[2], z0[3]), pkh(z1[0], z1[1]), pkh(z1[2], z1[3])};
    }
    __device__ __forceinline__ void operator()(const f32x4 (&acc)[2][2][4][2], const Unit& u, int wr, int wc, int fr, int fq) const { walk8(acc, u, wr, wc, fr, fq, *this); }
};
struct EpiSwiglu {
    static constexpr bool PERM = true, AFTER_DRAIN = false;
    bf16_t* Hd; int ldh;
    __device__ __forceinline__ void emit(int row, int col, const float (&v)[8]) const {
        float h[4];
#pragma unroll
        for (int e = 0; e < 4; ++e) h[e] = v[e] * __builtin_amdgcn_rcpf(1.f + __expf(-v[e])) * v[e + 4];
        typedef unsigned u32x2 __attribute__((ext_vector_type(2)));
        u32x2 w; w.x = cvt_pk_bf16(h[0], h[1]); w.y = cvt_pk_bf16(h[2], h[3]);
        *(u32x2*)(Hd + (size_t)row * ldh + (col >> 1)) = w;
    }
    __device__ __forceinline__ void operator()(const f32x4 (&acc)[2][2][4][2], const Unit& u, int wr, int wc, int fr, int fq) const { walk8(acc, u, wr, wc, fr, fq, *this); }
};
struct EpiOddIn {
    static constexpr bool PERM = true, AFTER_DRAIN = false;
    bf16_t *Qn, *Kn, *Vn, *Qd, *Vd, *Sg; float *Zf, *Zb;
    __device__ __forceinline__ void emit(int row, int col, const float (&v)[8]) const {
        const int sec = col >> 9, c = col & 511; const size_t o = (size_t)row * 512 + c;
        if (sec == 0) { *(u32x4*)(Qn + o) = pack8(v, C2_64); }
        else if (sec == 1) { *(u32x4*)(Kn + o) = pack8(v, 1.f); }
        else if (sec == 2) { *(u32x4*)(Vn + o) = pack8(v, 1.f); }
        else if (sec == 4) { *(u32x4*)(Vd + o) = pack8(v, 1.f); }
        else if (sec == 5 || sec == 6) { float* p = (sec == 5 ? Zf : Zb) + o; *(f32x4*)p = (f32x4){v[0], v[1], v[2], v[3]}; *(f32x4*)(p + 4) = (f32x4){v[4], v[5], v[6], v[7]}; }
        else { float s[8];
#pragma unroll
            for (int e = 0; e < 8; ++e) s[e] = v[e] * __builtin_amdgcn_rcpf(1.f + __expf(-v[e]));
            *(u32x4*)((sec == 3 ? Qd : Sg) + o) = pack8(s, 1.f); }
    }
    __device__ __forceinline__ void operator()(const f32x4 (&acc)[2][2][4][2], const Unit& u, int wr, int wc, int fr, int fq) const { walk8(acc, u, wr, wc, fr, fq, *this); }
};
struct EpiSwigluS {
    static constexpr bool PERM = true, AFTER_DRAIN = false;
    bf16_t* Hd; int ldh; float s;
    __device__ __forceinline__ void emit(int row, int col, const float (&v)[8]) const {
        float h[4]; const float c1 = -s * 1.4426950408889634f, k2 = 1.f / (s * s);
#pragma unroll
        for (int e = 0; e < 4; ++e) h[e] = (v[e] * v[e + 4]) * __builtin_amdgcn_rcpf(__builtin_fmaf(__builtin_amdgcn_exp2f(v[e] * c1), k2, k2));
        typedef unsigned u32x2 __attribute__((ext_vector_type(2)));
        u32x2 w; w.x = cvt_pk_bf16(h[0], h[1]); w.y = cvt_pk_bf16(h[2], h[3]);
        *(u32x2*)(Hd + (size_t)row * ldh + (col >> 1)) = w;
    }
    __device__ __forceinline__ void operator()(const f32x4 (&acc)[2][2][4][2], const Unit& u, int wr, int wc, int fr, int fq) const { walk8(acc, u, wr, wc, fr, fq, *this); }
};
struct EpiSwigluF8 {
    static constexpr bool PERM = true, AFTER_DRAIN = false;
    unsigned char* Hd; int ldh; float s;
    __device__ __forceinline__ void emit(int row, int col, const float (&v)[8]) const {
        float h[4]; const float c1 = -s * 1.4426950408889634f, k2 = 1.f / (s * s);
#pragma unroll
        for (int e = 0; e < 4; ++e) h[e] = (v[e] * v[e + 4]) * __builtin_amdgcn_rcpf(__builtin_fmaf(__builtin_amdgcn_exp2f(v[e] * c1), k2, k2));
        unsigned w = 0u; w = __builtin_amdgcn_cvt_pk_fp8_f32(h[0], h[1], w, false); w = __builtin_amdgcn_cvt_pk_fp8_f32(h[2], h[3], w, true);
        *(unsigned*)(Hd + (size_t)row * ldh + (col >> 1)) = w;
    }
    __device__ __forceinline__ void operator()(const f32x4 (&acc)[2][2][4][2], const Unit& u, int wr, int wc, int fr, int fq) const { walk8(acc, u, wr, wc, fr, fq, *this); }
};
struct EpiScaledBf16 {
    static constexpr bool PERM = true, AFTER_DRAIN = false;
    bf16_t* O; int ldc; float s;
    __device__ __forceinline__ void emit(int row, int col, const float (&v)[8]) const { *(u32x4*)(O + (size_t)row * ldc + col) = pack8(v, s); }
    __device__ __forceinline__ void operator()(const f32x4 (&acc)[2][2][4][2], const Unit& u, int wr, int wc, int fr, int fq) const { walk8(acc, u, wr, wc, fr, fq, *this); }
};
struct GroupedOrder {
    int nM, nN, nwg, G, c; int toff[NEXP_ + 1]; long estride;
    __device__ __forceinline__ bool next(int i, Unit& u) const {
        const long L = (long)i * G + c; if (L >= nwg) return false;
        int wgid = (int)L; { const int q = nwg / NXCD, r = nwg % NXCD, xcd = wgid % NXCD, off = wgid / NXCD; wgid = (xcd < r ? xcd * (q + 1) : r * (q + 1) + (xcd - r) * q) + off; }
        const int nig = WGM * nN, gid = wgid / nig, fm = gid * WGM, gsz = (nM - fm) < WGM ? (nM - fm) : WGM;
        u.pm = fm + ((wgid % nig) % gsz); u.pn = (wgid % nig) / gsz;
        int e = 0;
#pragma unroll
        for (int k = 1; k < NEXP_; ++k) e += (u.pm >= toff[k]) ? 1 : 0;
        u.boff = (long)e * estride; return true;
    }
    __device__ __forceinline__ void a_ready(const Unit&) const {}
    __device__ __forceinline__ void done(const Unit&) const {}
};
}
#define XB_TMO      128
#define XB_XCNT(j)  (256  + 64 * (j))
#define XB_XSUB(j)  (1280 + 64 * (j))
#define XB_XGEN(j)  (2304 + 64 * (j))
#define XB_TOP      3328
#define XB_TOPGEN   3392
#define XCD_BAR_WORDS 3456
#define XB_SPIN_CAP (1u << 18)

__device__ __forceinline__ unsigned xb_ld(unsigned* p)              { return __hip_atomic_load(p, __ATOMIC_RELAXED, __HIP_MEMORY_SCOPE_AGENT); }
__device__ __forceinline__ unsigned xb_add(unsigned* p, unsigned v) { return __hip_atomic_fetch_add(p, v, __ATOMIC_RELAXED, __HIP_MEMORY_SCOPE_AGENT); }
__device__ __forceinline__ unsigned xb_xcc_id() { return (unsigned)__builtin_amdgcn_s_getreg((3 << 11) | 20) & 0xFu; }
#define XB_SPIN(cond, bar) do { unsigned _sp = 0; while (cond) { __builtin_amdgcn_s_sleep(1); \
    if ((++_sp & 255u) == 0u) { if (xb_ld(&(bar)[XB_TMO])) break; if (_sp > XB_SPIN_CAP) { atomicAdd(&(bar)[XB_TMO], 1u); break; } } } } while (0)

struct XcdBarrier {
    unsigned* bar; unsigned x;
    volatile LAS unsigned* st;
};

__device__ __forceinline__ XcdBarrier xcd_barrier_post(unsigned* bar, volatile LAS unsigned* st) {
    XcdBarrier b; b.bar = bar; b.x = xb_xcc_id(); b.st = st;
    if (threadIdx.x == 0) (void)xb_add(&bar[XB_XCNT(b.x)], 1u);
    return b;
}
__device__ __forceinline__ void xcd_barrier_complete(unsigned* bar, unsigned x, unsigned& nloc, unsigned& nx) {
    const unsigned G = gridDim.x * gridDim.y * gridDim.z;
    unsigned sum, cnt, mine, sp = 0u;
    for (;;) {
        sum = 0u; cnt = 0u; mine = 0u;
#pragma unroll
        for (unsigned j = 0; j < 16; ++j) { const unsigned c = xb_ld(&bar[XB_XCNT(j)]); sum += c; cnt += (c > 0u) ? 1u : 0u; mine = (j == x) ? c : mine; }
        if (sum == G) break;
        __builtin_amdgcn_s_sleep(1);
        if ((++sp & 255u) == 0u) { if (xb_ld(&bar[XB_TMO])) break; if (sp > XB_SPIN_CAP) { atomicAdd(&bar[XB_TMO], 1u); break; } }
    }
    nloc = mine > 0u ? mine : 1u; nx = cnt > 0u ? cnt : 1u;
}

__device__ __forceinline__ void xcd_barrier(const XcdBarrier& b) {
    asm volatile("s_waitcnt vmcnt(0)" ::: "memory");
    __syncthreads();
    if (threadIdx.x == 0) {
        unsigned* bar = b.bar;
        __builtin_amdgcn_s_waitcnt(0);
        unsigned nloc = b.st[0], nx = b.st[1];
        if (nloc == 0u) { xcd_barrier_complete(bar, b.x, nloc, nx); b.st[0] = nloc; b.st[1] = nx; }
        const unsigned old = xb_add(&bar[XB_XSUB(b.x)], 1u);
        const unsigned gen = old / nloc;
        if (old + 1u == (gen + 1u) * nloc) {
            __builtin_amdgcn_fence(__ATOMIC_RELEASE, "agent");
            asm volatile("s_waitcnt vmcnt(0)" ::: "memory");
            const unsigned og = xb_add(&bar[XB_TOP], 1u);
            const unsigned tg = og / nx;
            if (og + 1u == (tg + 1u) * nx) xb_add(&bar[XB_TOPGEN], 1u);
            else XB_SPIN(xb_ld(&bar[XB_TOPGEN]) == tg, bar);
            __builtin_amdgcn_fence(__ATOMIC_ACQUIRE, "agent");
            xb_add(&bar[XB_XGEN(b.x)], 1u);
            asm volatile("s_waitcnt vmcnt(0)" ::: "memory");
        } else {
            XB_SPIN(xb_ld(&bar[XB_XGEN(b.x)]) == gen, bar);
            __builtin_amdgcn_fence(__ATOMIC_ACQUIRE, "agent");
            asm volatile("s_waitcnt vmcnt(0)" ::: "memory");
        }
    }
    __syncthreads();
}
struct Frame {
    LAS unsigned char* lds;
    gu32* ctl;
    unsigned char* ws;
    int tid, lane, wave, vcu, G;
};
struct Args { const float* in[30]; float* out; unsigned char* ws; int ph_lo, ph_hi; };
struct InTab { LAS unsigned long long* t;
    __device__ __forceinline__ const float* operator[](int i) const { const unsigned long long v = t[i]; const unsigned lo = __builtin_amdgcn_readfirstlane((unsigned)v), hi = __builtin_amdgcn_readfirstlane((unsigned)(v >> 32)); return (const float*)(((unsigned long long)hi << 32) | lo); } };
struct PArgs { InTab in; float* out; };
#define LDS_WAIT() asm volatile("s_waitcnt lgkmcnt(0)" ::: "memory")
#define VM_WAIT() asm volatile("s_waitcnt vmcnt(0)" ::: "memory")
enum { I_X = 0, I_C, I_CTX, I_CCTX, I_ADAW, I_ADAB, I_LN1G, I_LN1B, I_LN2G, I_LN2B, I_EVWIN, I_QNG, I_KNG, I_CQG, I_CKVG, I_WUQ, I_WUKV, I_EVWOUT,
       I_FFG, I_FFU, I_FFD, I_ODWIN, I_RPB, I_LBL, I_ONG, I_ODWOUT, I_ROUTER, I_MG, I_MU, I_MD };

__device__ __forceinline__ void cvt_item(const float* src0, const float* src1, int K, int N, int Np, bf16* dst, int mode, int item, LAS float* scr, int lane, bool f8 = false) {
    const int nblk = Np >> 5, kb = item / nblk, nb = item - kb * nblk, k0 = 64 * kb, n0 = 32 * nb;
    const int np = n0 + (lane & 31);
    const float* src = src0; int col = np; bool ok = np < N;
    if (mode == 1) { const int head = np / 96, c = np - head * 96; if (c >= 64) { const int r = c - 64, g = r >> 3, e = r & 7; const int base = (g >> 1) * 16 + (g & 1) * 4; col = head * 96 + 64 + base + (e < 4 ? e : 8 + (e - 4)); } }
    else if (mode == 2) { src = (np & 4) ? src1 : src0; col = ((np >> 3) << 2) + (np & 3); ok = true; }
    float rr[32];
    { const GAS float* sp_ = (const GAS float*)src + (size_t)(k0 + (lane >> 5)) * N + col;
#pragma unroll
      for (int i = 0; i < 32; ++i) rr[i] = ok ? sp_[(size_t)(2 * i) * N] : 0.f; }
#pragma unroll
    for (int i = 0; i < 32; ++i) { const int kk = 2 * i + (lane >> 5); scr[kk * 33 + (lane & 31)] = rr[i]; }
    LDS_WAIT(); asm volatile("" ::: "memory");
    const int c8 = lane & 7;
    if (f8) {
        unsigned char* d8 = (unsigned char*)dst;
#pragma unroll
        for (int j = 0; j < 4; ++j) { const int n = (lane >> 3) + 8 * j; const LAS float* s = scr + (8 * c8) * 33 + n;
            unsigned w0 = 0u, w1 = 0u;
            w0 = __builtin_amdgcn_cvt_pk_fp8_f32(s[0 * 33] * MOE_WSCALE, s[1 * 33] * MOE_WSCALE, w0, false); w0 = __builtin_amdgcn_cvt_pk_fp8_f32(s[2 * 33] * MOE_WSCALE, s[3 * 33] * MOE_WSCALE, w0, true);
            w1 = __builtin_amdgcn_cvt_pk_fp8_f32(s[4 * 33] * MOE_WSCALE, s[5 * 33] * MOE_WSCALE, w1, false); w1 = __builtin_amdgcn_cvt_pk_fp8_f32(s[6 * 33] * MOE_WSCALE, s[7 * 33] * MOE_WSCALE, w1, true);
            *(GAS v2u*)(d8 + (size_t)(n0 + n) * K + k0 + 8 * c8) = (v2u){w0, w1}; }
    } else {
#pragma unroll
        for (int j = 0; j < 4; ++j) { const int n = (lane >> 3) + 8 * j; const LAS float* s = scr + (8 * c8) * 33 + n;
            v4u o; o.x = pkbf(s[0 * 33], s[1 * 33]); o.y = pkbf(s[2 * 33], s[3 * 33]); o.z = pkbf(s[4 * 33], s[5 * 33]); o.w = pkbf(s[6 * 33], s[7 * 33]);
            *(GAS v4u*)(dst + (size_t)(n0 + n) * K + k0 + 8 * c8) = o; }
    }
    LDS_WAIT(); asm volatile("" ::: "memory");
}
__device__ __forceinline__ void sincos_red(float ang, float& s, float& c) {
    const float n = __builtin_rintf(ang * 0.636619772367581343f);
    float y = __builtin_fmaf(-n, 1.5703125f, ang); y = __builtin_fmaf(-n, 4.837512969970703125e-4f, y); y = __builtin_fmaf(-n, 7.54978995489188e-8f, y);
    const float z = y * y;
    const float sy = y + y * z * (-1.6666654611e-1f + z * (8.3321608736e-3f + z * (-1.9515295891e-4f)));
    const float cy = 1.0f - 0.5f * z + z * z * (4.166664568298827e-2f + z * (-1.388731625493765e-3f + z * 2.443315711809948e-5f));
    const int q = ((int)n) & 3;
    s = (q == 0) ? sy : (q == 1) ? cy : (q == 2) ? -sy : -cy;
    c = (q == 0) ? cy : (q == 1) ? -sy : (q == 2) ? -cy : sy;
}
__device__ __forceinline__ float inv_freq_pow(double r, int f) { double v = 1.0; for (int i = 0; i < f; ++i) v *= r; return (float)v; }

__device__ __forceinline__ void phase_cv(Frame& F, const PArgs& A, int j) {
    const int gw = F.vcu * NWAVES + F.wave, NGW = F.G * NWAVES;
    float* mods = (float*)(F.ws + WS_SMALL + SM_MODS);
    if (j == 0) {
        LAS float* Ssm = (LAS float*)F.lds;
        LAS float* Psm = (LAS float*)(F.lds + 20480);
        if ((int)blockIdx.x < 192) {
            for (int i = F.tid; i < 5 * 1024; i += NTHR) { const int r = i >> 10, k = i & 1023; const float cv = (r < 4) ? A.in[I_C][r * 1024 + k] : A.in[I_CCTX][k]; Ssm[i] = cv * frcp(1.f + __expf(-cv)); }
            __syncthreads();
            for (int u = blockIdx.x; u < 192; u += F.G) {
                const int l = u / 48, n = (u - l * 48) * 128 + 2 * F.lane;
                float a0[5] = {0.f, 0.f, 0.f, 0.f, 0.f}, a1[5] = {0.f, 0.f, 0.f, 0.f, 0.f};
                const float* wp = A.in[I_ADAW] + ((size_t)l * 1024 + F.wave * 128) * 6144 + n;
#pragma unroll 16
                for (int k = 0; k < 128; ++k) { const f32x2_t w = *(const GAS f32x2_t*)(wp + (size_t)k * 6144); const int kk = F.wave * 128 + k;
#pragma unroll
                    for (int r = 0; r < 5; ++r) { const float sv = Ssm[r * 1024 + kk]; a0[r] += sv * w.x; a1[r] += sv * w.y; } }
#pragma unroll
                for (int r = 0; r < 5; ++r) { Psm[(F.wave * 5 + r) * 128 + 2 * F.lane] = a0[r]; Psm[(F.wave * 5 + r) * 128 + 2 * F.lane + 1] = a1[r]; }
                __syncthreads();
                for (int i = F.tid; i < 640; i += NTHR) { const int r = i >> 7, c = i & 127; float s = 0.f;
#pragma unroll
                    for (int w = 0; w < 8; ++w) s += Psm[(w * 5 + r) * 128 + c];
                    const int nn = (u - l * 48) * 128 + c; mods[((size_t)l * 5 + r) * 6144 + nn] = s + A.in[I_ADAB][l * 6144 + nn]; }
                __syncthreads();
            }
        } else if ((int)blockIdx.x == 192) {
            float* ra = (float*)(F.ws + WS_SMALL + SM_ROPEA); float* rb = (float*)(F.ws + WS_SMALL + SM_ROPEB); float* lb = (float*)(F.ws + WS_SMALL + SM_LB);
            for (int i = F.tid; i < 128 * 16; i += NTHR) { const int pos = i >> 4, f = i & 15; const float inv = inv_freq_pow(0.56234132519034908, f); float s, c; sincos_red((float)pos * inv, s, c); ra[2 * i] = c; ra[2 * i + 1] = s; }
            for (int i = F.tid; i < 128 * 8; i += NTHR) { const int pos = i >> 3, f = i & 7; const float inv = inv_freq_pow(0.31622776601683794, f); float s, c; sincos_red((float)pos * inv, s, c); rb[2 * i] = c; rb[2 * i + 1] = s; }
            for (int i = F.tid; i < 2 * 512; i += NTHR) { const int dir = i >> 9, c = i & 511; const float l0 = A.in[I_LBL][(dir * 2 + 0) * 512 + c], l1 = A.in[I_LBL][(dir * 2 + 1) * 512 + c];
                const float mx = fmaxf(l0, l1), e0 = __expf(l0 - mx), e1 = __expf(l1 - mx), p0 = e0 / (e0 + e1), p1 = e1 / (e0 + e1);
                lb[(0 * 2 + dir) * 512 + c] = p0 - p0; lb[(1 * 2 + dir) * 512 + c] = (p0 + p1) - p0; }
        }
        __syncthreads();
    }
    LAS float* scr = (LAS float*)(F.lds + 49152 + F.wave * 8704);
    bf16* W = (bf16*)(F.ws + WS_W); bf16* WM = (bf16*)(F.ws + WS_WMOE);
    constexpr int N1 = 2 * 768, N2 = 2 * 144, N3 = 2 * 128, N4 = 2 * 512, N5 = 2 * 2816, N6 = 2 * 1408, N7 = 2 * 2048, N8 = 2 * 512, N9 = 8 * 3584, N10 = 8 * 1792;
    const int nfix = (j == 0) ? (N1 + N2 + N3 + N4 + N5 + N6 + N7 + N8) : 0;
    const int total = nfix + N9 + N10;
    for (int it = gw; it < total; it += NGW) {
        int r = it; const float* s0; const float* s1 = nullptr; int K, N, Np, mode = 0, item; bf16* d; bool f8 = false;
        if (r >= nfix) { r -= nfix;
            if (r < N9) { const int e = r / 3584; item = r - e * 3584; const size_t so = ((size_t)(j * 8 + e)) * 1024 * 3584; s0 = A.in[I_MG] + so; s1 = A.in[I_MU] + so; K = 1024; N = 3584; Np = 7168; mode = 2; f8 = true; d = (bf16*)((unsigned char*)WM + WM_GU + (size_t)e * 7168 * 1024); }
            else { r -= N9; const int e = r / 1792; item = r - e * 1792; s0 = A.in[I_MD] + ((size_t)(j * 8 + e)) * 3584 * 1024; K = 3584; N = 1024; Np = 1024; f8 = true; d = (bf16*)((unsigned char*)WM + WM_D + (size_t)e * 1024 * 3584); }
        } else if (r < N1) { const int b = r / 768; item = r - b * 768; s0 = A.in[I_EVWIN] + (size_t)b * 1024 * EV_IN; K = 1024; N = EV_IN; Np = EV_INP; d = W + W_EVIN + (size_t)b * EV_INP * 1024; }
        else if ((r -= N1) < N2) { const int b = r / 144; item = r - b * 144; s0 = A.in[I_WUQ] + (size_t)b * 384 * 768; K = 384; N = 768; Np = 768; mode = 1; d = W + W_UQ + (size_t)b * 768 * 384; }
        else if ((r -= N2) < N3) { const int b = r / 128; item = r - b * 128; s0 = A.in[I_WUKV] + (size_t)b * 256 * 1024; K = 256; N = 1024; Np = 1024; d = W + W_UKV + (size_t)b * 1024 * 256; }
        else if ((r -= N3) < N4) { const int b = r / 512; item = r - b * 512; s0 = A.in[I_EVWOUT] + (size_t)b * 1024 * 1024; K = 1024; N = 1024; Np = 1024; d = W + W_EVOUT + (size_t)b * 1024 * 1024; }
        else if ((r -= N4) < N5) { const int b = r / 2816; item = r - b * 2816; s0 = A.in[I_FFG] + (size_t)b * 1024 * DFF; s1 = A.in[I_FFU] + (size_t)b * 1024 * DFF; K = 1024; N = DFF; Np = 2 * DFF; mode = 2; f8 = FFN_F8; d = FFN_F8 ? (bf16*)((unsigned char*)(W + W_FFGU) + (size_t)b * 2 * DFF * 1024) : W + W_FFGU + (size_t)b * 2 * DFF * 1024; }
        else if ((r -= N5) < N6) { const int b = r / 1408; item = r - b * 1408; s0 = A.in[I_FFD] + (size_t)b * DFF * 1024; K = DFF; N = 1024; Np = 1024; d = W + W_FFD + (size_t)b * 1024 * DFF; }
        else if ((r -= N6) < N7) { const int b = r / 2048; item = r - b * 2048; s0 = A.in[I_ODWIN] + (size_t)b * 1024 * 4096; K = 1024; N = 4096; Np = 4096; d = W + W_ODIN + (size_t)b * 4096 * 1024; }
        else { r -= N7; const int b = r / 512; item = r - b * 512; s0 = A.in[I_ODWOUT] + (size_t)b * 1024 * 1024; K = 1024; N = 1024; Np = 1024; d = W + W_ODOUT + (size_t)b * 1024 * 1024; }
        cvt_item(s0, s1, K, N, Np, d, mode, item, scr, F.lane, f8);
    }
}

__device__ __forceinline__ void store_bf16_row(bf16* orow, int lane, const f32x4 (&v)[4]) {
    GAS unsigned long long* o8 = (GAS unsigned long long*)orow + lane;
#pragma unroll
    for (int j = 0; j < 4; ++j) o8[64 * j] = (unsigned long long)pkbf(v[j].x, v[j].y) | ((unsigned long long)pkbf(v[j].z, v[j].w) << 32);
}
__device__ __forceinline__ void phase_mod(Frame& F, const PArgs& A) {
    const int gw = F.vcu * NWAVES + F.wave, NGW = F.G * NWAVES;
    const float* mods = (const float*)(F.ws + WS_SMALL + SM_MODS);
    bf16* H = (bf16*)(F.ws + WS_H);
    for (int m = gw; m < MROWS; m += NGW) {
        const float* src = (m < MLAT) ? A.in[I_X] + (size_t)m * 1024 : A.in[I_CTX] + (size_t)(m - MLAT) * 1024;
        const float* md = mods + (size_t)modrow(m) * 6144;
        f32x4 v[4], h[4];
#pragma unroll
        for (int j = 0; j < 4; ++j) { v[j] = *((const f32x4*)src + F.lane + 64 * j); const f32x4 sh = *((const f32x4*)md + F.lane + 64 * j), sc = *((const f32x4*)(md + 1024) + F.lane + 64 * j);
            h[j] = v[j] * (sc + 1.0f) + sh; }
        store_bf16_row(H + (size_t)m * 1024, F.lane, h);
    }
}
template <bool MOE, bool ROUTER, bool H8 = false>
__device__ __forceinline__ void phase_ln(Frame& F, const PArgs& A, const float* lng, const float* lnb, const float* mshift  , const float* g5  ,
                                         const float* router, int jodd, bool last, int nrows = MROWS) {
    const int gw = F.vcu * NWAVES + F.wave, NGW = F.G * NWAVES;
#define LNCH(j_) (2 * F.lane + ((j_) & 1) + 128 * ((j_) >> 1))
    bf16* X = (bf16*)(F.ws + WS_X); bf16* H = (bf16*)(F.ws + WS_H);
    int* topk = (int*)(F.ws + WS_TOPK);
    const bf16* Y = (const bf16*)(F.ws + WS_XG);
    LAS unsigned* lcnt = (LAS unsigned*)(F.lds);
    if (ROUTER) { if (F.tid < 8) lcnt[F.tid] = 0u; __syncthreads(); }
    f32x4 gv[4], bv[4];
#pragma unroll
    for (int j = 0; j < 4; ++j) { gv[j] = *((const f32x4*)lng + LNCH(j)); bv[j] = *((const f32x4*)lnb + LNCH(j)); }
    f32x4 rwa[4][4], rwb[4][4];
    if (ROUTER) {
#pragma unroll
        for (int j = 0; j < 4; ++j)
#pragma unroll
            for (int i = 0; i < 4; ++i) { const float* rp = router + (size_t)(4 * LNCH(j) + i) * 8; rwa[j][i] = *(const GAS f32x4*)rp; rwb[j][i] = *(const GAS f32x4*)(rp + 4); }
    }
    for (int m = gw; m < nrows; m += NGW) {
        bf16* xr = X + (size_t)m * 1024; const int mr = modrow(m);
        f32x4 v[4];
        if (MOE) {
#pragma unroll
            for (int jj = 0; jj < 2; ++jj) { const v4u xx = *((const GAS v4u*)xr + F.lane + 64 * jj);
                v[2 * jj] = __builtin_convertvector(__builtin_bit_cast(h16x4, (v2u){xx.x, xx.y}), f32x4); v[2 * jj + 1] = __builtin_convertvector(__builtin_bit_cast(h16x4, (v2u){xx.z, xx.w}), f32x4); }
        } else {
            const bf16* zr = (const bf16*)(F.ws + WS_ZR) + (size_t)m * 1024;
#pragma unroll
            for (int jj = 0; jj < 2; ++jj) { const v4u zz = *((const GAS v4u*)zr + F.lane + 64 * jj);
                v[2 * jj] = __builtin_convertvector(__builtin_bit_cast(h16x4, (v2u){zz.x, zz.y}), f32x4); v[2 * jj + 1] = __builtin_convertvector(__builtin_bit_cast(h16x4, (v2u){zz.z, zz.w}), f32x4); }
        }
        if (MOE) {
            const int r1 = topk[m * 6 + 4], r2 = topk[m * 6 + 5]; const float w1 = __int_as_float(topk[m * 6 + 2]), w2 = __int_as_float(topk[m * 6 + 3]);
            const float* gg = g5 + (size_t)mr * 6144;
#pragma unroll
            for (int j = 0; j < 4; ++j) { const v2u y1 = *((const v2u*)(Y + (size_t)r1 * 1024) + LNCH(j)), y2 = *((const v2u*)(Y + (size_t)r2 * 1024) + LNCH(j));
                const f32x4 gq = *((const f32x4*)gg + LNCH(j));
                f32x4 yy; yy.x = w1 * bf_lo(y1.x) + w2 * bf_lo(y2.x); yy.y = w1 * bf_hi(y1.x) + w2 * bf_hi(y2.x); yy.z = w1 * bf_lo(y1.y) + w2 * bf_lo(y2.y); yy.w = w1 * bf_hi(y1.y) + w2 * bf_hi(y2.y);
                v[j] = v[j] * ALPHA + gq * yy; }
        }
        float s = 0.f;
#pragma unroll
        for (int j = 0; j < 4; ++j) s += (v[j].x + v[j].y) + (v[j].z + v[j].w);
        const float mean = wave_sum(s, F.lane) * (1.f / 1024.f); float s2 = 0.f;
#pragma unroll
        for (int j = 0; j < 4; ++j) { v[j] = v[j] - mean; s2 += (v[j].x * v[j].x + v[j].y * v[j].y) + (v[j].z * v[j].z + v[j].w * v[j].w); }
        const float rstd = __builtin_amdgcn_rsqf(wave_sum(s2, F.lane) * (1.f / 1024.f) + 1e-6f);
#pragma unroll
        for (int j = 0; j < 4; ++j) v[j] = v[j] * rstd * gv[j] + bv[j];
        if (!last) {
#pragma unroll
            for (int jj = 0; jj < 2; ++jj) *((GAS v4u*)xr + F.lane + 64 * jj) = (v4u){pkh(v[2 * jj].x, v[2 * jj].y), pkh(v[2 * jj].z, v[2 * jj].w), pkh(v[2 * jj + 1].x, v[2 * jj + 1].y), pkh(v[2 * jj + 1].z, v[2 * jj + 1].w)}; }
#if defined(SELFCHK)
        if (last) { const float cn = __hip_atomic_load((const float*)(F.ctl + 12288), __ATOMIC_RELAXED, __HIP_MEMORY_SCOPE_AGENT), cd = __hip_atomic_load((const float*)(F.ctl + 12288) + 1, __ATOMIC_RELAXED, __HIP_MEMORY_SCOPE_AGENT);
            const float cscale = 1.f + sqrtf(cn / fmaxf(cd, 1e-30f));
#pragma unroll
            for (int j = 0; j < 4; ++j) v[j] = v[j] * cscale; }
#endif
        if (last) { if (m < MLAT) {
#pragma unroll
                for (int j = 0; j < 4; ++j) *((f32x4*)(A.out + (size_t)m * 1024) + LNCH(j)) = v[j]; }
            continue; }
        const float* md = mshift + (size_t)mr * 6144;
#pragma unroll
        for (int j = 0; j < 4; ++j) { const f32x4 sh = *((const f32x4*)md + LNCH(j)), sc = *((const f32x4*)(md + 1024) + LNCH(j)); v[j] = v[j] * (sc + 1.0f) + sh; }
        if (H8) {
#pragma unroll
            for (int jj = 0; jj < 2; ++jj) { unsigned w0 = 0u, w1 = 0u;
                w0 = __builtin_amdgcn_cvt_pk_fp8_f32(v[2 * jj].x, v[2 * jj].y, w0, false); w0 = __builtin_amdgcn_cvt_pk_fp8_f32(v[2 * jj].z, v[2 * jj].w, w0, true);
                w1 = __builtin_amdgcn_cvt_pk_fp8_f32(v[2 * jj + 1].x, v[2 * jj + 1].y, w1, false); w1 = __builtin_amdgcn_cvt_pk_fp8_f32(v[2 * jj + 1].z, v[2 * jj + 1].w, w1, true);
                *((GAS v2u*)((unsigned char*)H + (size_t)m * 1024) + F.lane + 64 * jj) = (v2u){w0, w1}; }
        } else {
#pragma unroll
            for (int jj = 0; jj < 2; ++jj) *((GAS v4u*)(H + (size_t)m * 1024) + F.lane + 64 * jj) = (v4u){pkbf(v[2 * jj].x, v[2 * jj].y), pkbf(v[2 * jj].z, v[2 * jj].w), pkbf(v[2 * jj + 1].x, v[2 * jj + 1].y), pkbf(v[2 * jj + 1].z, v[2 * jj + 1].w)}; }
        if (ROUTER) {
            float pa[8] = {0.f, 0.f, 0.f, 0.f, 0.f, 0.f, 0.f, 0.f};
#pragma unroll
            for (int j = 0; j < 4; ++j)
#pragma unroll
                for (int i = 0; i < 4; ++i) { const float hv = v[j][i]; const f32x4 ra = rwa[j][i], rb = rwb[j][i];
                    pa[0] += hv * ra.x; pa[1] += hv * ra.y; pa[2] += hv * ra.z; pa[3] += hv * ra.w; pa[4] += hv * rb.x; pa[5] += hv * rb.y; pa[6] += hv * rb.z; pa[7] += hv * rb.w; }
            float lg[8];
            { const bool b5 = (F.lane & 32) != 0, b4 = (F.lane & 16) != 0, b3 = (F.lane & 8) != 0; float q4[4], q2[2];
#pragma unroll
              for (int k = 0; k < 4; ++k) { const float snd = b5 ? pa[k] : pa[k + 4], own = b5 ? pa[k + 4] : pa[k]; q4[k] = own + shx(snd, 32, F.lane); }
#pragma unroll
              for (int k = 0; k < 2; ++k) { const float snd = b4 ? q4[k] : q4[k + 2], own = b4 ? q4[k + 2] : q4[k]; q2[k] = own + shx(snd, 16, F.lane); }
              float q1 = (b3 ? q2[1] : q2[0]) + shx(b3 ? q2[0] : q2[1], 8, F.lane);
              q1 += shx(q1, 4, F.lane); q1 += shx(q1, 2, F.lane); q1 += shx(q1, 1, F.lane);
#pragma unroll
              for (int e = 0; e < 8; ++e) lg[e] = __builtin_bit_cast(float, __builtin_amdgcn_readlane(__builtin_bit_cast(int, q1), 32 * (e >> 2) + 16 * ((e >> 1) & 1) + 8 * (e & 1))); }
            int e1 = 0; float v1 = lg[0];
#pragma unroll
            for (int e = 1; e < 8; ++e) if (lg[e] > v1) { v1 = lg[e]; e1 = e; }
            int e2 = -1; float v2 = -INFINITY;
#pragma unroll
            for (int e = 0; e < 8; ++e) if (e != e1 && lg[e] > v2) { v2 = lg[e]; e2 = e; }
            const float w1 = frcp(1.f + __expf(v2 - v1)), w2 = 1.f - w1;
            if (F.lane == 0) { topk[m * 6 + 0] = e1; topk[m * 6 + 1] = e2; topk[m * 6 + 2] = __float_as_int(w1); topk[m * 6 + 3] = __float_as_int(w2);
                atomicAdd((unsigned*)&lcnt[e1], 1u); atomicAdd((unsigned*)&lcnt[e2], 1u); }
        }
    }
    if (ROUTER) { LDS_WAIT(); __syncthreads(); if (F.tid < 8) __hip_atomic_fetch_add((unsigned*)(F.ctl + CW_CNT + 64 * jodd) + F.tid, lcnt[F.tid], __ATOMIC_RELAXED, __HIP_MEMORY_SCOPE_AGENT); }
}
#undef LNCH
typedef short v4i16_t __attribute__((ext_vector_type(4)));
__device__ __forceinline__ int crow(int r, int hi) { return (r & 3) + 8 * (r >> 2) + 4 * hi; }
__device__ __forceinline__ float swap_max(float m) { auto rr = __builtin_amdgcn_permlane32_swap(__float_as_uint(m), __float_as_uint(m), false, false); return fmaxf(__uint_as_float(rr[0]), __uint_as_float(rr[1])); }
__device__ __forceinline__ float swap_sum(float m) { auto rr = __builtin_amdgcn_permlane32_swap(__float_as_uint(m), __float_as_uint(m), false, false); return __uint_as_float(rr[0]) + __uint_as_float(rr[1]); }

#ifndef ATT_THR
#define ATT_THR 6.f
#endif
template <int DK, int MODE>
__device__ __forceinline__ void attn_unit(LAS unsigned char* lds, int tid, const bf16* Q, int qp, const bf16* K1, const bf16* V1, int nt1, const bf16* K2, const bf16* V2, int nt2,
                                          int kp, int vp, bf16* O, int op, int rq0, int kr0, const float* rpbh) {
    constexpr int KROW = DK * 2 + 16, KSZ = 64 * KROW, CPK = DK / 8  , NPK = 64 * CPK;
    constexpr int VB = 4 * KSZ, SCR = VB + 4 * 8192, BIAS = SCR + 2048;
    const int lane = tid & 63, r32 = lane & 31, hi = lane >> 5; const int wid = __builtin_amdgcn_readfirstlane(tid >> 6);
    const int NT = nt1 + nt2;
    LAS float* wsf = (LAS float*)(lds + SCR) + wid * 64;
    const int kkey0 = tid / CPK, kch0 = tid - kkey0 * CPK;
    const int kkey1 = (tid + 512) / CPK, kch1 = (tid + 512) - kkey1 * CPK;
    const bool two = (NPK > 512) && (tid + 512 < NPK);
    const int vkey = tid >> 3, vch = tid & 7;
    const int vdst = ((vkey >> 3) * 2 + (vch >> 2)) * 512 + (vkey & 7) * 64 + (vch & 3) * 16;
    v4u kA0, kA1 = {0u, 0u, 0u, 0u}, vA, kB0, kB1 = {0u, 0u, 0u, 0u}, vB;
#define ATT_LOAD(t, K0_, K1_, V_) do { const int t_ = (t); const bf16* kb_ = (t_ < nt1) ? K1 + (size_t)t_ * 64 * kp : K2 + (size_t)(t_ - nt1) * 64 * kp; \
        const bf16* vb_ = (t_ < nt1) ? V1 + (size_t)t_ * 64 * vp : V2 + (size_t)(t_ - nt1) * 64 * vp; \
        K0_ = *(const GAS v4u*)(kb_ + (size_t)kkey0 * kp + kch0 * 8); if (two) K1_ = *(const GAS v4u*)(kb_ + (size_t)kkey1 * kp + kch1 * 8); \
        V_ = *(const GAS v4u*)(vb_ + (size_t)vkey * vp + vch * 8); } while (0)
#define ATT_STORE(buf, K0_, K1_, V_) do { LAS unsigned char* kd_ = lds + (buf) * KSZ; *(LAS v4u*)(kd_ + kkey0 * KROW + kch0 * 16) = K0_; if (two) *(LAS v4u*)(kd_ + kkey1 * KROW + kch1 * 16) = K1_; \
        *(LAS v4u*)(lds + VB + (buf) * 8192 + vdst) = V_; } while (0)
    ATT_LOAD(0, kA0, kA1, vA); if (NT > 1) ATT_LOAD(1, kB0, kB1, vB);
    if (MODE == 1) { LAS float* bs = (LAS float*)(lds + BIAS); for (int i = tid; i < 15 * 31; i += NTHR) bs[i] = rpbh[i] * LOG2E; }
    bf16x8 qr[DK / 16];
#pragma unroll
    for (int d0 = 0; d0 < DK / 16; ++d0) qr[d0] = *(const GAS bf16x8*)(Q + (size_t)(wid * 32 + r32) * qp + d0 * 16 + hi * 8);
    ATT_STORE(0, kA0, kA1, vA); if (NT > 1) ATT_STORE(1, kB0, kB1, vB);
    __syncthreads();
    float m_run = 0.f, l_run = 0.f; f32x16 o0, o1, negm;
    { float zz; asm volatile("v_mov_b32 %0, 0" : "=v"(zz));
#pragma unroll
      for (int r = 0; r < 16; ++r) { o0[r] = zz; o1[r] = zz; negm[r] = zz; } }
    const int rq = rq0 + (wid >> 1), rsq = min(max(rq - 4, 0), 120), qc = (wid & 1) * 32 + r32, cs = min(max(qc - 8, 0), 48);
    unsigned nmask0 = 0u, nmask1 = 0u;
    if (MODE == 1) {
#pragma unroll
        for (int r = 0; r < 16; ++r) { const int kc0 = crow(r, hi), kc1 = kc0 + 32; nmask0 |= ((kc0 >= cs) && (kc0 < cs + 16)) ? (1u << r) : 0u; nmask1 |= ((kc1 >= cs) && (kc1 < cs + 16)) ? (1u << r) : 0u; } }
    const int koff = r32 * KROW + hi * 16;
    const int vlane = (4 * hi + ((lane & 15) >> 2)) * 64 + ((lane >> 4) & 1) * 32 + (lane & 3) * 8;
#define ATT_TILE(tt) do { const int t_c = (tt); const int buf = t_c & 3; \
        bool act = true; int kr = 0; \
        if (MODE == 1) { kr = kr0 + t_c; act = (t_c >= nt1) || (kr >= rsq && kr < rsq + 8); } \
        if (act) { \
            const LAS unsigned char* kb = lds + buf * KSZ + koff; \
            f32x16 s0, s1; bf16x8 ka0[DK / 16], ka1[DK / 16]; \
            _Pragma("unroll") for (int d0 = 0; d0 < DK / 16; ++d0) { ka0[d0] = *(const LAS bf16x8*)(kb + d0 * 32); ka1[d0] = *(const LAS bf16x8*)(kb + 32 * KROW + d0 * 32); } \
            __builtin_amdgcn_sched_barrier(0);            \
            _Pragma("unroll") for (int d0 = 0; d0 < DK / 16; ++d0) { \
                if (d0 == 0) { s0 = __builtin_amdgcn_mfma_f32_32x32x16_bf16(ka0[0], qr[0], negm, 0, 0, 0); s1 = __builtin_amdgcn_mfma_f32_32x32x16_bf16(ka1[0], qr[0], negm, 0, 0, 0); } \
                else { s0 = __builtin_amdgcn_mfma_f32_32x32x16_bf16(ka0[d0], qr[d0], s0, 0, 0, 0); s1 = __builtin_amdgcn_mfma_f32_32x32x16_bf16(ka1[d0], qr[d0], s1, 0, 0, 0); } } \
            const LAS unsigned char* vb = lds + VB + buf * 8192 + vlane; \
            v4i16_t vlo[8], vhh[8]; \
            _Pragma("unroll") for (int i = 0; i < 8; ++i) { const int ks = i >> 1, db = i & 1; \
                vlo[i] = __builtin_amdgcn_ds_read_tr16_b64_v4i16((LAS v4i16_t*)(vb + ((ks * 2 + 0) * 2 + db) * 512)); \
                vhh[i] = __builtin_amdgcn_ds_read_tr16_b64_v4i16((LAS v4i16_t*)(vb + ((ks * 2 + 1) * 2 + db) * 512)); } \
            __builtin_amdgcn_sched_barrier(0);            \
            if (MODE == 1) { if (t_c < nt1) { \
                unsigned bo_ = (unsigned)(size_t)((const LAS float*)(lds + BIAS) + (kr - rq + 7) * 31 - qc + 15 + 4 * hi); asm volatile("" : "+v"(bo_)); \
                const LAS float* bs = (const LAS float*)(size_t)bo_;        \
                _Pragma("unroll") for (int r = 0; r < 16; ++r) { const int kk_ = (r & 3) + 8 * (r >> 2); \
                    const float b0 = bs[kk_], b1 = bs[kk_ + 32]; \
                    s0[r] = ((nmask0 >> r) & 1u) ? s0[r] + b0 : -INFINITY; s1[r] = ((nmask1 >> r) & 1u) ? s1[r] + b1 : -INFINITY; } } } \
            float ma = __builtin_fmaxf(__builtin_fmaxf(s0[0], s0[1]), s1[0]), mb = __builtin_fmaxf(__builtin_fmaxf(s0[2], s0[3]), s1[1]); \
            ma = __builtin_fmaxf(__builtin_fmaxf(ma, s1[2]), s1[3]); \
            _Pragma("unroll") for (int r = 4; r < 16; r += 4) { ma = __builtin_fmaxf(__builtin_fmaxf(ma, s0[r]), s0[r + 1]); mb = __builtin_fmaxf(__builtin_fmaxf(mb, s0[r + 2]), s0[r + 3]); \
                ma = __builtin_fmaxf(__builtin_fmaxf(ma, s1[r]), s1[r + 1]); mb = __builtin_fmaxf(__builtin_fmaxf(mb, s1[r + 2]), s1[r + 3]); } \
            const float mx = swap_max(__builtin_fmaxf(ma, mb)); \
            if (__any(mx > ATT_THR)) {        \
                const float dl = __builtin_fmaxf(mx, 0.f); m_run += dl; const float f = fast_exp2(-dl); l_run *= f; if (hi == 0) wsf[r32] = f; LDS_WAIT(); \
                _Pragma("unroll") for (int r = 0; r < 16; ++r) { const float fr_ = wsf[crow(r, hi)]; o0[r] *= fr_; o1[r] *= fr_; s0[r] -= dl; s1[r] -= dl; } \
                _Pragma("unroll") for (int r = 0; r < 16; ++r) negm[r] = -m_run; \
                asm volatile("" : "+v"(negm)); \
            } \
            float ls = 0.f; \
            _Pragma("unroll") for (int r = 0; r < 16; ++r) { s0[r] = fast_exp2(s0[r]); s1[r] = fast_exp2(s1[r]); ls += s0[r] + s1[r]; } \
            l_run += ls; \
            v4u pw[4]; \
            pw[0] = (v4u){pkbf(s0[0], s0[1]), pkbf(s0[2], s0[3]), pkbf(s0[4], s0[5]), pkbf(s0[6], s0[7])}; \
            pw[1] = (v4u){pkbf(s0[8], s0[9]), pkbf(s0[10], s0[11]), pkbf(s0[12], s0[13]), pkbf(s0[14], s0[15])}; \
            pw[2] = (v4u){pkbf(s1[0], s1[1]), pkbf(s1[2], s1[3]), pkbf(s1[4], s1[5]), pkbf(s1[6], s1[7])}; \
            pw[3] = (v4u){pkbf(s1[8], s1[9]), pkbf(s1[10], s1[11]), pkbf(s1[12], s1[13]), pkbf(s1[14], s1[15])}; \
            __builtin_amdgcn_sched_barrier(0); \
            _Pragma("unroll") for (int ks = 0; ks < 4; ++ks) { \
                const bf16x8 pa = __builtin_bit_cast(bf16x8, pw[ks]); \
                _Pragma("unroll") for (int db = 0; db < 2; ++db) { \
                    const v4i16_t lo = vlo[ks * 2 + db], hh = vhh[ks * 2 + db]; \
                    const bf16x8 vf = (bf16x8){lo[0], lo[1], lo[2], lo[3], hh[0], hh[1], hh[2], hh[3]}; \
                    if (db == 0) o0 = __builtin_amdgcn_mfma_f32_32x32x16_bf16(pa, vf, o0, 0, 0, 0); \
                    else         o1 = __builtin_amdgcn_mfma_f32_32x32x16_bf16(pa, vf, o1, 0, 0, 0); } } \
        } } while (0)
    for (int t = 0; t < NT; t += 2) {
        if (t + 2 < NT) ATT_LOAD(t + 2, kA0, kA1, vA);
        if (t + 3 < NT) ATT_LOAD(t + 3, kB0, kB1, vB);
        ATT_TILE(t);
        if (t + 1 < NT) ATT_TILE(t + 1);
        if (t + 2 < NT) ATT_STORE((t + 2) & 3, kA0, kA1, vA);
        if (t + 3 < NT) ATT_STORE((t + 3) & 3, kB0, kB1, vB);
        __syncthreads();
    }
    const float lt = swap_sum(l_run);
    if (hi == 0) wsf[32 + r32] = frcp(lt);
    LDS_WAIT();
#pragma unroll
    for (int r = 0; r < 16; ++r) { const int q = crow(r, hi); const float il = wsf[32 + q]; bf16* orow = O + (size_t)(wid * 32 + q) * op;
        orow[r32] = f2bf(o0[r] * il); orow[32 + r32] = f2bf(o1[r] * il); }
    __syncthreads();
#undef ATT_LOAD
#undef ATT_STORE
#undef ATT_TILE
}
#define PINF(x_) asm volatile("" : "+v"(x_))
#if defined(PROBE_EXP2X)
#define PROBE_XEXP(x_) do { float dd_; asm volatile("v_exp_f32 %0, %1" : "=v"(dd_) : "v"(x_)); } while (0)
#else
#define PROBE_XEXP(x_) do {} while (0)
#endif
#if defined(PROBE_ACC)
#define PACC_T0(id_) do { if ((id_) == PROBE_ACC && blockIdx.x == 0 && tid == 0) { volatile LAS unsigned* pm_ = (volatile LAS unsigned*)(lds + MISC_OFF); pm_[16] = (unsigned)__builtin_amdgcn_s_memrealtime(); } } while (0)
#define PACC_T1(id_) do { if ((id_) == PROBE_ACC && blockIdx.x == 0 && tid == 0) { volatile LAS unsigned* pm_ = (volatile LAS unsigned*)(lds + MISC_OFF); pm_[18] += (unsigned)__builtin_amdgcn_s_memrealtime() - pm_[16]; } } while (0)
#else
#define PACC_T0(id_) do {} while (0)
#define PACC_T1(id_) do {} while (0)
#endif
template <int DK>
__device__ __forceinline__ void attn_unit_p(LAS unsigned char* lds, int tid, const bf16* Q, int qp, const bf16* K1, const bf16* V1, int nt1, const bf16* K2, const bf16* V2, int nt2,
                                            int kp, int vp, bf16* O, int op) {
    constexpr int NK = DK / 16, G = 2 * NK, PRE = 4;
    constexpr int KROW = DK * 2 + 16, KSZ = 64 * KROW, CPK = DK / 8, NPK = 64 * CPK;
    constexpr int VB = 4 * KSZ, SCR = VB + 4 * 8192;
    const int lane = tid & 63, r32 = lane & 31, hi = lane >> 5; const int wid = __builtin_amdgcn_readfirstlane(tid >> 6);
    const int NT = nt1 + nt2;
    LAS float* wsf = (LAS float*)(lds + SCR) + wid * 64;
    const int kkey0 = tid / CPK, kch0 = tid - kkey0 * CPK;
    const int kkey1 = (tid + 512) / CPK, kch1 = (tid + 512) - kkey1 * CPK;
    const bool two = (NPK > 512) && (tid + 512 < NPK);
    const int vkey = tid >> 3, vch = tid & 7;
    const int vdst = ((vkey >> 3) * 2 + (vch >> 2)) * 512 + (vkey & 7) * 64 + (vch & 3) * 16;
    v4u kA0, kA1 = {0u, 0u, 0u, 0u}, vA, kB0, kB1 = {0u, 0u, 0u, 0u}, vB;
#define ATT_LOADK(t, K0_, K1_) do { const int t_ = (t); const bf16* kb_ = (t_ < nt1) ? K1 + (size_t)t_ * 64 * kp : K2 + (size_t)(t_ - nt1) * 64 * kp; \
        K0_ = *(const GAS v4u*)(kb_ + (size_t)kkey0 * kp + kch0 * 8); if (two) K1_ = *(const GAS v4u*)(kb_ + (size_t)kkey1 * kp + kch1 * 8); } while (0)
#define ATT_LOADV(t, V_) do { const int t_ = (t); const bf16* vb_ = (t_ < nt1) ? V1 + (size_t)t_ * 64 * vp : V2 + (size_t)(t_ - nt1) * 64 * vp; \
        V_ = *(const GAS v4u*)(vb_ + (size_t)vkey * vp + vch * 8); } while (0)
#define ATT_STOREK(buf, K0_, K1_) do { LAS unsigned char* kd_ = lds + (buf) * KSZ; *(LAS v4u*)(kd_ + kkey0 * KROW + kch0 * 16) = K0_; if (two) *(LAS v4u*)(kd_ + kkey1 * KROW + kch1 * 16) = K1_; } while (0)
#define ATT_STOREV(buf, V_) do { *(LAS v4u*)(lds + VB + (buf) * 8192 + vdst) = V_; } while (0)
    { v4u kT0, kT1 = {0u, 0u, 0u, 0u};
      ATT_LOADK(0, kA0, kA1); ATT_LOADV(0, vA); ATT_LOADK(1, kB0, kB1); ATT_LOADV(1, vB); ATT_LOADK(2, kT0, kT1);
      ATT_STOREK(0, kA0, kA1); ATT_STOREV(0, vA); ATT_STOREK(1, kB0, kB1); ATT_STOREV(1, vB); ATT_STOREK(2, kT0, kT1); }
    bf16x8 qr[NK];
#pragma unroll
    for (int d0 = 0; d0 < NK; ++d0) qr[d0] = *(const GAS bf16x8*)(Q + (size_t)(wid * 32 + r32) * qp + d0 * 16 + hi * 8);
    __syncthreads();
    float m_run = 0.f, l4[4]; f32x16 o0, o1, negm;
    { float zz; asm volatile("v_mov_b32 %0, 0" : "=v"(zz));
#pragma unroll
      for (int r = 0; r < 16; ++r) { o0[r] = zz; o1[r] = zz; negm[r] = zz; }
      l4[0] = zz; l4[1] = zz; l4[2] = zz; l4[3] = zz; }
    const int koff = r32 * KROW + hi * 16;
    const int vlane = (4 * hi + ((lane & 15) >> 2)) * 64 + ((lane >> 4) & 1) * 32 + (lane & 3) * 8;
#define KREAD(i_) (*(const LAS bf16x8*)(kb + ((i_) & 1) * 32 * KROW + ((i_) >> 1) * 32))
#define VREADLO(g_) __builtin_amdgcn_ds_read_tr16_b64_v4i16((LAS v4i16_t*)(vb + ((((g_) >> 1) * 2 + 0) * 2 + ((g_) & 1)) * 512))
#define VREADHI(g_) __builtin_amdgcn_ds_read_tr16_b64_v4i16((LAS v4i16_t*)(vb + ((((g_) >> 1) * 2 + 1) * 2 + ((g_) & 1)) * 512))
#define MAX3(a_, b_, c_) __builtin_fmaxf(__builtin_fmaxf(a_, b_), c_)
#define ATT_DECIDE(N0, N1, ma_, mb_) do { const float mloc = __builtin_fmaxf(ma_, mb_);        \
        if (__any(mloc > ATT_THR)) { const float mx = swap_max(mloc); \
            const float dl = __builtin_fmaxf(mx, 0.f); m_run += dl; const float f = fast_exp2(-dl); l4[0] *= f; l4[1] *= f; l4[2] *= f; l4[3] *= f; if (hi == 0) wsf[r32] = f; LDS_WAIT(); \
            _Pragma("unroll") for (int r = 0; r < 16; ++r) { const float fr_ = wsf[crow(r, hi)]; o0[r] *= fr_; o1[r] *= fr_; N0[r] -= dl; N1[r] -= dl; } \
            _Pragma("unroll") for (int r = 0; r < 16; ++r) negm[r] = -m_run; \
            asm volatile("" : "+v"(negm)); \
        } } while (0)
#define CE(C0, C1, e_) (((e_) < 16) ? C0[(e_) & 15] : C1[(e_) & 15])
#define EOF_(g_) (PRE + (32 - PRE) * (g_) / G)
#define MS_(g_) ((g_) < 2 ? 0 : (g_) == 2 ? 3 : 2 * (g_) - 1)
#define ATT_STEP(C0, C1, N0, N1, T) do { const int t_s = (T); \
        if ((t_s & 1) != 0) { if (wid >= 4) __builtin_amdgcn_s_setprio(0); else __builtin_amdgcn_s_setprio(1); } else { if (wid >= 4) __builtin_amdgcn_s_setprio(1); else __builtin_amdgcn_s_setprio(0); }        \
        PACC_T0(5); PACC_T0(2); \
        const LAS unsigned char* kb = lds + ((t_s + 1) & 3) * KSZ + koff; \
        const LAS unsigned char* vb = lds + VB + (t_s & 3) * 8192 + vlane; \
        bf16x8 kf[G]; float x[32]; unsigned pwv[16]; v4i16_t vlo[8], vhh[8]; float ma, mb; \
        kf[0] = KREAD(0); kf[1] = KREAD(1); kf[2] = KREAD(2); \
        _Pragma("unroll") for (int e = 0; e < PRE; ++e) { x[e] = fast_exp2(CE(C0, C1, e)); PINF(x[e]); } \
        __builtin_amdgcn_sched_barrier(0); \
        _Pragma("unroll") for (int g = 0; g < G; ++g) { \
            if (g + 3 < G) kf[g + 3] = KREAD(g + 3); \
            if (g >= G - 4) { vlo[g - (G - 4)] = VREADLO(g - (G - 4)); vhh[g - (G - 4)] = VREADHI(g - (G - 4)); } \
            if (g == 0) N0 = __builtin_amdgcn_mfma_f32_32x32x16_bf16(kf[0], qr[0], negm, 0, 0, 0); \
            else if (g == 1) N1 = __builtin_amdgcn_mfma_f32_32x32x16_bf16(kf[1], qr[0], negm, 0, 0, 0); \
            else if (g & 1) N1 = __builtin_amdgcn_mfma_f32_32x32x16_bf16(kf[g], qr[g >> 1], N1, 0, 0, 0); \
            else N0 = __builtin_amdgcn_mfma_f32_32x32x16_bf16(kf[g], qr[g >> 1], N0, 0, 0, 0); \
            if (g & 1) PINF(N1); else PINF(N0);            \
            _Pragma("unroll") for (int e = EOF_(g); e < EOF_(g + 1); ++e) { x[e] = fast_exp2(CE(C0, C1, e)); PINF(x[e]); PROBE_XEXP(x[e]); } \
            _Pragma("unroll") for (int k = (g == 0 ? 0 : EOF_(g - 1) / 2); k < EOF_(g) / 2; ++k) { pwv[k] = pkbf(x[2 * k], x[2 * k + 1]); PINF(pwv[k]); } \
            __builtin_amdgcn_sched_barrier(0); } \
        PACC_T1(2); PACC_T0(3); \
        _Pragma("unroll") for (int g = 0; g < 8; ++g) { \
            if (g < 4) { vlo[g + 4] = VREADLO(g + 4); vhh[g + 4] = VREADHI(g + 4); } \
            if (g == 0) { _Pragma("unroll") for (int k = EOF_(G - 1) / 2; k < 16; ++k) { pwv[k] = pkbf(x[2 * k], x[2 * k + 1]); PINF(pwv[k]); } } \
            { const int ks = g >> 1; const bf16x8 pa = __builtin_bit_cast(bf16x8, ((v4u){pwv[4 * ks], pwv[4 * ks + 1], pwv[4 * ks + 2], pwv[4 * ks + 3]})); \
              const bf16x8 vf = (bf16x8){vlo[g][0], vlo[g][1], vlo[g][2], vlo[g][3], vhh[g][0], vhh[g][1], vhh[g][2], vhh[g][3]}; \
              if (g & 1) { o1 = __builtin_amdgcn_mfma_f32_32x32x16_bf16(pa, vf, o1, 0, 0, 0); PINF(o1); } else { o0 = __builtin_amdgcn_mfma_f32_32x32x16_bf16(pa, vf, o0, 0, 0, 0); PINF(o0); } } \
            _Pragma("unroll") for (int jj = 0; jj < 4; ++jj) { l4[jj] += x[4 * g + jj]; PINF(l4[jj]); } \
            { _Pragma("unroll") for (int i = MS_(g); i < MS_(g + 1); ++i) { \
                  if (i == 0) ma = MAX3(CE(N0, N1, 0), CE(N0, N1, 1), CE(N0, N1, 2)); else if (i == 1) mb = MAX3(CE(N0, N1, 3), CE(N0, N1, 4), CE(N0, N1, 5)); \
                  else if (i & 1) mb = MAX3(mb, CE(N0, N1, 2 * i + 2), CE(N0, N1, 2 * i + 3)); else ma = MAX3(ma, CE(N0, N1, 2 * i + 2), CE(N0, N1, 2 * i + 3)); \
                  if (i & 1) PINF(mb); else PINF(ma); } } \
            __builtin_amdgcn_sched_barrier(0); } \
        PACC_T1(3); PACC_T0(4); \
        ATT_DECIDE(N0, N1, ma, mb); \
        PACC_T1(4); PACC_T1(5); \
    } while (0)
    if (wid >= 4) __builtin_amdgcn_s_setprio(1);
    f32x16 a0, a1, b0, b1;
    {
        const LAS unsigned char* kb = lds + koff; bf16x8 kf[G];
#pragma unroll
        for (int g = 0; g < G; ++g) kf[g] = KREAD(g);
        __builtin_amdgcn_sched_barrier(0);
#pragma unroll
        for (int g = 0; g < G; ++g) {
            if (g == 0) a0 = __builtin_amdgcn_mfma_f32_32x32x16_bf16(kf[0], qr[0], negm, 0, 0, 0);
            else if (g == 1) a1 = __builtin_amdgcn_mfma_f32_32x32x16_bf16(kf[1], qr[0], negm, 0, 0, 0);
            else if (g & 1) a1 = __builtin_amdgcn_mfma_f32_32x32x16_bf16(kf[g], qr[g >> 1], a1, 0, 0, 0);
            else a0 = __builtin_amdgcn_mfma_f32_32x32x16_bf16(kf[g], qr[g >> 1], a0, 0, 0, 0); }
        float ma = __builtin_fmaxf(a0[0], a0[1]), mb = __builtin_fmaxf(a0[2], a0[3]);
#pragma unroll
        for (int i = 2; i < 16; ++i) { if (i & 1) mb = MAX3(mb, CE(a0, a1, 2 * i), CE(a0, a1, 2 * i + 1)); else ma = MAX3(ma, CE(a0, a1, 2 * i), CE(a0, a1, 2 * i + 1)); }
        m_run = swap_max(__builtin_fmaxf(ma, mb));
#pragma unroll
        for (int r = 0; r < 16; ++r) { a0[r] -= m_run; a1[r] -= m_run; negm[r] = -m_run; }
        asm volatile("" : "+v"(negm));
    }
    for (int t = 0; t + 2 < NT; t += 2) {
        ATT_LOADK(t + 3, kA0, kA1); ATT_LOADV(t + 2, vA); ATT_LOADV(t + 3, vB); if (t + 4 < NT) ATT_LOADK(t + 4, kB0, kB1);
        ATT_STEP(a0, a1, b0, b1, t); ATT_STEP(b0, b1, a0, a1, t + 1);
        ATT_STOREK((t + 3) & 3, kA0, kA1); ATT_STOREV((t + 2) & 3, vA); ATT_STOREV((t + 3) & 3, vB); if (t + 4 < NT) ATT_STOREK((t + 4) & 3, kB0, kB1);
        PACC_T0(1);
        __syncthreads();
        PACC_T1(1);
    }
    ATT_STEP(a0, a1, b0, b1, NT - 2);
    {
        const LAS unsigned char* vb = lds + VB + ((NT - 1) & 3) * 8192 + vlane; v4i16_t vlo[8], vhh[8];
#pragma unroll
        for (int g = 0; g < 8; ++g) { vlo[g] = VREADLO(g); vhh[g] = VREADHI(g); }
        __builtin_amdgcn_sched_barrier(0);
        float ls = 0.f;
#pragma unroll
        for (int r = 0; r < 16; ++r) { b0[r] = fast_exp2(b0[r]); b1[r] = fast_exp2(b1[r]); ls += b0[r] + b1[r]; }
        l4[0] += ls;
        v4u pw[4];
        pw[0] = (v4u){pkbf(b0[0], b0[1]), pkbf(b0[2], b0[3]), pkbf(b0[4], b0[5]), pkbf(b0[6], b0[7])};
        pw[1] = (v4u){pkbf(b0[8], b0[9]), pkbf(b0[10], b0[11]), pkbf(b0[12], b0[13]), pkbf(b0[14], b0[15])};
        pw[2] = (v4u){pkbf(b1[0], b1[1]), pkbf(b1[2], b1[3]), pkbf(b1[4], b1[5]), pkbf(b1[6], b1[7])};
        pw[3] = (v4u){pkbf(b1[8], b1[9]), pkbf(b1[10], b1[11]), pkbf(b1[12], b1[13]), pkbf(b1[14], b1[15])};
#pragma unroll
        for (int g = 0; g < 8; ++g) { const bf16x8 pa = __builtin_bit_cast(bf16x8, pw[g >> 1]);
            const bf16x8 vf = (bf16x8){vlo[g][0], vlo[g][1], vlo[g][2], vlo[g][3], vhh[g][0], vhh[g][1], vhh[g][2], vhh[g][3]};
            if (g & 1) o1 = __builtin_amdgcn_mfma_f32_32x32x16_bf16(pa, vf, o1, 0, 0, 0); else o0 = __builtin_amdgcn_mfma_f32_32x32x16_bf16(pa, vf, o0, 0, 0, 0); }
    }
    __builtin_amdgcn_s_setprio(0);
    const float lt = swap_sum((l4[0] + l4[1]) + (l4[2] + l4[3]));
    if (hi == 0) wsf[32 + r32] = frcp(lt);
    LDS_WAIT();
#pragma unroll
    for (int r = 0; r < 16; ++r) { const int q = crow(r, hi); const float il = wsf[32 + q]; bf16* orow = O + (size_t)(wid * 32 + q) * op;
        orow[r32] = f2bf(o0[r] * il); orow[32 + r32] = f2bf(o1[r] * il); }
    __syncthreads();
#undef ATT_LOADK
#undef ATT_LOADV
#undef ATT_STOREK
#undef ATT_STOREV
#undef ATT_STEP
#undef ATT_DECIDE
#undef KREAD
#undef VREADLO
#undef VREADHI
#undef CE
#undef EOF_
#undef MS_
}
__device__ __forceinline__ int hg_blk_row(int b, int blk) { return blk < 2 ? MLAT + b * CTXL + 128 * blk : b * SEQ + 128 * (blk - 2); }
__device__ __forceinline__ int hg_mc_of_blk(int dir, int blk) { return dir ? (blk < 2 ? 1 - blk : 67 - blk) : blk; }
template <int KT> __device__ __forceinline__ f32x16 mma_nt(f32x16 acc, const LAS bf16* A, int lda, const LAS bf16* Bt, int ldb, int r32, int hi) {
    const LAS bf16* ap = A + r32 * lda + 8 * hi; const LAS bf16* bp = Bt + r32 * ldb + 8 * hi;
#pragma unroll
    for (int k0 = 0; k0 < KT; k0 += 16) acc = __builtin_amdgcn_mfma_f32_32x32x16_bf16(*(const LAS bf16x8*)(ap + k0), *(const LAS bf16x8*)(bp + k0), acc, 0, 0, 0);
    return acc;
}
__device__ __forceinline__ void ldq16(const bf16* p, float (&o)[16]) {
    const v4u a = *(const GAS v4u*)p, b = *(const GAS v4u*)(p + 8);
    o[0] = bf_lo(a.x); o[1] = bf_hi(a.x); o[2] = bf_lo(a.y); o[3] = bf_hi(a.y); o[4] = bf_lo(a.z); o[5] = bf_hi(a.z); o[6] = bf_lo(a.w); o[7] = bf_hi(a.w);
    o[8] = bf_lo(b.x); o[9] = bf_hi(b.x); o[10] = bf_lo(b.y); o[11] = bf_hi(b.y); o[12] = bf_lo(b.z); o[13] = bf_hi(b.z); o[14] = bf_lo(b.w); o[15] = bf_hi(b.w);
}
__device__ __forceinline__ void ldf16(const float* p, float (&o)[16]) {
#pragma unroll
    for (int k = 0; k < 4; ++k) { const f32x4 a = *((const GAS f32x4*)p + k); o[4 * k] = a.x; o[4 * k + 1] = a.y; o[4 * k + 2] = a.z; o[4 * k + 3] = a.w; }
}
__device__ __forceinline__ void st16(LAS bf16* p, const float (&v)[16]) {
    *(LAS v4u*)p = (v4u){pkbf(v[0], v[1]), pkbf(v[2], v[3]), pkbf(v[4], v[5]), pkbf(v[6], v[7])};
    *(LAS v4u*)(p + 8) = (v4u){pkbf(v[8], v[9]), pkbf(v[10], v[11]), pkbf(v[12], v[13]), pkbf(v[14], v[15])};
}

__device__ __forceinline__ void ldq8(const bf16* p, float (&o)[8]) { const v4u a = *(const GAS v4u*)p;
    o[0] = bf_lo(a.x); o[1] = bf_hi(a.x); o[2] = bf_lo(a.y); o[3] = bf_hi(a.y); o[4] = bf_lo(a.z); o[5] = bf_hi(a.z); o[6] = bf_lo(a.w); o[7] = bf_hi(a.w); }
__device__ __forceinline__ void ldf8(const float* p, float (&o)[8]) { const f32x4 a = *(const GAS f32x4*)p, b = *((const GAS f32x4*)p + 1); o[0] = a.x; o[1] = a.y; o[2] = a.z; o[3] = a.w; o[4] = b.x; o[5] = b.y; o[6] = b.z; o[7] = b.w; }
__device__ __forceinline__ void st8(LAS bf16* p, const float (&v)[8]) { *(LAS v4u*)p = (v4u){pkbf(v[0], v[1]), pkbf(v[2], v[3]), pkbf(v[4], v[5]), pkbf(v[6], v[7])}; }

struct HgT { const bf16 *Qd, *Vd, *Sg; const float *Zf, *Zb; const float* lb  ; float* HST; float* HDM; const float* ong; bf16* OO; };

__device__ __forceinline__ void hg_a_unit(Frame& F, const HgT& T, int chain, int mc) {
    const int dir = chain & 1, h = (chain >> 1) & 3, b = chain >> 3, hoff = h * 128;
    const int row0 = hg_blk_row(b, hg_mc_of_blk(dir, mc));
    const float* Z = dir ? T.Zb : T.Zf;
    LAS float* PT = (LAS float*)F.lds;
    LAS bf16* KET = (LAS bf16*)(F.lds + 2048);
    LAS bf16* VT = (LAS bf16*)(F.lds + 2048 + 34816);
    const int tid = F.tid, lane = F.lane, r32 = lane & 31, hi = lane >> 5, wid = F.wave;
    const int e = tid & 127, p = __builtin_amdgcn_readfirstlane(tid >> 7);
    const float lbv = T.lb[dir * 512 + hoff + e];
    const float* zp = Z + (size_t)(row0 + 32 * p) * 512 + hoff; const bf16* vp = T.Vd + (size_t)(row0 + 32 * p) * 512 + hoff;
    float w[32], kk[32]; unsigned vv[16];
#pragma unroll
    for (int i = 0; i < 32; ++i) { const float z = ((const GAS float*)(zp + (size_t)i * 512))[e]; const float sg = sigmoidf_(z); w[i] = __logf(lbv + (1.f - lbv) * sg); kk[i] = (1.f - lbv) * (1.f - sg); }
#pragma unroll
    for (int i = 0; i < 16; ++i) vv[i] = (unsigned)((const GAS bf16*)(vp + (size_t)(2 * i) * 512))[e] | ((unsigned)((const GAS bf16*)(vp + (size_t)(2 * i + 1) * 512))[e] << 16);
    float run = 0.f;
    if (dir == 0) {
#pragma unroll
        for (int i = 31; i >= 0; --i) { const float tmp = w[i]; w[i] = run; run += tmp; }
    } else {
#pragma unroll
        for (int i = 0; i < 32; ++i) { const float tmp = w[i]; w[i] = run; run += tmp; }
    }
    PT[p * 128 + e] = run;
    __syncthreads();
    { const float p0 = PT[e], p1 = PT[128 + e], p2 = PT[256 + e], p3 = PT[384 + e];
      const float offs = dir == 0 ? ((p < 3 ? p3 : 0.f) + (p < 2 ? p2 : 0.f) + (p < 1 ? p1 : 0.f)) : ((p > 0 ? p0 : 0.f) + (p > 1 ? p1 : 0.f) + (p > 2 ? p2 : 0.f));
      if (p == 0) T.HDM[((size_t)chain * 66 + mc) * 128 + e] = __expf((p0 + p1) + (p2 + p3));
#pragma unroll
      for (int g = 0; g < 4; ++g) { unsigned pk[4];
#pragma unroll
          for (int c = 0; c < 4; ++c) { const int i = 8 * g + 2 * c; pk[c] = pkbf(kk[i] * __expf(w[i] + offs), kk[i + 1] * __expf(w[i + 1] + offs)); }
          *(LAS v4u*)(KET + e * 136 + 32 * p + 8 * g) = (v4u){pk[0], pk[1], pk[2], pk[3]};
          *(LAS v4u*)(VT + e * 136 + 32 * p + 8 * g) = (v4u){vv[4 * g], vv[4 * g + 1], vv[4 * g + 2], vv[4 * g + 3]}; } }
    __syncthreads();
    { const int ei = wid & 3, fp = wid >> 2; float* dst = T.HST + ((size_t)chain * 66 + mc) * 16384;
#pragma unroll
      for (int k = 0; k < 2; ++k) { const int fi = 2 * fp + k; f32x16 acc = {}; acc = mma_nt<128>(acc, KET + 32 * ei * 136, 136, VT + 32 * fi * 136, 136, r32, hi);
#pragma unroll
          for (int r = 0; r < 16; ++r) dst[(32 * ei + crow(r, hi)) * 128 + 32 * fi + r32] = acc[r]; } }
    __syncthreads();
}
__device__ __forceinline__ void phase_hg_b(Frame& F, const HgT& T) {
    const int g = F.vcu * NTHR + F.tid;
    for (int gi = g; gi < 32 * 4096; gi += F.G * NTHR) {
        const int chain = gi >> 12, idx = gi & 4095, e = idx >> 5, f4 = idx & 31;
        f32x4* base = (f32x4*)(T.HST + (size_t)chain * 66 * 16384 + e * 128) + f4; const float* dmp = T.HDM + (size_t)chain * 66 * 128 + e;
        f32x4 S = {0.f, 0.f, 0.f, 0.f};
#pragma unroll 6
        for (int mc = 0; mc < 66; ++mc) { const f32x4 kv = base[(size_t)mc * 4096]; const float d = dmp[mc * 128]; base[(size_t)mc * 4096] = S; S = S * d + kv; }
    }
}
__device__ __forceinline__ void hg_c_unit(Frame& F, const HgT& T, int b, int h, int blk) {
    const int hoff = h * 128, row0 = hg_blk_row(b, blk);
    const int tid = F.tid, lane = F.lane, r32 = lane & 31, hi = lane >> 5, wid = F.wave;
    LAS bf16* P = (LAS bf16*)F.lds;
    LAS float* PT = (LAS float*)(F.lds + 32768);
    LAS float* DE = (LAS float*)(F.lds + 34816);
    LAS float* BR = (LAS float*)(F.lds + 35328);
    LAS bf16* QB = (LAS bf16*)(F.lds + 35840);
    LAS bf16* QS = (LAS bf16*)(F.lds + 53248);
    LAS bf16* KS = (LAS bf16*)(F.lds + 70656);
    LAS bf16* KET = (LAS bf16*)(F.lds + 88064);
    LAS bf16* VT = (LAS bf16*)(F.lds + 106496);
    LAS bf16* ST = (LAS bf16*)(F.lds + 124928);
    LAS float* OUT = (LAS float*)(F.lds + 35840);
    const int ti = wid & 1, fi = wid >> 1;
    const int ei = wid & 3, fp = wid >> 2;
    f32x16 oacc0 = {}, oacc1 = {};
    const int se = tid & 127, sp = __builtin_amdgcn_readfirstlane(tid >> 7);
#ifndef HGDIR_LO
#define HGDIR_LO 0
#define HGDIR_HI 2
#endif
    float zraw[16]; unsigned qraw[16], vraw[16];
#define HC_LOAD(dir_, cc_) do { const int ci_ = (dir_) ? 1 - (cc_) : (cc_); const int rowc_ = row0 + 64 * ci_; const float* Z_ = (dir_) ? T.Zb : T.Zf; \
        const float* zp_ = Z_ + (size_t)(rowc_ + 16 * sp) * 512 + hoff; const bf16* qp_ = T.Qd + (size_t)(rowc_ + 16 * sp) * 512 + hoff; const bf16* vp_ = T.Vd + (size_t)(rowc_ + 16 * sp) * 512 + hoff; \
        _Pragma("unroll") for (int i = 0; i < 16; ++i) { zraw[i] = ((const GAS float*)(zp_ + (size_t)i * 512))[se]; qraw[i] = ((const GAS bf16*)(qp_ + (size_t)i * 512))[se]; vraw[i] = ((const GAS bf16*)(vp_ + (size_t)i * 512))[se]; } } while (0)
    HC_LOAD(HGDIR_LO, 0);
#pragma unroll 1
    for (int dir = HGDIR_LO; dir < HGDIR_HI; ++dir) {
        const int chain = (b * 4 + h) * 2 + dir; const float* Z = dir ? T.Zb : T.Zf;
        const float* Sin = T.HST + ((size_t)chain * 66 + hg_mc_of_blk(dir, blk)) * 16384;
        f32x16 S[2];
#pragma unroll
        for (int k = 0; k < 2; ++k)
#pragma unroll
            for (int r = 0; r < 16; ++r) S[k][r] = ((const GAS float*)(Sin + (32 * ei + (r & 3) + 8 * (r >> 2)) * 128 + 32 * (2 * fp + k)))[4 * hi * 128 + r32];
#pragma unroll
        for (int k = 0; k < 2; ++k)
#pragma unroll
            for (int g = 0; g < 4; ++g) *(LAS v2u*)(ST + (32 * (2 * fp + k) + r32) * 136 + 32 * ei + 8 * g + 4 * hi) = (v2u){pkbf(S[k][4 * g], S[k][4 * g + 1]), pkbf(S[k][4 * g + 2], S[k][4 * g + 3])};
#pragma unroll 1
        for (int cc = 0; cc < 2; ++cc) {
            const int ci = dir ? 1 - cc : cc; const int rowc = row0 + 64 * ci;
            { const float lbv = T.lb[dir * 512 + hoff + se];
              float bq[16], kk[16], qv[16]; unsigned vv[8];
#pragma unroll
              for (int i = 0; i < 16; ++i) { const float z = zraw[i]; const float sg = sigmoidf_(z); bq[i] = __logf(lbv + (1.f - lbv) * sg); kk[i] = (1.f - lbv) * (1.f - sg); qv[i] = __uint_as_float(qraw[i] << 16); }
#pragma unroll
              for (int i = 0; i < 8; ++i) vv[i] = vraw[2 * i] | (vraw[2 * i + 1] << 16);
              float run = 0.f;
              if (dir == 0) {
#pragma unroll
                  for (int i = 0; i < 16; ++i) { run += bq[i]; bq[i] = run; }
              } else {
#pragma unroll
                  for (int i = 15; i >= 0; --i) { run += bq[i]; bq[i] = run; }
              }
              PT[sp * 128 + se] = run;
              if (dir == 0) { if (sp == 1) BR[se] = bq[15]; } else { if (sp == 2) BR[se] = bq[0]; }
              __syncthreads();
              const float p0 = PT[se], p1 = PT[128 + se], p2 = PT[256 + se], p3 = PT[384 + se];
              const float offs = dir == 0 ? ((sp > 0 ? p0 : 0.f) + (sp > 1 ? p1 : 0.f) + (sp > 2 ? p2 : 0.f)) : ((sp < 3 ? p3 : 0.f) + (sp < 2 ? p2 : 0.f) + (sp < 1 ? p1 : 0.f));
              const float bend = (p0 + p1) + (p2 + p3), br = BR[se] + (dir == 0 ? p0 : p3);
              if (sp == 0) DE[se] = __expf(bend);
              unsigned ke[8];
#pragma unroll
              for (int c = 0; c < 8; ++c) { const float b0 = bq[2 * c] + offs, b1 = bq[2 * c + 1] + offs; ke[c] = pkbf(kk[2 * c] * __expf(bend - b0), kk[2 * c + 1] * __expf(bend - b1)); }
              *(LAS v4u*)(KET + se * 72 + 16 * sp) = (v4u){ke[0], ke[1], ke[2], ke[3]}; *(LAS v4u*)(KET + se * 72 + 16 * sp + 8) = (v4u){ke[4], ke[5], ke[6], ke[7]};
              *(LAS v4u*)(VT + se * 72 + 16 * sp) = (v4u){vv[0], vv[1], vv[2], vv[3]}; *(LAS v4u*)(VT + se * 72 + 16 * sp + 8) = (v4u){vv[4], vv[5], vv[6], vv[7]};
#pragma unroll
              for (int i = 0; i < 16; ++i) { const float bb = bq[i] + offs; const int tok = 16 * sp + i;
                  QB[tok * 136 + se] = f2bf(qv[i] * __expf(bb)); QS[tok * 136 + se] = f2bf(qv[i] * __expf(bb - br)); KS[tok * 136 + se] = f2bf(kk[i] * __expf(br - bb)); } }
            __syncthreads();
            if (cc == 0) HC_LOAD(dir, 1); else if (dir + 1 < HGDIR_HI) HC_LOAD(dir + 1, 0);
            if (wid < 4) { const int tb = wid & 1, sb = wid >> 1; f32x16 sc = {}; sc = mma_nt<128>(sc, QS + 32 * tb * 136, 136, KS + 32 * sb * 136, 136, r32, hi);
#pragma unroll
                for (int r = 0; r < 16; ++r) { const int t = 32 * tb + crow(r, hi), s = 32 * sb + r32; const bool keep = dir ? (s >= t) : (s <= t); P[t * 72 + s] = f2bf(keep ? sc[r] : 0.f); } }
            __syncthreads();
            { f32x16 a = ci ? oacc1 : oacc0; a = mma_nt<64>(a, P + 32 * ti * 72, 72, VT + 32 * fi * 72, 72, r32, hi); a = mma_nt<128>(a, QB + 32 * ti * 136, 136, ST + 32 * fi * 136, 136, r32, hi); if (ci) oacc1 = a; else oacc0 = a; }
            __syncthreads();
#pragma unroll
            for (int k = 0; k < 2; ++k) {
#pragma unroll
                for (int r = 0; r < 16; ++r) S[k][r] *= DE[32 * ei + crow(r, hi)];
                S[k] = mma_nt<64>(S[k], KET + 32 * ei * 72, 72, VT + 32 * (2 * fp + k) * 72, 72, r32, hi);
                asm volatile("s_nop 15\n\ts_nop 7" : "+v"(S[k]));
#pragma unroll
                for (int g = 0; g < 4; ++g) *(LAS v2u*)(ST + (32 * (2 * fp + k) + r32) * 136 + 32 * ei + 8 * g + 4 * hi) = (v2u){pkbf(S[k][4 * g], S[k][4 * g + 1]), pkbf(S[k][4 * g + 2], S[k][4 * g + 3])};
            }
            __syncthreads();
        }
#if defined(SELFCHK) && SELFCHK == 6
        { const int pair = (b == 1 && h == 2) ? 0 : (b == 3 && h == 0) ? 1 : -1;
          if (pair >= 0) {
#pragma unroll
            for (int r = 0; r < 16; ++r) { OUT[(32 * ti + crow(r, hi)) * 132 + 32 * fi + r32] = oacc0[r]; OUT[(64 + 32 * ti + crow(r, hi)) * 132 + 32 * fi + r32] = oacc1[r]; }
            __syncthreads();
            float* D = (float*)(F.ws + 1002 * MiB) + ((size_t)(dir * 2 + pair) * 8448 + (blk < 2 ? 128 * blk : 256 + 128 * (blk - 2))) * 128;
            for (int i = tid; i < 128 * 128; i += NTHR) D[i] = OUT[(i >> 7) * 132 + (i & 127)];
            __syncthreads(); } }
#endif
    }
#undef HC_LOAD
    { int l2; asm volatile("v_mbcnt_lo_u32_b32 %0, -1, 0\n\tv_mbcnt_hi_u32_b32 %0, -1, %0" : "=v"(l2)); const int r32b = l2 & 31, hib = l2 >> 5;
#pragma unroll
      for (int r = 0; r < 16; ++r) { OUT[(32 * ti + crow(r, hib)) * 132 + 32 * fi + r32b] = oacc0[r]; OUT[(64 + 32 * ti + crow(r, hib)) * 132 + 32 * fi + r32b] = oacc1[r]; }
      __syncthreads();
      for (int k = 0; k < 16; ++k) { const int t = 16 * wid + k; const float a0 = OUT[t * 132 + l2], a1 = OUT[t * 132 + 64 + l2];
        const float ms = wave_sum(a0 * a0 + a1 * a1, l2) * (1.f / 128.f); const float rs = __builtin_amdgcn_rsqf(ms + 1e-6f);
        const bf16* sgr = T.Sg + (size_t)(row0 + t) * 512 + hoff; bf16* orow = T.OO + (size_t)(row0 + t) * 1024 + 512 + hoff;
        ((GAS bf16*)orow)[l2] = f2bf(a0 * rs * ((const GAS float*)T.ong)[l2] * bf2f(((const GAS bf16*)sgr)[l2])); ((GAS bf16*)orow)[64 + l2] = f2bf(a1 * rs * ((const GAS float*)T.ong)[64 + l2] * bf2f(((const GAS bf16*)sgr)[64 + l2])); } }
    __syncthreads();
}
__device__ __forceinline__ void ld8(const float* p, float (&v)[8]) { const f32x4 a = *(const GAS f32x4*)p, b = *(const GAS f32x4*)(p + 4); v[0] = a.x; v[1] = a.y; v[2] = a.z; v[3] = a.w; v[4] = b.x; v[5] = b.y; v[6] = b.z; v[7] = b.w; }
__device__ __forceinline__ void ld8(const bf16* p, float (&v)[8]) { const v4u a = *(const GAS v4u*)p;
    v[0] = __uint_as_float(a.x << 16); v[1] = __uint_as_float(a.x & 0xffff0000u); v[2] = __uint_as_float(a.y << 16); v[3] = __uint_as_float(a.y & 0xffff0000u);
    v[4] = __uint_as_float(a.z << 16); v[5] = __uint_as_float(a.z & 0xffff0000u); v[6] = __uint_as_float(a.w << 16); v[7] = __uint_as_float(a.w & 0xffff0000u); }
__device__ __forceinline__ v4u pk8(const float (&v)[8], float s) { return (v4u){pkbf(v[0] * s, v[1] * s), pkbf(v[2] * s, v[3] * s), pkbf(v[4] * s, v[5] * s), pkbf(v[6] * s, v[7] * s)}; }
template <int R>
__device__ __forceinline__ void head_norm_rope(float (&v)[R][8], const float (&g8)[8], int l8  , const bool (&rope)[R], const int (&trow)[R], const int (&tcol)[R], const float* ropeA, int lane) {
    float ss[R];
#pragma unroll
    for (int q = 0; q < R; ++q) { ss[q] = 0.f;
#pragma unroll
        for (int e = 0; e < 8; ++e) ss[q] += v[q][e] * v[q][e]; }
#pragma unroll
    for (int q = 0; q < R; ++q) ss[q] += shx(ss[q], 1, lane);
#pragma unroll
    for (int q = 0; q < R; ++q) ss[q] += shx(ss[q], 2, lane);
#pragma unroll
    for (int q = 0; q < R; ++q) ss[q] += shx(ss[q], 4, lane);
    float pr[R][8];
#pragma unroll
    for (int q = 0; q < R; ++q) { const float rs = __builtin_amdgcn_rsqf(ss[q] * (1.f / 64.f) + 1e-6f);
#pragma unroll
        for (int e = 0; e < 8; ++e) v[q][e] = v[q][e] * rs * g8[e]; }
#pragma unroll
    for (int q = 0; q < R; ++q)
#pragma unroll
        for (int e = 0; e < 8; ++e) pr[q][e] = shx(v[q][e], 2, lane);
#pragma unroll
    for (int q = 0; q < R; ++q) if (rope[q]) { const int axis = l8 >> 2, pos = axis ? tcol[q] : trow[q]; const float* cs = ropeA + (pos * 16 + 8 * (l8 & 1)) * 2; const bool second = (l8 & 2) != 0;
        float cc[16];
#pragma unroll
        for (int k = 0; k < 4; ++k) { const f32x4 c4 = *((const GAS f32x4*)cs + k); cc[4 * k] = c4.x; cc[4 * k + 1] = c4.y; cc[4 * k + 2] = c4.z; cc[4 * k + 3] = c4.w; }
#pragma unroll
        for (int e = 0; e < 8; ++e) { const float c_ = cc[2 * e], s_ = cc[2 * e + 1]; v[q][e] = second ? (v[q][e] * c_ + pr[q][e] * s_) : (v[q][e] * c_ - pr[q][e] * s_); } }
}
__device__ __forceinline__ void phase_even_post(Frame& F, const PArgs& A, int j) {
    constexpr int R = 2;
    const int gw = F.vcu * NWAVES + F.wave, NGW = F.G * NWAVES, lane = F.lane;
    const bf16* RAW = (const bf16*)(F.ws + WS_RAW);
    bf16 *QG = (bf16*)(F.ws + WS_QG), *KG = (bf16*)(F.ws + WS_KG), *VG = (bf16*)(F.ws + WS_VG), *CQN = (bf16*)(F.ws + WS_CQN), *CKVN = (bf16*)(F.ws + WS_CKVN), *KM = (bf16*)(F.ws + WS_KM);
    const float* ropeA = (const float*)(F.ws + WS_SMALL + SM_ROPEA); const float* ropeB = (const float*)(F.ws + WS_SMALL + SM_ROPEB);
    float gq[8], gk[8], gcq[8], gckv[8];
    ld8(A.in[I_QNG] + j * 64 + 8 * (lane & 7), gq); ld8(A.in[I_KNG] + j * 64 + 8 * (lane & 7), gk); ld8(A.in[I_CQG] + j * 384 + 8 * (lane < 48 ? lane : 0), gcq); ld8(A.in[I_CKVG] + j * 256 + 8 * (lane & 31), gckv);
    constexpr int NR = (MROWS + R - 1) / R;
    for (int g = gw; g < NR; g += NGW) {
        const bf16* r[R]; bool lat[R]; int trow[R], tcol[R], m[R];
#pragma unroll
        for (int q = 0; q < R; ++q) { m[q] = R * g + q; r[q] = RAW + (size_t)m[q] * EV_INP; lat[q] = m[q] < MLAT; const int t = m[q] & (SEQ - 1); trow[q] = t >> 6; tcol[q] = t & 63; }
        float v[R][8], w[R][8];
#pragma unroll
        for (int q = 0; q < R; ++q) ld8(r[q] + 8 * lane, v[q]);
        head_norm_rope<R>(v, gq, lane & 7, lat, trow, tcol, ropeA, lane);
#pragma unroll
        for (int q = 0; q < R; ++q) *(GAS v4u*)(QG + (size_t)m[q] * 512 + 8 * lane) = pk8(v[q], C2_64);
        { const int l = lane & 31;
#pragma unroll
          for (int q = 0; q < R; ++q) { ld8(r[q] + 512 + 8 * l, v[q]);
#pragma unroll
              for (int e = 0; e < 8; ++e) w[q][e] = v[q][e]; }
          head_norm_rope<R>(w, gk, l & 7, lat, trow, tcol, ropeA, lane);
#pragma unroll
          for (int q = 0; q < R; ++q) { if (lane < 16) *(GAS v4u*)(KG + (size_t)m[q] * 128 + 8 * lane) = pk8(w[q], 1.f);
              else if (lane < 32) *(GAS v4u*)(VG + (size_t)m[q] * 128 + 8 * (lane - 16)) = pk8(v[q], 1.f); } }
        { const bool on1 = lane < 48, on2 = lane < 32; float s1[R], s2[R];
#pragma unroll
          for (int q = 0; q < R; ++q) { ld8(r[q] + 768 + 8 * (on1 ? lane : 0), v[q]); ld8(r[q] + 1152 + 8 * (lane & 31), w[q]); s1[q] = 0.f; s2[q] = 0.f;
#pragma unroll
              for (int e = 0; e < 8; ++e) { s1[q] += on1 ? v[q][e] * v[q][e] : 0.f; s2[q] += on2 ? w[q][e] * w[q][e] : 0.f; } }
#pragma unroll
          for (int o = 1; o < 64; o <<= 1) {
#pragma unroll
              for (int q = 0; q < R; ++q) { s1[q] += shx(s1[q], o, lane); s2[q] += shx(s2[q], o, lane); } }
#pragma unroll
          for (int q = 0; q < R; ++q) { const float rs1 = __builtin_amdgcn_rsqf(s1[q] * (1.f / 384.f) + 1e-6f), rs2 = __builtin_amdgcn_rsqf(s2[q] * (1.f / 256.f) + 1e-6f);
#pragma unroll
              for (int e = 0; e < 8; ++e) { v[q][e] = v[q][e] * rs1 * gcq[e]; w[q][e] = w[q][e] * rs2 * gckv[e]; }
              if (on1) *(GAS v4u*)(CQN + (size_t)m[q] * 384 + 8 * lane) = pk8(v[q], 1.f);
              if (on2) *(GAS v4u*)(CKVN + (size_t)m[q] * 256 + 8 * lane) = pk8(w[q], 1.f); } }
        { const int l4 = lane & 3;
#pragma unroll
          for (int q = 0; q < R; ++q) ld8(r[q] + 1408 + 8 * l4, v[q]);
#pragma unroll
          for (int q = 0; q < R; ++q)
#pragma unroll
              for (int e = 0; e < 8; ++e) w[q][e] = shx(v[q][e], 1, lane);
#pragma unroll
          for (int q = 0; q < R; ++q) { if (lat[q]) { const int axis = l4 >> 1, pos = axis ? tcol[q] : trow[q]; const float* cs = ropeB + pos * 16; const bool second = (l4 & 1) != 0;
                  float cc[16];
#pragma unroll
                  for (int k = 0; k < 4; ++k) { const f32x4 c4 = *((const GAS f32x4*)cs + k); cc[4 * k] = c4.x; cc[4 * k + 1] = c4.y; cc[4 * k + 2] = c4.z; cc[4 * k + 3] = c4.w; }
#pragma unroll
                  for (int e = 0; e < 8; ++e) { const float c_ = cc[2 * e], s_ = cc[2 * e + 1]; v[q][e] = second ? (v[q][e] * c_ + w[q][e] * s_) : (v[q][e] * c_ - w[q][e] * s_); } }
              if (lane < 32) { const int head = lane >> 2; *(GAS v4u*)(KM + (size_t)m[q] * 768 + head * 96 + 64 + 8 * l4) = pk8(v[q], 1.f); } } }
    }
}
__device__ __forceinline__ void phase_even_attn(Frame& F) {
    const bf16 *QG = (const bf16*)(F.ws + WS_QG), *KG = (const bf16*)(F.ws + WS_KG), *VG = (const bf16*)(F.ws + WS_VG);
    const bf16 *QM = (const bf16*)(F.ws + WS_QM), *KM = (const bf16*)(F.ws + WS_KM), *VM = (const bf16*)(F.ws + WS_VM); bf16* OE = (bf16*)(F.ws + WS_OE);
    for (int u = F.vcu; u < 1024 + 32; u += F.G) {
        if (u < 1024) {
            const int qb = u & 31, hq = (u >> 5) & 3, kvh = (u >> 7) & 1, b = u >> 8, h = kvh * 4 + hq; const size_t r0 = (size_t)b * SEQ + qb * 256, kl = (size_t)b * SEQ, kc = (size_t)MLAT + b * CTXL;
            attn_unit_p<64>(F.lds, F.tid, QG + r0 * 512 + h * 64, 512, KG + kl * 128 + kvh * 64, VG + kl * 128 + kvh * 64, 128, KG + kc * 128 + kvh * 64, VG + kc * 128 + kvh * 64, 4, 128, 128,
                             OE + r0 * 1024 + h * 64, 1024);
        } else { const int id = u - 1024, h = id & 7, b = id >> 3, kvh = h >> 2; const size_t kc = (size_t)MLAT + b * CTXL;
            attn_unit_p<64>(F.lds, F.tid, QG + kc * 512 + h * 64, 512, nullptr, nullptr, 0, KG + kc * 128 + kvh * 64, VG + kc * 128 + kvh * 64, 4, 128, 128, OE + kc * 1024 + h * 64, 1024); }
    }
    for (int u = F.vcu; u < 1024 + 32; u += F.G) {
        if (u < 1024) {
            const int qb = u & 31, h = (u >> 5) & 7, b = u >> 8; const size_t r0 = (size_t)b * SEQ + qb * 256, kl = (size_t)b * SEQ, kc = (size_t)MLAT + b * CTXL;
            attn_unit_p<96>(F.lds, F.tid, QM + r0 * 768 + h * 96, 768, KM + kl * 768 + h * 96, VM + kl * 512 + h * 64, 128, KM + kc * 768 + h * 96, VM + kc * 512 + h * 64, 4, 768, 512,
                             OE + r0 * 1024 + 512 + h * 64, 1024);
        } else { const int id = u - 1024, h = id & 7, b = id >> 3; const size_t kc = (size_t)MLAT + b * CTXL;
            attn_unit_p<96>(F.lds, F.tid, QM + kc * 768 + h * 96, 768, nullptr, nullptr, 0, KM + kc * 768 + h * 96, VM + kc * 512 + h * 64, 4, 768, 512, OE + kc * 1024 + 512 + h * 64, 1024); }
    }
}
__device__ __forceinline__ void phase_odd_mix(Frame& F, const PArgs& A, const HgT& T, int j) {
    const bf16 *QN = (const bf16*)(F.ws + WS_QN), *KN = (const bf16*)(F.ws + WS_KN), *VN = (const bf16*)(F.ws + WS_VN); bf16* OO = (bf16*)(F.ws + WS_OO);
    const float* rpb = A.in[I_RPB] + (size_t)j * 8 * 15 * 31;
#ifndef NO_NA
#if defined(NA_TWICE)
    for (int rep = 0; rep < 2; ++rep)
#endif
    for (int u = F.vcu; u < 1024; u += F.G) {
        const int rg = u & 31, h = (u >> 5) & 7, b = u >> 8; const int rlo = min(max(4 * rg - 4, 0), 120), rhi = min(max(4 * rg + 3 - 4, 0), 120) + 8;
        const size_t r0 = (size_t)b * SEQ + (size_t)rg * 256, kl = (size_t)b * SEQ + (size_t)rlo * 64, kc = (size_t)MLAT + b * CTXL;
        attn_unit<64, 1>(F.lds, F.tid, QN + r0 * 512 + h * 64, 512, KN + kl * 512 + h * 64, VN + kl * 512 + h * 64, rhi - rlo, KN + kc * 512 + h * 64, VN + kc * 512 + h * 64, 4, 512, 512,
                         OO + r0 * 1024 + h * 64, 1024, 4 * rg, rlo, rpb + h * 465);
    }
#endif
    for (int u = F.vcu; u < (j == 1 ? 0 : 32); u += F.G) {
        const int h = u & 7, b = u >> 3; const size_t kc = (size_t)MLAT + b * CTXL;
        attn_unit<64, 0>(F.lds, F.tid, QN + kc * 512 + h * 64, 512, nullptr, nullptr, 0, KN + kc * 512 + h * 64, VN + kc * 512 + h * 64, 4, 512, 512, OO + kc * 1024 + h * 64, 1024, 0, 0, nullptr);
    }
#ifndef NO_HA
    for (int u = F.vcu; u < 2112; u += F.G) hg_a_unit(F, T, u / 66, u % 66);
#if defined(HA_TWICE)
    for (int u = F.vcu; u < 2112; u += F.G) hg_a_unit(F, T, u / 66, u % 66);
#endif
#endif
}
__device__ __forceinline__ void ctx_resid_gemm(Frame& F, const bf16* A  , const bf16* Bt  , int K, bf16* Z, const float* gate, const void* base, bool src16  ) {
    const int tid = F.tid, lane = F.lane, r32 = lane & 31, hi = lane >> 5, wid = F.wave;
    LAS float* part = (LAS float*)F.lds;
    for (int u = F.vcu; u < 256; u += F.G) {
        const int tm = u >> 4, tn = u & 15;
        const int ks = K / 8, k0 = wid * ks;
        const bf16* a0 = A + (size_t)(MLAT + 64 * tm + r32) * K + k0 + 8 * hi; const bf16* b0 = Bt + (size_t)(64 * tn + r32) * K + k0 + 8 * hi;
        f32x16 c00, c01, c10, c11;
#pragma unroll
        for (int r = 0; r < 16; ++r) { c00[r] = 0.f; c01[r] = 0.f; c10[r] = 0.f; c11[r] = 0.f; }
#pragma unroll 2
        for (int k = 0; k < ks; k += 16) {
            const bf16x8 fa0 = *(const GAS bf16x8*)(a0 + k), fa1 = *(const GAS bf16x8*)(a0 + (size_t)32 * K + k), fb0 = *(const GAS bf16x8*)(b0 + k), fb1 = *(const GAS bf16x8*)(b0 + (size_t)32 * K + k);
            c00 = __builtin_amdgcn_mfma_f32_32x32x16_bf16(fa0, fb0, c00, 0, 0, 0); c01 = __builtin_amdgcn_mfma_f32_32x32x16_bf16(fa0, fb1, c01, 0, 0, 0);
            c10 = __builtin_amdgcn_mfma_f32_32x32x16_bf16(fa1, fb0, c10, 0, 0, 0); c11 = __builtin_amdgcn_mfma_f32_32x32x16_bf16(fa1, fb1, c11, 0, 0, 0);
        }
        LAS float* pw = part + wid * (64 * 65);
#pragma unroll
        for (int r = 0; r < 16; ++r) { const int i = crow(r, hi); pw[i * 65 + r32] = c00[r]; pw[i * 65 + 32 + r32] = c01[r]; pw[(32 + i) * 65 + r32] = c10[r]; pw[(32 + i) * 65 + 32 + r32] = c11[r]; }
        __syncthreads();
        for (int e = tid; e < 64 * 64; e += NTHR) { const int i = e >> 6, jc = e & 63; float s = 0.f;
#pragma unroll
            for (int w = 0; w < 8; ++w) s += part[w * (64 * 65) + i * 65 + jc];
            const size_t xo = (size_t)(MLAT + 64 * tm + i) * 1024 + 64 * tn + jc; const int col = 64 * tn + jc;
            const size_t bo = (size_t)(64 * tm + i) * 1024 + col;
            const float xb = src16 ? (float)__builtin_bit_cast(_Float16, ((const bf16*)base)[bo]) : ((const float*)base)[bo];
            Z[xo] = (bf16)(pkh(ALPHA * xb + gate[4 * 6144 + col] * s, 0.f) & 0xffffu); }
        __syncthreads();
    }
}
__device__ __forceinline__ void moe_offsets(const gu32* cnt, int (&off)[9]) {
    int a = 0;
#pragma unroll
    for (int e = 0; e < 8; ++e) { off[e] = a; const int c = __builtin_amdgcn_readfirstlane((int)__hip_atomic_load(cnt + e, __ATOMIC_RELAXED, __HIP_MEMORY_SCOPE_AGENT)); a += (c + 255) & ~255; }
    off[8] = a;
}
__device__ __forceinline__ void phase_moe_dispatch(Frame& F, int j, int nrows) {
    int* topk = (int*)(F.ws + WS_TOPK); const bf16* H = (const bf16*)(F.ws + WS_H); unsigned char* XG8 = F.ws + WS_XG8;
    LAS unsigned* lc = (LAS unsigned*)F.lds;
    LAS int* lrow = (LAS int*)(F.lds + 256);
    int off[9]; moe_offsets(F.ctl + CW_CNT + 64 * j, off);
    const int per = nrows / 256;
    for (int c0 = F.vcu * per; c0 < nrows; c0 += F.G * per) {
        if (F.tid < 8) lc[F.tid] = 0u;
        __syncthreads();
        int e1 = 0, e2 = 0, li1 = 0, li2 = 0; const bool on = F.tid < per;
        if (on) { e1 = topk[(c0 + F.tid) * 6]; e2 = topk[(c0 + F.tid) * 6 + 1]; li1 = (int)atomicAdd((unsigned*)&lc[e1], 1u); li2 = (int)atomicAdd((unsigned*)&lc[e2], 1u); }
        __syncthreads();
        if (F.tid < 8) lc[8 + F.tid] = __hip_atomic_fetch_add((unsigned*)(F.ctl + CW_CNT2 + 64 * j) + F.tid, lc[F.tid], __ATOMIC_RELAXED, __HIP_MEMORY_SCOPE_AGENT);
        __syncthreads();
        if (on) {
            int o1 = 0, o2 = 0;
#pragma unroll
            for (int e = 0; e < 8; ++e) { o1 = (e == e1) ? off[e] : o1; o2 = (e == e2) ? off[e] : o2; }
            const int r1 = o1 + (int)lc[8 + e1] + li1, r2 = o2 + (int)lc[8 + e2] + li2;
            topk[(c0 + F.tid) * 6 + 4] = r1; topk[(c0 + F.tid) * 6 + 5] = r2; lrow[2 * F.tid] = r1; lrow[2 * F.tid + 1] = r2;
        }
        __syncthreads();
        for (int p = F.wave; p < 2 * per; p += NWAVES) { const int tok = c0 + (p >> 1), dst = lrow[p];
            const GAS v4u* s = (const GAS v4u*)(H + (size_t)tok * 1024) + 2 * F.lane; const v4u a = s[0], b2 = s[1];
            unsigned w0 = 0u, w1 = 0u, w2 = 0u, w3 = 0u;
            w0 = __builtin_amdgcn_cvt_pk_fp8_f32(bf_lo(a.x), bf_hi(a.x), w0, false); w0 = __builtin_amdgcn_cvt_pk_fp8_f32(bf_lo(a.y), bf_hi(a.y), w0, true);
            w1 = __builtin_amdgcn_cvt_pk_fp8_f32(bf_lo(a.z), bf_hi(a.z), w1, false); w1 = __builtin_amdgcn_cvt_pk_fp8_f32(bf_lo(a.w), bf_hi(a.w), w1, true);
            w2 = __builtin_amdgcn_cvt_pk_fp8_f32(bf_lo(b2.x), bf_hi(b2.x), w2, false); w2 = __builtin_amdgcn_cvt_pk_fp8_f32(bf_lo(b2.y), bf_hi(b2.y), w2, true);
            w3 = __builtin_amdgcn_cvt_pk_fp8_f32(bf_lo(b2.z), bf_hi(b2.z), w3, false); w3 = __builtin_amdgcn_cvt_pk_fp8_f32(bf_lo(b2.w), bf_hi(b2.w), w3, true);
            *((GAS v4u*)((unsigned char*)XG8 + (size_t)dst * 1024) + F.lane) = (v4u){w0, w1, w2, w3}; }
        __syncthreads();
    }
}
#if defined(SELFCHK)
constexpr int CW_CHK = 12288;
__device__ __forceinline__ int chk_row(int s) {
    if (s >= 48) return MLAT + ((s - 48) * 61) % MCTX;
    const int b = s & 3; int t = (s * 683 + 17 * (s >> 2) * 97) & (SEQ - 1);
    if (s < 4) t = 0; else if (s < 8) t = SEQ - 1; else if (s < 12) t = 63; else if (s < 16) t = 64;
    return b * SEQ + t;
}
__device__ __forceinline__ void chk_accum(Frame& F, float num, float den) {
    LAS float* red = (LAS float*)(F.lds + 150000);
    __syncthreads();
    num = wave_sum(num, F.lane); den = wave_sum(den, F.lane);
    if (F.lane == 0) { red[F.wave * 2] = num; red[F.wave * 2 + 1] = den; }
    __syncthreads();
    if (F.tid == 0) { float a = 0.f, b = 0.f; for (int w = 0; w < 8; ++w) { a += red[2 * w]; b += red[2 * w + 1]; }
        atomicAdd((float*)(F.ctl + CW_CHK), a); atomicAdd((float*)(F.ctl + CW_CHK) + 1, b); }
    __syncthreads();
}
__device__ __forceinline__ float chk_rope(const LAS float* x, int d, int rot_dim, int t) {
    const int axis_dim = rot_dim / 2, half = axis_dim / 2, axis = d / axis_dim, i = d % axis_dim;
    const float pos = (float)(axis == 0 ? t / GRIDW : t % GRIDW);
    const float inv = powf(10000.f, -(float)(2 * (i % half)) / (float)axis_dim);
    const float ang = pos * inv; float sn, cs; sincos_red(ang, sn, cs);
    const float rot = (i < half) ? -x[axis * axis_dim + i + half] : x[axis * axis_dim + i - half];
    return x[d] * cs + rot * sn;
}
__device__ __forceinline__ void phase_selfcheck_even(Frame& F, const PArgs& A, int j) {
    const bf16* H = (const bf16*)(F.ws + WS_H);
    const bf16 *QG = (const bf16*)(F.ws + WS_QG), *KG = (const bf16*)(F.ws + WS_KG), *VG = (const bf16*)(F.ws + WS_VG), *CQN = (const bf16*)(F.ws + WS_CQN), *CKVN = (const bf16*)(F.ws + WS_CKVN);
    const bf16 *QM = (const bf16*)(F.ws + WS_QM), *KM = (const bf16*)(F.ws + WS_KM), *VM = (const bf16*)(F.ws + WS_VM), *OE = (const bf16*)(F.ws + WS_OE);
    LAS float* raw = (LAS float*)F.lds;
    LAS float* xn = (LAS float*)(F.lds + 8192);
    LAS float* sc = (LAS float*)(F.lds + 16384);
    LAS float* red = (LAS float*)(F.lds + 65536);
    const int tid = F.tid;
#if SELFCHK >= 5
#elif SELFCHK == 1 || SELFCHK == 2
    for (int s = F.vcu; s < 64; s += F.G) {
        const int row = chk_row(s); const bool lat = row < MLAT; const int t = row & (SEQ - 1);
        float num = 0.f, den = 0.f;
#if SELFCHK == 1
        const float* W = A.in[I_EVWIN] + (size_t)j * 1024 * EV_IN;
        for (int c = tid; c < EV_IN; c += NTHR) { float a = 0.f; for (int k = 0; k < 1024; ++k) a += bf2f(H[(size_t)row * 1024 + k]) * W[(size_t)k * EV_IN + c]; raw[c] = a; }
        __syncthreads();
        for (int c = tid; c < 640; c += NTHR) { const int hb = (c / 64) * 64, d = c % 64; float ss = 0.f; for (int k = 0; k < 64; ++k) ss += raw[hb + k] * raw[hb + k];
            const float g = (c < 512) ? A.in[I_QNG][j * 64 + d] : A.in[I_KNG][j * 64 + d]; xn[c] = raw[c] * (1.f / sqrtf(ss / 64.f + 1e-6f)) * g; }
        __syncthreads();
        for (int c = tid; c < 640; c += NTHR) { const int hb = (c / 64) * 64, d = c % 64; const float ref = lat ? chk_rope(xn + hb, d, 64, t) : xn[c];
            const float got = (c < 512) ? bf2f(QG[(size_t)row * 512 + c]) / C2_64 : bf2f(KG[(size_t)row * 128 + (c - 512)]); num += (got - ref) * (got - ref); den += ref * ref; }
        for (int c = tid; c < 128; c += NTHR) { const float ref = raw[640 + c], got = bf2f(VG[(size_t)row * 128 + c]); num += (got - ref) * (got - ref); den += ref * ref; }
        { float ss = 0.f; for (int k = 0; k < 384; ++k) ss += raw[768 + k] * raw[768 + k]; const float rs = 1.f / sqrtf(ss / 384.f + 1e-6f);
          for (int c = tid; c < 384; c += NTHR) { const float ref = raw[768 + c] * rs * A.in[I_CQG][j * 384 + c], got = bf2f(CQN[(size_t)row * 384 + c]); num += (got - ref) * (got - ref); den += ref * ref; } }
        { float ss = 0.f; for (int k = 0; k < 256; ++k) ss += raw[1152 + k] * raw[1152 + k]; const float rs = 1.f / sqrtf(ss / 256.f + 1e-6f);
          for (int c = tid; c < 256; c += NTHR) { const float ref = raw[1152 + c] * rs * A.in[I_CKVG][j * 256 + c], got = bf2f(CKVN[(size_t)row * 256 + c]); num += (got - ref) * (got - ref); den += ref * ref; } }
        for (int c = tid; c < 256; c += NTHR) { const int head = c / 32, d = c % 32; const float ref = lat ? chk_rope(raw + 1408, d, 32, t) : raw[1408 + d];
            const float got = bf2f(KM[(size_t)row * 768 + head * 96 + 64 + d]); num += (got - ref) * (got - ref); den += ref * ref; }
#else
        const float* Wq = A.in[I_WUQ] + (size_t)j * 384 * 768; const float* Wkv = A.in[I_WUKV] + (size_t)j * 256 * 1024;
        for (int c = tid; c < 768; c += NTHR) { float a = 0.f; for (int k = 0; k < 384; ++k) a += bf2f(CQN[(size_t)row * 384 + k]) * Wq[(size_t)k * 768 + c]; raw[c] = a; }
        __syncthreads();
        for (int c = tid; c < 768; c += NTHR) { const int head = c / 96, d = c % 96; const float ref = (d >= 64 && lat) ? chk_rope(raw + head * 96 + 64, d - 64, 32, t) : raw[c];
            const float got = bf2f(QM[(size_t)row * 768 + c]) / C2_96; num += (got - ref) * (got - ref); den += ref * ref; }
        for (int c = tid; c < 1024; c += NTHR) { float a = 0.f; for (int k = 0; k < 256; ++k) a += bf2f(CKVN[(size_t)row * 256 + k]) * Wkv[(size_t)k * 1024 + c];
            const int head = c / 128, d = c % 128; const float got = (d < 64) ? bf2f(KM[(size_t)row * 768 + head * 96 + d]) : bf2f(VM[(size_t)row * 512 + head * 64 + (d - 64)]); num += (got - a) * (got - a); den += a * a; }
#endif
        chk_accum(F, num, den);
    }
#elif SELFCHK == 3 || SELFCHK == 4
    for (int u = F.vcu; u < 64 * 8; u += F.G) {
        const int s = u >> 3, h = u & 7; const int row = chk_row(s); const bool lat = row < MLAT; const int b = lat ? row / SEQ : (row - MLAT) / CTXL;
        const int nk = lat ? SEQ + CTXL : CTXL;
#if SELFCHK == 3
        constexpr int DKK = 64; const bf16* qp = QG + (size_t)row * 512 + h * 64; const int kvh = h / 4;
#define CHK_K(key) (KG + (size_t)(key) * 128 + kvh * 64)
#define CHK_V(key) (VG + (size_t)(key) * 128 + kvh * 64)
        const bf16* op = OE + (size_t)row * 1024 + h * 64;
#else
        constexpr int DKK = 96; const bf16* qp = QM + (size_t)row * 768 + h * 96;
#define CHK_K(key) (KM + (size_t)(key) * 768 + h * 96)
#define CHK_V(key) (VM + (size_t)(key) * 512 + h * 64)
        const bf16* op = OE + (size_t)row * 1024 + 512 + h * 64;
#endif
        float mx = -INFINITY;
        for (int kk = tid; kk < nk; kk += NTHR) { const int key = lat ? (kk < SEQ ? b * SEQ + kk : MLAT + b * CTXL + (kk - SEQ)) : MLAT + b * CTXL + kk;
            float a = 0.f; for (int d = 0; d < DKK; ++d) a += bf2f(qp[d]) * bf2f(CHK_K(key)[d]); sc[kk] = a; mx = fmaxf(mx, a); }
#pragma unroll
        for (int o = 1; o < 64; o <<= 1) mx = fmaxf(mx, shx(mx, o, F.lane));
        if (F.lane == 0) red[F.wave] = mx;
        __syncthreads();
        mx = red[0]; for (int w = 1; w < 8; ++w) mx = fmaxf(mx, red[w]);
        float ls = 0.f;
        for (int kk = tid; kk < nk; kk += NTHR) { const float p = exp2f(sc[kk] - mx); sc[kk] = p; ls += p; }
        ls = wave_sum(ls, F.lane);
        __syncthreads();
        if (F.lane == 0) red[8 + F.wave] = ls;
        __syncthreads();
        ls = 0.f; for (int w = 0; w < 8; ++w) ls += red[8 + w];
        { const int d = tid & 63, part = tid >> 6; float a = 0.f;
          for (int kk = part; kk < nk; kk += 8) { const int key = lat ? (kk < SEQ ? b * SEQ + kk : MLAT + b * CTXL + (kk - SEQ)) : MLAT + b * CTXL + kk; a += sc[kk] * bf2f(CHK_V(key)[d]); }
          red[64 + part * 64 + d] = a; }
        __syncthreads();
        float num = 0.f, den = 0.f;
        if (tid < 64) { float a = 0.f; for (int p = 0; p < 8; ++p) a += red[64 + p * 64 + tid]; const float ref = a / ls, got = bf2f(op[tid]); num = (got - ref) * (got - ref); den = ref * ref; }
        chk_accum(F, num, den);
#undef CHK_K
#undef CHK_V
    }
#endif
}
#endif

#if defined(SELFCHK) && (SELFCHK == 5 || SELFCHK == 6 || SELFCHK == 7)
__device__ __forceinline__ void phase_selfcheck_na(Frame& F, const PArgs& A, int j) {
    const bf16 *QN = (const bf16*)(F.ws + WS_QN), *KN = (const bf16*)(F.ws + WS_KN), *VN = (const bf16*)(F.ws + WS_VN), *OO = (const bf16*)(F.ws + WS_OO);
    LAS float* sc = (LAS float*)(F.lds + 16384); LAS float* red = (LAS float*)(F.lds + 65536); LAS int* kid = (LAS int*)(F.lds + 32768);
    const int tid = F.tid;
    for (int u = F.vcu; u < 64 * 8; u += F.G) {
        const int s = u >> 3, h = u & 7; const int row = chk_row(s); const bool lat = row < MLAT; const int b = lat ? row / SEQ : (row - MLAT) / CTXL;
        if (!lat && j == 1) continue;
        const bf16* qp = QN + (size_t)row * 512 + h * 64; const float* rpb = A.in[I_RPB] + ((size_t)j * 8 + h) * 15 * 31;
        int nk = CTXL;
        if (lat) { nk = 128 + CTXL; const int t = row % SEQ, r = t / GRIDW, cc = t % GRIDW;
            const int rs = min(max(r - 4, 0), 128 - 8), cs = min(max(cc - 8, 0), GRIDW - 16);
            for (int w = tid; w < 128; w += NTHR) { const int i = w / 16, jj = w % 16; const int kr = rs + i, kc = cs + jj; kid[w] = b * SEQ + kr * GRIDW + kc;
                sc[1024 + w] = rpb[(kr - r + 7) * 31 + (kc - cc + 15)] * LOG2E; }
            for (int w = tid; w < CTXL; w += NTHR) { kid[128 + w] = MLAT + b * CTXL + w; sc[1024 + 128 + w] = 0.f; }
        } else { for (int w = tid; w < CTXL; w += NTHR) { kid[w] = MLAT + b * CTXL + w; sc[1024 + w] = 0.f; } }
        __syncthreads();
        float mx = -INFINITY;
        for (int kk = tid; kk < nk; kk += NTHR) { const bf16* kp = KN + (size_t)kid[kk] * 512 + h * 64; float a = 0.f; for (int d = 0; d < 64; ++d) a += bf2f(qp[d]) * bf2f(kp[d]); a += sc[1024 + kk]; sc[kk] = a; mx = fmaxf(mx, a); }
#pragma unroll
        for (int o = 1; o < 64; o <<= 1) mx = fmaxf(mx, shx(mx, o, F.lane));
        if (F.lane == 0) red[F.wave] = mx;
        __syncthreads();
        mx = red[0]; for (int w = 1; w < 8; ++w) mx = fmaxf(mx, red[w]);
        float ls = 0.f;
        for (int kk = tid; kk < nk; kk += NTHR) { const float p = exp2f(sc[kk] - mx); sc[kk] = p; ls += p; }
        ls = wave_sum(ls, F.lane);
        __syncthreads();
        if (F.lane == 0) red[8 + F.wave] = ls;
        __syncthreads();
        ls = 0.f; for (int w = 0; w < 8; ++w) ls += red[8 + w];
        { const int d = tid & 63, part = tid >> 6; float a = 0.f;
          for (int kk = part; kk < nk; kk += 8) a += sc[kk] * bf2f(VN[(size_t)kid[kk] * 512 + h * 64 + d]);
          red[64 + part * 64 + d] = a; }
        __syncthreads();
        float num = 0.f, den = 0.f;
        if (tid < 64) { float a = 0.f; for (int p = 0; p < 8; ++p) a += red[64 + p * 64 + tid]; const float ref = a / ls, got = bf2f(OO[(size_t)row * 1024 + h * 64 + tid]); num = (got - ref) * (got - ref); den = ref * ref; }
        chk_accum(F, num, den);
    }
}
constexpr size_t WS_CHKO = WS_END;
__device__ __forceinline__ int chk_seq_row(int b, int dir, int sq) { if (sq < CTXL) return MLAT + b * CTXL + (dir ? CTXL - 1 - sq : sq); const int jq = sq - CTXL; return b * SEQ + (dir ? SEQ - 1 - jq : jq); }
__device__ __forceinline__ void phase_selfcheck_hg_scan(Frame& F, const PArgs& A, int j) {
    if (F.vcu >= 4) return;
    const int c = F.vcu, dir = c & 1, pair = c >> 1; const int b = pair ? 3 : 1, h = pair ? 0 : 2, hoff = h * 128;
    const bf16 *Qd = (const bf16*)(F.ws + WS_QD), *Vd = (const bf16*)(F.ws + WS_VD); const float* Z = (const float*)(F.ws + (dir ? WS_ZB : WS_ZF));
    float* OF = (float*)(F.ws + WS_CHKO) + (size_t)c * 8448 * 128;
    LAS float* vec = (LAS float*)F.lds;
    LAS float* part = (LAS float*)(F.lds + 4096);
    const int tid = F.tid, f = tid & 127, eq = tid >> 7;
    float S[32];
#pragma unroll
    for (int i = 0; i < 32; ++i) S[i] = 0.f;
    for (int sq = 0; sq < CTXL + SEQ; ++sq) {
        const int row = chk_seq_row(b, dir, sq);
        if (tid < 128) { const int ch = hoff + tid; const float l0 = A.in[I_LBL][(dir * 2 + 0) * 512 + ch], l1 = A.in[I_LBL][(dir * 2 + 1) * 512 + ch];
            const float m = fmaxf(l0, l1), p0 = expf(l0 - m) / (expf(l0 - m) + expf(l1 - m)), p1 = expf(l1 - m) / (expf(l0 - m) + expf(l1 - m)); const float lb = (j == 0) ? 0.f : (p0 + p1) - p0;
            const float z = Z[(size_t)row * 512 + ch]; const float sg = 1.f / (1.f + expf(-z));
            vec[tid] = bf2f(Qd[(size_t)row * 512 + ch]); vec[128 + tid] = (1.f - lb) * (1.f / (1.f + expf(z))); vec[256 + tid] = bf2f(Vd[(size_t)row * 512 + ch]); vec[384 + tid] = lb + (1.f - lb) * sg; }
        __syncthreads();
        float o = 0.f; const float vf = vec[256 + f];
#pragma unroll
        for (int i = 0; i < 32; ++i) { const int e = eq * 32 + i; S[i] = vec[384 + e] * S[i] + vec[128 + e] * vf; o += S[i] * vec[e]; }
        part[eq * 128 + f] = o;
        __syncthreads();
        if (tid < 128) OF[(size_t)sq * 128 + tid] = part[tid] + part[128 + tid] + part[256 + tid] + part[384 + tid];
    }
}
__device__ __forceinline__ void phase_selfcheck_hg_cmp(Frame& F, const PArgs& A, int j) {
    const bf16 *Sg = (const bf16*)(F.ws + WS_SG), *OO = (const bf16*)(F.ws + WS_OO); const float* OF = (const float*)(F.ws + WS_CHKO);
    const int gw = F.vcu * NWAVES + F.wave, NGW = F.G * NWAVES;
    float num = 0.f, den = 0.f;
    for (int it = gw; it < 2 * 8448; it += NGW) { const int pair = it / 8448, sq = it % 8448; const int b = pair ? 3 : 1, h = pair ? 0 : 2, hoff = h * 128;
        const int row = chk_seq_row(b, 0, sq);
        const int sqb = (sq < CTXL) ? (CTXL - 1 - sq) : (CTXL + (SEQ - 1 - (sq - CTXL)));
        const float* of = OF + ((size_t)(pair * 2 + 0) * 8448 + sq) * 128; const float* ob = OF + ((size_t)(pair * 2 + 1) * 8448 + sqb) * 128;
        const float* D0 = (const float*)(F.ws + 1002 * MiB) + ((size_t)(0 * 2 + pair) * 8448 + sq) * 128; const float* D1 = (const float*)(F.ws + 1002 * MiB) + ((size_t)(1 * 2 + pair) * 8448 + sq) * 128;
#ifndef CHKSEL
#define CHKSEL 0
#endif
        (void)row; (void)Sg; (void)OO;
#pragma unroll
        for (int q2 = 0; q2 < 2; ++q2) { const int ff = F.lane + 64 * q2;
            const float ref = (CHKSEL != 1) ? of[ff] : ob[ff]; const float got = (CHKSEL != 1) ? D0[ff] : (D1[ff] - D0[ff]);
            const bool use = (CHKSEL == 10) ? (sq < 64) : (CHKSEL == 11) ? (sq >= 64 && sq < 128) : (CHKSEL == 12) ? (sq >= 128 && sq < 256) : (CHKSEL == 13) ? (sq >= 256 && ((sq & 127) < 64)) : (CHKSEL == 14) ? (sq >= 256 && ((sq & 127) >= 64)) : true;
            if (use && (j == 0 || sq >= CTXL)) { num += (got - ref) * (got - ref); den += ref * ref; } } }
    chk_accum(F, num, den);
}
#endif
constexpr int PH_CV = 0, PH_MOD = 1, PH_E1 = 2, PH_E2 = 3, PH_E3 = 4, PH_E5 = 5, PH_E6 = 6, PH_E7 = 7, PH_E8 = 8, PH_E9 = 9, PH_E10 = 10,
              PH_O1 = 11, PH_O2 = 12, PH_O3 = 13, PH_O4 = 14, PH_O5 = 15, PH_O6 = 16, PH_O7 = 17, PH_O8 = 18, PH_O9 = 19, PH_O10 = 20, PH_PER = 21;
constexpr int NPHASES = 2 * PH_PER;

__global__ void __launch_bounds__(NTHR, 2) mk_fwd(Args args) {
    extern __shared__ __attribute__((aligned(16))) unsigned char lds[];
    Frame F;
    F.lds = (LAS unsigned char*)lds; F.ws = args.ws; F.ctl = (gu32*)(args.ws + WS_CTL);
    F.tid = threadIdx.x; F.lane = F.tid & 63; F.wave = __builtin_amdgcn_readfirstlane(F.tid >> 6);
    F.G = gridDim.x; { const int bx = blockIdx.x; F.vcu = (F.G % 8 == 0) ? (bx % 8) * (F.G / 8) + bx / 8 : bx; }
    volatile LAS unsigned* MISC = (volatile LAS unsigned*)(F.lds + MISC_OFF);
    if (F.tid < 64) MISC[F.tid] = 0u;
    { LAS unsigned long long* tab = (LAS unsigned long long*)(F.lds + MISC_OFF + 256);
      if (F.tid == 0) {
#pragma unroll
          for (int i = 0; i < 30; ++i) tab[i] = (unsigned long long)args.in[i];
          tab[30] = (unsigned long long)args.out; } }
    __syncthreads();
    const int lo = args.ph_lo, hi = args.ph_hi; const int wv0 = F.wave;
    const bool multi = (hi - lo) > 1;
    XcdBarrier bar; bar.bar = (unsigned*)(F.ctl + CW_BAR); bar.x = 0; bar.st = nullptr;
    if (multi) bar = xcd_barrier_post((unsigned*)(F.ctl + CW_BAR), MISC + 8);
#ifndef PHMASK
#define PHMASK 0x1fffff
#endif
#define IN(k) ((((PHMASK) >> ((k) % PH_PER)) & 1) && lo <= (k) && (k) < hi)
#if defined(PROBE_PH)
    if (PROBE_PH == 0 && blockIdx.x == 0 && threadIdx.x == 0) MISC[16] = (unsigned)__builtin_amdgcn_s_memrealtime();
#endif
#define MKT HgT T; T.Qd = (const bf16*)(ws + WS_QD); T.Vd = (const bf16*)(ws + WS_VD); T.Sg = (const bf16*)(ws + WS_SG); T.Zf = (const float*)(ws + WS_ZF); T.Zb = (const float*)(ws + WS_ZB); \
    T.lb = (const float*)(ws + WS_SMALL + SM_LB) + j * 1024; T.HST = (float*)(ws + WS_HST); T.HDM = (float*)(ws + WS_HDM); T.ong = PA.in[I_ONG] + j * 128; T.OO = (bf16*)(ws + WS_OO);
#define FRESH() int t_; asm volatile("v_mbcnt_lo_u32_b32 %0, -1, 0\n\tv_mbcnt_hi_u32_b32 %0, -1, %0" : "=v"(t_)); t_ += wv0 * 64; F.tid = t_; F.lane = t_ & 63; F.wave = __builtin_amdgcn_readfirstlane(t_ >> 6); \
    unsigned char* ws = ws0; asm volatile("" : "+s"(ws)); F.ws = ws; F.ctl = (gu32*)(ws + WS_CTL); PArgs PA; PA.in.t = (LAS unsigned long long*)(F.lds + MISC_OFF + 256); PA.out = (float*)PA.in[30]; \
    float* mods = (float*)(ws + WS_SMALL + SM_MODS); bf16* W = (bf16*)(ws + WS_W); bf16* WM = (bf16*)(ws + WS_WMOE); bf16* H = (bf16*)(ws + WS_H); bf16* X = (bf16*)(ws + WS_X); \
    const float* modE = mods + (size_t)Le * 5 * 6144; const float* modO = mods + (size_t)Lo * 5 * 6144; (void)W; (void)WM; (void)H; (void)X; (void)modE; (void)modO;
#if defined(PROBE_PH)
#define IS_T0() ({ int l_; asm volatile("v_mbcnt_lo_u32_b32 %0, -1, 0\n\tv_mbcnt_hi_u32_b32 %0, -1, %0" : "=v"(l_)); (wv0 == 0 && l_ == 0); })
#if defined(PROBE_CLK)
#define PROBE_NOW() ((unsigned)__builtin_amdgcn_s_memtime())
#else
#define PROBE_NOW() ((unsigned)__builtin_amdgcn_s_memrealtime())
#endif
#define PROBE_T0(k) do { if ((k) == PROBE_PH && blockIdx.x == 0 && IS_T0()) { MISC[16] = PROBE_NOW(); } } while (0)
#define PROBE_T1(k) do { if ((k) == PROBE_PH && blockIdx.x == 0 && IS_T0()) { MISC[18] = PROBE_NOW() - MISC[16]; } } while (0)
#else
#define PROBE_T0(k) do {} while (0)
#define PROBE_T1(k) do {} while (0)
#endif
#if defined(PROBE_WALL)
#define SEAM(k) do { if (IN(k) && IN((k) + 1)) xcd_barrier(bar); PROBE_T1(k); PROBE_T0((k) + 1); } while (0)
#else
#define SEAM(k) do { PROBE_T1(k); if (IN(k) && IN((k) + 1)) xcd_barrier(bar); PROBE_T0((k) + 1); } while (0)
#endif
    unsigned char* const ws0 = args.ws;
#pragma unroll 1
    for (int j = 0; j < 2; ++j) {
        const int pb = j * PH_PER, Le = 2 * j, Lo = 2 * j + 1;
        if (j == 0) { if (IN(pb + PH_CV)) { FRESH(); phase_cv(F, PA, 0); } SEAM(pb + PH_CV);
                      if (IN(pb + PH_MOD)) { FRESH(); phase_mod(F, PA); } SEAM(pb + PH_MOD); }
        if (IN(pb + PH_E1)) { FRESH();
            pg8::Gemm g{H, W + W_EVIN + (size_t)j * EV_INP * 1024, MROWS, EV_INP, 1024}; pg8::StaticOrder S; S.init(MROWS, EV_INP, F.G, (int)blockIdx.x);
            pg8::EpiPlainBf16 E{(pg8::bf16_t*)(ws + WS_RAW), EV_INP};
            pg8::gemm_phase<pg8::EpiPlainBf16, pg8::StaticOrder, true, true>(F.lds, g, S, E, F.tid);
        } SEAM(pb + PH_E1);
        if (IN(pb + PH_E2)) { FRESH(); phase_even_post(F, PA, j); } SEAM(pb + PH_E2);
        if (IN(pb + PH_E3)) { FRESH();
            { pg8::Gemm g{(const bf16*)(ws + WS_CQN), W + W_UQ + (size_t)j * 768 * 384, MROWS, 768, 384}; pg8::StaticOrder S; S.init(MROWS, 768, F.G, (int)blockIdx.x);
              pg8::EpiMlaQ E{(bf16*)(ws + WS_QM), (const float*)(ws + WS_SMALL + SM_ROPEB)};
              pg8::gemm_phase<pg8::EpiMlaQ, pg8::StaticOrder, true, true>(F.lds, g, S, E, F.tid); }
            { asm volatile("v_mbcnt_lo_u32_b32 %0, -1, 0\n\tv_mbcnt_hi_u32_b32 %0, -1, %0" : "=v"(t_)); t_ += wv0 * 64; F.tid = t_; F.lane = t_ & 63;
              pg8::Gemm g{(const bf16*)(ws + WS_CKVN), W + W_UKV + (size_t)j * 1024 * 256, MROWS, 1024, 256}; pg8::StaticOrder S; S.init(MROWS, 1024, F.G, (int)blockIdx.x);
              pg8::EpiMlaKV E{(bf16*)(ws + WS_KM), (bf16*)(ws + WS_VM)};
              pg8::gemm_phase<pg8::EpiMlaKV, pg8::StaticOrder, true, true>(F.lds, g, S, E, F.tid); }
        } SEAM(pb + PH_E3);
        if (IN(pb + PH_E5)) { FRESH(); phase_even_attn(F); } SEAM(pb + PH_E5);
#if defined(SELFCHK)
        if (IN(pb + PH_E6)) { FRESH(); phase_selfcheck_even(F, PA, j); }
#endif
        if (IN(pb + PH_E6)) { FRESH();
            { pg8::Gemm g{(const bf16*)(ws + WS_OE), W + W_EVOUT + (size_t)j * 1024 * 1024, MLAT, 1024, 1024}; pg8::StaticOrder S; S.init(MLAT, 1024, F.G, (int)blockIdx.x);
              pg8::EpiResid E{(pg8::bf16_t*)(ws + WS_ZR), modE + 2 * 1024, j == 0 ? (const void*)PA.in[I_X] : (const void*)X, j == 0 ? (const void*)PA.in[I_CTX] : (const void*)(X + (size_t)MLAT * 1024), j != 0};
              pg8::gemm_phase<pg8::EpiResid, pg8::StaticOrder, true, true>(F.lds, g, S, E, F.tid); }
            ctx_resid_gemm(F, (const bf16*)(ws + WS_OE), W + W_EVOUT + (size_t)j * 1024 * 1024, 1024, (bf16*)(ws + WS_ZR), modE + 2 * 1024, j == 0 ? (const void*)PA.in[I_CTX] : (const void*)(X + (size_t)MLAT * 1024), j != 0);
        } SEAM(pb + PH_E6);
        if (IN(pb + PH_E7)) { FRESH(); phase_ln<false, false, FFN_F8>(F, PA, PA.in[I_LN1G] + Le * 1024, PA.in[I_LN1B] + Le * 1024, modE + 3 * 1024, nullptr, nullptr, 0, false); } SEAM(pb + PH_E7);
        if (IN(pb + PH_E8)) { FRESH();
            if constexpr (FFN_F8) {
                pg8::Gemm g{H, (const bf16*)((unsigned char*)(W + W_FFGU) + (size_t)j * 2 * DFF * 1024), MROWS, 2 * DFF, 1024 / 2}; pg8::StaticOrder S; S.init(MROWS, 2 * DFF, F.G, (int)blockIdx.x);
                pg8::EpiSwigluS E{(bf16*)(ws + WS_FFH), DFF, 1.f / MOE_WSCALE};
                pg8::gemm_phase<pg8::EpiSwigluS, pg8::StaticOrder, true, true, true>(F.lds, g, S, E, F.tid);
            } else {
                pg8::Gemm g{H, W + W_FFGU + (size_t)j * 2 * DFF * 1024, MROWS, 2 * DFF, 1024}; pg8::StaticOrder S; S.init(MROWS, 2 * DFF, F.G, (int)blockIdx.x);
                pg8::EpiSwiglu E{(bf16*)(ws + WS_FFH), DFF};
                pg8::gemm_phase<pg8::EpiSwiglu, pg8::StaticOrder, true, true>(F.lds, g, S, E, F.tid);
            }
        } SEAM(pb + PH_E8);
        if (IN(pb + PH_E9)) { FRESH();
            { pg8::Gemm g{(const bf16*)(ws + WS_FFH), W + W_FFD + (size_t)j * 1024 * DFF, MLAT, 1024, DFF}; pg8::StaticOrder S; S.init(MLAT, 1024, F.G, (int)blockIdx.x);
              pg8::EpiResid E{(pg8::bf16_t*)(ws + WS_ZR), modE + 5 * 1024, X, X + (size_t)MLAT * 1024, true};
              pg8::gemm_phase<pg8::EpiResid, pg8::StaticOrder, true, true>(F.lds, g, S, E, F.tid); }
            ctx_resid_gemm(F, (const bf16*)(ws + WS_FFH), W + W_FFD + (size_t)j * 1024 * DFF, DFF, (bf16*)(ws + WS_ZR), modE + 5 * 1024, X + (size_t)MLAT * 1024, true);
        } SEAM(pb + PH_E9);
        if (IN(pb + PH_E10)) { FRESH(); phase_ln<false, false>(F, PA, PA.in[I_LN2G] + Le * 1024, PA.in[I_LN2B] + Le * 1024, modO + 0 * 1024, nullptr, nullptr, 0, false); } SEAM(pb + PH_E10);
        if (IN(pb + PH_O1)) { FRESH();
            pg8::Gemm g{H, W + W_ODIN + (size_t)j * 4096 * 1024, MROWS, 4096, 1024}; pg8::StaticOrder S; S.init(MROWS, 4096, F.G, (int)blockIdx.x);
            pg8::EpiOddIn E{(bf16*)(ws + WS_QN), (bf16*)(ws + WS_KN), (bf16*)(ws + WS_VN), (bf16*)(ws + WS_QD), (bf16*)(ws + WS_VD), (bf16*)(ws + WS_SG), (float*)(ws + WS_ZF), (float*)(ws + WS_ZB)};
            pg8::gemm_phase<pg8::EpiOddIn, pg8::StaticOrder, true, true>(F.lds, g, S, E, F.tid);
        } SEAM(pb + PH_O1);
        if (IN(pb + PH_O2)) { FRESH(); MKT phase_odd_mix(F, PA, T, j); } SEAM(pb + PH_O2);
        if (IN(pb + PH_O3)) { FRESH(); MKT phase_hg_b(F, T); } SEAM(pb + PH_O3);
        if (IN(pb + PH_O4)) { FRESH(); MKT if (j == 1) { for (int u = F.vcu; u < 16 * 64; u += F.G) hg_c_unit(F, T, u >> 8, (u >> 6) & 3, 2 + (u & 63)); }
            else { for (int u = F.vcu; u < 16 * 66; u += F.G) hg_c_unit(F, T, u / 264, (u / 66) & 3, u % 66); } } SEAM(pb + PH_O4);
#if defined(SELFCHK) && SELFCHK == 5
        if (IN(pb + PH_O5)) { FRESH(); phase_selfcheck_na(F, PA, j); }
#endif
#if defined(SELFCHK) && SELFCHK == 6
#ifndef CHKJ
#define CHKJ j
#endif
        if (IN(pb + PH_O5) && j == (CHKJ)) { { FRESH(); phase_selfcheck_hg_scan(F, PA, j); } xcd_barrier(bar); { FRESH(); phase_selfcheck_hg_cmp(F, PA, j); } }
#endif
        if (IN(pb + PH_O5)) { FRESH();
            { pg8::Gemm g{(const bf16*)(ws + WS_OO), W + W_ODOUT + (size_t)j * 1024 * 1024, MLAT, 1024, 1024}; pg8::StaticOrder S; S.init(MLAT, 1024, F.G, (int)blockIdx.x);
              pg8::EpiResid E{(pg8::bf16_t*)(ws + WS_ZR), modO + 2 * 1024, X, X + (size_t)MLAT * 1024, true};
              pg8::gemm_phase<pg8::EpiResid, pg8::StaticOrder, true, true>(F.lds, g, S, E, F.tid); }
            if (j == 0) ctx_resid_gemm(F, (const bf16*)(ws + WS_OO), W + W_ODOUT + (size_t)j * 1024 * 1024, 1024, (bf16*)(ws + WS_ZR), modO + 2 * 1024, X + (size_t)MLAT * 1024, true);
        } SEAM(pb + PH_O5);
        if (IN(pb + PH_O6)) { FRESH(); phase_ln<false, true>(F, PA, PA.in[I_LN1G] + Lo * 1024, PA.in[I_LN1B] + Lo * 1024, modO + 3 * 1024, nullptr, PA.in[I_ROUTER] + (size_t)j * 1024 * 8, j, false, (j == 1) ? MLAT : MROWS); } SEAM(pb + PH_O6);
        if (IN(pb + PH_O7)) { FRESH(); phase_moe_dispatch(F, j, (j == 1) ? MLAT : MROWS); } SEAM(pb + PH_O7);
        if (IN(pb + PH_O8)) { FRESH();
            int off[9]; moe_offsets(F.ctl + CW_CNT + 64 * j, off);
            pg8::GroupedOrder S; S.nM = off[8] >> 8; S.nN = 2 * DFFE / 256; S.nwg = S.nM * S.nN; S.G = F.G; S.c = (int)blockIdx.x; S.estride = (long)2 * DFFE * 1024;
#pragma unroll
            for (int e = 0; e < 9; ++e) S.toff[e] = off[e] >> 8;
            pg8::Gemm g{(const bf16*)(ws + WS_XG8), (const bf16*)((unsigned char*)WM + WM_GU), MOE_ROWS, 2 * DFFE, 1024 / 2};
            pg8::EpiSwigluF8 E{ws + WS_MH, DFFE, 1.f / MOE_WSCALE};
            pg8::gemm_phase<pg8::EpiSwigluF8, pg8::GroupedOrder, true, true, true>(F.lds, g, S, E, F.tid);
        } SEAM(pb + PH_O8);
        if (IN(pb + PH_O9)) { FRESH();
            int off[9]; moe_offsets(F.ctl + CW_CNT + 64 * j, off);
            pg8::GroupedOrder S; S.nM = off[8] >> 8; S.nN = 1024 / 256; S.nwg = S.nM * S.nN; S.G = F.G; S.c = (int)blockIdx.x; S.estride = (long)1024 * DFFE;
#pragma unroll
            for (int e = 0; e < 9; ++e) S.toff[e] = off[e] >> 8;
            pg8::Gemm g{(const bf16*)(ws + WS_MH), (const bf16*)((unsigned char*)WM + WM_D), MOE_ROWS, 1024, DFFE / 2};
            pg8::EpiScaledBf16 E{(bf16*)(ws + WS_XG), 1024, 1.f / MOE_WSCALE};
            pg8::gemm_phase<pg8::EpiScaledBf16, pg8::GroupedOrder, true, true, true>(F.lds, g, S, E, F.tid);
        } SEAM(pb + PH_O9);
        if (IN(pb + PH_O10)) { FRESH(); phase_ln<true, false>(F, PA, PA.in[I_LN2G] + Lo * 1024, PA.in[I_LN2B] + Lo * 1024, mods + (size_t)(j == 0 ? 2 : 0) * 5 * 6144, modO + 5 * 1024, nullptr, 0, j == 1, (j == 1) ? MLAT : MROWS); }
        if (j == 0) { if (IN(pb + PH_O10)) { FRESH(); phase_cv(F, PA, 1); }
                      if (IN(pb + PH_O10) && IN(PH_PER + PH_E1)) xcd_barrier(bar); }
    }
#if defined(PROBE_BARRIERS)
    for (int i = 0; i < PROBE_BARRIERS; ++i) xcd_barrier(bar);
#endif
#if defined(PROBE_ACC)
    if (blockIdx.x == 0 && ({ int l_; asm volatile("v_mbcnt_lo_u32_b32 %0, -1, 0\n\tv_mbcnt_hi_u32_b32 %0, -1, %0" : "=v"(l_)); (wv0 == 0 && l_ == 0); })) { const unsigned d = MISC[18]; const unsigned t0 = (unsigned)__builtin_amdgcn_s_memrealtime(); while ((unsigned)__builtin_amdgcn_s_memrealtime() - t0 < 9u * d) __builtin_amdgcn_s_sleep(8); }
#endif
#if defined(PROBE_PH)
#if defined(PROBE_CLK)
    if (blockIdx.x == 0 && IS_T0()) { const unsigned d = MISC[18] / 20u; const unsigned t0 = (unsigned)__builtin_amdgcn_s_memrealtime(); while ((unsigned)__builtin_amdgcn_s_memrealtime() - t0 < 9u * d) __builtin_amdgcn_s_sleep(8); }
#else
    if (blockIdx.x == 0 && IS_T0()) { const unsigned d = MISC[18]; const unsigned t0 = (unsigned)__builtin_amdgcn_s_memrealtime(); while ((unsigned)__builtin_amdgcn_s_memrealtime() - t0 < 9u * d) __builtin_amdgcn_s_sleep(8); }
#endif
#endif
#undef IN
#undef SEAM
}

extern "C" void kernel_launch(void* const* d_in, const int* in_sizes, int n_in, void* d_out, int out_size, void* d_ws, size_t ws_size, hipStream_t stream) {
    static int grid = 0;
    if (grid == 0) {
        if (n_in != 30 || in_sizes[0] != MLAT * DM || out_size != MLAT * DM || ws_size < WS_END) { fprintf(stderr, "kernel_launch: unexpected shapes / workspace (n_in %d, ws %zu)\n", n_in, ws_size); grid = -1; return; }
        int dev = 0, cus = 0, per_cu = 0;
        if (hipGetDevice(&dev) != hipSuccess || hipDeviceGetAttribute(&cus, hipDeviceAttributeMultiprocessorCount, dev) != hipSuccess) { grid = -1; return; }
        if (hipFuncSetAttribute((const void*)mk_fwd, hipFuncAttributeMaxDynamicSharedMemorySize, LDS_BYTES) != hipSuccess) { fprintf(stderr, "kernel_launch: hipFuncSetAttribute failed\n"); grid = -1; return; }
        if (hipOccupancyMaxActiveBlocksPerMultiprocessor(&per_cu, (const void*)mk_fwd, NTHR, LDS_BYTES) != hipSuccess || per_cu < 1) { fprintf(stderr, "kernel_launch: occupancy query says %d\n", per_cu); }
        (void)hipGetLastError();
        grid = cus;
        if (grid != 256) { fprintf(stderr, "kernel_launch: built for 256 CUs, found %d\n", cus); grid = -1; return; }
    }
    if (grid < 0) return;
    if (hipMemsetAsync((char*)d_ws + WS_CTL, 0, CTL_ZERO_BYTES, stream) != hipSuccess) return;
    Args a{};
    for (int i = 0; i < 30; ++i) a.in[i] = (const float*)d_in[i];
    a.out = (float*)d_out; a.ws = (unsigned char*)d_ws;
#if MK_MULTI
    for (int ph = 0; ph < NPHASES; ++ph) {
        if (ph == PH_PER + PH_MOD || ph == PH_PER + PH_CV) continue;
        a.ph_lo = ph; a.ph_hi = ph + 1;
        hipLaunchKernelGGL(mk_fwd, dim3(grid), dim3(NTHR), LDS_BYTES, stream, a);
    }
#else
    a.ph_lo = 0; a.ph_hi = NPHASES;
    hipLaunchKernelGGL(mk_fwd, dim3(grid), dim3(NTHR), LDS_BYTES, stream, a);
#endif
}
```

```cpp
#include <hip/hip_runtime.h>
#include <cstdio>
#include <cstdint>

#ifndef MK_MULTI
#define MK_MULTI 0
#endif

constexpr int DM = 1024, NB = 4, SEQ = 8192, CTXL = 256, GRIDW = 64;
constexpr int MLAT = NB * SEQ, MCTX = NB * CTXL, MROWS = MLAT + MCTX;
constexpr int DEPTH = 4;
constexpr int EV_IN = 1440, EV_INP = 1536;
constexpr int DFF = 2816, DFFE = 3584, NEXP = 8;
constexpr int MOE_ROWS = 2 * MROWS + NEXP * 256;
constexpr float ALPHA = 1.6817928305074290f;
constexpr float LOG2E = 1.4426950408889634f;
constexpr float C2_64 = 0.125f * LOG2E;
constexpr float C2_96 = 0.10206207261596577f * LOG2E;

constexpr size_t MiB = 1u << 20;
constexpr size_t WS_CTL = 0, CTL_ZERO_BYTES = 1 * MiB;
constexpr size_t WS_SMALL = 2 * MiB;
constexpr size_t WS_TOPK = 4 * MiB;
constexpr size_t WS_W = 6 * MiB;
constexpr size_t WS_WMOE = 72 * MiB;
constexpr size_t WS_X = 240 * MiB;
constexpr size_t WS_H = 372 * MiB;
constexpr size_t WS_S = 438 * MiB;
constexpr size_t WS_RAW = WS_S;
constexpr size_t WS_QG = 636 * MiB, WS_KG = 669 * MiB, WS_VG = 678 * MiB, WS_CQN = 687 * MiB, WS_CKVN = 712 * MiB;
constexpr size_t WS_QM = 729 * MiB, WS_KM = 779 * MiB, WS_VM = 829 * MiB, WS_OE = 862 * MiB;
constexpr size_t WS_FFH = WS_S;
constexpr size_t WS_QN = 438 * MiB, WS_KN = 471 * MiB, WS_VN = 504 * MiB, WS_QD = 537 * MiB, WS_VD = 570 * MiB, WS_SG = 603 * MiB;
constexpr size_t WS_ZF = 636 * MiB, WS_ZB = 702 * MiB, WS_OO = 768 * MiB, WS_HST = 834 * MiB, WS_HDM = 966 * MiB;
constexpr size_t WS_MH = 372 * MiB;
constexpr size_t WS_XG = 848 * MiB;
constexpr size_t WS_XG8 = 612 * MiB;
constexpr size_t WS_ZR = 700 * MiB;
constexpr size_t WS_END = 984 * MiB;
static_assert(WS_QG >= WS_RAW + (size_t)MROWS * EV_INP * 4 && WS_OE + (size_t)MROWS * 2048 <= 984 * MiB, "even map");
static_assert(WS_HST + (size_t)32 * 66 * 65536 <= WS_HDM && WS_HDM + (size_t)32 * 66 * 512 <= WS_END, "odd map");
static_assert(WS_MH + (size_t)MOE_ROWS * DFFE <= WS_XG8 && WS_XG8 + (size_t)MOE_ROWS * 1024 <= WS_XG && WS_XG + (size_t)MOE_ROWS * 2048 <= WS_END, "moe map");
constexpr size_t SM_MODS = 0;
constexpr size_t SM_ROPEA = 512 * 1024;
constexpr size_t SM_ROPEB = SM_ROPEA + 16384;
constexpr size_t SM_LB = SM_ROPEB + 8192;
constexpr size_t W_EVIN = 0;
constexpr size_t W_UQ = W_EVIN + (size_t)2 * 1536 * 1024;
constexpr size_t W_UKV = W_UQ + (size_t)2 * 768 * 384;
constexpr size_t W_EVOUT = W_UKV + (size_t)2 * 1024 * 256;
constexpr size_t W_FFGU = W_EVOUT + (size_t)2 * 1024 * 1024;
constexpr size_t W_FFD = W_FFGU + (size_t)2 * 5632 * 1024;
constexpr size_t W_ODIN = W_FFD + (size_t)2 * 1024 * 2816;
constexpr size_t W_ODOUT = W_ODIN + (size_t)2 * 4096 * 1024;
constexpr size_t W_ENDE = W_ODOUT + (size_t)2 * 1024 * 1024;
static_assert(W_ENDE * 2 <= 66 * MiB, "weights map");
constexpr size_t WM_GU = 0;
constexpr size_t WM_D = (size_t)8 * 7168 * 1024;
#ifndef FFN_F8
#define FFN_F8 true
#endif
constexpr float MOE_WSCALE = 64.f;
constexpr int CW_BAR = 4096;
constexpr int CW_CNT = 8192;
constexpr int CW_CNT2 = 8192 + 256;
constexpr int LDS_BYTES = 160256;
constexpr int MISC_OFF = LDS_BYTES - 512;
constexpr int NWAVES = 8, NTHR = 512;

#define GAS __attribute__((address_space(1)))
#define LAS __attribute__((address_space(3)))
typedef unsigned short bf16;
typedef unsigned v4u __attribute__((ext_vector_type(4)));
typedef unsigned v2u __attribute__((ext_vector_type(2)));
typedef float f32x4 __attribute__((ext_vector_type(4)));
typedef float f32x16 __attribute__((ext_vector_type(16)));
typedef short bf16x8 __attribute__((ext_vector_type(8)));
typedef short s16x4 __attribute__((ext_vector_type(4)));
typedef GAS unsigned gu32;

typedef float f32x2_t __attribute__((ext_vector_type(2))); typedef __bf16 bf16x2_t __attribute__((ext_vector_type(2)));
__device__ __forceinline__ unsigned pkbf(float lo, float hi) { f32x2_t v = {lo, hi}; bf16x2_t b = __builtin_convertvector(v, bf16x2_t); return __builtin_bit_cast(unsigned, b); }
typedef _Float16 h16x2 __attribute__((ext_vector_type(2)));
typedef _Float16 h16x4 __attribute__((ext_vector_type(4)));
typedef float f32x2v __attribute__((ext_vector_type(2)));
__device__ __forceinline__ unsigned pkh(float a, float b) { return __builtin_bit_cast(unsigned, __builtin_convertvector((f32x2v){a, b}, h16x2)); }
__device__ __forceinline__ float bf_lo(unsigned u) { return __uint_as_float(u << 16); }
__device__ __forceinline__ float bf_hi(unsigned u) { return __uint_as_float(u & 0xffff0000u); }
__device__ __forceinline__ float bf2f(bf16 h) { return __uint_as_float(((unsigned)h) << 16); }
__device__ __forceinline__ bf16 f2bf(float f) { return (bf16)(pkbf(f, 0.f) & 0xffffu); }
__device__ __forceinline__ float fast_exp2(float x) { return __builtin_amdgcn_exp2f(x); }
__device__ __forceinline__ float frcp(float x) { return __builtin_amdgcn_rcpf(x); }
__device__ __forceinline__ float sigmoidf_(float x) { return frcp(1.f + __expf(-x)); }
__device__ __forceinline__ float siluf_(float x) { return x * frcp(1.f + __expf(-x)); }
__device__ __forceinline__ float shx(float v, int m, int lane) { return __int_as_float(__builtin_amdgcn_ds_bpermute((lane ^ m) << 2, __float_as_int(v))); }
__device__ __forceinline__ float wave_sum(float v, int lane) {
#pragma unroll
    for (int o = 1; o < 64; o <<= 1) v += shx(v, o, lane);
    return v;
}
__device__ __forceinline__ int modrow(int row) { return row < MLAT ? (row >> 13) : 4; }
namespace pg8 {
#define PG8_LAS __attribute__((address_space(3)))
typedef unsigned short bf16_t;
typedef short bf16x8 __attribute__((ext_vector_type(8)));
typedef float f32x4 __attribute__((ext_vector_type(4)));
typedef unsigned u32x4 __attribute__((ext_vector_type(4)));
constexpr int BM = 256, BK = 64, HALF = 128, HTB = HALF * BK * 2  , STAGE_BYTES = 8 * HTB, NXCD = 8, WGM = 8;

__host__ __device__ __forceinline__ int lds_byte(int r, int c) { const int st = (r >> 4) * 2 + (c >> 5), rr = r & 15, cc = c & 31, ob = rr * 64 + cc * 2; return st * 1024 + (ob ^ (((ob >> 9) & 1) << 5)); }
__host__ __device__ __forceinline__ void stage_rc(int b, int& R, int& C) { const int st = b / 1024, sb = b % 1024, swz = sb ^ (((sb >> 9) & 1) << 5); R = (st >> 1) * 16 + swz / 64; C = (st & 1) * 32 + (swz % 64) / 2; }
__host__ __device__ __forceinline__ int perm32(int rho) { const int n = rho >> 4, i = rho & 15; return 8 * (i >> 2) + 4 * n + (i & 3); }

struct Unit { int pm, pn; long boff; };
struct Gemm { const bf16_t* A; const bf16_t* Bt; int M, N, K; };

struct StaticOrder {
    int nM, nN, nwg, G, c;
    __host__ __device__ void init(int M, int N, int G_, int c_) { nM = M / BM; nN = N / BM; nwg = nM * nN; G = G_; c = c_; }
    __host__ __device__ bool next(int i, Unit& u) const {
        const long L = (long)i * G + c; if (L >= nwg) return false;
        int wgid = (int)L; { const int q = nwg / NXCD, r = nwg % NXCD, xcd = wgid % NXCD, off = wgid / NXCD; wgid = (xcd < r ? xcd * (q + 1) : r * (q + 1) + (xcd - r) * q) + off; }
        const int nig = WGM * nN, gid = wgid / nig, fm = gid * WGM, gsz = (nM - fm) < WGM ? (nM - fm) : WGM;
        u.pm = fm + ((wgid % nig) % gsz); u.pn = (wgid % nig) / gsz; u.boff = 0; return true;
    }
    __device__ __forceinline__ void a_ready(const Unit&) const {}
    __device__ __forceinline__ void done(const Unit&) const {}
};

__device__ __forceinline__ unsigned cvt_pk_bf16(float lo, float hi) { return pkbf(lo, hi); }
typedef float f32x2 __attribute__((ext_vector_type(2)));
template <class Epi, class Sched, bool ALIGN_EPI = false, bool SP2 = false, bool F8 = false>
__device__ __forceinline__ void gemm_phase(PG8_LAS unsigned char* lds, const Gemm g, const Sched& S, const Epi& E, int tid_in) {
    int tid_ = tid_in; asm volatile("" : "+v"(tid_));
    const int tid = tid_, wid = __builtin_amdgcn_readfirstlane(tid >> 6), lane = tid & 63, wr = wid >> 2, wc = wid & 3, fr = lane & 15, fq = lane >> 4;
    const int K = g.K, nt = K / BK;
    unsigned voffA[2], voffB[2];
#pragma unroll
    for (int i = 0; i < 2; ++i) { int R, C; stage_rc(tid * 16 + i * 8192, R, C); const int Rb = Epi::PERM ? ((R & ~31) + perm32(R & 31)) : R;
        voffA[i] = (unsigned)(R * K + C) * 2u; voffB[i] = (unsigned)(Rb * K + C) * 2u; }
    const size_t kstep = (size_t)(BK * 2);
    const size_t hstep = (size_t)HALF * K * 2;
    const size_t tstep = 2 * hstep;
    const unsigned ldsw = (unsigned)wid * 1024u;
    const int aoff = lds_byte(wr * 64 + fr, fq * 8), boff = lds_byte(wc * 32 + fr, fq * 8);
#define PG8_SA(b, h) (((b) * 2 + (h)) * HTB)
#define PG8_SB(b, h) ((4 + (b) * 2 + (h)) * HTB)
#define PG8_STAGE(bufoff, gbase, voff) do { _Pragma("unroll") for (int _i = 0; _i < 2; ++_i) \
        __builtin_amdgcn_global_load_lds((const unsigned*)((const char*)(gbase) + (voff)[_i]), (PG8_LAS unsigned*)(lds + (bufoff) + ldsw + _i * 8192), 16, 0, 0); } while (0)
#define PG8_LDA(dst, b, h) do { if constexpr (F8) { _Pragma("unroll") for (int m = 0; m < 4; ++m) dst##8[m] = __builtin_shufflevector(*(const PG8_LAS v4i_*)(lds + PG8_SA(b, h) + aoff + m * 2048), *(const PG8_LAS v4i_*)(lds + PG8_SA(b, h) + aoff + m * 2048 + 1024), 0, 1, 2, 3, 4, 5, 6, 7); } \
        else { _Pragma("unroll") for (int m = 0; m < 4; ++m) _Pragma("unroll") for (int k = 0; k < 2; ++k) dst[m][k] = *(const PG8_LAS bf16x8*)(lds + PG8_SA(b, h) + aoff + m * 2048 + k * 1024); } } while (0)
#define PG8_LDB(dst, b, h) do { if constexpr (F8) { _Pragma("unroll") for (int n = 0; n < 2; ++n) dst##8[n] = __builtin_shufflevector(*(const PG8_LAS v4i_*)(lds + PG8_SB(b, h) + boff + n * 2048), *(const PG8_LAS v4i_*)(lds + PG8_SB(b, h) + boff + n * 2048 + 1024), 0, 1, 2, 3, 4, 5, 6, 7); } \
        else { _Pragma("unroll") for (int n = 0; n < 2; ++n) _Pragma("unroll") for (int k = 0; k < 2; ++k) dst[n][k] = *(const PG8_LAS bf16x8*)(lds + PG8_SB(b, h) + boff + n * 2048 + k * 1024); } } while (0)
#define PG8_MMA(ai, bj, At, Bt) do { __builtin_amdgcn_s_setprio(1); _Pragma("unroll") for (int m = 0; m < 4; ++m) _Pragma("unroll") for (int n = 0; n < 2; ++n) { \
        if constexpr (F8) { asm volatile("v_mfma_f32_16x16x128_f8f6f4 %0, %1, %2, %0" : "+v"(acc[ai][bj][m][n]) : "v"(Bt##8[n]), "v"(At##8[m])); } \
        else { _Pragma("unroll") for (int k = 0; k < 2; ++k) acc[ai][bj][m][n] = __builtin_amdgcn_mfma_f32_16x16x32_bf16(Bt[n][k], At[m][k], acc[ai][bj][m][n], 0, 0, 0); } } \
        __builtin_amdgcn_s_setprio(0); } while (0)
#define PG8_WAIT_V(n) asm volatile("s_waitcnt vmcnt(" #n ")" ::: "memory")
#define PG8_WAIT_L(n) asm volatile("s_waitcnt lgkmcnt(" #n ")" ::: "memory")
#define PG8_BAR __builtin_amdgcn_s_barrier()
#define PG8_SCHED __builtin_amdgcn_sched_barrier(0)
    Unit cur, nxt; int ui = 0;
    if (!S.next(0, cur)) return;
    f32x4 acc[2][2][4][2];
#pragma unroll
    for (int a = 0; a < 2; ++a)
#pragma unroll
        for (int b = 0; b < 2; ++b)
#pragma unroll
            for (int m = 0; m < 4; ++m)
#pragma unroll
                for (int n = 0; n < 2; ++n) acc[a][b][m][n] = (f32x4){0.f, 0.f, 0.f, 0.f};
    typedef int v4i_ __attribute__((ext_vector_type(4))); typedef int v8i_ __attribute__((ext_vector_type(8)));
    bf16x8 At[4][2], B0[2][2], B1[2][2]; v8i_ At8[4], B08[2], B18[2];
    const char* cA = (const char*)g.A + (size_t)cur.pm * tstep; const char* cB = (const char*)g.Bt + (size_t)cur.pn * tstep + cur.boff;
    S.a_ready(cur);
    if constexpr (SP2) {
        PG8_STAGE(PG8_SB(0, 0), cB, voffB); PG8_STAGE(PG8_SB(0, 1), cB + hstep, voffB); PG8_STAGE(PG8_SA(0, 0), cA, voffA); PG8_STAGE(PG8_SA(0, 1), cA + hstep, voffA);
        if (wr == 1) PG8_BAR;
        PG8_WAIT_V(2); PG8_BAR;
        PG8_STAGE(PG8_SB(1, 0), cB + kstep, voffB); PG8_STAGE(PG8_SA(1, 0), cA + kstep, voffA); PG8_STAGE(PG8_SB(1, 1), cB + hstep + kstep, voffB);
        PG8_WAIT_V(6); PG8_BAR;
    } else {
        PG8_STAGE(PG8_SB(0, 0), cB, voffB); PG8_STAGE(PG8_SA(0, 0), cA, voffA); PG8_STAGE(PG8_SB(0, 1), cB + hstep, voffB); PG8_STAGE(PG8_SA(0, 1), cA + hstep, voffA);
        if (wr == 1) PG8_BAR;
        PG8_WAIT_V(4); PG8_BAR;
        PG8_STAGE(PG8_SB(1, 0), cB + kstep, voffB); PG8_STAGE(PG8_SA(1, 0), cA + kstep, voffA); PG8_STAGE(PG8_SB(1, 1), cB + hstep + kstep, voffB);
        PG8_WAIT_V(6); PG8_BAR;
    }
    for (;;) {
        const bool has_next = S.next(ui + 1, nxt);
        const char* nA = has_next ? (const char*)g.A + (size_t)nxt.pm * tstep : cA; const char* nB = has_next ? (const char*)g.Bt + (size_t)nxt.pn * tstep + nxt.boff : cB;
        for (int t = 0; t < nt; t += 2) {
            const bool last = (t == nt - 2);
            const char* a1 = cA + (size_t)(t + 1) * kstep;
            const char* a2 = last ? nA : cA + (size_t)(t + 2) * kstep; const char* b2 = last ? nB : cB + (size_t)(t + 2) * kstep;
            const char* a3 = a2 + kstep; const char* b3 = b2 + kstep;
            if (last && has_next) S.a_ready(nxt);
            if constexpr (SP2) {
            PG8_LDB(B0, 0, 0); PG8_LDB(B1, 0, 1); PG8_SCHED; PG8_LDA(At, 0, 0); PG8_STAGE(PG8_SA(1, 1), a1 + hstep, voffA);
            PG8_WAIT_V(8); PG8_WAIT_L(0); PG8_BAR; PG8_MMA(0, 0, At, B0); PG8_MMA(0, 1, At, B1); PG8_BAR; PG8_SCHED;
            PG8_LDA(At, 0, 1); PG8_STAGE(PG8_SB(0, 0), b2, voffB); PG8_STAGE(PG8_SB(0, 1), b2 + hstep, voffB); PG8_STAGE(PG8_SA(0, 0), a2, voffA);
            PG8_WAIT_V(8); PG8_WAIT_L(0); PG8_BAR; PG8_MMA(1, 0, At, B0); PG8_MMA(1, 1, At, B1); PG8_BAR; PG8_SCHED;
            PG8_LDB(B0, 1, 0); PG8_LDB(B1, 1, 1); PG8_SCHED; PG8_LDA(At, 1, 0); PG8_STAGE(PG8_SA(0, 1), a2 + hstep, voffA);
            PG8_WAIT_V(8); PG8_WAIT_L(0); PG8_BAR; PG8_MMA(0, 0, At, B0); PG8_MMA(0, 1, At, B1); PG8_BAR; PG8_SCHED;
            PG8_LDA(At, 1, 1); PG8_STAGE(PG8_SB(1, 0), b3, voffB); PG8_STAGE(PG8_SB(1, 1), b3 + hstep, voffB); PG8_STAGE(PG8_SA(1, 0), a3, voffA);
            PG8_WAIT_V(8); PG8_WAIT_L(0); PG8_BAR; PG8_MMA(1, 0, At, B0); PG8_MMA(1, 1, At, B1); PG8_BAR; PG8_SCHED;
            } else {
            PG8_LDB(B0, 0, 0); PG8_SCHED; PG8_LDA(At, 0, 0); PG8_STAGE(PG8_SA(1, 1), a1 + hstep, voffA);
            PG8_WAIT_L(8); PG8_BAR; PG8_WAIT_L(0); PG8_MMA(0, 0, At, B0); PG8_BAR; PG8_SCHED;
            PG8_LDB(B1, 0, 1); PG8_STAGE(PG8_SB(0, 0), b2, voffB);
            PG8_BAR; PG8_WAIT_L(0); PG8_MMA(0, 1, At, B1); PG8_BAR;
            PG8_LDA(At, 0, 1); PG8_STAGE(PG8_SA(0, 0), a2, voffA);
            PG8_BAR; PG8_WAIT_L(0); PG8_MMA(1, 0, At, B0); PG8_BAR; PG8_SCHED;
            PG8_STAGE(PG8_SB(0, 1), b2 + hstep, voffB);
            PG8_WAIT_V(6); PG8_BAR; PG8_MMA(1, 1, At, B1); PG8_BAR;
            PG8_LDB(B0, 1, 0); PG8_SCHED; PG8_LDA(At, 1, 0); PG8_STAGE(PG8_SA(0, 1), a2 + hstep, voffA);
            PG8_WAIT_L(8); PG8_BAR; PG8_WAIT_L(0); PG8_MMA(0, 0, At, B0); PG8_BAR; PG8_SCHED;
            PG8_LDB(B1, 1, 1); PG8_STAGE(PG8_SB(1, 0), b3, voffB);
            PG8_BAR; PG8_WAIT_L(0); PG8_MMA(0, 1, At, B1); PG8_BAR;
            PG8_LDA(At, 1, 1); PG8_STAGE(PG8_SA(1, 0), a3, voffA);
            PG8_BAR; PG8_WAIT_L(0); PG8_MMA(1, 0, At, B0); PG8_BAR; PG8_SCHED;
            PG8_STAGE(PG8_SB(1, 1), b3 + hstep, voffB);
            PG8_WAIT_V(6); PG8_BAR; PG8_MMA(1, 1, At, B1); PG8_BAR;
            }
        }
        if constexpr (ALIGN_EPI) { if (wr == 0) PG8_BAR; }
        if constexpr (!Epi::AFTER_DRAIN) { int l2_; asm volatile("v_mbcnt_lo_u32_b32 %0, -1, 0\n\tv_mbcnt_hi_u32_b32 %0, -1, %0" : "=v"(l2_)); const int fr2 = l2_ & 15, fq2 = l2_ >> 4;     E(acc, cur, wr, wc, fr2, fq2); S.done(cur); }
        if (!has_next) break;
#pragma unroll
        for (int a = 0; a < 2; ++a)
#pragma unroll
            for (int b = 0; b < 2; ++b)
#pragma unroll
                for (int m = 0; m < 4; ++m)
#pragma unroll
                    for (int n = 0; n < 2; ++n) acc[a][b][m][n] = (f32x4){0.f, 0.f, 0.f, 0.f};
        cur = nxt; cA = nA; cB = nB; ++ui;
        if constexpr (ALIGN_EPI) { if (wr == 1) PG8_BAR; }
    }
    PG8_WAIT_V(0);
    if constexpr (!ALIGN_EPI) { if (wr == 0) PG8_BAR; }
    PG8_BAR;
    if constexpr (Epi::AFTER_DRAIN) { E.fused(acc, cur, wr, wc, fr, fq, lds, wid, lane); S.done(cur); }
#undef PG8_SA
#undef PG8_SB
#undef PG8_STAGE
#undef PG8_LDA
#undef PG8_LDB
#undef PG8_MMA
#undef PG8_WAIT_V
#undef PG8_WAIT_L
#undef PG8_BAR
#undef PG8_SCHED
}
}
namespace pg8 {
constexpr int NEXP_ = 8;
template <class F> __device__ __forceinline__ void walk8(const f32x4 (&acc)[2][2][4][2], const Unit& u, int wr, int wc, int fr, int fq, const F& f) {
    asm volatile("s_nop 15\n\ts_nop 15\n\ts_nop 15\n\ts_nop 7" ::: "memory");
    const int row0 = u.pm * BM + wr * 64 + fr, col0 = u.pn * BM + wc * 32 + 8 * fq;
#pragma unroll
    for (int ai = 0; ai < 2; ++ai)
#pragma unroll
        for (int m = 0; m < 4; ++m)
#pragma unroll
            for (int bj = 0; bj < 2; ++bj) {
                const f32x4 a = acc[ai][bj][m][0], b = acc[ai][bj][m][1];
                float v[8] = {a[0], a[1], a[2], a[3], b[0], b[1], b[2], b[3]};
                f.emit(row0 + ai * HALF + m * 16, col0 + bj * HALF, v);
                asm volatile("" ::: "memory");
            }
}
__device__ __forceinline__ u32x4 pack8(const float (&v)[8], float s) {
    u32x4 w; w.x = cvt_pk_bf16(v[0] * s, v[1] * s); w.y = cvt_pk_bf16(v[2] * s, v[3] * s); w.z = cvt_pk_bf16(v[4] * s, v[5] * s); w.w = cvt_pk_bf16(v[6] * s, v[7] * s); return w;
}
struct EpiRawF32 {
    static constexpr bool PERM = true, AFTER_DRAIN = false;
    float* O; int ldc;
    __device__ __forceinline__ void emit(int row, int col, const float (&v)[8]) const {
        float* p = O + (size_t)row * ldc + col; *(f32x4*)p = (f32x4){v[0], v[1], v[2], v[3]}; *(f32x4*)(p + 4) = (f32x4){v[4], v[5], v[6], v[7]};
    }
    __device__ __forceinline__ void operator()(const f32x4 (&acc)[2][2][4][2], const Unit& u, int wr, int wc, int fr, int fq) const { walk8(acc, u, wr, wc, fr, fq, *this); }
};
struct EpiPlainBf16 {
    static constexpr bool PERM = true, AFTER_DRAIN = false;
    bf16_t* O; int ldc;
    __device__ __forceinline__ void emit(int row, int col, const float (&v)[8]) const { *(u32x4*)(O + (size_t)row * ldc + col) = pack8(v, 1.f); }
    __device__ __forceinline__ void operator()(const f32x4 (&acc)[2][2][4][2], const Unit& u, int wr, int wc, int fr, int fq) const { walk8(acc, u, wr, wc, fr, fq, *this); }
};
struct EpiMlaQ {
    static constexpr bool PERM = true, AFTER_DRAIN = false;
    bf16_t* Qm; const float* ropeB;
    __device__ __forceinline__ void emit(int row, int col, const float (&v)[8]) const {
        const int head = col / 96, c = col - head * 96;
        bf16_t* q = Qm + (size_t)row * 768 + head * 96;
        const bool isr = c >= 64;
        const int g = (c - 64) >> 3, axis = g >> 1, base = axis * 16 + (g & 1) * 4;
        f32x4 cs0 = {1.f, 0.f, 1.f, 0.f}, cs1 = {1.f, 0.f, 1.f, 0.f};
        if (isr && row < MLAT) { const int t = row & (SEQ - 1), pos = axis ? (t & 63) : (t >> 6); const float* cs = ropeB + (pos * 8 + (g & 1) * 4) * 2; cs0 = *(const f32x4*)cs; cs1 = *(const f32x4*)(cs + 4); }
        const float o10 = v[0] * cs0[0] - v[4] * cs0[1], o20 = v[4] * cs0[0] + v[0] * cs0[1], o11 = v[1] * cs0[2] - v[5] * cs0[3], o21 = v[5] * cs0[2] + v[1] * cs0[3];
        const float o12 = v[2] * cs1[0] - v[6] * cs1[1], o22 = v[6] * cs1[0] + v[2] * cs1[1], o13 = v[3] * cs1[2] - v[7] * cs1[3], o23 = v[7] * cs1[2] + v[3] * cs1[3];
        typedef unsigned u32x2 __attribute__((ext_vector_type(2)));
        u32x2 w1, w2; w1.x = cvt_pk_bf16(o10 * C2_96, o11 * C2_96); w1.y = cvt_pk_bf16(o12 * C2_96, o13 * C2_96); w2.x = cvt_pk_bf16(o20 * C2_96, o21 * C2_96); w2.y = cvt_pk_bf16(o22 * C2_96, o23 * C2_96);
        bf16_t* p1 = isr ? q + 64 + base : q + c; bf16_t* p2 = isr ? q + 64 + base + 8 : q + c + 4;
        *(u32x2*)p1 = w1; *(u32x2*)p2 = w2;
    }
    __device__ __forceinline__ void operator()(const f32x4 (&acc)[2][2][4][2], const Unit& u, int wr, int wc, int fr, int fq) const { walk8(acc, u, wr, wc, fr, fq, *this); }
};
struct EpiMlaKV {
    static constexpr bool PERM = true, AFTER_DRAIN = false;
    bf16_t* Km; bf16_t* Vm;
    __device__ __forceinline__ void emit(int row, int col, const float (&v)[8]) const {
        const int head = col >> 7, c = col & 127;
        if (c < 64) *(u32x4*)(Km + (size_t)row * 768 + head * 96 + c) = pack8(v, 1.f);
        else        *(u32x4*)(Vm + (size_t)row * 512 + head * 64 + (c - 64)) = pack8(v, 1.f);
    }
    __device__ __forceinline__ void operator()(const f32x4 (&acc)[2][2][4][2], const Unit& u, int wr, int wc, int fr, int fq) const { walk8(acc, u, wr, wc, fr, fq, *this); }
};
struct EpiResid {
    static constexpr bool PERM = true, AFTER_DRAIN = false;
    bf16_t* Z; const float* gate; const void* bl; const void* bc; bool src16;
    __device__ __forceinline__ void emit(int row, int col, const float (&v)[8]) const {
        const float* g = gate + (size_t)(row < MLAT ? (row >> 13) : 4) * 6144 + col;
        const size_t qo = (row < MLAT ? (size_t)row * 1024 : (size_t)(row - MLAT) * 1024) + col; const void* qb = row < MLAT ? bl : bc;
        f32x4 x0, x1;
        if (src16) { const u32x4 r = *(const u32x4*)((const bf16_t*)qb + qo); typedef _Float16 h16x8_ __attribute__((ext_vector_type(8))); typedef float f32x8_ __attribute__((ext_vector_type(8)));
            const f32x8_ xf = __builtin_convertvector(__builtin_bit_cast(h16x8_, r), f32x8_); x0 = (f32x4){xf[0], xf[1], xf[2], xf[3]}; x1 = (f32x4){xf[4], xf[5], xf[6], xf[7]}; }
        else { const float* q = (const float*)qb + qo; x0 = *(const f32x4*)q; x1 = *(const f32x4*)(q + 4); }
        const f32x4 g0 = *(const f32x4*)g, g1 = *(const f32x4*)(g + 4);
        const f32x4 z0 = x0 * ALPHA + g0 * (f32x4){v[0], v[1], v[2], v[3]}, z1 = x1 * ALPHA + g1 * (f32x4){v[4], v[5], v[6], v[7]};
        *(u32x4*)(Z + (size_t)row * 1024 + col) = (u32x4){pkh(z0[0], z0[1]), pkh(z0[2], z0[3]), pkh(z1[0], z1[1]), pkh(z1[2], z1[3])};
    }
    __device__ __forceinline__ void operator()(const f32x4 (&acc)[2][2][4][2], const Unit& u, int wr, int wc, int fr, int fq) const { walk8(acc, u, wr, wc, fr, fq, *this); }
};
struct EpiSwiglu {
    static constexpr bool PERM = true, AFTER_DRAIN = false;
    bf16_t* Hd; int ldh;
    __device__ __forceinline__ void emit(int row, int col, const float (&v)[8]) const {
        float h[4];
#pragma unroll
        for (int e = 0; e < 4; ++e) h[e] = v[e] * __builtin_amdgcn_rcpf(1.f + __expf(-v[e])) * v[e + 4];
        typedef unsigned u32x2 __attribute__((ext_vector_type(2)));
        u32x2 w; w.x = cvt_pk_bf16(h[0], h[1]); w.y = cvt_pk_bf16(h[2], h[3]);
        *(u32x2*)(Hd + (size_t)row * ldh + (col >> 1)) = w;
    }
    __device__ __forceinline__ void operator()(const f32x4 (&acc)[2][2][4][2], const Unit& u, int wr, int wc, int fr, int fq) const { walk8(acc, u, wr, wc, fr, fq, *this); }
};
struct EpiOddIn {
    static constexpr bool PERM = true, AFTER_DRAIN = false;
    bf16_t *Qn, *Kn, *Vn, *Qd, *Vd, *Sg; float *Zf, *Zb;
    __device__ __forceinline__ void emit(int row, int col, const float (&v)[8]) const {
        const int sec = col >> 9, c = col & 511; const size_t o = (size_t)row * 512 + c;
        if (sec == 0) { *(u32x4*)(Qn + o) = pack8(v, C2_64); }
        else if (sec == 1) { *(u32x4*)(Kn + o) = pack8(v, 1.f); }
        else if (sec == 2) { *(u32x4*)(Vn + o) = pack8(v, 1.f); }
        else if (sec == 4) { *(u32x4*)(Vd + o) = pack8(v, 1.f); }
        else if (sec == 5 || sec == 6) { float* p = (sec == 5 ? Zf : Zb) + o; *(f32x4*)p = (f32x4){v[0], v[1], v[2], v[3]}; *(f32x4*)(p + 4) = (f32x4){v[4], v[5], v[6], v[7]}; }
        else { float s[8];
#pragma unroll
            for (int e = 0; e < 8; ++e) s[e] = v[e] * __builtin_amdgcn_rcpf(1.f + __expf(-v[e]));
            *(u32x4*)((sec == 3 ? Qd : Sg) + o) = pack8(s, 1.f); }
    }
    __device__ __forceinline__ void operator()(const f32x4 (&acc)[2][2][4][2], const Unit& u, int wr, int wc, int fr, int fq) const { walk8(acc, u, wr, wc, fr, fq, *this); }
};
struct EpiSwigluS {
    static constexpr bool PERM = true, AFTER_DRAIN = false;
    bf16_t* Hd; int ldh; float s;
    __device__ __forceinline__ void emit(int row, int col, const float (&v)[8]) const {
        float h[4]; const float c1 = -s * 1.4426950408889634f, k2 = 1.f / (s * s);
#pragma unroll
        for (int e = 0; e < 4; ++e) h[e] = (v[e] * v[e + 4]) * __builtin_amdgcn_rcpf(__builtin_fmaf(__builtin_amdgcn_exp2f(v[e] * c1), k2, k2));
        typedef unsigned u32x2 __attribute__((ext_vector_type(2)));
        u32x2 w; w.x = cvt_pk_bf16(h[0], h[1]); w.y = cvt_pk_bf16(h[2], h[3]);
        *(u32x2*)(Hd + (size_t)row * ldh + (col >> 1)) = w;
    }
    __device__ __forceinline__ void operator()(const f32x4 (&acc)[2][2][4][2], const Unit& u, int wr, int wc, int fr, int fq) const { walk8(acc, u, wr, wc, fr, fq, *this); }
};
struct EpiSwigluF8 {
    static constexpr bool PERM = true, AFTER_DRAIN = false;
    unsigned char* Hd; int ldh; float s;
    __device__ __forceinline__ void emit(int row, int col, const float (&v)[8]) const {
        float h[4]; const float c1 = -s * 1.4426950408889634f, k2 = 1.f / (s * s);
#pragma unroll
        for (int e = 0; e < 4; ++e) h[e] = (v[e] * v[e + 4]) * __builtin_amdgcn_rcpf(__builtin_fmaf(__builtin_amdgcn_exp2f(v[e] * c1), k2, k2));
        unsigned w = 0u; w = __builtin_amdgcn_cvt_pk_fp8_f32(h[0], h[1], w, false); w = __builtin_amdgcn_cvt_pk_fp8_f32(h[2], h[3], w, true);
        *(unsigned*)(Hd + (size_t)row * ldh + (col >> 1)) = w;
    }
    __device__ __forceinline__ void operator()(const f32x4 (&acc)[2][2][4][2], const Unit& u, int wr, int wc, int fr, int fq) const { walk8(acc, u, wr, wc, fr, fq, *this); }
};
struct EpiScaledBf16 {
    static constexpr bool PERM = true, AFTER_DRAIN = false;
    bf16_t* O; int ldc; float s;
    __device__ __forceinline__ void emit(int row, int col, const float (&v)[8]) const { *(u32x4*)(O + (size_t)row * ldc + col) = pack8(v, s); }
    __device__ __forceinline__ void operator()(const f32x4 (&acc)[2][2][4][2], const Unit& u, int wr, int wc, int fr, int fq) const { walk8(acc, u, wr, wc, fr, fq, *this); }
};
struct GroupedOrder {
    int nM, nN, nwg, G, c; int toff[NEXP_ + 1]; long estride;
    __device__ __forceinline__ bool next(int i, Unit& u) const {
        const long L = (long)i * G + c; if (L >= nwg) return false;
        int wgid = (int)L; { const int q = nwg / NXCD, r = nwg % NXCD, xcd = wgid % NXCD, off = wgid / NXCD; wgid = (xcd < r ? xcd * (q + 1) : r * (q + 1) + (xcd - r) * q) + off; }
        const int nig = WGM * nN, gid = wgid / nig, fm = gid * WGM, gsz = (nM - fm) < WGM ? (nM - fm) : WGM;
        u.pm = fm + ((wgid % nig) % gsz); u.pn = (wgid % nig) / gsz;
        int e = 0;
#pragma unroll
        for (int k = 1; k < NEXP_; ++k) e += (u.pm >= toff[k]) ? 1 : 0;
        u.boff = (long)e * estride; return true;
    }
    __device__ __forceinline__ void a_ready(const Unit&) const {}
    __device__ __forceinline__ void done(const Unit&) const {}
};
}
#define XB_TMO      128
#define XB_XCNT(j)  (256  + 64 * (j))
#define XB_XSUB(j)  (1280 + 64 * (j))
#define XB_XGEN(j)  (2304 + 64 * (j))
#define XB_TOP      3328
#define XB_TOPGEN   3392
#define XCD_BAR_WORDS 3456
#define XB_SPIN_CAP (1u << 18)

__device__ __forceinline__ unsigned xb_ld(unsigned* p)              { return __hip_atomic_load(p, __ATOMIC_RELAXED, __HIP_MEMORY_SCOPE_AGENT); }
__device__ __forceinline__ unsigned xb_add(unsigned* p, unsigned v) { return __hip_atomic_fetch_add(p, v, __ATOMIC_RELAXED, __HIP_MEMORY_SCOPE_AGENT); }
__device__ __forceinline__ unsigned xb_xcc_id() { return (unsigned)__builtin_amdgcn_s_getreg((3 << 11) | 20) & 0xFu; }
#define XB_SPIN(cond, bar) do { unsigned _sp = 0; while (cond) { __builtin_amdgcn_s_sleep(1); \
    if ((++_sp & 255u) == 0u) { if (xb_ld(&(bar)[XB_TMO])) break; if (_sp > XB_SPIN_CAP) { atomicAdd(&(bar)[XB_TMO], 1u); break; } } } } while (0)

struct XcdBarrier {
    unsigned* bar; unsigned x;
    volatile LAS unsigned* st;
};

__device__ __forceinline__ XcdBarrier xcd_barrier_post(unsigned* bar, volatile LAS unsigned* st) {
    XcdBarrier b; b.bar = bar; b.x = xb_xcc_id(); b.st = st;
    if (threadIdx.x == 0) (void)xb_add(&bar[XB_XCNT(b.x)], 1u);
    return b;
}
__device__ __forceinline__ void xcd_barrier_complete(unsigned* bar, unsigned x, unsigned& nloc, unsigned& nx) {
    const unsigned G = gridDim.x * gridDim.y * gridDim.z;
    unsigned sum, cnt, mine, sp = 0u;
    for (;;) {
        sum = 0u; cnt = 0u; mine = 0u;
#pragma unroll
        for (unsigned j = 0; j < 16; ++j) { const unsigned c = xb_ld(&bar[XB_XCNT(j)]); sum += c; cnt += (c > 0u) ? 1u : 0u; mine = (j == x) ? c : mine; }
        if (sum == G) break;
        __builtin_amdgcn_s_sleep(1);
        if ((++sp & 255u) == 0u) { if (xb_ld(&bar[XB_TMO])) break; if (sp > XB_SPIN_CAP) { atomicAdd(&bar[XB_TMO], 1u); break; } }
    }
    nloc = mine > 0u ? mine : 1u; nx = cnt > 0u ? cnt : 1u;
}

__device__ __forceinline__ void xcd_barrier(const XcdBarrier& b) {
    asm volatile("s_waitcnt vmcnt(0)" ::: "memory");
    __syncthreads();
    if (threadIdx.x == 0) {
        unsigned* bar = b.bar;
        __builtin_amdgcn_s_waitcnt(0);
        unsigned nloc = b.st[0], nx = b.st[1];
        if (nloc == 0u) { xcd_barrier_complete(bar, b.x, nloc, nx); b.st[0] = nloc; b.st[1] = nx; }
        const unsigned old = xb_add(&bar[XB_XSUB(b.x)], 1u);
        const unsigned gen = old / nloc;
        if (old + 1u == (gen + 1u) * nloc) {
            __builtin_amdgcn_fence(__ATOMIC_RELEASE, "agent");
            asm volatile("s_waitcnt vmcnt(0)" ::: "memory");
            const unsigned og = xb_add(&bar[XB_TOP], 1u);
            const unsigned tg = og / nx;
            if (og + 1u == (tg + 1u) * nx) xb_add(&bar[XB_TOPGEN], 1u);
            else XB_SPIN(xb_ld(&bar[XB_TOPGEN]) == tg, bar);
            __builtin_amdgcn_fence(__ATOMIC_ACQUIRE, "agent");
            xb_add(&bar[XB_XGEN(b.x)], 1u);
            asm volatile("s_waitcnt vmcnt(0)" ::: "memory");
        } else {
            XB_SPIN(xb_ld(&bar[XB_XGEN(b.x)]) == gen, bar);
            __builtin_amdgcn_fence(__ATOMIC_ACQUIRE, "agent");
            asm volatile("s_waitcnt vmcnt(0)" ::: "memory");
        }
    }
    __syncthreads();
}
struct Frame {
    LAS unsigned char* lds;
    gu32* ctl;
    unsigned char* ws;
    int tid, lane, wave, vcu, G;
};
struct Args { const float* in[30]; float* out; unsigned char* ws; int ph_lo, ph_hi; };
struct InTab { LAS unsigned long long* t;
    __device__ __forceinline__ const float* operator[](int i) const { const unsigned long long v = t[i]; const unsigned lo = __builtin_amdgcn_readfirstlane((unsigned)v), hi = __builtin_amdgcn_readfirstlane((unsigned)(v >> 32)); return (const float*)(((unsigned long long)hi << 32) | lo); } };
struct PArgs { InTab in; float* out; };
#define LDS_WAIT() asm volatile("s_waitcnt lgkmcnt(0)" ::: "memory")
#define VM_WAIT() asm volatile("s_waitcnt vmcnt(0)" ::: "memory")
enum { I_X = 0, I_C, I_CTX, I_CCTX, I_ADAW, I_ADAB, I_LN1G, I_LN1B, I_LN2G, I_LN2B, I_EVWIN, I_QNG, I_KNG, I_CQG, I_CKVG, I_WUQ, I_WUKV, I_EVWOUT,
       I_FFG, I_FFU, I_FFD, I_ODWIN, I_RPB, I_LBL, I_ONG, I_ODWOUT, I_ROUTER, I_MG, I_MU, I_MD };

__device__ __forceinline__ void cvt_item(const float* src0, const float* src1, int K, int N, int Np, bf16* dst, int mode, int item, LAS float* scr, int lane, bool f8 = false) {
    const int nblk = Np >> 5, kb = item / nblk, nb = item - kb * nblk, k0 = 64 * kb, n0 = 32 * nb;
    const int np = n0 + (lane & 31);
    const float* src = src0; int col = np; bool ok = np < N;
    if (mode == 1) { const int head = np / 96, c = np - head * 96; if (c >= 64) { const int r = c - 64, g = r >> 3, e = r & 7; const int base = (g >> 1) * 16 + (g & 1) * 4; col = head * 96 + 64 + base + (e < 4 ? e : 8 + (e - 4)); } }
    else if (mode == 2) { src = (np & 4) ? src1 : src0; col = ((np >> 3) << 2) + (np & 3); ok = true; }
    float rr[32];
    { const GAS float* sp_ = (const GAS float*)src + (size_t)(k0 + (lane >> 5)) * N + col;
#pragma unroll
      for (int i = 0; i < 32; ++i) rr[i] = ok ? sp_[(size_t)(2 * i) * N] : 0.f; }
#pragma unroll
    for (int i = 0; i < 32; ++i) { const int kk = 2 * i + (lane >> 5); scr[kk * 33 + (lane & 31)] = rr[i]; }
    LDS_WAIT(); asm volatile("" ::: "memory");
    const int c8 = lane & 7;
    if (f8) {
        unsigned char* d8 = (unsigned char*)dst;
#pragma unroll
        for (int j = 0; j < 4; ++j) { const int n = (lane >> 3) + 8 * j; const LAS float* s = scr + (8 * c8) * 33 + n;
            unsigned w0 = 0u, w1 = 0u;
            w0 = __builtin_amdgcn_cvt_pk_fp8_f32(s[0 * 33] * MOE_WSCALE, s[1 * 33] * MOE_WSCALE, w0, false); w0 = __builtin_amdgcn_cvt_pk_fp8_f32(s[2 * 33] * MOE_WSCALE, s[3 * 33] * MOE_WSCALE, w0, true);
            w1 = __builtin_amdgcn_cvt_pk_fp8_f32(s[4 * 33] * MOE_WSCALE, s[5 * 33] * MOE_WSCALE, w1, false); w1 = __builtin_amdgcn_cvt_pk_fp8_f32(s[6 * 33] * MOE_WSCALE, s[7 * 33] * MOE_WSCALE, w1, true);
            *(GAS v2u*)(d8 + (size_t)(n0 + n) * K + k0 + 8 * c8) = (v2u){w0, w1}; }
    } else {
#pragma unroll
        for (int j = 0; j < 4; ++j) { const int n = (lane >> 3) + 8 * j; const LAS float* s = scr + (8 * c8) * 33 + n;
            v4u o; o.x = pkbf(s[0 * 33], s[1 * 33]); o.y = pkbf(s[2 * 33], s[3 * 33]); o.z = pkbf(s[4 * 33], s[5 * 33]); o.w = pkbf(s[6 * 33], s[7 * 33]);
            *(GAS v4u*)(dst + (size_t)(n0 + n) * K + k0 + 8 * c8) = o; }
    }
    LDS_WAIT(); asm volatile("" ::: "memory");
}
__device__ __forceinline__ void sincos_red(float ang, float& s, float& c) {
    const float n = __builtin_rintf(ang * 0.636619772367581343f);
    float y = __builtin_fmaf(-n, 1.5703125f, ang); y = __builtin_fmaf(-n, 4.837512969970703125e-4f, y); y = __builtin_fmaf(-n, 7.54978995489188e-8f, y);
    const float z = y * y;
    const float sy = y + y * z * (-1.6666654611e-1f + z * (8.3321608736e-3f + z * (-1.9515295891e-4f)));
    const float cy = 1.0f - 0.5f * z + z * z * (4.166664568298827e-2f + z * (-1.388731625493765e-3f + z * 2.443315711809948e-5f));
    const int q = ((int)n) & 3;
    s = (q == 0) ? sy : (q == 1) ? cy : (q == 2) ? -sy : -cy;
    c = (q == 0) ? cy : (q == 1) ? -sy : (q == 2) ? -cy : sy;
}
__device__ __forceinline__ float inv_freq_pow(double r, int f) { double v = 1.0; for (int i = 0; i < f; ++i) v *= r; return (float)v; }

__device__ __forceinline__ void phase_cv(Frame& F, const PArgs& A, int j) {
    const int gw = F.vcu * NWAVES + F.wave, NGW = F.G * NWAVES;
    float* mods = (float*)(F.ws + WS_SMALL + SM_MODS);
    if (j == 0) {
        LAS float* Ssm = (LAS float*)F.lds;
        LAS float* Psm = (LAS float*)(F.lds + 20480);
        if ((int)blockIdx.x < 192) {
            for (int i = F.tid; i < 5 * 1024; i += NTHR) { const int r = i >> 10, k = i & 1023; const float cv = (r < 4) ? A.in[I_C][r * 1024 + k] : A.in[I_CCTX][k]; Ssm[i] = cv * frcp(1.f + __expf(-cv)); }
            __syncthreads();
            for (int u = blockIdx.x; u < 192; u += F.G) {
                const int l = u / 48, n = (u - l * 48) * 128 + 2 * F.lane;
                float a0[5] = {0.f, 0.f, 0.f, 0.f, 0.f}, a1[5] = {0.f, 0.f, 0.f, 0.f, 0.f};
                const float* wp = A.in[I_ADAW] + ((size_t)l * 1024 + F.wave * 128) * 6144 + n;
#pragma unroll 16
                for (int k = 0; k < 128; ++k) { const f32x2_t w = *(const GAS f32x2_t*)(wp + (size_t)k * 6144); const int kk = F.wave * 128 + k;
#pragma unroll
                    for (int r = 0; r < 5; ++r) { const float sv = Ssm[r * 1024 + kk]; a0[r] += sv * w.x; a1[r] += sv * w.y; } }
#pragma unroll
                for (int r = 0; r < 5; ++r) { Psm[(F.wave * 5 + r) * 128 + 2 * F.lane] = a0[r]; Psm[(F.wave * 5 + r) * 128 + 2 * F.lane + 1] = a1[r]; }
                __syncthreads();
                for (int i = F.tid; i < 640; i += NTHR) { const int r = i >> 7, c = i & 127; float s = 0.f;
#pragma unroll
                    for (int w = 0; w < 8; ++w) s += Psm[(w * 5 + r) * 128 + c];
                    const int nn = (u - l * 48) * 128 + c; mods[((size_t)l * 5 + r) * 6144 + nn] = s + A.in[I_ADAB][l * 6144 + nn]; }
                __syncthreads();
            }
        } else if ((int)blockIdx.x == 192) {
            float* ra = (float*)(F.ws + WS_SMALL + SM_ROPEA); float* rb = (float*)(F.ws + WS_SMALL + SM_ROPEB); float* lb = (float*)(F.ws + WS_SMALL + SM_LB);
            for (int i = F.tid; i < 128 * 16; i += NTHR) { const int pos = i >> 4, f = i & 15; const float inv = inv_freq_pow(0.56234132519034908, f); float s, c; sincos_red((float)pos * inv, s, c); ra[2 * i] = c; ra[2 * i + 1] = s; }
            for (int i = F.tid; i < 128 * 8; i += NTHR) { const int pos = i >> 3, f = i & 7; const float inv = inv_freq_pow(0.31622776601683794, f); float s, c; sincos_red((float)pos * inv, s, c); rb[2 * i] = c; rb[2 * i + 1] = s; }
            for (int i = F.tid; i < 2 * 512; i += NTHR) { const int dir = i >> 9, c = i & 511; const float l0 = A.in[I_LBL][(dir * 2 + 0) * 512 + c], l1 = A.in[I_LBL][(dir * 2 + 1) * 512 + c];
                const float mx = fmaxf(l0, l1), e0 = __expf(l0 - mx), e1 = __expf(l1 - mx), p0 = e0 / (e0 + e1), p1 = e1 / (e0 + e1);
                lb[(0 * 2 + dir) * 512 + c] = p0 - p0; lb[(1 * 2 + dir) * 512 + c] = (p0 + p1) - p0; }
        }
        __syncthreads();
    }
    LAS float* scr = (LAS float*)(F.lds + 49152 + F.wave * 8704);
    bf16* W = (bf16*)(F.ws + WS_W); bf16* WM = (bf16*)(F.ws + WS_WMOE);
    constexpr int N1 = 2 * 768, N2 = 2 * 144, N3 = 2 * 128, N4 = 2 * 512, N5 = 2 * 2816, N6 = 2 * 1408, N7 = 2 * 2048, N8 = 2 * 512, N9 = 8 * 3584, N10 = 8 * 1792;
    const int nfix = (j == 0) ? (N1 + N2 + N3 + N4 + N5 + N6 + N7 + N8) : 0;
    const int total = nfix + N9 + N10;
    for (int it = gw; it < total; it += NGW) {
        int r = it; const float* s0; const float* s1 = nullptr; int K, N, Np, mode = 0, item; bf16* d; bool f8 = false;
        if (r >= nfix) { r -= nfix;
            if (r < N9) { const int e = r / 3584; item = r - e * 3584; const size_t so = ((size_t)(j * 8 + e)) * 1024 * 3584; s0 = A.in[I_MG] + so; s1 = A.in[I_MU] + so; K = 1024; N = 3584; Np = 7168; mode = 2; f8 = true; d = (bf16*)((unsigned char*)WM + WM_GU + (size_t)e * 7168 * 1024); }
            else { r -= N9; const int e = r / 1792; item = r - e * 1792; s0 = A.in[I_MD] + ((size_t)(j * 8 + e)) * 3584 * 1024; K = 3584; N = 1024; Np = 1024; f8 = true; d = (bf16*)((unsigned char*)WM + WM_D + (size_t)e * 1024 * 3584); }
        } else if (r < N1) { const int b = r / 768; item = r - b * 768; s0 = A.in[I_EVWIN] + (size_t)b * 1024 * EV_IN; K = 1024; N = EV_IN; Np = EV_INP; d = W + W_EVIN + (size_t)b * EV_INP * 1024; }
        else if ((r -= N1) < N2) { const int b = r / 144; item = r - b * 144; s0 = A.in[I_WUQ] + (size_t)b * 384 * 768; K = 384; N = 768; Np = 768; mode = 1; d = W + W_UQ + (size_t)b * 768 * 384; }
        else if ((r -= N2) < N3) { const int b = r / 128; item = r - b * 128; s0 = A.in[I_WUKV] + (size_t)b * 256 * 1024; K = 256; N = 1024; Np = 1024; d = W + W_UKV + (size_t)b * 1024 * 256; }
        else if ((r -= N3) < N4) { const int b = r / 512; item = r - b * 512; s0 = A.in[I_EVWOUT] + (size_t)b * 1024 * 1024; K = 1024; N = 1024; Np = 1024; d = W + W_EVOUT + (size_t)b * 1024 * 1024; }
        else if ((r -= N4) < N5) { const int b = r / 2816; item = r - b * 2816; s0 = A.in[I_FFG] + (size_t)b * 1024 * DFF; s1 = A.in[I_FFU] + (size_t)b * 1024 * DFF; K = 1024; N = DFF; Np = 2 * DFF; mode = 2; f8 = FFN_F8; d = FFN_F8 ? (bf16*)((unsigned char*)(W + W_FFGU) + (size_t)b * 2 * DFF * 1024) : W + W_FFGU + (size_t)b * 2 * DFF * 1024; }
        else if ((r -= N5) < N6) { const int b = r / 1408; item = r - b * 1408; s0 = A.in[I_FFD] + (size_t)b * DFF * 1024; K = DFF; N = 1024; Np = 1024; d = W + W_FFD + (size_t)b * 1024 * DFF; }
        else if ((r -= N6) < N7) { const int b = r / 2048; item = r - b * 2048; s0 = A.in[I_ODWIN] + (size_t)b * 1024 * 4096; K = 1024; N = 4096; Np = 4096; d = W + W_ODIN + (size_t)b * 4096 * 1024; }
        else { r -= N7; const int b = r / 512; item = r - b * 512; s0 = A.in[I_ODWOUT] + (size_t)b * 1024 * 1024; K = 1024; N = 1024; Np = 1024; d = W + W_ODOUT + (size_t)b * 1024 * 1024; }
        cvt_item(s0, s1, K, N, Np, d, mode, item, scr, F.lane, f8);
    }
}

__device__ __forceinline__ void store_bf16_row(bf16* orow, int lane, const f32x4 (&v)[4]) {
    GAS unsigned long long* o8 = (GAS unsigned long long*)orow + lane;
#pragma unroll
    for (int j = 0; j < 4; ++j) o8[64 * j] = (unsigned long long)pkbf(v[j].x, v[j].y) | ((unsigned long long)pkbf(v[j].z, v[j].w) << 32);
}
__device__ __forceinline__ void phase_mod(Frame& F, const PArgs& A) {
    const int gw = F.vcu * NWAVES + F.wave, NGW = F.G * NWAVES;
    const float* mods = (const float*)(F.ws + WS_SMALL + SM_MODS);
    bf16* H = (bf16*)(F.ws + WS_H);
    for (int m = gw; m < MROWS; m += NGW) {
        const float* src = (m < MLAT) ? A.in[I_X] + (size_t)m * 1024 : A.in[I_CTX] + (size_t)(m - MLAT) * 1024;
        const float* md = mods + (size_t)modrow(m) * 6144;
        f32x4 v[4], h[4];
#pragma unroll
        for (int j = 0; j < 4; ++j) { v[j] = *((const f32x4*)src + F.lane + 64 * j); const f32x4 sh = *((const f32x4*)md + F.lane + 64 * j), sc = *((const f32x4*)(md + 1024) + F.lane + 64 * j);
            h[j] = v[j] * (sc + 1.0f) + sh; }
        store_bf16_row(H + (size_t)m * 1024, F.lane, h);
    }
}
template <bool MOE, bool ROUTER, bool H8 = false>
__device__ __forceinline__ void phase_ln(Frame& F, const PArgs& A, const float* lng, const float* lnb, const float* mshift  , const float* g5  ,
                                         const float* router, int jodd, bool last, int nrows = MROWS) {
    const int gw = F.vcu * NWAVES + F.wave, NGW = F.G * NWAVES;
#define LNCH(j_) (2 * F.lane + ((j_) & 1) + 128 * ((j_) >> 1))
    bf16* X = (bf16*)(F.ws + WS_X); bf16* H = (bf16*)(F.ws + WS_H);
    int* topk = (int*)(F.ws + WS_TOPK);
    const bf16* Y = (const bf16*)(F.ws + WS_XG);
    LAS unsigned* lcnt = (LAS unsigned*)(F.lds);
    if (ROUTER) { if (F.tid < 8) lcnt[F.tid] = 0u; __syncthreads(); }
    f32x4 gv[4], bv[4];
#pragma unroll
    for (int j = 0; j < 4; ++j) { gv[j] = *((const f32x4*)lng + LNCH(j)); bv[j] = *((const f32x4*)lnb + LNCH(j)); }
    f32x4 rwa[4][4], rwb[4][4];
    if (ROUTER) {
#pragma unroll
        for (int j = 0; j < 4; ++j)
#pragma unroll
            for (int i = 0; i < 4; ++i) { const float* rp = router + (size_t)(4 * LNCH(j) + i) * 8; rwa[j][i] = *(const GAS f32x4*)rp; rwb[j][i] = *(const GAS f32x4*)(rp + 4); }
    }
    for (int m = gw; m < nrows; m += NGW) {
        bf16* xr = X + (size_t)m * 1024; const int mr = modrow(m);
        f32x4 v[4];
        if (MOE) {
#pragma unroll
            for (int jj = 0; jj < 2; ++jj) { const v4u xx = *((const GAS v4u*)xr + F.lane + 64 * jj);
                v[2 * jj] = __builtin_convertvector(__builtin_bit_cast(h16x4, (v2u){xx.x, xx.y}), f32x4); v[2 * jj + 1] = __builtin_convertvector(__builtin_bit_cast(h16x4, (v2u){xx.z, xx.w}), f32x4); }
        } else {
            const bf16* zr = (const bf16*)(F.ws + WS_ZR) + (size_t)m * 1024;
#pragma unroll
            for (int jj = 0; jj < 2; ++jj) { const v4u zz = *((const GAS v4u*)zr + F.lane + 64 * jj);
                v[2 * jj] = __builtin_convertvector(__builtin_bit_cast(h16x4, (v2u){zz.x, zz.y}), f32x4); v[2 * jj + 1] = __builtin_convertvector(__builtin_bit_cast(h16x4, (v2u){zz.z, zz.w}), f32x4); }
        }
        if (MOE) {
            const int r1 = topk[m * 6 + 4], r2 = topk[m * 6 + 5]; const float w1 = __int_as_float(topk[m * 6 + 2]), w2 = __int_as_float(topk[m * 6 + 3]);
            const float* gg = g5 + (size_t)mr * 6144;
#pragma unroll
            for (int j = 0; j < 4; ++j) { const v2u y1 = *((const v2u*)(Y + (size_t)r1 * 1024) + LNCH(j)), y2 = *((const v2u*)(Y + (size_t)r2 * 1024) + LNCH(j));
                const f32x4 gq = *((const f32x4*)gg + LNCH(j));
                f32x4 yy; yy.x = w1 * bf_lo(y1.x) + w2 * bf_lo(y2.x); yy.y = w1 * bf_hi(y1.x) + w2 * bf_hi(y2.x); yy.z = w1 * bf_lo(y1.y) + w2 * bf_lo(y2.y); yy.w = w1 * bf_hi(y1.y) + w2 * bf_hi(y2.y);
                v[j] = v[j] * ALPHA + gq * yy; }
        }
        float s = 0.f;
#pragma unroll
        for (int j = 0; j < 4; ++j) s += (v[j].x + v[j].y) + (v[j].z + v[j].w);
        const float mean = wave_sum(s, F.lane) * (1.f / 1024.f); float s2 = 0.f;
#pragma unroll
        for (int j = 0; j < 4; ++j) { v[j] = v[j] - mean; s2 += (v[j].x * v[j].x + v[j].y * v[j].y) + (v[j].z * v[j].z + v[j].w * v[j].w); }
        const float rstd = __builtin_amdgcn_rsqf(wave_sum(s2, F.lane) * (1.f / 1024.f) + 1e-6f);
#pragma unroll
        for (int j = 0; j < 4; ++j) v[j] = v[j] * rstd * gv[j] + bv[j];
        if (!last) {
#pragma unroll
            for (int jj = 0; jj < 2; ++jj) *((GAS v4u*)xr + F.lane + 64 * jj) = (v4u){pkh(v[2 * jj].x, v[2 * jj].y), pkh(v[2 * jj].z, v[2 * jj].w), pkh(v[2 * jj + 1].x, v[2 * jj + 1].y), pkh(v[2 * jj + 1].z, v[2 * jj + 1].w)}; }
#if defined(SELFCHK)
        if (last) { const float cn = __hip_atomic_load((const float*)(F.ctl + 12288), __ATOMIC_RELAXED, __HIP_MEMORY_SCOPE_AGENT), cd = __hip_atomic_load((const float*)(F.ctl + 12288) + 1, __ATOMIC_RELAXED, __HIP_MEMORY_SCOPE_AGENT);
            const float cscale = 1.f + sqrtf(cn / fmaxf(cd, 1e-30f));
#pragma unroll
            for (int j = 0; j < 4; ++j) v[j] = v[j] * cscale; }
#endif
        if (last) { if (m < MLAT) {
#pragma unroll
                for (int j = 0; j < 4; ++j) *((f32x4*)(A.out + (size_t)m * 1024) + LNCH(j)) = v[j]; }
            continue; }
        const float* md = mshift + (size_t)mr * 6144;
#pragma unroll
        for (int j = 0; j < 4; ++j) { const f32x4 sh = *((const f32x4*)md + LNCH(j)), sc = *((const f32x4*)(md + 1024) + LNCH(j)); v[j] = v[j] * (sc + 1.0f) + sh; }
        if (H8) {
#pragma unroll
            for (int jj = 0; jj < 2; ++jj) { unsigned w0 = 0u, w1 = 0u;
                w0 = __builtin_amdgcn_cvt_pk_fp8_f32(v[2 * jj].x, v[2 * jj].y, w0, false); w0 = __builtin_amdgcn_cvt_pk_fp8_f32(v[2 * jj].z, v[2 * jj].w, w0, true);
                w1 = __builtin_amdgcn_cvt_pk_fp8_f32(v[2 * jj + 1].x, v[2 * jj + 1].y, w1, false); w1 = __builtin_amdgcn_cvt_pk_fp8_f32(v[2 * jj + 1].z, v[2 * jj + 1].w, w1, true);
                *((GAS v2u*)((unsigned char*)H + (size_t)m * 1024) + F.lane + 64 * jj) = (v2u){w0, w1}; }
        } else {
#pragma unroll
            for (int jj = 0; jj < 2; ++jj) *((GAS v4u*)(H + (size_t)m * 1024) + F.lane + 64 * jj) = (v4u){pkbf(v[2 * jj].x, v[2 * jj].y), pkbf(v[2 * jj].z, v[2 * jj].w), pkbf(v[2 * jj + 1].x, v[2 * jj + 1].y), pkbf(v[2 * jj + 1].z, v[2 * jj + 1].w)}; }
        if (ROUTER) {
            float pa[8] = {0.f, 0.f, 0.f, 0.f, 0.f, 0.f, 0.f, 0.f};
#pragma unroll
            for (int j = 0; j < 4; ++j)
#pragma unroll
                for (int i = 0; i < 4; ++i) { const float hv = v[j][i]; const f32x4 ra = rwa[j][i], rb = rwb[j][i];
                    pa[0] += hv * ra.x; pa[1] += hv * ra.y; pa[2] += hv * ra.z; pa[3] += hv * ra.w; pa[4] += hv * rb.x; pa[5] += hv * rb.y; pa[6] += hv * rb.z; pa[7] += hv * rb.w; }
            float lg[8];
            { const bool b5 = (F.lane & 32) != 0, b4 = (F.lane & 16) != 0, b3 = (F.lane & 8) != 0; float q4[4], q2[2];
#pragma unroll
              for (int k = 0; k < 4; ++k) { const float snd = b5 ? pa[k] : pa[k + 4], own = b5 ? pa[k + 4] : pa[k]; q4[k] = own + shx(snd, 32, F.lane); }
#pragma unroll
              for (int k = 0; k < 2; ++k) { const float snd = b4 ? q4[k] : q4[k + 2], own = b4 ? q4[k + 2] : q4[k]; q2[k] = own + shx(snd, 16, F.lane); }
              float q1 = (b3 ? q2[1] : q2[0]) + shx(b3 ? q2[0] : q2[1], 8, F.lane);
              q1 += shx(q1, 4, F.lane); q1 += shx(q1, 2, F.lane); q1 += shx(q1, 1, F.lane);
#pragma unroll
              for (int e = 0; e < 8; ++e) lg[e] = __builtin_bit_cast(float, __builtin_amdgcn_readlane(__builtin_bit_cast(int, q1), 32 * (e >> 2) + 16 * ((e >> 1) & 1) + 8 * (e & 1))); }
            int e1 = 0; float v1 = lg[0];
#pragma unroll
            for (int e = 1; e < 8; ++e) if (lg[e] > v1) { v1 = lg[e]; e1 = e; }
            int e2 = -1; float v2 = -INFINITY;
#pragma unroll
            for (int e = 0; e < 8; ++e) if (e != e1 && lg[e] > v2) { v2 = lg[e]; e2 = e; }
            const float w1 = frcp(1.f + __expf(v2 - v1)), w2 = 1.f - w1;
            if (F.lane == 0) { topk[m * 6 + 0] = e1; topk[m * 6 + 1] = e2; topk[m * 6 + 2] = __float_as_int(w1); topk[m * 6 + 3] = __float_as_int(w2);
                atomicAdd((unsigned*)&lcnt[e1], 1u); atomicAdd((unsigned*)&lcnt[e2], 1u); }
        }
    }
    if (ROUTER) { LDS_WAIT(); __syncthreads(); if (F.tid < 8) __hip_atomic_fetch_add((unsigned*)(F.ctl + CW_CNT + 64 * jodd) + F.tid, lcnt[F.tid], __ATOMIC_RELAXED, __HIP_MEMORY_SCOPE_AGENT); }
}
#undef LNCH
typedef short v4i16_t __attribute__((ext_vector_type(4)));
__device__ __forceinline__ int crow(int r, int hi) { return (r & 3) + 8 * (r >> 2) + 4 * hi; }
__device__ __forceinline__ float swap_max(float m) { auto rr = __builtin_amdgcn_permlane32_swap(__float_as_uint(m), __float_as_uint(m), false, false); return fmaxf(__uint_as_float(rr[0]), __uint_as_float(rr[1])); }
__device__ __forceinline__ float swap_sum(float m) { auto rr = __builtin_amdgcn_permlane32_swap(__float_as_uint(m), __float_as_uint(m), false, false); return __uint_as_float(rr[0]) + __uint_as_float(rr[1]); }

#ifndef ATT_THR
#define ATT_THR 6.f
#endif
template <int DK, int MODE>
__device__ __forceinline__ void attn_unit(LAS unsigned char* lds, int tid, const bf16* Q, int qp, const bf16* K1, const bf16* V1, int nt1, const bf16* K2, const bf16* V2, int nt2,
                                          int kp, int vp, bf16* O, int op, int rq0, int kr0, const float* rpbh) {
    constexpr int KROW = DK * 2 + 16, KSZ = 64 * KROW, CPK = DK / 8  , NPK = 64 * CPK;
    constexpr int VB = 4 * KSZ, SCR = VB + 4 * 8192, BIAS = SCR + 2048;
    const int lane = tid & 63, r32 = lane & 31, hi = lane >> 5; const int wid = __builtin_amdgcn_readfirstlane(tid >> 6);
    const int NT = nt1 + nt2;
    LAS float* wsf = (LAS float*)(lds + SCR) + wid * 64;
    const int kkey0 = tid / CPK, kch0 = tid - kkey0 * CPK;
    const int kkey1 = (tid + 512) / CPK, kch1 = (tid + 512) - kkey1 * CPK;
    const bool two = (NPK > 512) && (tid + 512 < NPK);
    const int vkey = tid >> 3, vch = tid & 7;
    const int vdst = ((vkey >> 3) * 2 + (vch >> 2)) * 512 + (vkey & 7) * 64 + (vch & 3) * 16;
    v4u kA0, kA1 = {0u, 0u, 0u, 0u}, vA, kB0, kB1 = {0u, 0u, 0u, 0u}, vB;
#define ATT_LOAD(t, K0_, K1_, V_) do { const int t_ = (t); const bf16* kb_ = (t_ < nt1) ? K1 + (size_t)t_ * 64 * kp : K2 + (size_t)(t_ - nt1) * 64 * kp; \
        const bf16* vb_ = (t_ < nt1) ? V1 + (size_t)t_ * 64 * vp : V2 + (size_t)(t_ - nt1) * 64 * vp; \
        K0_ = *(const GAS v4u*)(kb_ + (size_t)kkey0 * kp + kch0 * 8); if (two) K1_ = *(const GAS v4u*)(kb_ + (size_t)kkey1 * kp + kch1 * 8); \
        V_ = *(const GAS v4u*)(vb_ + (size_t)vkey * vp + vch * 8); } while (0)
#define ATT_STORE(buf, K0_, K1_, V_) do { LAS unsigned char* kd_ = lds + (buf) * KSZ; *(LAS v4u*)(kd_ + kkey0 * KROW + kch0 * 16) = K0_; if (two) *(LAS v4u*)(kd_ + kkey1 * KROW + kch1 * 16) = K1_; \
        *(LAS v4u*)(lds + VB + (buf) * 8192 + vdst) = V_; } while (0)
    ATT_LOAD(0, kA0, kA1, vA); if (NT > 1) ATT_LOAD(1, kB0, kB1, vB);
    if (MODE == 1) { LAS float* bs = (LAS float*)(lds + BIAS); for (int i = tid; i < 15 * 31; i += NTHR) bs[i] = rpbh[i] * LOG2E; }
    bf16x8 qr[DK / 16];
#pragma unroll
    for (int d0 = 0; d0 < DK / 16; ++d0) qr[d0] = *(const GAS bf16x8*)(Q + (size_t)(wid * 32 + r32) * qp + d0 * 16 + hi * 8);
    ATT_STORE(0, kA0, kA1, vA); if (NT > 1) ATT_STORE(1, kB0, kB1, vB);
    __syncthreads();
    float m_run = 0.f, l_run = 0.f; f32x16 o0, o1, negm;
    { float zz; asm volatile("v_mov_b32 %0, 0" : "=v"(zz));
#pragma unroll
      for (int r = 0; r < 16; ++r) { o0[r] = zz; o1[r] = zz; negm[r] = zz; } }
    const int rq = rq0 + (wid >> 1), rsq = min(max(rq - 4, 0), 120), qc = (wid & 1) * 32 + r32, cs = min(max(qc - 8, 0), 48);
    unsigned nmask0 = 0u, nmask1 = 0u;
    if (MODE == 1) {
#pragma unroll
        for (int r = 0; r < 16; ++r) { const int kc0 = crow(r, hi), kc1 = kc0 + 32; nmask0 |= ((kc0 >= cs) && (kc0 < cs + 16)) ? (1u << r) : 0u; nmask1 |= ((kc1 >= cs) && (kc1 < cs + 16)) ? (1u << r) : 0u; } }
    const int koff = r32 * KROW + hi * 16;
    const int vlane = (4 * hi + ((lane & 15) >> 2)) * 64 + ((lane >> 4) & 1) * 32 + (lane & 3) * 8;
#define ATT_TILE(tt) do { const int t_c = (tt); const int buf = t_c & 3; \
        bool act = true; int kr = 0; \
        if (MODE == 1) { kr = kr0 + t_c; act = (t_c >= nt1) || (kr >= rsq && kr < rsq + 8); } \
        if (act) { \
            const LAS unsigned char* kb = lds + buf * KSZ + koff; \
            f32x16 s0, s1; bf16x8 ka0[DK / 16], ka1[DK / 16]; \
            _Pragma("unroll") for (int d0 = 0; d0 < DK / 16; ++d0) { ka0[d0] = *(const LAS bf16x8*)(kb + d0 * 32); ka1[d0] = *(const LAS bf16x8*)(kb + 32 * KROW + d0 * 32); } \
            __builtin_amdgcn_sched_barrier(0);            \
            _Pragma("unroll") for (int d0 = 0; d0 < DK / 16; ++d0) { \
                if (d0 == 0) { s0 = __builtin_amdgcn_mfma_f32_32x32x16_bf16(ka0[0], qr[0], negm, 0, 0, 0); s1 = __builtin_amdgcn_mfma_f32_32x32x16_bf16(ka1[0], qr[0], negm, 0, 0, 0); } \
                else { s0 = __builtin_amdgcn_mfma_f32_32x32x16_bf16(ka0[d0], qr[d0], s0, 0, 0, 0); s1 = __builtin_amdgcn_mfma_f32_32x32x16_bf16(ka1[d0], qr[d0], s1, 0, 0, 0); } } \
            const LAS unsigned char* vb = lds + VB + buf * 8192 + vlane; \
            v4i16_t vlo[8], vhh[8]; \
            _Pragma("unroll") for (int i = 0; i < 8; ++i) { const int ks = i >> 1, db = i & 1; \
                vlo[i] = __builtin_amdgcn_ds_read_tr16_b64_v4i16((LAS v4i16_t*)(vb + ((ks * 2 + 0) * 2 + db) * 512)); \
                vhh[i] = __builtin_amdgcn_ds_read_tr16_b64_v4i16((LAS v4i16_t*)(vb + ((ks * 2 + 1) * 2 + db) * 512)); } \
            __builtin_amdgcn_sched_barrier(0);            \
            if (MODE == 1) { if (t_c < nt1) { \
                unsigned bo_ = (unsigned)(size_t)((const LAS float*)(lds + BIAS) + (kr - rq + 7) * 31 - qc + 15 + 4 * hi); asm volatile("" : "+v"(bo_)); \
                const LAS float* bs = (const LAS float*)(size_t)bo_;        \
                _Pragma("unroll") for (int r = 0; r < 16; ++r) { const int kk_ = (r & 3) + 8 * (r >> 2); \
                    const float b0 = bs[kk_], b1 = bs[kk_ + 32]; \
                    s0[r] = ((nmask0 >> r) & 1u) ? s0[r] + b0 : -INFINITY; s1[r] = ((nmask1 >> r) & 1u) ? s1[r] + b1 : -INFINITY; } } } \
            float ma = __builtin_fmaxf(__builtin_fmaxf(s0[0], s0[1]), s1[0]), mb = __builtin_fmaxf(__builtin_fmaxf(s0[2], s0[3]), s1[1]); \
            ma = __builtin_fmaxf(__builtin_fmaxf(ma, s1[2]), s1[3]); \
            _Pragma("unroll") for (int r = 4; r < 16; r += 4) { ma = __builtin_fmaxf(__builtin_fmaxf(ma, s0[r]), s0[r + 1]); mb = __builtin_fmaxf(__builtin_fmaxf(mb, s0[r + 2]), s0[r + 3]); \
                ma = __builtin_fmaxf(__builtin_fmaxf(ma, s1[r]), s1[r + 1]); mb = __builtin_fmaxf(__builtin_fmaxf(mb, s1[r + 2]), s1[r + 3]); } \
            const float mx = swap_max(__builtin_fmaxf(ma, mb)); \
            if (__any(mx > ATT_THR)) {        \
                const float dl = __builtin_fmaxf(mx, 0.f); m_run += dl; const float f = fast_exp2(-dl); l_run *= f; if (hi == 0) wsf[r32] = f; LDS_WAIT(); \
                _Pragma("unroll") for (int r = 0; r < 16; ++r) { const float fr_ = wsf[crow(r, hi)]; o0[r] *= fr_; o1[r] *= fr_; s0[r] -= dl; s1[r] -= dl; } \
                _Pragma("unroll") for (int r = 0; r < 16; ++r) negm[r] = -m_run; \
                asm volatile("" : "+v"(negm)); \
            } \
            float ls = 0.f; \
            _Pragma("unroll") for (int r = 0; r < 16; ++r) { s0[r] = fast_exp2(s0[r]); s1[r] = fast_exp2(s1[r]); ls += s0[r] + s1[r]; } \
            l_run += ls; \
            v4u pw[4]; \
            pw[0] = (v4u){pkbf(s0[0], s0[1]), pkbf(s0[2], s0[3]), pkbf(s0[4], s0[5]), pkbf(s0[6], s0[7])}; \
            pw[1] = (v4u){pkbf(s0[8], s0[9]), pkbf(s0[10], s0[11]), pkbf(s0[12], s0[13]), pkbf(s0[14], s0[15])}; \
            pw[2] = (v4u){pkbf(s1[0], s1[1]), pkbf(s1[2], s1[3]), pkbf(s1[4], s1[5]), pkbf(s1[6], s1[7])}; \
            pw[3] = (v4u){pkbf(s1[8], s1[9]), pkbf(s1[10], s1[11]), pkbf(s1[12], s1[13]), pkbf(s1[14], s1[15])}; \
            __builtin_amdgcn_sched_barrier(0); \
            _Pragma("unroll") for (int ks = 0; ks < 4; ++ks) { \
                const bf16x8 pa = __builtin_bit_cast(bf16x8, pw[ks]); \
                _Pragma("unroll") for (int db = 0; db < 2; ++db) { \
                    const v4i16_t lo = vlo[ks * 2 + db], hh = vhh[ks * 2 + db]; \
                    const bf16x8 vf = (bf16x8){lo[0], lo[1], lo[2], lo[3], hh[0], hh[1], hh[2], hh[3]}; \
                    if (db == 0) o0 = __builtin_amdgcn_mfma_f32_32x32x16_bf16(pa, vf, o0, 0, 0, 0); \
                    else         o1 = __builtin_amdgcn_mfma_f32_32x32x16_bf16(pa, vf, o1, 0, 0, 0); } } \
        } } while (0)
    for (int t = 0; t < NT; t += 2) {
        if (t + 2 < NT) ATT_LOAD(t + 2, kA0, kA1, vA);
        if (t + 3 < NT) ATT_LOAD(t + 3, kB0, kB1, vB);
        ATT_TILE(t);
        if (t + 1 < NT) ATT_TILE(t + 1);
        if (t + 2 < NT) ATT_STORE((t + 2) & 3, kA0, kA1, vA);
        if (t + 3 < NT) ATT_STORE((t + 3) & 3, kB0, kB1, vB);
        __syncthreads();
    }
    const float lt = swap_sum(l_run);
    if (hi == 0) wsf[32 + r32] = frcp(lt);
    LDS_WAIT();
#pragma unroll
    for (int r = 0; r < 16; ++r) { const int q = crow(r, hi); const float il = wsf[32 + q]; bf16* orow = O + (size_t)(wid * 32 + q) * op;
        orow[r32] = f2bf(o0[r] * il); orow[32 + r32] = f2bf(o1[r] * il); }
    __syncthreads();
#undef ATT_LOAD
#undef ATT_STORE
#undef ATT_TILE
}
#define PINF(x_) asm volatile("" : "+v"(x_))
#if defined(PROBE_EXP2X)
#define PROBE_XEXP(x_) do { float dd_; asm volatile("v_exp_f32 %0, %1" : "=v"(dd_) : "v"(x_)); } while (0)
#else
#define PROBE_XEXP(x_) do {} while (0)
#endif
#if defined(PROBE_ACC)
#define PACC_T0(id_) do { if ((id_) == PROBE_ACC && blockIdx.x == 0 && tid == 0) { volatile LAS unsigned* pm_ = (volatile LAS unsigned*)(lds + MISC_OFF); pm_[16] = (unsigned)__builtin_amdgcn_s_memrealtime(); } } while (0)
#define PACC_T1(id_) do { if ((id_) == PROBE_ACC && blockIdx.x == 0 && tid == 0) { volatile LAS unsigned* pm_ = (volatile LAS unsigned*)(lds + MISC_OFF); pm_[18] += (unsigned)__builtin_amdgcn_s_memrealtime() - pm_[16]; } } while (0)
#else
#define PACC_T0(id_) do {} while (0)
#define PACC_T1(id_) do {} while (0)
#endif
template <int DK>
__device__ __forceinline__ void attn_unit_p(LAS unsigned char* lds, int tid, const bf16* Q, int qp, const bf16* K1, const bf16* V1, int nt1, const bf16* K2, const bf16* V2, int nt2,
                                            int kp, int vp, bf16* O, int op) {
    constexpr int NK = DK / 16, G = 2 * NK, PRE = 4;
    constexpr int KROW = DK * 2 + 16, KSZ = 64 * KROW, CPK = DK / 8, NPK = 64 * CPK;
    constexpr int VB = 4 * KSZ, SCR = VB + 4 * 8192;
    const int lane = tid & 63, r32 = lane & 31, hi = lane >> 5; const int wid = __builtin_amdgcn_readfirstlane(tid >> 6);
    const int NT = nt1 + nt2;
    LAS float* wsf = (LAS float*)(lds + SCR) + wid * 64;
    const int kkey0 = tid / CPK, kch0 = tid - kkey0 * CPK;
    const int kkey1 = (tid + 512) / CPK, kch1 = (tid + 512) - kkey1 * CPK;
    const bool two = (NPK > 512) && (tid + 512 < NPK);
    const int vkey = tid >> 3, vch = tid & 7;
    const int vdst = ((vkey >> 3) * 2 + (vch >> 2)) * 512 + (vkey & 7) * 64 + (vch & 3) * 16;
    v4u kA0, kA1 = {0u, 0u, 0u, 0u}, vA, kB0, kB1 = {0u, 0u, 0u, 0u}, vB;
#define ATT_LOADK(t, K0_, K1_) do { const int t_ = (t); const bf16* kb_ = (t_ < nt1) ? K1 + (size_t)t_ * 64 * kp : K2 + (size_t)(t_ - nt1) * 64 * kp; \
        K0_ = *(const GAS v4u*)(kb_ + (size_t)kkey0 * kp + kch0 * 8); if (two) K1_ = *(const GAS v4u*)(kb_ + (size_t)kkey1 * kp + kch1 * 8); } while (0)
#define ATT_LOADV(t, V_) do { const int t_ = (t); const bf16* vb_ = (t_ < nt1) ? V1 + (size_t)t_ * 64 * vp : V2 + (size_t)(t_ - nt1) * 64 * vp; \
        V_ = *(const GAS v4u*)(vb_ + (size_t)vkey * vp + vch * 8); } while (0)
#define ATT_STOREK(buf, K0_, K1_) do { LAS unsigned char* kd_ = lds + (buf) * KSZ; *(LAS v4u*)(kd_ + kkey0 * KROW + kch0 * 16) = K0_; if (two) *(LAS v4u*)(kd_ + kkey1 * KROW + kch1 * 16) = K1_; } while (0)
#define ATT_STOREV(buf, V_) do { *(LAS v4u*)(lds + VB + (buf) * 8192 + vdst) = V_; } while (0)
    { v4u kT0, kT1 = {0u, 0u, 0u, 0u};
      ATT_LOADK(0, kA0, kA1); ATT_LOADV(0, vA); ATT_LOADK(1, kB0, kB1); ATT_LOADV(1, vB); ATT_LOADK(2, kT0, kT1);
      ATT_STOREK(0, kA0, kA1); ATT_STOREV(0, vA); ATT_STOREK(1, kB0, kB1); ATT_STOREV(1, vB); ATT_STOREK(2, kT0, kT1); }
    bf16x8 qr[NK];
#pragma unroll
    for (int d0 = 0; d0 < NK; ++d0) qr[d0] = *(const GAS bf16x8*)(Q + (size_t)(wid * 32 + r32) * qp + d0 * 16 + hi * 8);
    __syncthreads();
    float m_run = 0.f, l4[4]; f32x16 o0, o1, negm;
    { float zz; asm volatile("v_mov_b32 %0, 0" : "=v"(zz));
#pragma unroll
      for (int r = 0; r < 16; ++r) { o0[r] = zz; o1[r] = zz; negm[r] = zz; }
      l4[0] = zz; l4[1] = zz; l4[2] = zz; l4[3] = zz; }
    const int koff = r32 * KROW + hi * 16;
    const int vlane = (4 * hi + ((lane & 15) >> 2)) * 64 + ((lane >> 4) & 1) * 32 + (lane & 3) * 8;
#define KREAD(i_) (*(const LAS bf16x8*)(kb + ((i_) & 1) * 32 * KROW + ((i_) >> 1) * 32))
#define VREADLO(g_) __builtin_amdgcn_ds_read_tr16_b64_v4i16((LAS v4i16_t*)(vb + ((((g_) >> 1) * 2 + 0) * 2 + ((g_) & 1)) * 512))
#define VREADHI(g_) __builtin_amdgcn_ds_read_tr16_b64_v4i16((LAS v4i16_t*)(vb + ((((g_) >> 1) * 2 + 1) * 2 + ((g_) & 1)) * 512))
#define MAX3(a_, b_, c_) __builtin_fmaxf(__builtin_fmaxf(a_, b_), c_)
#define ATT_DECIDE(N0, N1, ma_, mb_) do { const float mloc = __builtin_fmaxf(ma_, mb_);        \
        if (__any(mloc > ATT_THR)) { const float mx = swap_max(mloc); \
            const float dl = __builtin_fmaxf(mx, 0.f); m_run += dl; const float f = fast_exp2(-dl); l4[0] *= f; l4[1] *= f; l4[2] *= f; l4[3] *= f; if (hi == 0) wsf[r32] = f; LDS_WAIT(); \
            _Pragma("unroll") for (int r = 0; r < 16; ++r) { const float fr_ = wsf[crow(r, hi)]; o0[r] *= fr_; o1[r] *= fr_; N0[r] -= dl; N1[r] -= dl; } \
            _Pragma("unroll") for (int r = 0; r < 16; ++r) negm[r] = -m_run; \
            asm volatile("" : "+v"(negm)); \
        } } while (0)
#define CE(C0, C1, e_) (((e_) < 16) ? C0[(e_) & 15] : C1[(e_) & 15])
#define EOF_(g_) (PRE + (32 - PRE) * (g_) / G)
#define MS_(g_) ((g_) < 2 ? 0 : (g_) == 2 ? 3 : 2 * (g_) - 1)
#define ATT_STEP(C0, C1, N0, N1, T) do { const int t_s = (T); \
        if ((t_s & 1) != 0) { if (wid >= 4) __builtin_amdgcn_s_setprio(0); else __builtin_amdgcn_s_setprio(1); } else { if (wid >= 4) __builtin_amdgcn_s_setprio(1); else __builtin_amdgcn_s_setprio(0); }        \
        PACC_T0(5); PACC_T0(2); \
        const LAS unsigned char* kb = lds + ((t_s + 1) & 3) * KSZ + koff; \
        const LAS unsigned char* vb = lds + VB + (t_s & 3) * 8192 + vlane; \
        bf16x8 kf[G]; float x[32]; unsigned pwv[16]; v4i16_t vlo[8], vhh[8]; float ma, mb; \
        kf[0] = KREAD(0); kf[1] = KREAD(1); kf[2] = KREAD(2); \
        _Pragma("unroll") for (int e = 0; e < PRE; ++e) { x[e] = fast_exp2(CE(C0, C1, e)); PINF(x[e]); } \
        __builtin_amdgcn_sched_barrier(0); \
        _Pragma("unroll") for (int g = 0; g < G; ++g) { \
            if (g + 3 < G) kf[g + 3] = KREAD(g + 3); \
            if (g >= G - 4) { vlo[g - (G - 4)] = VREADLO(g - (G - 4)); vhh[g - (G - 4)] = VREADHI(g - (G - 4)); } \
            if (g == 0) N0 = __builtin_amdgcn_mfma_f32_32x32x16_bf16(kf[0], qr[0], negm, 0, 0, 0); \
            else if (g == 1) N1 = __builtin_amdgcn_mfma_f32_32x32x16_bf16(kf[1], qr[0], negm, 0, 0, 0); \
            else if (g & 1) N1 = __builtin_amdgcn_mfma_f32_32x32x16_bf16(kf[g], qr[g >> 1], N1, 0, 0, 0); \
            else N0 = __builtin_amdgcn_mfma_f32_32x32x16_bf16(kf[g], qr[g >> 1], N0, 0, 0, 0); \
            if (g & 1) PINF(N1); else PINF(N0);            \
            _Pragma("unroll") for (int e = EOF_(g); e < EOF_(g + 1); ++e) { x[e] = fast_exp2(CE(C0, C1, e)); PINF(x[e]); PROBE_XEXP(x[e]); } \
            _Pragma("unroll") for (int k = (g == 0 ? 0 : EOF_(g - 1) / 2); k < EOF_(g) / 2; ++k) { pwv[k] = pkbf(x[2 * k], x[2 * k + 1]); PINF(pwv[k]); } \
            __builtin_amdgcn_sched_barrier(0); } \
        PACC_T1(2); PACC_T0(3); \
        _Pragma("unroll") for (int g = 0; g < 8; ++g) { \
            if (g < 4) { vlo[g + 4] = VREADLO(g + 4); vhh[g + 4] = VREADHI(g + 4); } \
            if (g == 0) { _Pragma("unroll") for (int k = EOF_(G - 1) / 2; k < 16; ++k) { pwv[k] = pkbf(x[2 * k], x[2 * k + 1]); PINF(pwv[k]); } } \
            { const int ks = g >> 1; const bf16x8 pa = __builtin_bit_cast(bf16x8, ((v4u){pwv[4 * ks], pwv[4 * ks + 1], pwv[4 * ks + 2], pwv[4 * ks + 3]})); \
              const bf16x8 vf = (bf16x8){vlo[g][0], vlo[g][1], vlo[g][2], vlo[g][3], vhh[g][0], vhh[g][1], vhh[g][2], vhh[g][3]}; \
              if (g & 1) { o1 = __builtin_amdgcn_mfma_f32_32x32x16_bf16(pa, vf, o1, 0, 0, 0); PINF(o1); } else { o0 = __builtin_amdgcn_mfma_f32_32x32x16_bf16(pa, vf, o0, 0, 0, 0); PINF(o0); } } \
            _Pragma("unroll") for (int jj = 0; jj < 4; ++jj) { l4[jj] += x[4 * g + jj]; PINF(l4[jj]); } \
            { _Pragma("unroll") for (int i = MS_(g); i < MS_(g + 1); ++i) { \
                  if (i == 0) ma = MAX3(CE(N0, N1, 0), CE(N0, N1, 1), CE(N0, N1, 2)); else if (i == 1) mb = MAX3(CE(N0, N1, 3), CE(N0, N1, 4), CE(N0, N1, 5)); \
                  else if (i & 1) mb = MAX3(mb, CE(N0, N1, 2 * i + 2), CE(N0, N1, 2 * i + 3)); else ma = MAX3(ma, CE(N0, N1, 2 * i + 2), CE(N0, N1, 2 * i + 3)); \
                  if (i & 1) PINF(mb); else PINF(ma); } } \
            __builtin_amdgcn_sched_barrier(0); } \
        PACC_T1(3); PACC_T0(4); \
        ATT_DECIDE(N0, N1, ma, mb); \
        PACC_T1(4); PACC_T1(5); \
    } while (0)
    if (wid >= 4) __builtin_amdgcn_s_setprio(1);
    f32x16 a0, a1, b0, b1;
    {
        const LAS unsigned char* kb = lds + koff; bf16x8 kf[G];
#pragma unroll
        for (int g = 0; g < G; ++g) kf[g] = KREAD(g);
        __builtin_amdgcn_sched_barrier(0);
#pragma unroll
        for (int g = 0; g < G; ++g) {
            if (g == 0) a0 = __builtin_amdgcn_mfma_f32_32x32x16_bf16(kf[0], qr[0], negm, 0, 0, 0);
            else if (g == 1) a1 = __builtin_amdgcn_mfma_f32_32x32x16_bf16(kf[1], qr[0], negm, 0, 0, 0);
            else if (g & 1) a1 = __builtin_amdgcn_mfma_f32_32x32x16_bf16(kf[g], qr[g >> 1], a1, 0, 0, 0);
            else a0 = __builtin_amdgcn_mfma_f32_32x32x16_bf16(kf[g], qr[g >> 1], a0, 0, 0, 0); }
        float ma = __builtin_fmaxf(a0[0], a0[1]), mb = __builtin_fmaxf(a0[2], a0[3]);
#pragma unroll
        for (int i = 2; i < 16; ++i) { if (i & 1) mb = MAX3(mb, CE(a0, a1, 2 * i), CE(a0, a1, 2 * i + 1)); else ma = MAX3(ma, CE(a0, a1, 2 * i), CE(a0, a1, 2 * i + 1)); }
        m_run = swap_max(__builtin_fmaxf(ma, mb));
#pragma unroll
        for (int r = 0; r < 16; ++r) { a0[r] -= m_run; a1[r] -= m_run; negm[r] = -m_run; }
        asm volatile("" : "+v"(negm));
    }
    for (int t = 0; t + 2 < NT; t += 2) {
        ATT_LOADK(t + 3, kA0, kA1); ATT_LOADV(t + 2, vA); ATT_LOADV(t + 3, vB); if (t + 4 < NT) ATT_LOADK(t + 4, kB0, kB1);
        ATT_STEP(a0, a1, b0, b1, t); ATT_STEP(b0, b1, a0, a1, t + 1);
        ATT_STOREK((t + 3) & 3, kA0, kA1); ATT_STOREV((t + 2) & 3, vA); ATT_STOREV((t + 3) & 3, vB); if (t + 4 < NT) ATT_STOREK((t + 4) & 3, kB0, kB1);
        PACC_T0(1);
        __syncthreads();
        PACC_T1(1);
    }
    ATT_STEP(a0, a1, b0, b1, NT - 2);
    {
        const LAS unsigned char* vb = lds + VB + ((NT - 1) & 3) * 8192 + vlane; v4i16_t vlo[8], vhh[8];
#pragma unroll
        for (int g = 0; g < 8; ++g) { vlo[g] = VREADLO(g); vhh[g] = VREADHI(g); }
        __builtin_amdgcn_sched_barrier(0);
        float ls = 0.f;
#pragma unroll
        for (int r = 0; r < 16; ++r) { b0[r] = fast_exp2(b0[r]); b1[r] = fast_exp2(b1[r]); ls += b0[r] + b1[r]; }
        l4[0] += ls;
        v4u pw[4];
        pw[0] = (v4u){pkbf(b0[0], b0[1]), pkbf(b0[2], b0[3]), pkbf(b0[4], b0[5]), pkbf(b0[6], b0[7])};
        pw[1] = (v4u){pkbf(b0[8], b0[9]), pkbf(b0[10], b0[11]), pkbf(b0[12], b0[13]), pkbf(b0[14], b0[15])};
        pw[2] = (v4u){pkbf(b1[0], b1[1]), pkbf(b1[2], b1[3]), pkbf(b1[4], b1[5]), pkbf(b1[6], b1[7])};
        pw[3] = (v4u){pkbf(b1[8], b1[9]), pkbf(b1[10], b1[11]), pkbf(b1[12], b1[13]), pkbf(b1[14], b1[15])};
#pragma unroll
        for (int g = 0; g < 8; ++g) { const bf16x8 pa = __builtin_bit_cast(bf16x8, pw[g >> 1]);
            const bf16x8 vf = (bf16x8){vlo[g][0], vlo[g][1], vlo[g][2], vlo[g][3], vhh[g][0], vhh[g][1], vhh[g][2], vhh[g][3]};
            if (g & 1) o1 = __builtin_amdgcn_mfma_f32_32x32x16_bf16(pa, vf, o1, 0, 0, 0); else o0 = __builtin_amdgcn_mfma_f32_32x32x16_bf16(pa, vf, o0, 0, 0, 0); }
    }
    __builtin_amdgcn_s_setprio(0);
    const float lt = swap_sum((l4[0] + l4[1]) + (l4[2] + l4[3]));
    if (hi == 0) wsf[32 + r32] = frcp(lt);
    LDS_WAIT();
#pragma unroll
    for (int r = 0; r < 16; ++r) { const int q = crow(r, hi); const float il = wsf[32 + q]; bf16* orow = O + (size_t)(wid * 32 + q) * op;
        orow[r32] = f2bf(o0[r] * il); orow[32 + r32] = f2bf(o1[r] * il); }
    __syncthreads();
#undef ATT_LOADK
#undef ATT_LOADV
#undef ATT_STOREK
#undef ATT_STOREV
#undef ATT_STEP
#undef ATT_DECIDE
#undef KREAD
#undef VREADLO
#undef VREADHI
#undef CE
#undef EOF_
#undef MS_
}
__device__ __forceinline__ int hg_blk_row(int b, int blk) { return blk < 2 ? MLAT + b * CTXL + 128 * blk : b * SEQ + 128 * (blk - 2); }
__device__ __forceinline__ int hg_mc_of_blk(int dir, int blk) { return dir ? (blk < 2 ? 1 - blk : 67 - blk) : blk; }
template <int KT> __device__ __forceinline__ f32x16 mma_nt(f32x16 acc, const LAS bf16* A, int lda, const LAS bf16* Bt, int ldb, int r32, int hi) {
    const LAS bf16* ap = A + r32 * lda + 8 * hi; const LAS bf16* bp = Bt + r32 * ldb + 8 * hi;
#pragma unroll
    for (int k0 = 0; k0 < KT; k0 += 16) acc = __builtin_amdgcn_mfma_f32_32x32x16_bf16(*(const LAS bf16x8*)(ap + k0), *(const LAS bf16x8*)(bp + k0), acc, 0, 0, 0);
    return acc;
}
__device__ __forceinline__ void ldq16(const bf16* p, float (&o)[16]) {
    const v4u a = *(const GAS v4u*)p, b = *(const GAS v4u*)(p + 8);
    o[0] = bf_lo(a.x); o[1] = bf_hi(a.x); o[2] = bf_lo(a.y); o[3] = bf_hi(a.y); o[4] = bf_lo(a.z); o[5] = bf_hi(a.z); o[6] = bf_lo(a.w); o[7] = bf_hi(a.w);
    o[8] = bf_lo(b.x); o[9] = bf_hi(b.x); o[10] = bf_lo(b.y); o[11] = bf_hi(b.y); o[12] = bf_lo(b.z); o[13] = bf_hi(b.z); o[14] = bf_lo(b.w); o[15] = bf_hi(b.w);
}
__device__ __forceinline__ void ldf16(const float* p, float (&o)[16]) {
#pragma unroll
    for (int k = 0; k < 4; ++k) { const f32x4 a = *((const GAS f32x4*)p + k); o[4 * k] = a.x; o[4 * k + 1] = a.y; o[4 * k + 2] = a.z; o[4 * k + 3] = a.w; }
}
__device__ __forceinline__ void st16(LAS bf16* p, const float (&v)[16]) {
    *(LAS v4u*)p = (v4u){pkbf(v[0], v[1]), pkbf(v[2], v[3]), pkbf(v[4], v[5]), pkbf(v[6], v[7])};
    *(LAS v4u*)(p + 8) = (v4u){pkbf(v[8], v[9]), pkbf(v[10], v[11]), pkbf(v[12], v[13]), pkbf(v[14], v[15])};
}

__device__ __forceinline__ void ldq8(const bf16* p, float (&o)[8]) { const v4u a = *(const GAS v4u*)p;
    o[0] = bf_lo(a.x); o[1] = bf_hi(a.x); o[2] = bf_lo(a.y); o[3] = bf_hi(a.y); o[4] = bf_lo(a.z); o[5] = bf_hi(a.z); o[6] = bf_lo(a.w); o[7] = bf_hi(a.w); }
__device__ __forceinline__ void ldf8(const float* p, float (&o)[8]) { const f32x4 a = *(const GAS f32x4*)p, b = *((const GAS f32x4*)p + 1); o[0] = a.x; o[1] = a.y; o[2] = a.z; o[3] = a.w; o[4] = b.x; o[5] = b.y; o[6] = b.z; o[7] = b.w; }
__device__ __forceinline__ void st8(LAS bf16* p, const float (&v)[8]) { *(LAS v4u*)p = (v4u){pkbf(v[0], v[1]), pkbf(v[2], v[3]), pkbf(v[4], v[5]), pkbf(v[6], v[7])}; }

struct HgT { const bf16 *Qd, *Vd, *Sg; const float *Zf, *Zb; const float* lb  ; float* HST; float* HDM; const float* ong; bf16* OO; };

__device__ __forceinline__ void hg_a_unit(Frame& F, const HgT& T, int chain, int mc) {
    const int dir = chain & 1, h = (chain >> 1) & 3, b = chain >> 3, hoff = h * 128;
    const int row0 = hg_blk_row(b, hg_mc_of_blk(dir, mc));
    const float* Z = dir ? T.Zb : T.Zf;
    LAS float* PT = (LAS float*)F.lds;
    LAS bf16* KET = (LAS bf16*)(F.lds + 2048);
    LAS bf16* VT = (LAS bf16*)(F.lds + 2048 + 34816);
    const int tid = F.tid, lane = F.lane, r32 = lane & 31, hi = lane >> 5, wid = F.wave;
    const int e = tid & 127, p = __builtin_amdgcn_readfirstlane(tid >> 7);
    const float lbv = T.lb[dir * 512 + hoff + e];
    const float* zp = Z + (size_t)(row0 + 32 * p) * 512 + hoff; const bf16* vp = T.Vd + (size_t)(row0 + 32 * p) * 512 + hoff;
    float w[32], kk[32]; unsigned vv[16];
#pragma unroll
    for (int i = 0; i < 32; ++i) { const float z = ((const GAS float*)(zp + (size_t)i * 512))[e]; const float sg = sigmoidf_(z); w[i] = __logf(lbv + (1.f - lbv) * sg); kk[i] = (1.f - lbv) * (1.f - sg); }
#pragma unroll
    for (int i = 0; i < 16; ++i) vv[i] = (unsigned)((const GAS bf16*)(vp + (size_t)(2 * i) * 512))[e] | ((unsigned)((const GAS bf16*)(vp + (size_t)(2 * i + 1) * 512))[e] << 16);
    float run = 0.f;
    if (dir == 0) {
#pragma unroll
        for (int i = 31; i >= 0; --i) { const float tmp = w[i]; w[i] = run; run += tmp; }
    } else {
#pragma unroll
        for (int i = 0; i < 32; ++i) { const float tmp = w[i]; w[i] = run; run += tmp; }
    }
    PT[p * 128 + e] = run;
    __syncthreads();
    { const float p0 = PT[e], p1 = PT[128 + e], p2 = PT[256 + e], p3 = PT[384 + e];
      const float offs = dir == 0 ? ((p < 3 ? p3 : 0.f) + (p < 2 ? p2 : 0.f) + (p < 1 ? p1 : 0.f)) : ((p > 0 ? p0 : 0.f) + (p > 1 ? p1 : 0.f) + (p > 2 ? p2 : 0.f));
      if (p == 0) T.HDM[((size_t)chain * 66 + mc) * 128 + e] = __expf((p0 + p1) + (p2 + p3));
#pragma unroll
      for (int g = 0; g < 4; ++g) { unsigned pk[4];
#pragma unroll
          for (int c = 0; c < 4; ++c) { const int i = 8 * g + 2 * c; pk[c] = pkbf(kk[i] * __expf(w[i] + offs), kk[i + 1] * __expf(w[i + 1] + offs)); }
          *(LAS v4u*)(KET + e * 136 + 32 * p + 8 * g) = (v4u){pk[0], pk[1], pk[2], pk[3]};
          *(LAS v4u*)(VT + e * 136 + 32 * p + 8 * g) = (v4u){vv[4 * g], vv[4 * g + 1], vv[4 * g + 2], vv[4 * g + 3]}; } }
    __syncthreads();
    { const int ei = wid & 3, fp = wid >> 2; float* dst = T.HST + ((size_t)chain * 66 + mc) * 16384;
#pragma unroll
      for (int k = 0; k < 2; ++k) { const int fi = 2 * fp + k; f32x16 acc = {}; acc = mma_nt<128>(acc, KET + 32 * ei * 136, 136, VT + 32 * fi * 136, 136, r32, hi);
#pragma unroll
          for (int r = 0; r < 16; ++r) dst[(32 * ei + crow(r, hi)) * 128 + 32 * fi + r32] = acc[r]; } }
    __syncthreads();
}
__device__ __forceinline__ void phase_hg_b(Frame& F, const HgT& T) {
    const int g = F.vcu * NTHR + F.tid;
    for (int gi = g; gi < 32 * 4096; gi += F.G * NTHR) {
        const int chain = gi >> 12, idx = gi & 4095, e = idx >> 5, f4 = idx & 31;
        f32x4* base = (f32x4*)(T.HST + (size_t)chain * 66 * 16384 + e * 128) + f4; const float* dmp = T.HDM + (size_t)chain * 66 * 128 + e;
        f32x4 S = {0.f, 0.f, 0.f, 0.f};
#pragma unroll 6
        for (int mc = 0; mc < 66; ++mc) { const f32x4 kv = base[(size_t)mc * 4096]; const float d = dmp[mc * 128]; base[(size_t)mc * 4096] = S; S = S * d + kv; }
    }
}
__device__ __forceinline__ void hg_c_unit(Frame& F, const HgT& T, int b, int h, int blk) {
    const int hoff = h * 128, row0 = hg_blk_row(b, blk);
    const int tid = F.tid, lane = F.lane, r32 = lane & 31, hi = lane >> 5, wid = F.wave;
    LAS bf16* P = (LAS bf16*)F.lds;
    LAS float* PT = (LAS float*)(F.lds + 32768);
    LAS float* DE = (LAS float*)(F.lds + 34816);
    LAS float* BR = (LAS float*)(F.lds + 35328);
    LAS bf16* QB = (LAS bf16*)(F.lds + 35840);
    LAS bf16* QS = (LAS bf16*)(F.lds + 53248);
    LAS bf16* KS = (LAS bf16*)(F.lds + 70656);
    LAS bf16* KET = (LAS bf16*)(F.lds + 88064);
    LAS bf16* VT = (LAS bf16*)(F.lds + 106496);
    LAS bf16* ST = (LAS bf16*)(F.lds + 124928);
    LAS float* OUT = (LAS float*)(F.lds + 35840);
    const int ti = wid & 1, fi = wid >> 1;
    const int ei = wid & 3, fp = wid >> 2;
    f32x16 oacc0 = {}, oacc1 = {};
    const int se = tid & 127, sp = __builtin_amdgcn_readfirstlane(tid >> 7);
#ifndef HGDIR_LO
#define HGDIR_LO 0
#define HGDIR_HI 2
#endif
    float zraw[16]; unsigned qraw[16], vraw[16];
#define HC_LOAD(dir_, cc_) do { const int ci_ = (dir_) ? 1 - (cc_) : (cc_); const int rowc_ = row0 + 64 * ci_; const float* Z_ = (dir_) ? T.Zb : T.Zf; \
        const float* zp_ = Z_ + (size_t)(rowc_ + 16 * sp) * 512 + hoff; const bf16* qp_ = T.Qd + (size_t)(rowc_ + 16 * sp) * 512 + hoff; const bf16* vp_ = T.Vd + (size_t)(rowc_ + 16 * sp) * 512 + hoff; \
        _Pragma("unroll") for (int i = 0; i < 16; ++i) { zraw[i] = ((const GAS float*)(zp_ + (size_t)i * 512))[se]; qraw[i] = ((const GAS bf16*)(qp_ + (size_t)i * 512))[se]; vraw[i] = ((const GAS bf16*)(vp_ + (size_t)i * 512))[se]; } } while (0)
    HC_LOAD(HGDIR_LO, 0);
#pragma unroll 1
    for (int dir = HGDIR_LO; dir < HGDIR_HI; ++dir) {
        const int chain = (b * 4 + h) * 2 + dir; const float* Z = dir ? T.Zb : T.Zf;
        const float* Sin = T.HST + ((size_t)chain * 66 + hg_mc_of_blk(dir, blk)) * 16384;
        f32x16 S[2];
#pragma unroll
        for (int k = 0; k < 2; ++k)
#pragma unroll
            for (int r = 0; r < 16; ++r) S[k][r] = ((const GAS float*)(Sin + (32 * ei + (r & 3) + 8 * (r >> 2)) * 128 + 32 * (2 * fp + k)))[4 * hi * 128 + r32];
#pragma unroll
        for (int k = 0; k < 2; ++k)
#pragma unroll
            for (int g = 0; g < 4; ++g) *(LAS v2u*)(ST + (32 * (2 * fp + k) + r32) * 136 + 32 * ei + 8 * g + 4 * hi) = (v2u){pkbf(S[k][4 * g], S[k][4 * g + 1]), pkbf(S[k][4 * g + 2], S[k][4 * g + 3])};
#pragma unroll 1
        for (int cc = 0; cc < 2; ++cc) {
            const int ci = dir ? 1 - cc : cc; const int rowc = row0 + 64 * ci;
            { const float lbv = T.lb[dir * 512 + hoff + se];
              float bq[16], kk[16], qv[16]; unsigned vv[8];
#pragma unroll
              for (int i = 0; i < 16; ++i) { const float z = zraw[i]; const float sg = sigmoidf_(z); bq[i] = __logf(lbv + (1.f - lbv) * sg); kk[i] = (1.f - lbv) * (1.f - sg); qv[i] = __uint_as_float(qraw[i] << 16); }
#pragma unroll
              for (int i = 0; i < 8; ++i) vv[i] = vraw[2 * i] | (vraw[2 * i + 1] << 16);
              float run = 0.f;
              if (dir == 0) {
#pragma unroll
                  for (int i = 0; i < 16; ++i) { run += bq[i]; bq[i] = run; }
              } else {
#pragma unroll
                  for (int i = 15; i >= 0; --i) { run += bq[i]; bq[i] = run; }
              }
              PT[sp * 128 + se] = run;
              if (dir == 0) { if (sp == 1) BR[se] = bq[15]; } else { if (sp == 2) BR[se] = bq[0]; }
              __syncthreads();
              const float p0 = PT[se], p1 = PT[128 + se], p2 = PT[256 + se], p3 = PT[384 + se];
              const float offs = dir == 0 ? ((sp > 0 ? p0 : 0.f) + (sp > 1 ? p1 : 0.f) + (sp > 2 ? p2 : 0.f)) : ((sp < 3 ? p3 : 0.f) + (sp < 2 ? p2 : 0.f) + (sp < 1 ? p1 : 0.f));
              const float bend = (p0 + p1) + (p2 + p3), br = BR[se] + (dir == 0 ? p0 : p3);
              if (sp == 0) DE[se] = __expf(bend);
              unsigned ke[8];
#pragma unroll
              for (int c = 0; c < 8; ++c) { const float b0 = bq[2 * c] + offs, b1 = bq[2 * c + 1] + offs; ke[c] = pkbf(kk[2 * c] * __expf(bend - b0), kk[2 * c + 1] * __expf(bend - b1)); }
              *(LAS v4u*)(KET + se * 72 + 16 * sp) = (v4u){ke[0], ke[1], ke[2], ke[3]}; *(LAS v4u*)(KET + se * 72 + 16 * sp + 8) = (v4u){ke[4], ke[5], ke[6], ke[7]};
              *(LAS v4u*)(VT + se * 72 + 16 * sp) = (v4u){vv[0], vv[1], vv[2], vv[3]}; *(LAS v4u*)(VT + se * 72 + 16 * sp + 8) = (v4u){vv[4], vv[5], vv[6], vv[7]};
#pragma unroll
              for (int i = 0; i < 16; ++i) { const float bb = bq[i] + offs; const int tok = 16 * sp + i;
                  QB[tok * 136 + se] = f2bf(qv[i] * __expf(bb)); QS[tok * 136 + se] = f2bf(qv[i] * __expf(bb - br)); KS[tok * 136 + se] = f2bf(kk[i] * __expf(br - bb)); } }
            __syncthreads();
            if (cc == 0) HC_LOAD(dir, 1); else if (dir + 1 < HGDIR_HI) HC_LOAD(dir + 1, 0);
            if (wid < 4) { const int tb = wid & 1, sb = wid >> 1; f32x16 sc = {}; sc = mma_nt<128>(sc, QS + 32 * tb * 136, 136, KS + 32 * sb * 136, 136, r32, hi);
#pragma unroll
                for (int r = 0; r < 16; ++r) { const int t = 32 * tb + crow(r, hi), s = 32 * sb + r32; const bool keep = dir ? (s >= t) : (s <= t); P[t * 72 + s] = f2bf(keep ? sc[r] : 0.f); } }
            __syncthreads();
            { f32x16 a = ci ? oacc1 : oacc0; a = mma_nt<64>(a, P + 32 * ti * 72, 72, VT + 32 * fi * 72, 72, r32, hi); a = mma_nt<128>(a, QB + 32 * ti * 136, 136, ST + 32 * fi * 136, 136, r32, hi); if (ci) oacc1 = a; else oacc0 = a; }
            __syncthreads();
#pragma unroll
            for (int k = 0; k < 2; ++k) {
#pragma unroll
                for (int r = 0; r < 16; ++r) S[k][r] *= DE[32 * ei + crow(r, hi)];
                S[k] = mma_nt<64>(S[k], KET + 32 * ei * 72, 72, VT + 32 * (2 * fp + k) * 72, 72, r32, hi);
                asm volatile("s_nop 15\n\ts_nop 7" : "+v"(S[k]));
#pragma unroll
                for (int g = 0; g < 4; ++g) *(LAS v2u*)(ST + (32 * (2 * fp + k) + r32) * 136 + 32 * ei + 8 * g + 4 * hi) = (v2u){pkbf(S[k][4 * g], S[k][4 * g + 1]), pkbf(S[k][4 * g + 2], S[k][4 * g + 3])};
            }
            __syncthreads();
        }
#if defined(SELFCHK) && SELFCHK == 6
        { const int pair = (b == 1 && h == 2) ? 0 : (b == 3 && h == 0) ? 1 : -1;
          if (pair >= 0) {
#pragma unroll
            for (int r = 0; r < 16; ++r) { OUT[(32 * ti + crow(r, hi)) * 132 + 32 * fi + r32] = oacc0[r]; OUT[(64 + 32 * ti + crow(r, hi)) * 132 + 32 * fi + r32] = oacc1[r]; }
            __syncthreads();
            float* D = (float*)(F.ws + 1002 * MiB) + ((size_t)(dir * 2 + pair) * 8448 + (blk < 2 ? 128 * blk : 256 + 128 * (blk - 2))) * 128;
            for (int i = tid; i < 128 * 128; i += NTHR) D[i] = OUT[(i >> 7) * 132 + (i & 127)];
            __syncthreads(); } }
#endif
    }
#undef HC_LOAD
    { int l2; asm volatile("v_mbcnt_lo_u32_b32 %0, -1, 0\n\tv_mbcnt_hi_u32_b32 %0, -1, %0" : "=v"(l2)); const int r32b = l2 & 31, hib = l2 >> 5;
#pragma unroll
      for (int r = 0; r < 16; ++r) { OUT[(32 * ti + crow(r, hib)) * 132 + 32 * fi + r32b] = oacc0[r]; OUT[(64 + 32 * ti + crow(r, hib)) * 132 + 32 * fi + r32b] = oacc1[r]; }
      __syncthreads();
      for (int k = 0; k < 16; ++k) { const int t = 16 * wid + k; const float a0 = OUT[t * 132 + l2], a1 = OUT[t * 132 + 64 + l2];
        const float ms = wave_sum(a0 * a0 + a1 * a1, l2) * (1.f / 128.f); const float rs = __builtin_amdgcn_rsqf(ms + 1e-6f);
        const bf16* sgr = T.Sg + (size_t)(row0 + t) * 512 + hoff; bf16* orow = T.OO + (size_t)(row0 + t) * 1024 + 512 + hoff;
        ((GAS bf16*)orow)[l2] = f2bf(a0 * rs * ((const GAS float*)T.ong)[l2] * bf2f(((const GAS bf16*)sgr)[l2])); ((GAS bf16*)orow)[64 + l2] = f2bf(a1 * rs * ((const GAS float*)T.ong)[64 + l2] * bf2f(((const GAS bf16*)sgr)[64 + l2])); } }
    __syncthreads();
}
__device__ __forceinline__ void ld8(const float* p, float (&v)[8]) { const f32x4 a = *(const GAS f32x4*)p, b = *(const GAS f32x4*)(p + 4); v[0] = a.x; v[1] = a.y; v[2] = a.z; v[3] = a.w; v[4] = b.x; v[5] = b.y; v[6] = b.z; v[7] = b.w; }
__device__ __forceinline__ void ld8(const bf16* p, float (&v)[8]) { const v4u a = *(const GAS v4u*)p;
    v[0] = __uint_as_float(a.x << 16); v[1] = __uint_as_float(a.x & 0xffff0000u); v[2] = __uint_as_float(a.y << 16); v[3] = __uint_as_float(a.y & 0xffff0000u);
    v[4] = __uint_as_float(a.z << 16); v[5] = __uint_as_float(a.z & 0xffff0000u); v[6] = __uint_as_float(a.w << 16); v[7] = __uint_as_float(a.w & 0xffff0000u); }
__device__ __forceinline__ v4u pk8(const float (&v)[8], float s) { return (v4u){pkbf(v[0] * s, v[1] * s), pkbf(v[2] * s, v[3] * s), pkbf(v[4] * s, v[5] * s), pkbf(v[6] * s, v[7] * s)}; }
template <int R>
__device__ __forceinline__ void head_norm_rope(float (&v)[R][8], const float (&g8)[8], int l8  , const bool (&rope)[R], const int (&trow)[R], const int (&tcol)[R], const float* ropeA, int lane) {
    float ss[R];
#pragma unroll
    for (int q = 0; q < R; ++q) { ss[q] = 0.f;
#pragma unroll
        for (int e = 0; e < 8; ++e) ss[q] += v[q][e] * v[q][e]; }
#pragma unroll
    for (int q = 0; q < R; ++q) ss[q] += shx(ss[q], 1, lane);
#pragma unroll
    for (int q = 0; q < R; ++q) ss[q] += shx(ss[q], 2, lane);
#pragma unroll
    for (int q = 0; q < R; ++q) ss[q] += shx(ss[q], 4, lane);
    float pr[R][8];
#pragma unroll
    for (int q = 0; q < R; ++q) { const float rs = __builtin_amdgcn_rsqf(ss[q] * (1.f / 64.f) + 1e-6f);
#pragma unroll
        for (int e = 0; e < 8; ++e) v[q][e] = v[q][e] * rs * g8[e]; }
#pragma unroll
    for (int q = 0; q < R; ++q)
#pragma unroll
        for (int e = 0; e < 8; ++e) pr[q][e] = shx(v[q][e], 2, lane);
#pragma unroll
    for (int q = 0; q < R; ++q) if (rope[q]) { const int axis = l8 >> 2, pos = axis ? tcol[q] : trow[q]; const float* cs = ropeA + (pos * 16 + 8 * (l8 & 1)) * 2; const bool second = (l8 & 2) != 0;
        float cc[16];
#pragma unroll
        for (int k = 0; k < 4; ++k) { const f32x4 c4 = *((const GAS f32x4*)cs + k); cc[4 * k] = c4.x; cc[4 * k + 1] = c4.y; cc[4 * k + 2] = c4.z; cc[4 * k + 3] = c4.w; }
#pragma unroll
        for (int e = 0; e < 8; ++e) { const float c_ = cc[2 * e], s_ = cc[2 * e + 1]; v[q][e] = second ? (v[q][e] * c_ + pr[q][e] * s_) : (v[q][e] * c_ - pr[q][e] * s_); } }
}
__device__ __forceinline__ void phase_even_post(Frame& F, const PArgs& A, int j) {
    constexpr int R = 2;
    const int gw = F.vcu * NWAVES + F.wave, NGW = F.G * NWAVES, lane = F.lane;
    const bf16* RAW = (const bf16*)(F.ws + WS_RAW);
    bf16 *QG = (bf16*)(F.ws + WS_QG), *KG = (bf16*)(F.ws + WS_KG), *VG = (bf16*)(F.ws + WS_VG), *CQN = (bf16*)(F.ws + WS_CQN), *CKVN = (bf16*)(F.ws + WS_CKVN), *KM = (bf16*)(F.ws + WS_KM);
    const float* ropeA = (const float*)(F.ws + WS_SMALL + SM_ROPEA); const float* ropeB = (const float*)(F.ws + WS_SMALL + SM_ROPEB);
    float gq[8], gk[8], gcq[8], gckv[8];
    ld8(A.in[I_QNG] + j * 64 + 8 * (lane & 7), gq); ld8(A.in[I_KNG] + j * 64 + 8 * (lane & 7), gk); ld8(A.in[I_CQG] + j * 384 + 8 * (lane < 48 ? lane : 0), gcq); ld8(A.in[I_CKVG] + j * 256 + 8 * (lane & 31), gckv);
    constexpr int NR = (MROWS + R - 1) / R;
    for (int g = gw; g < NR; g += NGW) {
        const bf16* r[R]; bool lat[R]; int trow[R], tcol[R], m[R];
#pragma unroll
        for (int q = 0; q < R; ++q) { m[q] = R * g + q; r[q] = RAW + (size_t)m[q] * EV_INP; lat[q] = m[q] < MLAT; const int t = m[q] & (SEQ - 1); trow[q] = t >> 6; tcol[q] = t & 63; }
        float v[R][8], w[R][8];
#pragma unroll
        for (int q = 0; q < R; ++q) ld8(r[q] + 8 * lane, v[q]);
        head_norm_rope<R>(v, gq, lane & 7, lat, trow, tcol, ropeA, lane);
#pragma unroll
        for (int q = 0; q < R; ++q) *(GAS v4u*)(QG + (size_t)m[q] * 512 + 8 * lane) = pk8(v[q], C2_64);
        { const int l = lane & 31;
#pragma unroll
          for (int q = 0; q < R; ++q) { ld8(r[q] + 512 + 8 * l, v[q]);
#pragma unroll
              for (int e = 0; e < 8; ++e) w[q][e] = v[q][e]; }
          head_norm_rope<R>(w, gk, l & 7, lat, trow, tcol, ropeA, lane);
#pragma unroll
          for (int q = 0; q < R; ++q) { if (lane < 16) *(GAS v4u*)(KG + (size_t)m[q] * 128 + 8 * lane) = pk8(w[q], 1.f);
              else if (lane < 32) *(GAS v4u*)(VG + (size_t)m[q] * 128 + 8 * (lane - 16)) = pk8(v[q], 1.f); } }
        { const bool on1 = lane < 48, on2 = lane < 32; float s1[R], s2[R];
#pragma unroll
          for (int q = 0; q < R; ++q) { ld8(r[q] + 768 + 8 * (on1 ? lane : 0), v[q]); ld8(r[q] + 1152 + 8 * (lane & 31), w[q]); s1[q] = 0.f; s2[q] = 0.f;
#pragma unroll
              for (int e = 0; e < 8; ++e) { s1[q] += on1 ? v[q][e] * v[q][e] : 0.f; s2[q] += on2 ? w[q][e] * w[q][e] : 0.f; } }
#pragma unroll
          for (int o = 1; o < 64; o <<= 1) {
#pragma unroll
              for (int q = 0; q < R; ++q) { s1[q] += shx(s1[q], o, lane); s2[q] += shx(s2[q], o, lane); } }
#pragma unroll
          for (int q = 0; q < R; ++q) { const float rs1 = __builtin_amdgcn_rsqf(s1[q] * (1.f / 384.f) + 1e-6f), rs2 = __builtin_amdgcn_rsqf(s2[q] * (1.f / 256.f) + 1e-6f);
#pragma unroll
              for (int e = 0; e < 8; ++e) { v[q][e] = v[q][e] * rs1 * gcq[e]; w[q][e] = w[q][e] * rs2 * gckv[e]; }
              if (on1) *(GAS v4u*)(CQN + (size_t)m[q] * 384 + 8 * lane) = pk8(v[q], 1.f);
              if (on2) *(GAS v4u*)(CKVN + (size_t)m[q] * 256 + 8 * lane) = pk8(w[q], 1.f); } }
        { const int l4 = lane & 3;
#pragma unroll
          for (int q = 0; q < R; ++q) ld8(r[q] + 1408 + 8 * l4, v[q]);
#pragma unroll
          for (int q = 0; q < R; ++q)
#pragma unroll
              for (int e = 0; e < 8; ++e) w[q][e] = shx(v[q][e], 1, lane);
#pragma unroll
          for (int q = 0; q < R; ++q) { if (lat[q]) { const int axis = l4 >> 1, pos = axis ? tcol[q] : trow[q]; const float* cs = ropeB + pos * 16; const bool second = (l4 & 1) != 0;
                  float cc[16];
#pragma unroll
                  for (int k = 0; k < 4; ++k) { const f32x4 c4 = *((const GAS f32x4*)cs + k); cc[4 * k] = c4.x; cc[4 * k + 1] = c4.y; cc[4 * k + 2] = c4.z; cc[4 * k + 3] = c4.w; }
#pragma unroll
                  for (int e = 0; e < 8; ++e) { const float c_ = cc[2 * e], s_ = cc[2 * e + 1]; v[q][e] = second ? (v[q][e] * c_ + w[q][e] * s_) : (v[q][e] * c_ - w[q][e] * s_); } }
              if (lane < 32) { const int head = lane >> 2; *(GAS v4u*)(KM + (size_t)m[q] * 768 + head * 96 + 64 + 8 * l4) = pk8(v[q], 1.f); } } }
    }
}
__device__ __forceinline__ void phase_even_attn(Frame& F) {
    const bf16 *QG = (const bf16*)(F.ws + WS_QG), *KG = (const bf16*)(F.ws + WS_KG), *VG = (const bf16*)(F.ws + WS_VG);
    const bf16 *QM = (const bf16*)(F.ws + WS_QM), *KM = (const bf16*)(F.ws + WS_KM), *VM = (const bf16*)(F.ws + WS_VM); bf16* OE = (bf16*)(F.ws + WS_OE);
    for (int u = F.vcu; u < 1024 + 32; u += F.G) {
        if (u < 1024) {
            const int qb = u & 31, hq = (u >> 5) & 3, kvh = (u >> 7) & 1, b = u >> 8, h = kvh * 4 + hq; const size_t r0 = (size_t)b * SEQ + qb * 256, kl = (size_t)b * SEQ, kc = (size_t)MLAT + b * CTXL;
            attn_unit_p<64>(F.lds, F.tid, QG + r0 * 512 + h * 64, 512, KG + kl * 128 + kvh * 64, VG + kl * 128 + kvh * 64, 128, KG + kc * 128 + kvh * 64, VG + kc * 128 + kvh * 64, 4, 128, 128,
                             OE + r0 * 1024 + h * 64, 1024);
        } else { const int id = u - 1024, h = id & 7, b = id >> 3, kvh = h >> 2; const size_t kc = (size_t)MLAT + b * CTXL;
            attn_unit_p<64>(F.lds, F.tid, QG + kc * 512 + h * 64, 512, nullptr, nullptr, 0, KG + kc * 128 + kvh * 64, VG + kc * 128 + kvh * 64, 4, 128, 128, OE + kc * 1024 + h * 64, 1024); }
    }
    for (int u = F.vcu; u < 1024 + 32; u += F.G) {
        if (u < 1024) {
            const int qb = u & 31, h = (u >> 5) & 7, b = u >> 8; const size_t r0 = (size_t)b * SEQ + qb * 256, kl = (size_t)b * SEQ, kc = (size_t)MLAT + b * CTXL;
            attn_unit_p<96>(F.lds, F.tid, QM + r0 * 768 + h * 96, 768, KM + kl * 768 + h * 96, VM + kl * 512 + h * 64, 128, KM + kc * 768 + h * 96, VM + kc * 512 + h * 64, 4, 768, 512,
                             OE + r0 * 1024 + 512 + h * 64, 1024);
        } else { const int id = u - 1024, h = id & 7, b = id >> 3; const size_t kc = (size_t)MLAT + b * CTXL;
            attn_unit_p<96>(F.lds, F.tid, QM + kc * 768 + h * 96, 768, nullptr, nullptr, 0, KM + kc * 768 + h * 96, VM + kc * 512 + h * 64, 4, 768, 512, OE + kc * 1024 + 512 + h * 64, 1024); }
    }
}
__device__ __forceinline__ void phase_odd_mix(Frame& F, const PArgs& A, const HgT& T, int j) {
    const bf16 *QN = (const bf16*)(F.ws + WS_QN), *KN = (const bf16*)(F.ws + WS_KN), *VN = (const bf16*)(F.ws + WS_VN); bf16* OO = (bf16*)(F.ws + WS_OO);
    const float* rpb = A.in[I_RPB] + (size_t)j * 8 * 15 * 31;
#ifndef NO_NA
#if defined(NA_TWICE)
    for (int rep = 0; rep < 2; ++rep)
#endif
    for (int u = F.vcu; u < 1024; u += F.G) {
        const int rg = u & 31, h = (u >> 5) & 7, b = u >> 8; const int rlo = min(max(4 * rg - 4, 0), 120), rhi = min(max(4 * rg + 3 - 4, 0), 120) + 8;
        const size_t r0 = (size_t)b * SEQ + (size_t)rg * 256, kl = (size_t)b * SEQ + (size_t)rlo * 64, kc = (size_t)MLAT + b * CTXL;
        attn_unit<64, 1>(F.lds, F.tid, QN + r0 * 512 + h * 64, 512, KN + kl * 512 + h * 64, VN + kl * 512 + h * 64, rhi - rlo, KN + kc * 512 + h * 64, VN + kc * 512 + h * 64, 4, 512, 512,
                         OO + r0 * 1024 + h * 64, 1024, 4 * rg, rlo, rpb + h * 465);
    }
#endif
    for (int u = F.vcu; u < (j == 1 ? 0 : 32); u += F.G) {
        const int h = u & 7, b = u >> 3; const size_t kc = (size_t)MLAT + b * CTXL;
        attn_unit<64, 0>(F.lds, F.tid, QN + kc * 512 + h * 64, 512, nullptr, nullptr, 0, KN + kc * 512 + h * 64, VN + kc * 512 + h * 64, 4, 512, 512, OO + kc * 1024 + h * 64, 1024, 0, 0, nullptr);
    }
#ifndef NO_HA
    for (int u = F.vcu; u < 2112; u += F.G) hg_a_unit(F, T, u / 66, u % 66);
#if defined(HA_TWICE)
    for (int u = F.vcu; u < 2112; u += F.G) hg_a_unit(F, T, u / 66, u % 66);
#endif
#endif
}
__device__ __forceinline__ void ctx_resid_gemm(Frame& F, const bf16* A  , const bf16* Bt  , int K, bf16* Z, const float* gate, const void* base, bool src16  ) {
    const int tid = F.tid, lane = F.lane, r32 = lane & 31, hi = lane >> 5, wid = F.wave;
    LAS float* part = (LAS float*)F.lds;
    for (int u = F.vcu; u < 256; u += F.G) {
        const int tm = u >> 4, tn = u & 15;
        const int ks = K / 8, k0 = wid * ks;
        const bf16* a0 = A + (size_t)(MLAT + 64 * tm + r32) * K + k0 + 8 * hi; const bf16* b0 = Bt + (size_t)(64 * tn + r32) * K + k0 + 8 * hi;
        f32x16 c00, c01, c10, c11;
#pragma unroll
        for (int r = 0; r < 16; ++r) { c00[r] = 0.f; c01[r] = 0.f; c10[r] = 0.f; c11[r] = 0.f; }
#pragma unroll 2
        for (int k = 0; k < ks; k += 16) {
            const bf16x8 fa0 = *(const GAS bf16x8*)(a0 + k), fa1 = *(const GAS bf16x8*)(a0 + (size_t)32 * K + k), fb0 = *(const GAS bf16x8*)(b0 + k), fb1 = *(const GAS bf16x8*)(b0 + (size_t)32 * K + k);
            c00 = __builtin_amdgcn_mfma_f32_32x32x16_bf16(fa0, fb0, c00, 0, 0, 0); c01 = __builtin_amdgcn_mfma_f32_32x32x16_bf16(fa0, fb1, c01, 0, 0, 0);
            c10 = __builtin_amdgcn_mfma_f32_32x32x16_bf16(fa1, fb0, c10, 0, 0, 0); c11 = __builtin_amdgcn_mfma_f32_32x32x16_bf16(fa1, fb1, c11, 0, 0, 0);
        }
        LAS float* pw = part + wid * (64 * 65);
#pragma unroll
        for (int r = 0; r < 16; ++r) { const int i = crow(r, hi); pw[i * 65 + r32] = c00[r]; pw[i * 65 + 32 + r32] = c01[r]; pw[(32 + i) * 65 + r32] = c10[r]; pw[(32 + i) * 65 + 32 + r32] = c11[r]; }
        __syncthreads();
        for (int e = tid; e < 64 * 64; e += NTHR) { const int i = e >> 6, jc = e & 63; float s = 0.f;
#pragma unroll
            for (int w = 0; w < 8; ++w) s += part[w * (64 * 65) + i * 65 + jc];
            const size_t xo = (size_t)(MLAT + 64 * tm + i) * 1024 + 64 * tn + jc; const int col = 64 * tn + jc;
            const size_t bo = (size_t)(64 * tm + i) * 1024 + col;
            const float xb = src16 ? (float)__builtin_bit_cast(_Float16, ((const bf16*)base)[bo]) : ((const float*)base)[bo];
            Z[xo] = (bf16)(pkh(ALPHA * xb + gate[4 * 6144 + col] * s, 0.f) & 0xffffu); }
        __syncthreads();
    }
}
__device__ __forceinline__ void moe_offsets(const gu32* cnt, int (&off)[9]) {
    int a = 0;
#pragma unroll
    for (int e = 0; e < 8; ++e) { off[e] = a; const int c = __builtin_amdgcn_readfirstlane((int)__hip_atomic_load(cnt + e, __ATOMIC_RELAXED, __HIP_MEMORY_SCOPE_AGENT)); a += (c + 255) & ~255; }
    off[8] = a;
}
__device__ __forceinline__ void phase_moe_dispatch(Frame& F, int j, int nrows) {
    int* topk = (int*)(F.ws + WS_TOPK); const bf16* H = (const bf16*)(F.ws + WS_H); unsigned char* XG8 = F.ws + WS_XG8;
    LAS unsigned* lc = (LAS unsigned*)F.lds;
    LAS int* lrow = (LAS int*)(F.lds + 256);
    int off[9]; moe_offsets(F.ctl + CW_CNT + 64 * j, off);
    const int per = nrows / 256;
    for (int c0 = F.vcu * per; c0 < nrows; c0 += F.G * per) {
        if (F.tid < 8) lc[F.tid] = 0u;
        __syncthreads();
        int e1 = 0, e2 = 0, li1 = 0, li2 = 0; const bool on = F.tid < per;
        if (on) { e1 = topk[(c0 + F.tid) * 6]; e2 = topk[(c0 + F.tid) * 6 + 1]; li1 = (int)atomicAdd((unsigned*)&lc[e1], 1u); li2 = (int)atomicAdd((unsigned*)&lc[e2], 1u); }
        __syncthreads();
        if (F.tid < 8) lc[8 + F.tid] = __hip_atomic_fetch_add((unsigned*)(F.ctl + CW_CNT2 + 64 * j) + F.tid, lc[F.tid], __ATOMIC_RELAXED, __HIP_MEMORY_SCOPE_AGENT);
        __syncthreads();
        if (on) {
            int o1 = 0, o2 = 0;
#pragma unroll
            for (int e = 0; e < 8; ++e) { o1 = (e == e1) ? off[e] : o1; o2 = (e == e2) ? off[e] : o2; }
            const int r1 = o1 + (int)lc[8 + e1] + li1, r2 = o2 + (int)lc[8 + e2] + li2;
            topk[(c0 + F.tid) * 6 + 4] = r1; topk[(c0 + F.tid) * 6 + 5] = r2; lrow[2 * F.tid] = r1; lrow[2 * F.tid + 1] = r2;
        }
        __syncthreads();
        for (int p = F.wave; p < 2 * per; p += NWAVES) { const int tok = c0 + (p >> 1), dst = lrow[p];
            const v4u a = *((const GAS v4u*)((const unsigned char*)H + (size_t)tok * 1024) + F.lane);
            *((GAS v4u*)((unsigned char*)XG8 + (size_t)dst * 1024) + F.lane) = a; }
        __syncthreads();
    }
}
#if defined(SELFCHK)
constexpr int CW_CHK = 12288;
__device__ __forceinline__ int chk_row(int s) {
    if (s >= 48) return MLAT + ((s - 48) * 61) % MCTX;
    const int b = s & 3; int t = (s * 683 + 17 * (s >> 2) * 97) & (SEQ - 1);
    if (s < 4) t = 0; else if (s < 8) t = SEQ - 1; else if (s < 12) t = 63; else if (s < 16) t = 64;
    return b * SEQ + t;
}
__device__ __forceinline__ void chk_accum(Frame& F, float num, float den) {
    LAS float* red = (LAS float*)(F.lds + 150000);
    __syncthreads();
    num = wave_sum(num, F.lane); den = wave_sum(den, F.lane);
    if (F.lane == 0) { red[F.wave * 2] = num; red[F.wave * 2 + 1] = den; }
    __syncthreads();
    if (F.tid == 0) { float a = 0.f, b = 0.f; for (int w = 0; w < 8; ++w) { a += red[2 * w]; b += red[2 * w + 1]; }
        atomicAdd((float*)(F.ctl + CW_CHK), a); atomicAdd((float*)(F.ctl + CW_CHK) + 1, b); }
    __syncthreads();
}
__device__ __forceinline__ float chk_rope(const LAS float* x, int d, int rot_dim, int t) {
    const int axis_dim = rot_dim / 2, half = axis_dim / 2, axis = d / axis_dim, i = d % axis_dim;
    const float pos = (float)(axis == 0 ? t / GRIDW : t % GRIDW);
    const float inv = powf(10000.f, -(float)(2 * (i % half)) / (float)axis_dim);
    const float ang = pos * inv; float sn, cs; sincos_red(ang, sn, cs);
    const float rot = (i < half) ? -x[axis * axis_dim + i + half] : x[axis * axis_dim + i - half];
    return x[d] * cs + rot * sn;
}
__device__ __forceinline__ void phase_selfcheck_even(Frame& F, const PArgs& A, int j) {
    const bf16* H = (const bf16*)(F.ws + WS_H);
    const bf16 *QG = (const bf16*)(F.ws + WS_QG), *KG = (const bf16*)(F.ws + WS_KG), *VG = (const bf16*)(F.ws + WS_VG), *CQN = (const bf16*)(F.ws + WS_CQN), *CKVN = (const bf16*)(F.ws + WS_CKVN);
    const bf16 *QM = (const bf16*)(F.ws + WS_QM), *KM = (const bf16*)(F.ws + WS_KM), *VM = (const bf16*)(F.ws + WS_VM), *OE = (const bf16*)(F.ws + WS_OE);
    LAS float* raw = (LAS float*)F.lds;
    LAS float* xn = (LAS float*)(F.lds + 8192);
    LAS float* sc = (LAS float*)(F.lds + 16384);
    LAS float* red = (LAS float*)(F.lds + 65536);
    const int tid = F.tid;
#if SELFCHK >= 5
#elif SELFCHK == 1 || SELFCHK == 2
    for (int s = F.vcu; s < 64; s += F.G) {
        const int row = chk_row(s); const bool lat = row < MLAT; const int t = row & (SEQ - 1);
        float num = 0.f, den = 0.f;
#if SELFCHK == 1
        const float* W = A.in[I_EVWIN] + (size_t)j * 1024 * EV_IN;
        for (int c = tid; c < EV_IN; c += NTHR) { float a = 0.f; for (int k = 0; k < 1024; ++k) a += bf2f(H[(size_t)row * 1024 + k]) * W[(size_t)k * EV_IN + c]; raw[c] = a; }
        __syncthreads();
        for (int c = tid; c < 640; c += NTHR) { const int hb = (c / 64) * 64, d = c % 64; float ss = 0.f; for (int k = 0; k < 64; ++k) ss += raw[hb + k] * raw[hb + k];
            const float g = (c < 512) ? A.in[I_QNG][j * 64 + d] : A.in[I_KNG][j * 64 + d]; xn[c] = raw[c] * (1.f / sqrtf(ss / 64.f + 1e-6f)) * g; }
        __syncthreads();
        for (int c = tid; c < 640; c += NTHR) { const int hb = (c / 64) * 64, d = c % 64; const float ref = lat ? chk_rope(xn + hb, d, 64, t) : xn[c];
            const float got = (c < 512) ? bf2f(QG[(size_t)row * 512 + c]) / C2_64 : bf2f(KG[(size_t)row * 128 + (c - 512)]); num += (got - ref) * (got - ref); den += ref * ref; }
        for (int c = tid; c < 128; c += NTHR) { const float ref = raw[640 + c], got = bf2f(VG[(size_t)row * 128 + c]); num += (got - ref) * (got - ref); den += ref * ref; }
        { float ss = 0.f; for (int k = 0; k < 384; ++k) ss += raw[768 + k] * raw[768 + k]; const float rs = 1.f / sqrtf(ss / 384.f + 1e-6f);
          for (int c = tid; c < 384; c += NTHR) { const float ref = raw[768 + c] * rs * A.in[I_CQG][j * 384 + c], got = bf2f(CQN[(size_t)row * 384 + c]); num += (got - ref) * (got - ref); den += ref * ref; } }
        { float ss = 0.f; for (int k = 0; k < 256; ++k) ss += raw[1152 + k] * raw[1152 + k]; const float rs = 1.f / sqrtf(ss / 256.f + 1e-6f);
          for (int c = tid; c < 256; c += NTHR) { const float ref = raw[1152 + c] * rs * A.in[I_CKVG][j * 256 + c], got = bf2f(CKVN[(size_t)row * 256 + c]); num += (got - ref) * (got - ref); den += ref * ref; } }
        for (int c = tid; c < 256; c += NTHR) { const int head = c / 32, d = c % 32; const float ref = lat ? chk_rope(raw + 1408, d, 32, t) : raw[1408 + d];
            const float got = bf2f(KM[(size_t)row * 768 + head * 96 + 64 + d]); num += (got - ref) * (got - ref); den += ref * ref; }
#else
        const float* Wq = A.in[I_WUQ] + (size_t)j * 384 * 768; const float* Wkv = A.in[I_WUKV] + (size_t)j * 256 * 1024;
        for (int c = tid; c < 768; c += NTHR) { float a = 0.f; for (int k = 0; k < 384; ++k) a += bf2f(CQN[(size_t)row * 384 + k]) * Wq[(size_t)k * 768 + c]; raw[c] = a; }
        __syncthreads();
        for (int c = tid; c < 768; c += NTHR) { const int head = c / 96, d = c % 96; const float ref = (d >= 64 && lat) ? chk_rope(raw + head * 96 + 64, d - 64, 32, t) : raw[c];
            const float got = bf2f(QM[(size_t)row * 768 + c]) / C2_96; num += (got - ref) * (got - ref); den += ref * ref; }
        for (int c = tid; c < 1024; c += NTHR) { float a = 0.f; for (int k = 0; k < 256; ++k) a += bf2f(CKVN[(size_t)row * 256 + k]) * Wkv[(size_t)k * 1024 + c];
            const int head = c / 128, d = c % 128; const float got = (d < 64) ? bf2f(KM[(size_t)row * 768 + head * 96 + d]) : bf2f(VM[(size_t)row * 512 + head * 64 + (d - 64)]); num += (got - a) * (got - a); den += a * a; }
#endif
        chk_accum(F, num, den);
    }
#elif SELFCHK == 3 || SELFCHK == 4
    for (int u = F.vcu; u < 64 * 8; u += F.G) {
        const int s = u >> 3, h = u & 7; const int row = chk_row(s); const bool lat = row < MLAT; const int b = lat ? row / SEQ : (row - MLAT) / CTXL;
        const int nk = lat ? SEQ + CTXL : CTXL;
#if SELFCHK == 3
        constexpr int DKK = 64; const bf16* qp = QG + (size_t)row * 512 + h * 64; const int kvh = h / 4;
#define CHK_K(key) (KG + (size_t)(key) * 128 + kvh * 64)
#define CHK_V(key) (VG + (size_t)(key) * 128 + kvh * 64)
        const bf16* op = OE + (size_t)row * 1024 + h * 64;
#else
        constexpr int DKK = 96; const bf16* qp = QM + (size_t)row * 768 + h * 96;
#define CHK_K(key) (KM + (size_t)(key) * 768 + h * 96)
#define CHK_V(key) (VM + (size_t)(key) * 512 + h * 64)
        const bf16* op = OE + (size_t)row * 1024 + 512 + h * 64;
#endif
        float mx = -INFINITY;
        for (int kk = tid; kk < nk; kk += NTHR) { const int key = lat ? (kk < SEQ ? b * SEQ + kk : MLAT + b * CTXL + (kk - SEQ)) : MLAT + b * CTXL + kk;
            float a = 0.f; for (int d = 0; d < DKK; ++d) a += bf2f(qp[d]) * bf2f(CHK_K(key)[d]); sc[kk] = a; mx = fmaxf(mx, a); }
#pragma unroll
        for (int o = 1; o < 64; o <<= 1) mx = fmaxf(mx, shx(mx, o, F.lane));
        if (F.lane == 0) red[F.wave] = mx;
        __syncthreads();
        mx = red[0]; for (int w = 1; w < 8; ++w) mx = fmaxf(mx, red[w]);
        float ls = 0.f;
        for (int kk = tid; kk < nk; kk += NTHR) { const float p = exp2f(sc[kk] - mx); sc[kk] = p; ls += p; }
        ls = wave_sum(ls, F.lane);
        __syncthreads();
        if (F.lane == 0) red[8 + F.wave] = ls;
        __syncthreads();
        ls = 0.f; for (int w = 0; w < 8; ++w) ls += red[8 + w];
        { const int d = tid & 63, part = tid >> 6; float a = 0.f;
          for (int kk = part; kk < nk; kk += 8) { const int key = lat ? (kk < SEQ ? b * SEQ + kk : MLAT + b * CTXL + (kk - SEQ)) : MLAT + b * CTXL + kk; a += sc[kk] * bf2f(CHK_V(key)[d]); }
          red[64 + part * 64 + d] = a; }
        __syncthreads();
        float num = 0.f, den = 0.f;
        if (tid < 64) { float a = 0.f; for (int p = 0; p < 8; ++p) a += red[64 + p * 64 + tid]; const float ref = a / ls, got = bf2f(op[tid]); num = (got - ref) * (got - ref); den = ref * ref; }
        chk_accum(F, num, den);
#undef CHK_K
#undef CHK_V
    }
#endif
}
#endif

#if defined(SELFCHK) && (SELFCHK == 5 || SELFCHK == 6 || SELFCHK == 7)
__device__ __forceinline__ void phase_selfcheck_na(Frame& F, const PArgs& A, int j) {
    const bf16 *QN = (const bf16*)(F.ws + WS_QN), *KN = (const bf16*)(F.ws + WS_KN), *VN = (const bf16*)(F.ws + WS_VN), *OO = (const bf16*)(F.ws + WS_OO);
    LAS float* sc = (LAS float*)(F.lds + 16384); LAS float* red = (LAS float*)(F.lds + 65536); LAS int* kid = (LAS int*)(F.lds + 32768);
    const int tid = F.tid;
    for (int u = F.vcu; u < 64 * 8; u += F.G) {
        const int s = u >> 3, h = u & 7; const int row = chk_row(s); const bool lat = row < MLAT; const int b = lat ? row / SEQ : (row - MLAT) / CTXL;
        if (!lat && j == 1) continue;
        const bf16* qp = QN + (size_t)row * 512 + h * 64; const float* rpb = A.in[I_RPB] + ((size_t)j * 8 + h) * 15 * 31;
        int nk = CTXL;
        if (lat) { nk = 128 + CTXL; const int t = row % SEQ, r = t / GRIDW, cc = t % GRIDW;
            const int rs = min(max(r - 4, 0), 128 - 8), cs = min(max(cc - 8, 0), GRIDW - 16);
            for (int w = tid; w < 128; w += NTHR) { const int i = w / 16, jj = w % 16; const int kr = rs + i, kc = cs + jj; kid[w] = b * SEQ + kr * GRIDW + kc;
                sc[1024 + w] = rpb[(kr - r + 7) * 31 + (kc - cc + 15)] * LOG2E; }
            for (int w = tid; w < CTXL; w += NTHR) { kid[128 + w] = MLAT + b * CTXL + w; sc[1024 + 128 + w] = 0.f; }
        } else { for (int w = tid; w < CTXL; w += NTHR) { kid[w] = MLAT + b * CTXL + w; sc[1024 + w] = 0.f; } }
        __syncthreads();
        float mx = -INFINITY;
        for (int kk = tid; kk < nk; kk += NTHR) { const bf16* kp = KN + (size_t)kid[kk] * 512 + h * 64; float a = 0.f; for (int d = 0; d < 64; ++d) a += bf2f(qp[d]) * bf2f(kp[d]); a += sc[1024 + kk]; sc[kk] = a; mx = fmaxf(mx, a); }
#pragma unroll
        for (int o = 1; o < 64; o <<= 1) mx = fmaxf(mx, shx(mx, o, F.lane));
        if (F.lane == 0) red[F.wave] = mx;
        __syncthreads();
        mx = red[0]; for (int w = 1; w < 8; ++w) mx = fmaxf(mx, red[w]);
        float ls = 0.f;
        for (int kk = tid; kk < nk; kk += NTHR) { const float p = exp2f(sc[kk] - mx); sc[kk] = p; ls += p; }
        ls = wave_sum(ls, F.lane);
        __syncthreads();
        if (F.lane == 0) red[8 + F.wave] = ls;
        __syncthreads();
        ls = 0.f; for (int w = 0; w < 8; ++w) ls += red[8 + w];
        { const int d = tid & 63, part = tid >> 6; float a = 0.f;
          for (int kk = part; kk < nk; kk += 8) a += sc[kk] * bf2f(VN[(size_t)kid[kk] * 512 + h * 64 + d]);
          red[64 + part * 64 + d] = a; }
        __syncthreads();
        float num = 0.f, den = 0.f;
        if (tid < 64) { float a = 0.f; for (int p = 0; p < 8; ++p) a += red[64 + p * 64 + tid]; const float ref = a / ls, got = bf2f(OO[(size_t)row * 1024 + h * 64 + tid]); num = (got - ref) * (got - ref); den = ref * ref; }
        chk_accum(F, num, den);
    }
}
constexpr size_t WS_CHKO = WS_END;
__device__ __forceinline__ int chk_seq_row(int b, int dir, int sq) { if (sq < CTXL) return MLAT + b * CTXL + (dir ? CTXL - 1 - sq : sq); const int jq = sq - CTXL; return b * SEQ + (dir ? SEQ - 1 - jq : jq); }
__device__ __forceinline__ void phase_selfcheck_hg_scan(Frame& F, const PArgs& A, int j) {
    if (F.vcu >= 4) return;
    const int c = F.vcu, dir = c & 1, pair = c >> 1; const int b = pair ? 3 : 1, h = pair ? 0 : 2, hoff = h * 128;
    const bf16 *Qd = (const bf16*)(F.ws + WS_QD), *Vd = (const bf16*)(F.ws + WS_VD); const float* Z = (const float*)(F.ws + (dir ? WS_ZB : WS_ZF));
    float* OF = (float*)(F.ws + WS_CHKO) + (size_t)c * 8448 * 128;
    LAS float* vec = (LAS float*)F.lds;
    LAS float* part = (LAS float*)(F.lds + 4096);
    const int tid = F.tid, f = tid & 127, eq = tid >> 7;
    float S[32];
#pragma unroll
    for (int i = 0; i < 32; ++i) S[i] = 0.f;
    for (int sq = 0; sq < CTXL + SEQ; ++sq) {
        const int row = chk_seq_row(b, dir, sq);
        if (tid < 128) { const int ch = hoff + tid; const float l0 = A.in[I_LBL][(dir * 2 + 0) * 512 + ch], l1 = A.in[I_LBL][(dir * 2 + 1) * 512 + ch];
            const float m = fmaxf(l0, l1), p0 = expf(l0 - m) / (expf(l0 - m) + expf(l1 - m)), p1 = expf(l1 - m) / (expf(l0 - m) + expf(l1 - m)); const float lb = (j == 0) ? 0.f : (p0 + p1) - p0;
            const float z = Z[(size_t)row * 512 + ch]; const float sg = 1.f / (1.f + expf(-z));
            vec[tid] = bf2f(Qd[(size_t)row * 512 + ch]); vec[128 + tid] = (1.f - lb) * (1.f / (1.f + expf(z))); vec[256 + tid] = bf2f(Vd[(size_t)row * 512 + ch]); vec[384 + tid] = lb + (1.f - lb) * sg; }
        __syncthreads();
        float o = 0.f; const float vf = vec[256 + f];
#pragma unroll
        for (int i = 0; i < 32; ++i) { const int e = eq * 32 + i; S[i] = vec[384 + e] * S[i] + vec[128 + e] * vf; o += S[i] * vec[e]; }
        part[eq * 128 + f] = o;
        __syncthreads();
        if (tid < 128) OF[(size_t)sq * 128 + tid] = part[tid] + part[128 + tid] + part[256 + tid] + part[384 + tid];
    }
}
__device__ __forceinline__ void phase_selfcheck_hg_cmp(Frame& F, const PArgs& A, int j) {
    const bf16 *Sg = (const bf16*)(F.ws + WS_SG), *OO = (const bf16*)(F.ws + WS_OO); const float* OF = (const float*)(F.ws + WS_CHKO);
    const int gw = F.vcu * NWAVES + F.wave, NGW = F.G * NWAVES;
    float num = 0.f, den = 0.f;
    for (int it = gw; it < 2 * 8448; it += NGW) { const int pair = it / 8448, sq = it % 8448; const int b = pair ? 3 : 1, h = pair ? 0 : 2, hoff = h * 128;
        const int row = chk_seq_row(b, 0, sq);
        const int sqb = (sq < CTXL) ? (CTXL - 1 - sq) : (CTXL + (SEQ - 1 - (sq - CTXL)));
        const float* of = OF + ((size_t)(pair * 2 + 0) * 8448 + sq) * 128; const float* ob = OF + ((size_t)(pair * 2 + 1) * 8448 + sqb) * 128;
        const float* D0 = (const float*)(F.ws + 1002 * MiB) + ((size_t)(0 * 2 + pair) * 8448 + sq) * 128; const float* D1 = (const float*)(F.ws + 1002 * MiB) + ((size_t)(1 * 2 + pair) * 8448 + sq) * 128;
#ifndef CHKSEL
#define CHKSEL 0
#endif
        (void)row; (void)Sg; (void)OO;
#pragma unroll
        for (int q2 = 0; q2 < 2; ++q2) { const int ff = F.lane + 64 * q2;
            const float ref = (CHKSEL != 1) ? of[ff] : ob[ff]; const float got = (CHKSEL != 1) ? D0[ff] : (D1[ff] - D0[ff]);
            const bool use = (CHKSEL == 10) ? (sq < 64) : (CHKSEL == 11) ? (sq >= 64 && sq < 128) : (CHKSEL == 12) ? (sq >= 128 && sq < 256) : (CHKSEL == 13) ? (sq >= 256 && ((sq & 127) < 64)) : (CHKSEL == 14) ? (sq >= 256 && ((sq & 127) >= 64)) : true;
            if (use && (j == 0 || sq >= CTXL)) { num += (got - ref) * (got - ref); den += ref * ref; } } }
    chk_accum(F, num, den);
}
#endif
constexpr int PH_CV = 0, PH_MOD = 1, PH_E1 = 2, PH_E2 = 3, PH_E3 = 4, PH_E5 = 5, PH_E6 = 6, PH_E7 = 7, PH_E8 = 8, PH_E9 = 9, PH_E10 = 10,
              PH_O1 = 11, PH_O2 = 12, PH_O3 = 13, PH_O4 = 14, PH_O5 = 15, PH_O6 = 16, PH_O7 = 17, PH_O8 = 18, PH_O9 = 19, PH_O10 = 20, PH_PER = 21;
constexpr int NPHASES = 2 * PH_PER;

__global__ void __launch_bounds__(NTHR, 2) mk_fwd(Args args) {
    extern __shared__ __attribute__((aligned(16))) unsigned char lds[];
    Frame F;
    F.lds = (LAS unsigned char*)lds; F.ws = args.ws; F.ctl = (gu32*)(args.ws + WS_CTL);
    F.tid = threadIdx.x; F.lane = F.tid & 63; F.wave = __builtin_amdgcn_readfirstlane(F.tid >> 6);
    F.G = gridDim.x; { const int bx = blockIdx.x; F.vcu = (F.G % 8 == 0) ? (bx % 8) * (F.G / 8) + bx / 8 : bx; }
    volatile LAS unsigned* MISC = (volatile LAS unsigned*)(F.lds + MISC_OFF);
    if (F.tid < 64) MISC[F.tid] = 0u;
    { LAS unsigned long long* tab = (LAS unsigned long long*)(F.lds + MISC_OFF + 256);
      if (F.tid == 0) {
#pragma unroll
          for (int i = 0; i < 30; ++i) tab[i] = (unsigned long long)args.in[i];
          tab[30] = (unsigned long long)args.out; } }
    __syncthreads();
    const int lo = args.ph_lo, hi = args.ph_hi; const int wv0 = F.wave;
    const bool multi = (hi - lo) > 1;
    XcdBarrier bar; bar.bar = (unsigned*)(F.ctl + CW_BAR); bar.x = 0; bar.st = nullptr;
    if (multi) bar = xcd_barrier_post((unsigned*)(F.ctl + CW_BAR), MISC + 8);
#ifndef PHMASK
#define PHMASK 0x1fffff
#endif
#define IN(k) ((((PHMASK) >> ((k) % PH_PER)) & 1) && lo <= (k) && (k) < hi)
#if defined(PROBE_PH)
    if (PROBE_PH == 0 && blockIdx.x == 0 && threadIdx.x == 0) MISC[16] = (unsigned)__builtin_amdgcn_s_memrealtime();
#endif
#define MKT HgT T; T.Qd = (const bf16*)(ws + WS_QD); T.Vd = (const bf16*)(ws + WS_VD); T.Sg = (const bf16*)(ws + WS_SG); T.Zf = (const float*)(ws + WS_ZF); T.Zb = (const float*)(ws + WS_ZB); \
    T.lb = (const float*)(ws + WS_SMALL + SM_LB) + j * 1024; T.HST = (float*)(ws + WS_HST); T.HDM = (float*)(ws + WS_HDM); T.ong = PA.in[I_ONG] + j * 128; T.OO = (bf16*)(ws + WS_OO);
#define FRESH() int t_; asm volatile("v_mbcnt_lo_u32_b32 %0, -1, 0\n\tv_mbcnt_hi_u32_b32 %0, -1, %0" : "=v"(t_)); t_ += wv0 * 64; F.tid = t_; F.lane = t_ & 63; F.wave = __builtin_amdgcn_readfirstlane(t_ >> 6); \
    unsigned char* ws = ws0; asm volatile("" : "+s"(ws)); F.ws = ws; F.ctl = (gu32*)(ws + WS_CTL); PArgs PA; PA.in.t = (LAS unsigned long long*)(F.lds + MISC_OFF + 256); PA.out = (float*)PA.in[30]; \
    float* mods = (float*)(ws + WS_SMALL + SM_MODS); bf16* W = (bf16*)(ws + WS_W); bf16* WM = (bf16*)(ws + WS_WMOE); bf16* H = (bf16*)(ws + WS_H); bf16* X = (bf16*)(ws + WS_X); \
    const float* modE = mods + (size_t)Le * 5 * 6144; const float* modO = mods + (size_t)Lo * 5 * 6144; (void)W; (void)WM; (void)H; (void)X; (void)modE; (void)modO;
#if defined(PROBE_PH)
#define IS_T0() ({ int l_; asm volatile("v_mbcnt_lo_u32_b32 %0, -1, 0\n\tv_mbcnt_hi_u32_b32 %0, -1, %0" : "=v"(l_)); (wv0 == 0 && l_ == 0); })
#if defined(PROBE_CLK)
#define PROBE_NOW() ((unsigned)__builtin_amdgcn_s_memtime())
#else
#define PROBE_NOW() ((unsigned)__builtin_amdgcn_s_memrealtime())
#endif
#define PROBE_T0(k) do { if ((k) == PROBE_PH && blockIdx.x == 0 && IS_T0()) { MISC[16] = PROBE_NOW(); } } while (0)
#define PROBE_T1(k) do { if ((k) == PROBE_PH && blockIdx.x == 0 && IS_T0()) { MISC[18] = PROBE_NOW() - MISC[16]; } } while (0)
#else
#define PROBE_T0(k) do {} while (0)
#define PROBE_T1(k) do {} while (0)
#endif
#if defined(PROBE_WALL)
#define SEAM(k) do { if (IN(k) && IN((k) + 1)) xcd_barrier(bar); PROBE_T1(k); PROBE_T0((k) + 1); } while (0)
#else
#define SEAM(k) do { PROBE_T1(k); if (IN(k) && IN((k) + 1)) xcd_barrier(bar); PROBE_T0((k) + 1); } while (0)
#endif
    unsigned char* const ws0 = args.ws;
#pragma unroll 1
    for (int j = 0; j < 2; ++j) {
        const int pb = j * PH_PER, Le = 2 * j, Lo = 2 * j + 1;
        if (j == 0) { if (IN(pb + PH_CV)) { FRESH(); phase_cv(F, PA, 0); } SEAM(pb + PH_CV);
                      if (IN(pb + PH_MOD)) { FRESH(); phase_mod(F, PA); } SEAM(pb + PH_MOD); }
        if (IN(pb + PH_E1)) { FRESH();
            pg8::Gemm g{H, W + W_EVIN + (size_t)j * EV_INP * 1024, MROWS, EV_INP, 1024}; pg8::StaticOrder S; S.init(MROWS, EV_INP, F.G, (int)blockIdx.x);
            pg8::EpiPlainBf16 E{(pg8::bf16_t*)(ws + WS_RAW), EV_INP};
            pg8::gemm_phase<pg8::EpiPlainBf16, pg8::StaticOrder, true, true>(F.lds, g, S, E, F.tid);
        } SEAM(pb + PH_E1);
        if (IN(pb + PH_E2)) { FRESH(); phase_even_post(F, PA, j); } SEAM(pb + PH_E2);
        if (IN(pb + PH_E3)) { FRESH();
            { pg8::Gemm g{(const bf16*)(ws + WS_CQN), W + W_UQ + (size_t)j * 768 * 384, MROWS, 768, 384}; pg8::StaticOrder S; S.init(MROWS, 768, F.G, (int)blockIdx.x);
              pg8::EpiMlaQ E{(bf16*)(ws + WS_QM), (const float*)(ws + WS_SMALL + SM_ROPEB)};
              pg8::gemm_phase<pg8::EpiMlaQ, pg8::StaticOrder, true, true>(F.lds, g, S, E, F.tid); }
            { asm volatile("v_mbcnt_lo_u32_b32 %0, -1, 0\n\tv_mbcnt_hi_u32_b32 %0, -1, %0" : "=v"(t_)); t_ += wv0 * 64; F.tid = t_; F.lane = t_ & 63;
              pg8::Gemm g{(const bf16*)(ws + WS_CKVN), W + W_UKV + (size_t)j * 1024 * 256, MROWS, 1024, 256}; pg8::StaticOrder S; S.init(MROWS, 1024, F.G, (int)blockIdx.x);
              pg8::EpiMlaKV E{(bf16*)(ws + WS_KM), (bf16*)(ws + WS_VM)};
              pg8::gemm_phase<pg8::EpiMlaKV, pg8::StaticOrder, true, true>(F.lds, g, S, E, F.tid); }
        } SEAM(pb + PH_E3);
        if (IN(pb + PH_E5)) { FRESH(); phase_even_attn(F); } SEAM(pb + PH_E5);
#if defined(SELFCHK)
        if (IN(pb + PH_E6)) { FRESH(); phase_selfcheck_even(F, PA, j); }
#endif
        if (IN(pb + PH_E6)) { FRESH();
            { pg8::Gemm g{(const bf16*)(ws + WS_OE), W + W_EVOUT + (size_t)j * 1024 * 1024, MLAT, 1024, 1024}; pg8::StaticOrder S; S.init(MLAT, 1024, F.G, (int)blockIdx.x);
              pg8::EpiResid E{(pg8::bf16_t*)(ws + WS_ZR), modE + 2 * 1024, j == 0 ? (const void*)PA.in[I_X] : (const void*)X, j == 0 ? (const void*)PA.in[I_CTX] : (const void*)(X + (size_t)MLAT * 1024), j != 0};
              pg8::gemm_phase<pg8::EpiResid, pg8::StaticOrder, true, true>(F.lds, g, S, E, F.tid); }
            ctx_resid_gemm(F, (const bf16*)(ws + WS_OE), W + W_EVOUT + (size_t)j * 1024 * 1024, 1024, (bf16*)(ws + WS_ZR), modE + 2 * 1024, j == 0 ? (const void*)PA.in[I_CTX] : (const void*)(X + (size_t)MLAT * 1024), j != 0);
        } SEAM(pb + PH_E6);
        if (IN(pb + PH_E7)) { FRESH(); phase_ln<false, false, FFN_F8>(F, PA, PA.in[I_LN1G] + Le * 1024, PA.in[I_LN1B] + Le * 1024, modE + 3 * 1024, nullptr, nullptr, 0, false); } SEAM(pb + PH_E7);
        if (IN(pb + PH_E8)) { FRESH();
            if constexpr (FFN_F8) {
                pg8::Gemm g{H, (const bf16*)((unsigned char*)(W + W_FFGU) + (size_t)j * 2 * DFF * 1024), MROWS, 2 * DFF, 1024 / 2}; pg8::StaticOrder S; S.init(MROWS, 2 * DFF, F.G, (int)blockIdx.x);
                pg8::EpiSwigluS E{(bf16*)(ws + WS_FFH), DFF, 1.f / MOE_WSCALE};
                pg8::gemm_phase<pg8::EpiSwigluS, pg8::StaticOrder, true, true, true>(F.lds, g, S, E, F.tid);
            } else {
                pg8::Gemm g{H, W + W_FFGU + (size_t)j * 2 * DFF * 1024, MROWS, 2 * DFF, 1024}; pg8::StaticOrder S; S.init(MROWS, 2 * DFF, F.G, (int)blockIdx.x);
                pg8::EpiSwiglu E{(bf16*)(ws + WS_FFH), DFF};
                pg8::gemm_phase<pg8::EpiSwiglu, pg8::StaticOrder, true, true>(F.lds, g, S, E, F.tid);
            }
        } SEAM(pb + PH_E8);
        if (IN(pb + PH_E9)) { FRESH();
            { pg8::Gemm g{(const bf16*)(ws + WS_FFH), W + W_FFD + (size_t)j * 1024 * DFF, MLAT, 1024, DFF}; pg8::StaticOrder S; S.init(MLAT, 1024, F.G, (int)blockIdx.x);
              pg8::EpiResid E{(pg8::bf16_t*)(ws + WS_ZR), modE + 5 * 1024, X, X + (size_t)MLAT * 1024, true};
              pg8::gemm_phase<pg8::EpiResid, pg8::StaticOrder, true, true>(F.lds, g, S, E, F.tid); }
            ctx_resid_gemm(F, (const bf16*)(ws + WS_FFH), W + W_FFD + (size_t)j * 1024 * DFF, DFF, (bf16*)(ws + WS_ZR), modE + 5 * 1024, X + (size_t)MLAT * 1024, true);
        } SEAM(pb + PH_E9);
        if (IN(pb + PH_E10)) { FRESH(); phase_ln<false, false>(F, PA, PA.in[I_LN2G] + Le * 1024, PA.in[I_LN2B] + Le * 1024, modO + 0 * 1024, nullptr, nullptr, 0, false); } SEAM(pb + PH_E10);
        if (IN(pb + PH_O1)) { FRESH();
            pg8::Gemm g{H, W + W_ODIN + (size_t)j * 4096 * 1024, MROWS, 4096, 1024}; pg8::StaticOrder S; S.init(MROWS, 4096, F.G, (int)blockIdx.x);
            pg8::EpiOddIn E{(bf16*)(ws + WS_QN), (bf16*)(ws + WS_KN), (bf16*)(ws + WS_VN), (bf16*)(ws + WS_QD), (bf16*)(ws + WS_VD), (bf16*)(ws + WS_SG), (float*)(ws + WS_ZF), (float*)(ws + WS_ZB)};
            pg8::gemm_phase<pg8::EpiOddIn, pg8::StaticOrder, true, true>(F.lds, g, S, E, F.tid);
        } SEAM(pb + PH_O1);
        if (IN(pb + PH_O2)) { FRESH(); MKT phase_odd_mix(F, PA, T, j); } SEAM(pb + PH_O2);
        if (IN(pb + PH_O3)) { FRESH(); MKT phase_hg_b(F, T); } SEAM(pb + PH_O3);
        if (IN(pb + PH_O4)) { FRESH(); MKT if (j == 1) { for (int u = F.vcu; u < 16 * 64; u += F.G) hg_c_unit(F, T, u >> 8, (u >> 6) & 3, 2 + (u & 63)); }
            else { for (int u = F.vcu; u < 16 * 66; u += F.G) hg_c_unit(F, T, u / 264, (u / 66) & 3, u % 66); } } SEAM(pb + PH_O4);
#if defined(SELFCHK) && SELFCHK == 5
        if (IN(pb + PH_O5)) { FRESH(); phase_selfcheck_na(F, PA, j); }
#endif
#if defined(SELFCHK) && SELFCHK == 6
#ifndef CHKJ
#define CHKJ j
#endif
        if (IN(pb + PH_O5) && j == (CHKJ)) { { FRESH(); phase_selfcheck_hg_scan(F, PA, j); } xcd_barrier(bar); { FRESH(); phase_selfcheck_hg_cmp(F, PA, j); } }
#endif
        if (IN(pb + PH_O5)) { FRESH();
            { pg8::Gemm g{(const bf16*)(ws + WS_OO), W + W_ODOUT + (size_t)j * 1024 * 1024, MLAT, 1024, 1024}; pg8::StaticOrder S; S.init(MLAT, 1024, F.G, (int)blockIdx.x);
              pg8::EpiResid E{(pg8::bf16_t*)(ws + WS_ZR), modO + 2 * 1024, X, X + (size_t)MLAT * 1024, true};
              pg8::gemm_phase<pg8::EpiResid, pg8::StaticOrder, true, true>(F.lds, g, S, E, F.tid); }
            if (j == 0) ctx_resid_gemm(F, (const bf16*)(ws + WS_OO), W + W_ODOUT + (size_t)j * 1024 * 1024, 1024, (bf16*)(ws + WS_ZR), modO + 2 * 1024, X + (size_t)MLAT * 1024, true);
        } SEAM(pb + PH_O5);
        if (IN(pb + PH_O6)) { FRESH(); phase_ln<false, true, true>(F, PA, PA.in[I_LN1G] + Lo * 1024, PA.in[I_LN1B] + Lo * 1024, modO + 3 * 1024, nullptr, PA.in[I_ROUTER] + (size_t)j * 1024 * 8, j, false, (j == 1) ? MLAT : MROWS); } SEAM(pb + PH_O6);
        if (IN(pb + PH_O7)) { FRESH(); phase_moe_dispatch(F, j, (j == 1) ? MLAT : MROWS); } SEAM(pb + PH_O7);
        if (IN(pb + PH_O8)) { FRESH();
            int off[9]; moe_offsets(F.ctl + CW_CNT + 64 * j, off);
            pg8::GroupedOrder S; S.nM = off[8] >> 8; S.nN = 2 * DFFE / 256; S.nwg = S.nM * S.nN; S.G = F.G; S.c = (int)blockIdx.x; S.estride = (long)2 * DFFE * 1024;
#pragma unroll
            for (int e = 0; e < 9; ++e) S.toff[e] = off[e] >> 8;
            pg8::Gemm g{(const bf16*)(ws + WS_XG8), (const bf16*)((unsigned char*)WM + WM_GU), MOE_ROWS, 2 * DFFE, 1024 / 2};
            pg8::EpiSwigluF8 E{ws + WS_MH, DFFE, 1.f / MOE_WSCALE};
            pg8::gemm_phase<pg8::EpiSwigluF8, pg8::GroupedOrder, true, true, true>(F.lds, g, S, E, F.tid);
        } SEAM(pb + PH_O8);
        if (IN(pb + PH_O9)) { FRESH();
            int off[9]; moe_offsets(F.ctl + CW_CNT + 64 * j, off);
            pg8::GroupedOrder S; S.nM = off[8] >> 8; S.nN = 1024 / 256; S.nwg = S.nM * S.nN; S.G = F.G; S.c = (int)blockIdx.x; S.estride = (long)1024 * DFFE;
#pragma unroll
            for (int e = 0; e < 9; ++e) S.toff[e] = off[e] >> 8;
            pg8::Gemm g{(const bf16*)(ws + WS_MH), (const bf16*)((unsigned char*)WM + WM_D), MOE_ROWS, 1024, DFFE / 2};
            pg8::EpiScaledBf16 E{(bf16*)(ws + WS_XG), 1024, 1.f / MOE_WSCALE};
            pg8::gemm_phase<pg8::EpiScaledBf16, pg8::GroupedOrder, true, true, true>(F.lds, g, S, E, F.tid);
        } SEAM(pb + PH_O9);
        if (IN(pb + PH_O10)) { FRESH(); phase_ln<true, false>(F, PA, PA.in[I_LN2G] + Lo * 1024, PA.in[I_LN2B] + Lo * 1024, mods + (size_t)(j == 0 ? 2 : 0) * 5 * 6144, modO + 5 * 1024, nullptr, 0, j == 1, (j == 1) ? MLAT : MROWS); }
        if (j == 0) { if (IN(pb + PH_O10)) { FRESH(); phase_cv(F, PA, 1); }
                      if (IN(pb + PH_O10) && IN(PH_PER + PH_E1)) xcd_barrier(bar); }
    }
#if defined(PROBE_BARRIERS)
    for (int i = 0; i < PROBE_BARRIERS; ++i) xcd_barrier(bar);
#endif
#if defined(PROBE_ACC)
    if (blockIdx.x == 0 && ({ int l_; asm volatile("v_mbcnt_lo_u32_b32 %0, -1, 0\n\tv_mbcnt_hi_u32_b32 %0, -1, %0" : "=v"(l_)); (wv0 == 0 && l_ == 0); })) { const unsigned d = MISC[18]; const unsigned t0 = (unsigned)__builtin_amdgcn_s_memrealtime(); while ((unsigned)__builtin_amdgcn_s_memrealtime() - t0 < 9u * d) __builtin_amdgcn_s_sleep(8); }
#endif
#if defined(PROBE_PH)
#if defined(PROBE_CLK)
    if (blockIdx.x == 0 && IS_T0()) { const unsigned d = MISC[18] / 20u; const unsigned t0 = (unsigned)__builtin_amdgcn_s_memrealtime(); while ((unsigned)__builtin_amdgcn_s_memrealtime() - t0 < 9u * d) __builtin_amdgcn_s_sleep(8); }
#else
    if (blockIdx.x == 0 && IS_T0()) { const unsigned d = MISC[18]; const unsigned t0 = (unsigned)__builtin_amdgcn_s_memrealtime(); while ((unsigned)__builtin_amdgcn_s_memrealtime() - t0 < 9u * d) __builtin_amdgcn_s_sleep(8); }
#endif
#endif
#undef IN
#undef SEAM
}

extern "C" void kernel_launch(void* const* d_in, const int* in_sizes, int n_in, void* d_out, int out_size, void* d_ws, size_t ws_size, hipStream_t stream) {
    static int grid = 0;
    if (grid == 0) {
        if (n_in != 30 || in_sizes[0] != MLAT * DM || out_size != MLAT * DM || ws_size < WS_END) { fprintf(stderr, "kernel_launch: unexpected shapes / workspace (n_in %d, ws %zu)\n", n_in, ws_size); grid = -1; return; }
        int dev = 0, cus = 0, per_cu = 0;
        if (hipGetDevice(&dev) != hipSuccess || hipDeviceGetAttribute(&cus, hipDeviceAttributeMultiprocessorCount, dev) != hipSuccess) { grid = -1; return; }
        if (hipFuncSetAttribute((const void*)mk_fwd, hipFuncAttributeMaxDynamicSharedMemorySize, LDS_BYTES) != hipSuccess) { fprintf(stderr, "kernel_launch: hipFuncSetAttribute failed\n"); grid = -1; return; }
        if (hipOccupancyMaxActiveBlocksPerMultiprocessor(&per_cu, (const void*)mk_fwd, NTHR, LDS_BYTES) != hipSuccess || per_cu < 1) { fprintf(stderr, "kernel_launch: occupancy query says %d\n", per_cu); }
        (void)hipGetLastError();
        grid = cus;
        if (grid != 256) { fprintf(stderr, "kernel_launch: built for 256 CUs, found %d\n", cus); grid = -1; return; }
    }
    if (grid < 0) return;
    if (hipMemsetAsync((char*)d_ws + WS_CTL, 0, CTL_ZERO_BYTES, stream) != hipSuccess) return;
    Args a{};
    for (int i = 0; i < 30; ++i) a.in[i] = (const float*)d_in[i];
    a.out = (float*)d_out; a.ws = (unsigned char*)d_ws;
#if MK_MULTI
    for (int ph = 0; ph < NPHASES; ++ph) {
        if (ph == PH_PER + PH_MOD || ph == PH_PER + PH_CV) continue;
        a.ph_lo = ph; a.ph_hi = ph + 1;
        hipLaunchKernelGGL(mk_fwd, dim3(grid), dim3(NTHR), LDS_BYTES, stream, a);
    }
#else
    a.ph_lo = 0; a.ph_hi = NPHASES;
    hipLaunchKernelGGL(mk_fwd, dim3(grid), dim3(NTHR), LDS_BYTES, stream, a);
#endif
}
```

```cpp
#include <hip/hip_runtime.h>
#include <cstdio>
#include <cstdint>

#ifndef MK_MULTI
#define MK_MULTI 0
#endif

constexpr int DM = 1024, NB = 4, SEQ = 8192, CTXL = 256, GRIDW = 64;
constexpr int MLAT = NB * SEQ, MCTX = NB * CTXL, MROWS = MLAT + MCTX;
constexpr int DEPTH = 4;
constexpr int EV_IN = 1440, EV_INP = 1536;
constexpr int DFF = 2816, DFFE = 3584, NEXP = 8;
constexpr int MOE_ROWS = 2 * MROWS + NEXP * 256;
constexpr float ALPHA = 1.6817928305074290f;
constexpr float LOG2E = 1.4426950408889634f;
constexpr float C2_64 = 0.125f * LOG2E;
constexpr float C2_96 = 0.10206207261596577f * LOG2E;

constexpr size_t MiB = 1u << 20;
constexpr size_t WS_CTL = 0, CTL_ZERO_BYTES = 1 * MiB;
constexpr size_t WS_SMALL = 2 * MiB;
constexpr size_t WS_TOPK = 4 * MiB;
constexpr size_t WS_W = 6 * MiB;
constexpr size_t WS_WMOE = 72 * MiB;
constexpr size_t WS_X = 240 * MiB;
constexpr size_t WS_H = 372 * MiB;
constexpr size_t WS_S = 438 * MiB;
constexpr size_t WS_RAW = WS_S;
constexpr size_t WS_QG = 636 * MiB, WS_KG = 669 * MiB, WS_VG = 678 * MiB, WS_CQN = 687 * MiB, WS_CKVN = 712 * MiB;
constexpr size_t WS_QM = 729 * MiB, WS_KM = 779 * MiB, WS_VM = 829 * MiB, WS_OE = 862 * MiB;
constexpr size_t WS_FFH = WS_S;
constexpr size_t WS_QN = 438 * MiB, WS_KN = 471 * MiB, WS_VN = 504 * MiB, WS_QD = 537 * MiB, WS_VD = 570 * MiB, WS_SG = 603 * MiB;
constexpr size_t WS_ZF = 636 * MiB, WS_ZB = 702 * MiB, WS_OO = 768 * MiB, WS_HST = 834 * MiB, WS_HDM = 966 * MiB;
constexpr size_t WS_MH = 372 * MiB;
constexpr size_t WS_XG = 848 * MiB;
constexpr size_t WS_XG8 = 612 * MiB;
constexpr size_t WS_ZR = 700 * MiB;
constexpr size_t WS_END = 984 * MiB;
static_assert(WS_QG >= WS_RAW + (size_t)MROWS * EV_INP * 4 && WS_OE + (size_t)MROWS * 2048 <= 984 * MiB, "even map");
static_assert(WS_HST + (size_t)32 * 66 * 65536 <= WS_HDM && WS_HDM + (size_t)32 * 66 * 512 <= WS_END, "odd map");
static_assert(WS_MH + (size_t)MOE_ROWS * DFFE <= WS_XG8 && WS_XG8 + (size_t)MOE_ROWS * 1024 <= WS_XG && WS_XG + (size_t)MOE_ROWS * 2048 <= WS_END, "moe map");
constexpr size_t SM_MODS = 0;
constexpr size_t SM_ROPEA = 512 * 1024;
constexpr size_t SM_ROPEB = SM_ROPEA + 16384;
constexpr size_t SM_LB = SM_ROPEB + 8192;
constexpr size_t W_EVIN = 0;
constexpr size_t W_UQ = W_EVIN + (size_t)2 * 1536 * 1024;
constexpr size_t W_UKV = W_UQ + (size_t)2 * 768 * 384;
constexpr size_t W_EVOUT = W_UKV + (size_t)2 * 1024 * 256;
constexpr size_t W_FFGU = W_EVOUT + (size_t)2 * 1024 * 1024;
constexpr size_t W_FFD = W_FFGU + (size_t)2 * 5632 * 1024;
constexpr size_t W_ODIN = W_FFD + (size_t)2 * 1024 * 2816;
constexpr size_t W_ODOUT = W_ODIN + (size_t)2 * 4096 * 1024;
constexpr size_t W_ENDE = W_ODOUT + (size_t)2 * 1024 * 1024;
static_assert(W_ENDE * 2 <= 66 * MiB, "weights map");
constexpr size_t WM_GU = 0;
constexpr size_t WM_D = (size_t)8 * 7168 * 1024;
#ifndef FFN_F8
#define FFN_F8 true
#endif
constexpr float MOE_WSCALE = 64.f;
constexpr int CW_BAR = 4096;
constexpr int CW_CNT = 8192;
constexpr int CW_CNT2 = 8192 + 256;
constexpr int LDS_BYTES = 160256;
constexpr int MISC_OFF = LDS_BYTES - 512;
constexpr int NWAVES = 8, NTHR = 512;

#define GAS __attribute__((address_space(1)))
#define LAS __attribute__((address_space(3)))
typedef unsigned short bf16;
typedef unsigned v4u __attribute__((ext_vector_type(4)));
typedef unsigned v2u __attribute__((ext_vector_type(2)));
typedef float f32x4 __attribute__((ext_vector_type(4)));
typedef float f32x16 __attribute__((ext_vector_type(16)));
typedef short bf16x8 __attribute__((ext_vector_type(8)));
typedef short s16x4 __attribute__((ext_vector_type(4)));
typedef GAS unsigned gu32;

typedef float f32x2_t __attribute__((ext_vector_type(2))); typedef __bf16 bf16x2_t __attribute__((ext_vector_type(2)));
__device__ __forceinline__ unsigned pkbf(float lo, float hi) { f32x2_t v = {lo, hi}; bf16x2_t b = __builtin_convertvector(v, bf16x2_t); return __builtin_bit_cast(unsigned, b); }
typedef _Float16 h16x2 __attribute__((ext_vector_type(2)));
typedef _Float16 h16x4 __attribute__((ext_vector_type(4)));
typedef float f32x2v __attribute__((ext_vector_type(2)));
__device__ __forceinline__ unsigned pkh(float a, float b) { return __builtin_bit_cast(unsigned, __builtin_convertvector((f32x2v){a, b}, h16x2)); }
__device__ __forceinline__ float bf_lo(unsigned u) { return __uint_as_float(u << 16); }
__device__ __forceinline__ float bf_hi(unsigned u) { return __uint_as_float(u & 0xffff0000u); }
__device__ __forceinline__ float bf2f(bf16 h) { return __uint_as_float(((unsigned)h) << 16); }
__device__ __forceinline__ bf16 f2bf(float f) { return (bf16)(pkbf(f, 0.f) & 0xffffu); }
__device__ __forceinline__ float fast_exp2(float x) { return __builtin_amdgcn_exp2f(x); }
__device__ __forceinline__ float frcp(float x) { return __builtin_amdgcn_rcpf(x); }
__device__ __forceinline__ float flog_(float x) { return __builtin_amdgcn_logf(x) * 0.6931471805599453f; }
__device__ __forceinline__ float sigmoidf_(float x) { return frcp(1.f + __expf(-x)); }
__device__ __forceinline__ float siluf_(float x) { return x * frcp(1.f + __expf(-x)); }
__device__ __forceinline__ float shx(float v, int m, int lane) { return __int_as_float(__builtin_amdgcn_ds_bpermute((lane ^ m) << 2, __float_as_int(v))); }
__device__ __forceinline__ float wave_sum(float v, int lane) {
#pragma unroll
    for (int o = 1; o < 64; o <<= 1) v += shx(v, o, lane);
    return v;
}
__device__ __forceinline__ int modrow(int row) { return row < MLAT ? (row >> 13) : 4; }
namespace pg8 {
#define PG8_LAS __attribute__((address_space(3)))
typedef unsigned short bf16_t;
typedef short bf16x8 __attribute__((ext_vector_type(8)));
typedef float f32x4 __attribute__((ext_vector_type(4)));
typedef unsigned u32x4 __attribute__((ext_vector_type(4)));
constexpr int BM = 256, BK = 64, HALF = 128, HTB = HALF * BK * 2  , STAGE_BYTES = 8 * HTB, NXCD = 8, WGM = 8;

__host__ __device__ __forceinline__ int lds_byte(int r, int c) { const int st = (r >> 4) * 2 + (c >> 5), rr = r & 15, cc = c & 31, ob = rr * 64 + cc * 2; return st * 1024 + (ob ^ (((ob >> 9) & 1) << 5)); }
__host__ __device__ __forceinline__ void stage_rc(int b, int& R, int& C) { const int st = b / 1024, sb = b % 1024, swz = sb ^ (((sb >> 9) & 1) << 5); R = (st >> 1) * 16 + swz / 64; C = (st & 1) * 32 + (swz % 64) / 2; }
__host__ __device__ __forceinline__ int perm32(int rho) { const int n = rho >> 4, i = rho & 15; return 8 * (i >> 2) + 4 * n + (i & 3); }

struct Unit { int pm, pn; long boff; };
struct Gemm { const bf16_t* A; const bf16_t* Bt; int M, N, K; bool atiled = false; };

struct StaticOrder {
    int nM, nN, nwg, G, c;
    __host__ __device__ void init(int M, int N, int G_, int c_) { nM = M / BM; nN = N / BM; nwg = nM * nN; G = G_; c = c_; }
    __host__ __device__ bool next(int i, Unit& u) const {
        const long L = (long)i * G + c; if (L >= nwg) return false;
        int wgid = (int)L; { const int q = nwg / NXCD, r = nwg % NXCD, xcd = wgid % NXCD, off = wgid / NXCD; wgid = (xcd < r ? xcd * (q + 1) : r * (q + 1) + (xcd - r) * q) + off; }
        const int nig = WGM * nN, gid = wgid / nig, fm = gid * WGM, gsz = (nM - fm) < WGM ? (nM - fm) : WGM;
        u.pm = fm + ((wgid % nig) % gsz); u.pn = (wgid % nig) / gsz; u.boff = 0; return true;
    }
    __device__ __forceinline__ void a_ready(const Unit&) const {}
    __device__ __forceinline__ void done(const Unit&) const {}
};

__device__ __forceinline__ unsigned cvt_pk_bf16(float lo, float hi) { return pkbf(lo, hi); }
typedef float f32x2 __attribute__((ext_vector_type(2)));
template <class Epi, class Sched, bool ALIGN_EPI = false, bool SP2 = false, bool F8 = false>
__device__ __forceinline__ void gemm_phase(PG8_LAS unsigned char* lds, const Gemm g, const Sched& S, const Epi& E, int tid_in) {
    int tid_ = tid_in; asm volatile("" : "+v"(tid_));
    const int tid = tid_, wid = __builtin_amdgcn_readfirstlane(tid >> 6), lane = tid & 63, wr = wid >> 2, wc = wid & 3, fr = lane & 15, fq = lane >> 4;
    const int K = g.K, nt = K / BK;
    unsigned voffA[2], voffB[2];
#pragma unroll
    for (int i = 0; i < 2; ++i) { int R, C; stage_rc(tid * 16 + i * 8192, R, C); const int Rb = Epi::PERM ? ((R & ~31) + perm32(R & 31)) : R;
        voffA[i] = g.atiled ? (unsigned)(R * BK + C) * 2u : (unsigned)(R * K + C) * 2u; voffB[i] = (unsigned)(Rb * K + C) * 2u; }
    const size_t kstep = (size_t)(BK * 2);
    const size_t hstep = (size_t)HALF * K * 2;
    const size_t tstep = 2 * hstep;
    const size_t kstepA = g.atiled ? (size_t)BM * BK * 2 : kstep, hstepA = g.atiled ? (size_t)HALF * BK * 2 : hstep;
    const unsigned ldsw = (unsigned)wid * 1024u;
    const int aoff = lds_byte(wr * 64 + fr, fq * 8), boff = lds_byte(wc * 32 + fr, fq * 8);
#define PG8_SA(b, h) (((b) * 2 + (h)) * HTB)
#define PG8_SB(b, h) ((4 + (b) * 2 + (h)) * HTB)
#define PG8_STAGE(bufoff, gbase, voff) do { _Pragma("unroll") for (int _i = 0; _i < 2; ++_i) \
        __builtin_amdgcn_global_load_lds((const unsigned*)((const char*)(gbase) + (voff)[_i]), (PG8_LAS unsigned*)(lds + (bufoff) + ldsw + _i * 8192), 16, 0, 0); } while (0)
#define PG8_LDA(dst, b, h) do { if constexpr (F8) { _Pragma("unroll") for (int m = 0; m < 4; ++m) dst##8[m] = __builtin_shufflevector(*(const PG8_LAS v4i_*)(lds + PG8_SA(b, h) + aoff + m * 2048), *(const PG8_LAS v4i_*)(lds + PG8_SA(b, h) + aoff + m * 2048 + 1024), 0, 1, 2, 3, 4, 5, 6, 7); } \
        else { _Pragma("unroll") for (int m = 0; m < 4; ++m) _Pragma("unroll") for (int k = 0; k < 2; ++k) dst[m][k] = *(const PG8_LAS bf16x8*)(lds + PG8_SA(b, h) + aoff + m * 2048 + k * 1024); } } while (0)
#define PG8_LDB(dst, b, h) do { if constexpr (F8) { _Pragma("unroll") for (int n = 0; n < 2; ++n) dst##8[n] = __builtin_shufflevector(*(const PG8_LAS v4i_*)(lds + PG8_SB(b, h) + boff + n * 2048), *(const PG8_LAS v4i_*)(lds + PG8_SB(b, h) + boff + n * 2048 + 1024), 0, 1, 2, 3, 4, 5, 6, 7); } \
        else { _Pragma("unroll") for (int n = 0; n < 2; ++n) _Pragma("unroll") for (int k = 0; k < 2; ++k) dst[n][k] = *(const PG8_LAS bf16x8*)(lds + PG8_SB(b, h) + boff + n * 2048 + k * 1024); } } while (0)
#define PG8_MMA(ai, bj, At, Bt) do { __builtin_amdgcn_s_setprio(1); _Pragma("unroll") for (int m = 0; m < 4; ++m) _Pragma("unroll") for (int n = 0; n < 2; ++n) { \
        if constexpr (F8) { asm volatile("v_mfma_f32_16x16x128_f8f6f4 %0, %1, %2, %0" : "+v"(acc[ai][bj][m][n]) : "v"(Bt##8[n]), "v"(At##8[m])); } \
        else { _Pragma("unroll") for (int k = 0; k < 2; ++k) acc[ai][bj][m][n] = __builtin_amdgcn_mfma_f32_16x16x32_bf16(Bt[n][k], At[m][k], acc[ai][bj][m][n], 0, 0, 0); } } \
        __builtin_amdgcn_s_setprio(0); } while (0)
#define PG8_WAIT_V(n) asm volatile("s_waitcnt vmcnt(" #n ")" ::: "memory")
#define PG8_WAIT_L(n) asm volatile("s_waitcnt lgkmcnt(" #n ")" ::: "memory")
#define PG8_BAR __builtin_amdgcn_s_barrier()
#define PG8_SCHED __builtin_amdgcn_sched_barrier(0)
    Unit cur, nxt; int ui = 0;
    if (!S.next(0, cur)) return;
    f32x4 acc[2][2][4][2];
#pragma unroll
    for (int a = 0; a < 2; ++a)
#pragma unroll
        for (int b = 0; b < 2; ++b)
#pragma unroll
            for (int m = 0; m < 4; ++m)
#pragma unroll
                for (int n = 0; n < 2; ++n) acc[a][b][m][n] = (f32x4){0.f, 0.f, 0.f, 0.f};
    typedef int v4i_ __attribute__((ext_vector_type(4))); typedef int v8i_ __attribute__((ext_vector_type(8)));
    bf16x8 At[4][2], B0[2][2], B1[2][2]; v8i_ At8[4], B08[2], B18[2];
    const char* cA = (const char*)g.A + (size_t)cur.pm * tstep; const char* cB = (const char*)g.Bt + (size_t)cur.pn * tstep + cur.boff;
    S.a_ready(cur);
    if constexpr (SP2) {
        PG8_STAGE(PG8_SB(0, 0), cB, voffB); PG8_STAGE(PG8_SB(0, 1), cB + hstep, voffB); PG8_STAGE(PG8_SA(0, 0), cA, voffA); PG8_STAGE(PG8_SA(0, 1), cA + hstepA, voffA);
        if (wr == 1) PG8_BAR;
        PG8_WAIT_V(2); PG8_BAR;
        PG8_STAGE(PG8_SB(1, 0), cB + kstep, voffB); PG8_STAGE(PG8_SA(1, 0), cA + kstepA, voffA); PG8_STAGE(PG8_SB(1, 1), cB + hstep + kstep, voffB);
        PG8_WAIT_V(6); PG8_BAR;
    } else {
        PG8_STAGE(PG8_SB(0, 0), cB, voffB); PG8_STAGE(PG8_SA(0, 0), cA, voffA); PG8_STAGE(PG8_SB(0, 1), cB + hstep, voffB); PG8_STAGE(PG8_SA(0, 1), cA + hstepA, voffA);
        if (wr == 1) PG8_BAR;
        PG8_WAIT_V(4); PG8_BAR;
        PG8_STAGE(PG8_SB(1, 0), cB + kstep, voffB); PG8_STAGE(PG8_SA(1, 0), cA + kstepA, voffA); PG8_STAGE(PG8_SB(1, 1), cB + hstep + kstep, voffB);
        PG8_WAIT_V(6); PG8_BAR;
    }
    for (;;) {
        const bool has_next = S.next(ui + 1, nxt);
        const char* nA = has_next ? (const char*)g.A + (size_t)nxt.pm * tstep : cA; const char* nB = has_next ? (const char*)g.Bt + (size_t)nxt.pn * tstep + nxt.boff : cB;
        for (int t = 0; t < nt; t += 2) {
            const bool last = (t == nt - 2);
            const char* a1 = cA + (size_t)(t + 1) * kstepA;
            const char* a2 = last ? nA : cA + (size_t)(t + 2) * kstepA; const char* b2 = last ? nB : cB + (size_t)(t + 2) * kstep;
            const char* a3 = a2 + kstepA; const char* b3 = b2 + kstep;
            if (last && has_next) S.a_ready(nxt);
            if constexpr (SP2) {
            PG8_LDB(B0, 0, 0); PG8_LDB(B1, 0, 1); PG8_SCHED; PG8_LDA(At, 0, 0); PG8_STAGE(PG8_SA(1, 1), a1 + hstepA, voffA);
            PG8_WAIT_V(8); PG8_WAIT_L(0); PG8_BAR; PG8_MMA(0, 0, At, B0); PG8_MMA(0, 1, At, B1); PG8_BAR; PG8_SCHED;
            PG8_LDA(At, 0, 1); PG8_STAGE(PG8_SB(0, 0), b2, voffB); PG8_STAGE(PG8_SB(0, 1), b2 + hstep, voffB); PG8_STAGE(PG8_SA(0, 0), a2, voffA);
            PG8_WAIT_V(8); PG8_WAIT_L(0); PG8_BAR; PG8_MMA(1, 0, At, B0); PG8_MMA(1, 1, At, B1); PG8_BAR; PG8_SCHED;
            PG8_LDB(B0, 1, 0); PG8_LDB(B1, 1, 1); PG8_SCHED; PG8_LDA(At, 1, 0); PG8_STAGE(PG8_SA(0, 1), a2 + hstepA, voffA);
            PG8_WAIT_V(8); PG8_WAIT_L(0); PG8_BAR; PG8_MMA(0, 0, At, B0); PG8_MMA(0, 1, At, B1); PG8_BAR; PG8_SCHED;
            PG8_LDA(At, 1, 1); PG8_STAGE(PG8_SB(1, 0), b3, voffB); PG8_STAGE(PG8_SB(1, 1), b3 + hstep, voffB); PG8_STAGE(PG8_SA(1, 0), a3, voffA);
            PG8_WAIT_V(8); PG8_WAIT_L(0); PG8_BAR; PG8_MMA(1, 0, At, B0); PG8_MMA(1, 1, At, B1); PG8_BAR; PG8_SCHED;
            } else {
            PG8_LDB(B0, 0, 0); PG8_SCHED; PG8_LDA(At, 0, 0); PG8_STAGE(PG8_SA(1, 1), a1 + hstepA, voffA);
            PG8_WAIT_L(8); PG8_BAR; PG8_WAIT_L(0); PG8_MMA(0, 0, At, B0); PG8_BAR; PG8_SCHED;
            PG8_LDB(B1, 0, 1); PG8_STAGE(PG8_SB(0, 0), b2, voffB);
            PG8_BAR; PG8_WAIT_L(0); PG8_MMA(0, 1, At, B1); PG8_BAR;
            PG8_LDA(At, 0, 1); PG8_STAGE(PG8_SA(0, 0), a2, voffA);
            PG8_BAR; PG8_WAIT_L(0); PG8_MMA(1, 0, At, B0); PG8_BAR; PG8_SCHED;
            PG8_STAGE(PG8_SB(0, 1), b2 + hstep, voffB);
            PG8_WAIT_V(6); PG8_BAR; PG8_MMA(1, 1, At, B1); PG8_BAR;
            PG8_LDB(B0, 1, 0); PG8_SCHED; PG8_LDA(At, 1, 0); PG8_STAGE(PG8_SA(0, 1), a2 + hstepA, voffA);
            PG8_WAIT_L(8); PG8_BAR; PG8_WAIT_L(0); PG8_MMA(0, 0, At, B0); PG8_BAR; PG8_SCHED;
            PG8_LDB(B1, 1, 1); PG8_STAGE(PG8_SB(1, 0), b3, voffB);
            PG8_BAR; PG8_WAIT_L(0); PG8_MMA(0, 1, At, B1); PG8_BAR;
            PG8_LDA(At, 1, 1); PG8_STAGE(PG8_SA(1, 0), a3, voffA);
            PG8_BAR; PG8_WAIT_L(0); PG8_MMA(1, 0, At, B0); PG8_BAR; PG8_SCHED;
            PG8_STAGE(PG8_SB(1, 1), b3 + hstep, voffB);
            PG8_WAIT_V(6); PG8_BAR; PG8_MMA(1, 1, At, B1); PG8_BAR;
            }
        }
        if constexpr (ALIGN_EPI) { if (wr == 0) PG8_BAR; }
        if constexpr (!Epi::AFTER_DRAIN) { int l2_; asm volatile("v_mbcnt_lo_u32_b32 %0, -1, 0\n\tv_mbcnt_hi_u32_b32 %0, -1, %0" : "=v"(l2_)); const int fr2 = l2_ & 15, fq2 = l2_ >> 4;     E(acc, cur, wr, wc, fr2, fq2); S.done(cur); }
        if (!has_next) break;
#pragma unroll
        for (int a = 0; a < 2; ++a)
#pragma unroll
            for (int b = 0; b < 2; ++b)
#pragma unroll
                for (int m = 0; m < 4; ++m)
#pragma unroll
                    for (int n = 0; n < 2; ++n) acc[a][b][m][n] = (f32x4){0.f, 0.f, 0.f, 0.f};
        cur = nxt; cA = nA; cB = nB; ++ui;
        if constexpr (ALIGN_EPI) { if (wr == 1) PG8_BAR; }
    }
    PG8_WAIT_V(0);
    if constexpr (!ALIGN_EPI) { if (wr == 0) PG8_BAR; }
    PG8_BAR;
    if constexpr (Epi::AFTER_DRAIN) { E.fused(acc, cur, wr, wc, fr, fq, lds, wid, lane); S.done(cur); }
#undef PG8_SA
#undef PG8_SB
#undef PG8_STAGE
#undef PG8_LDA
#undef PG8_LDB
#undef PG8_MMA
#undef PG8_WAIT_V
#undef PG8_WAIT_L
#undef PG8_BAR
#undef PG8_SCHED
}
}
namespace pg8 {
constexpr int NEXP_ = 8;
template <class F> __device__ __forceinline__ void walk8(const f32x4 (&acc)[2][2][4][2], const Unit& u, int wr, int wc, int fr, int fq, const F& f) {
    asm volatile("s_nop 15\n\ts_nop 15\n\ts_nop 15\n\ts_nop 7" ::: "memory");
    const int row0 = u.pm * BM + wr * 64 + fr, col0 = u.pn * BM + wc * 32 + 8 * fq;
#pragma unroll
    for (int ai = 0; ai < 2; ++ai)
#pragma unroll
        for (int m = 0; m < 4; ++m)
#pragma unroll
            for (int bj = 0; bj < 2; ++bj) {
                const f32x4 a = acc[ai][bj][m][0], b = acc[ai][bj][m][1];
                float v[8] = {a[0], a[1], a[2], a[3], b[0], b[1], b[2], b[3]};
                f.emit(row0 + ai * HALF + m * 16, col0 + bj * HALF, v);
                asm volatile("" ::: "memory");
            }
}
__device__ __forceinline__ u32x4 pack8(const float (&v)[8], float s) {
    u32x4 w; w.x = cvt_pk_bf16(v[0] * s, v[1] * s); w.y = cvt_pk_bf16(v[2] * s, v[3] * s); w.z = cvt_pk_bf16(v[4] * s, v[5] * s); w.w = cvt_pk_bf16(v[6] * s, v[7] * s); return w;
}
struct EpiRawF32 {
    static constexpr bool PERM = true, AFTER_DRAIN = false;
    float* O; int ldc;
    __device__ __forceinline__ void emit(int row, int col, const float (&v)[8]) const {
        float* p = O + (size_t)row * ldc + col; *(f32x4*)p = (f32x4){v[0], v[1], v[2], v[3]}; *(f32x4*)(p + 4) = (f32x4){v[4], v[5], v[6], v[7]};
    }
    __device__ __forceinline__ void operator()(const f32x4 (&acc)[2][2][4][2], const Unit& u, int wr, int wc, int fr, int fq) const { walk8(acc, u, wr, wc, fr, fq, *this); }
};
struct EpiPlainBf16 {
    static constexpr bool PERM = true, AFTER_DRAIN = false;
    bf16_t* O; int ldc;
    __device__ __forceinline__ void emit(int row, int col, const float (&v)[8]) const { *(u32x4*)(O + (size_t)row * ldc + col) = pack8(v, 1.f); }
    __device__ __forceinline__ void operator()(const f32x4 (&acc)[2][2][4][2], const Unit& u, int wr, int wc, int fr, int fq) const { walk8(acc, u, wr, wc, fr, fq, *this); }
};
struct EpiMlaQ {
    static constexpr bool PERM = true, AFTER_DRAIN = false;
    bf16_t* Qm; const float* ropeB;
    __device__ __forceinline__ void emit(int row, int col, const float (&v)[8]) const {
        const int head = col / 96, c = col - head * 96;
        bf16_t* q = Qm + (size_t)row * 768 + head * 96;
        const bool isr = c >= 64;
        const int g = (c - 64) >> 3, axis = g >> 1, base = axis * 16 + (g & 1) * 4;
        f32x4 cs0 = {1.f, 0.f, 1.f, 0.f}, cs1 = {1.f, 0.f, 1.f, 0.f};
        if (isr && row < MLAT) { const int t = row & (SEQ - 1), pos = axis ? (t & 63) : (t >> 6); const float* cs = ropeB + (pos * 8 + (g & 1) * 4) * 2; cs0 = *(const f32x4*)cs; cs1 = *(const f32x4*)(cs + 4); }
        const float o10 = v[0] * cs0[0] - v[4] * cs0[1], o20 = v[4] * cs0[0] + v[0] * cs0[1], o11 = v[1] * cs0[2] - v[5] * cs0[3], o21 = v[5] * cs0[2] + v[1] * cs0[3];
        const float o12 = v[2] * cs1[0] - v[6] * cs1[1], o22 = v[6] * cs1[0] + v[2] * cs1[1], o13 = v[3] * cs1[2] - v[7] * cs1[3], o23 = v[7] * cs1[2] + v[3] * cs1[3];
        typedef unsigned u32x2 __attribute__((ext_vector_type(2)));
        u32x2 w1, w2; w1.x = cvt_pk_bf16(o10 * C2_96, o11 * C2_96); w1.y = cvt_pk_bf16(o12 * C2_96, o13 * C2_96); w2.x = cvt_pk_bf16(o20 * C2_96, o21 * C2_96); w2.y = cvt_pk_bf16(o22 * C2_96, o23 * C2_96);
        bf16_t* p1 = isr ? q + 64 + base : q + c; bf16_t* p2 = isr ? q + 64 + base + 8 : q + c + 4;
        *(u32x2*)p1 = w1; *(u32x2*)p2 = w2;
    }
    __device__ __forceinline__ void operator()(const f32x4 (&acc)[2][2][4][2], const Unit& u, int wr, int wc, int fr, int fq) const { walk8(acc, u, wr, wc, fr, fq, *this); }
};
struct EpiMlaKV {
    static constexpr bool PERM = true, AFTER_DRAIN = false;
    bf16_t* Km; bf16_t* Vm;
    __device__ __forceinline__ void emit(int row, int col, const float (&v)[8]) const {
        const int head = col >> 7, c = col & 127;
        if (c < 64) *(u32x4*)(Km + (size_t)row * 768 + head * 96 + c) = pack8(v, 1.f);
        else        *(u32x4*)(Vm + (size_t)row * 512 + head * 64 + (c - 64)) = pack8(v, 1.f);
    }
    __device__ __forceinline__ void operator()(const f32x4 (&acc)[2][2][4][2], const Unit& u, int wr, int wc, int fr, int fq) const { walk8(acc, u, wr, wc, fr, fq, *this); }
};
struct EpiResid {
    static constexpr bool PERM = true, AFTER_DRAIN = false;
    bf16_t* Z; const float* gate; const void* bl; const void* bc; bool src16;
    __device__ __forceinline__ void emit(int row, int col, const float (&v)[8]) const {
        const float* g = gate + (size_t)(row < MLAT ? (row >> 13) : 4) * 6144 + col;
        const size_t qo = (row < MLAT ? (size_t)row * 1024 : (size_t)(row - MLAT) * 1024) + col; const void* qb = row < MLAT ? bl : bc;
        f32x4 x0, x1;
        if (src16) { const u32x4 r = *(const u32x4*)((const bf16_t*)qb + qo); typedef _Float16 h16x8_ __attribute__((ext_vector_type(8))); typedef float f32x8_ __attribute__((ext_vector_type(8)));
            const f32x8_ xf = __builtin_convertvector(__builtin_bit_cast(h16x8_, r), f32x8_); x0 = (f32x4){xf[0], xf[1], xf[2], xf[3]}; x1 = (f32x4){xf[4], xf[5], xf[6], xf[7]}; }
        else { const float* q = (const float*)qb + qo; x0 = *(const f32x4*)q; x1 = *(const f32x4*)(q + 4); }
        const f32x4 g0 = *(const f32x4*)g, g1 = *(const f32x4*)(g + 4);
        const f32x4 z0 = x0 * ALPHA + g0 * (f32x4){v[0], v[1], v[2], v[3]}, z1 = x1 * ALPHA + g1 * (f32x4){v[4], v[5], v[6], v[7]};
        *(u32x4*)(Z + (size_t)row * 1024 + col) = (u32x4){pkh(z0[0], z0[1]), pkh(z0[2], z0[3]), pkh(z1[0], z1[1]), pkh(z1[2], z1[3])};
    }
    __device__ __forceinline__ void operator()(const f32x4 (&acc)[2][2][4][2], const Unit& u, int wr, int wc, int fr, int fq) const { walk8(acc, u, wr, wc, fr, fq, *this); }
};
struct EpiSwiglu {
    static constexpr bool PERM = true, AFTER_DRAIN = false;
    bf16_t* Hd; int ldh;
    __device__ __forceinline__ void emit(int row, int col, const float (&v)[8]) const {
        float h[4];
#pragma unroll
        for (int e = 0; e < 4; ++e) h[e] = v[e] * __builtin_amdgcn_rcpf(1.f + __expf(-v[e])) * v[e + 4];
        typedef unsigned u32x2 __attribute__((ext_vector_type(2)));
        u32x2 w; w.x = cvt_pk_bf16(h[0], h[1]); w.y = cvt_pk_bf16(h[2], h[3]);
        *(u32x2*)(Hd + (size_t)row * ldh + (col >> 1)) = w;
    }
    __device__ __forceinline__ void operator()(const f32x4 (&acc)[2][2][4][2], const Unit& u, int wr, int wc, int fr, int fq) const { walk8(acc, u, wr, wc, fr, fq, *this); }
};
struct EpiOddIn {
    static constexpr bool PERM = true, AFTER_DRAIN = false;
    bf16_t *Qn, *Kn, *Vn, *Qd, *Vd, *Sg; float *Zf, *Zb;
    __device__ __forceinline__ void emit(int row, int col, const float (&v)[8]) const {
        const int sec = col >> 9, c = col & 511; const size_t o = (size_t)row * 512 + c;
        if (sec == 0) { *(u32x4*)(Qn + o) = pack8(v, C2_64); }
        else if (sec == 1) { *(u32x4*)(Kn + o) = pack8(v, 1.f); }
        else if (sec == 2) { *(u32x4*)(Vn + o) = pack8(v, 1.f); }
        else if (sec == 4) { *(u32x4*)(Vd + o) = pack8(v, 1.f); }
        else if (sec == 5 || sec == 6) { float* p = (sec == 5 ? Zf : Zb) + o; *(f32x4*)p = (f32x4){v[0], v[1], v[2], v[3]}; *(f32x4*)(p + 4) = (f32x4){v[4], v[5], v[6], v[7]}; }
        else { float s[8];
#pragma unroll
            for (int e = 0; e < 8; ++e) s[e] = v[e] * __builtin_amdgcn_rcpf(1.f + __expf(-v[e]));
            *(u32x4*)((sec == 3 ? Qd : Sg) + o) = pack8(s, 1.f); }
    }
    __device__ __forceinline__ void operator()(const f32x4 (&acc)[2][2][4][2], const Unit& u, int wr, int wc, int fr, int fq) const { walk8(acc, u, wr, wc, fr, fq, *this); }
};
struct EpiSwigluS {
    static constexpr bool PERM = true, AFTER_DRAIN = false;
    bf16_t* Hd; int ldh; float s; int trows;
    __device__ __forceinline__ void emit(int row, int col, const float (&v)[8]) const {
        float h[4]; const float c1 = -s * 1.4426950408889634f, k2 = 1.f / (s * s);
#pragma unroll
        for (int e = 0; e < 4; ++e) h[e] = (v[e] * v[e + 4]) * __builtin_amdgcn_rcpf(__builtin_fmaf(__builtin_amdgcn_exp2f(v[e] * c1), k2, k2));
        typedef unsigned u32x2 __attribute__((ext_vector_type(2)));
        u32x2 w; w.x = cvt_pk_bf16(h[0], h[1]); w.y = cvt_pk_bf16(h[2], h[3]);
        const int oc = col >> 1;
        const size_t off = (row < trows) ? ((size_t)(row >> 8) * (size_t)(ldh >> 6) + (size_t)(oc >> 6)) * (size_t)(256 * 64) + (size_t)(row & 255) * 64 + (oc & 63) : (size_t)row * ldh + oc;
        *(u32x2*)(Hd + off) = w;
    }
    __device__ __forceinline__ void operator()(const f32x4 (&acc)[2][2][4][2], const Unit& u, int wr, int wc, int fr, int fq) const { walk8(acc, u, wr, wc, fr, fq, *this); }
};
struct EpiSwigluF8 {
    static constexpr bool PERM = true, AFTER_DRAIN = false;
    unsigned char* Hd; int ldh; float s;
    __device__ __forceinline__ void emit(int row, int col, const float (&v)[8]) const {
        float h[4]; const float c1 = -s * 1.4426950408889634f, k2 = 1.f / (s * s);
#pragma unroll
        for (int e = 0; e < 4; ++e) h[e] = (v[e] * v[e + 4]) * __builtin_amdgcn_rcpf(__builtin_fmaf(__builtin_amdgcn_exp2f(v[e] * c1), k2, k2));
        unsigned w = 0u; w = __builtin_amdgcn_cvt_pk_fp8_f32(h[0], h[1], w, false); w = __builtin_amdgcn_cvt_pk_fp8_f32(h[2], h[3], w, true);
        *(unsigned*)(Hd + (size_t)row * ldh + (col >> 1)) = w;
    }
    __device__ __forceinline__ void operator()(const f32x4 (&acc)[2][2][4][2], const Unit& u, int wr, int wc, int fr, int fq) const { walk8(acc, u, wr, wc, fr, fq, *this); }
};
struct EpiScaledBf16 {
    static constexpr bool PERM = true, AFTER_DRAIN = false;
    bf16_t* O; int ldc; float s;
    __device__ __forceinline__ void emit(int row, int col, const float (&v)[8]) const { *(u32x4*)(O + (size_t)row * ldc + col) = pack8(v, s); }
    __device__ __forceinline__ void operator()(const f32x4 (&acc)[2][2][4][2], const Unit& u, int wr, int wc, int fr, int fq) const { walk8(acc, u, wr, wc, fr, fq, *this); }
};
struct GroupedOrder {
    int nM, nN, nwg, G, c; int toff[NEXP_ + 1]; long estride;
    __device__ __forceinline__ bool next(int i, Unit& u) const {
        const long L = (long)i * G + c; if (L >= nwg) return false;
        int wgid = (int)L; { const int q = nwg / NXCD, r = nwg % NXCD, xcd = wgid % NXCD, off = wgid / NXCD; wgid = (xcd < r ? xcd * (q + 1) : r * (q + 1) + (xcd - r) * q) + off; }
        const int nig = WGM * nN, gid = wgid / nig, fm = gid * WGM, gsz = (nM - fm) < WGM ? (nM - fm) : WGM;
        u.pm = fm + ((wgid % nig) % gsz); u.pn = (wgid % nig) / gsz;
        int e = 0;
#pragma unroll
        for (int k = 1; k < NEXP_; ++k) e += (u.pm >= toff[k]) ? 1 : 0;
        u.boff = (long)e * estride; return true;
    }
    __device__ __forceinline__ void a_ready(const Unit&) const {}
    __device__ __forceinline__ void done(const Unit&) const {}
};
}
#define XB_TMO      128
#define XB_XCNT(j)  (256  + 64 * (j))
#define XB_XSUB(j)  (1280 + 64 * (j))
#define XB_XGEN(j)  (2304 + 64 * (j))
#define XB_TOP      3328
#define XB_TOPGEN   3392
#define XCD_BAR_WORDS 3456
#define XB_SPIN_CAP (1u << 18)

__device__ __forceinline__ unsigned xb_ld(unsigned* p)              { return __hip_atomic_load(p, __ATOMIC_RELAXED, __HIP_MEMORY_SCOPE_AGENT); }
__device__ __forceinline__ unsigned xb_add(unsigned* p, unsigned v) { return __hip_atomic_fetch_add(p, v, __ATOMIC_RELAXED, __HIP_MEMORY_SCOPE_AGENT); }
__device__ __forceinline__ unsigned xb_xcc_id() { return (unsigned)__builtin_amdgcn_s_getreg((3 << 11) | 20) & 0xFu; }
#define XB_SPIN(cond, bar) do { unsigned _sp = 0; while (cond) { __builtin_amdgcn_s_sleep(1); \
    if ((++_sp & 255u) == 0u) { if (xb_ld(&(bar)[XB_TMO])) break; if (_sp > XB_SPIN_CAP) { atomicAdd(&(bar)[XB_TMO], 1u); break; } } } } while (0)

struct XcdBarrier {
    unsigned* bar; unsigned x;
    volatile LAS unsigned* st;
};

__device__ __forceinline__ XcdBarrier xcd_barrier_post(unsigned* bar, volatile LAS unsigned* st) {
    XcdBarrier b; b.bar = bar; b.x = xb_xcc_id(); b.st = st;
    if (threadIdx.x == 0) (void)xb_add(&bar[XB_XCNT(b.x)], 1u);
    return b;
}
__device__ __forceinline__ void xcd_barrier_complete(unsigned* bar, unsigned x, unsigned& nloc, unsigned& nx) {
    const unsigned G = gridDim.x * gridDim.y * gridDim.z;
    unsigned sum, cnt, mine, sp = 0u;
    for (;;) {
        sum = 0u; cnt = 0u; mine = 0u;
#pragma unroll
        for (unsigned j = 0; j < 16; ++j) { const unsigned c = xb_ld(&bar[XB_XCNT(j)]); sum += c; cnt += (c > 0u) ? 1u : 0u; mine = (j == x) ? c : mine; }
        if (sum == G) break;
        __builtin_amdgcn_s_sleep(1);
        if ((++sp & 255u) == 0u) { if (xb_ld(&bar[XB_TMO])) break; if (sp > XB_SPIN_CAP) { atomicAdd(&bar[XB_TMO], 1u); break; } }
    }
    nloc = mine > 0u ? mine : 1u; nx = cnt > 0u ? cnt : 1u;
}

__device__ __forceinline__ void xcd_barrier(const XcdBarrier& b) {
    asm volatile("s_waitcnt vmcnt(0)" ::: "memory");
    __syncthreads();
    if (threadIdx.x == 0) {
        unsigned* bar = b.bar;
        __builtin_amdgcn_s_waitcnt(0);
        unsigned nloc = b.st[0], nx = b.st[1];
        if (nloc == 0u) { xcd_barrier_complete(bar, b.x, nloc, nx); b.st[0] = nloc; b.st[1] = nx; }
        const unsigned old = xb_add(&bar[XB_XSUB(b.x)], 1u);
        const unsigned gen = old / nloc;
        if (old + 1u == (gen + 1u) * nloc) {
            __builtin_amdgcn_fence(__ATOMIC_RELEASE, "agent");
            asm volatile("s_waitcnt vmcnt(0)" ::: "memory");
            const unsigned og = xb_add(&bar[XB_TOP], 1u);
            const unsigned tg = og / nx;
            if (og + 1u == (tg + 1u) * nx) xb_add(&bar[XB_TOPGEN], 1u);
            else XB_SPIN(xb_ld(&bar[XB_TOPGEN]) == tg, bar);
            __builtin_amdgcn_fence(__ATOMIC_ACQUIRE, "agent");
            xb_add(&bar[XB_XGEN(b.x)], 1u);
            asm volatile("s_waitcnt vmcnt(0)" ::: "memory");
        } else {
            XB_SPIN(xb_ld(&bar[XB_XGEN(b.x)]) == gen, bar);
            __builtin_amdgcn_fence(__ATOMIC_ACQUIRE, "agent");
            asm volatile("s_waitcnt vmcnt(0)" ::: "memory");
        }
    }
    __syncthreads();
}
struct Frame {
    LAS unsigned char* lds;
    gu32* ctl;
    unsigned char* ws;
    int tid, lane, wave, vcu, G;
};
struct Args { const float* in[30]; float* out; unsigned char* ws; int ph_lo, ph_hi; };
struct InTab { LAS unsigned long long* t;
    __device__ __forceinline__ const float* operator[](int i) const { const unsigned long long v = t[i]; const unsigned lo = __builtin_amdgcn_readfirstlane((unsigned)v), hi = __builtin_amdgcn_readfirstlane((unsigned)(v >> 32)); return (const float*)(((unsigned long long)hi << 32) | lo); } };
struct PArgs { InTab in; float* out; };
#define LDS_WAIT() asm volatile("s_waitcnt lgkmcnt(0)" ::: "memory")
#define VM_WAIT() asm volatile("s_waitcnt vmcnt(0)" ::: "memory")
enum { I_X = 0, I_C, I_CTX, I_CCTX, I_ADAW, I_ADAB, I_LN1G, I_LN1B, I_LN2G, I_LN2B, I_EVWIN, I_QNG, I_KNG, I_CQG, I_CKVG, I_WUQ, I_WUKV, I_EVWOUT,
       I_FFG, I_FFU, I_FFD, I_ODWIN, I_RPB, I_LBL, I_ONG, I_ODWOUT, I_ROUTER, I_MG, I_MU, I_MD };

__device__ __forceinline__ void cvt_item(const float* src0, const float* src1, int K, int N, int Np, bf16* dst, int mode, int item, LAS float* scr, int lane, bool f8 = false) {
    const int nblk = Np >> 5, kb = item / nblk, nb = item - kb * nblk, k0 = 64 * kb, n0 = 32 * nb;
    const int np = n0 + (lane & 31);
    const float* src = src0; int col = np; bool ok = np < N;
    if (mode == 1) { const int head = np / 96, c = np - head * 96; if (c >= 64) { const int r = c - 64, g = r >> 3, e = r & 7; const int base = (g >> 1) * 16 + (g & 1) * 4; col = head * 96 + 64 + base + (e < 4 ? e : 8 + (e - 4)); } }
    else if (mode == 2) { src = (np & 4) ? src1 : src0; col = ((np >> 3) << 2) + (np & 3); ok = true; }
    float rr[32];
    { const GAS float* sp_ = (const GAS float*)src + (size_t)(k0 + (lane >> 5)) * N + col;
#pragma unroll
      for (int i = 0; i < 32; ++i) rr[i] = ok ? sp_[(size_t)(2 * i) * N] : 0.f; }
#pragma unroll
    for (int i = 0; i < 32; ++i) { const int kk = 2 * i + (lane >> 5); scr[kk * 33 + (lane & 31)] = rr[i]; }
    LDS_WAIT(); asm volatile("" ::: "memory");
    const int c8 = lane & 7;
    if (f8) {
        unsigned char* d8 = (unsigned char*)dst;
#pragma unroll
        for (int j = 0; j < 4; ++j) { const int n = (lane >> 3) + 8 * j; const LAS float* s = scr + (8 * c8) * 33 + n;
            unsigned w0 = 0u, w1 = 0u;
            w0 = __builtin_amdgcn_cvt_pk_fp8_f32(s[0 * 33] * MOE_WSCALE, s[1 * 33] * MOE_WSCALE, w0, false); w0 = __builtin_amdgcn_cvt_pk_fp8_f32(s[2 * 33] * MOE_WSCALE, s[3 * 33] * MOE_WSCALE, w0, true);
            w1 = __builtin_amdgcn_cvt_pk_fp8_f32(s[4 * 33] * MOE_WSCALE, s[5 * 33] * MOE_WSCALE, w1, false); w1 = __builtin_amdgcn_cvt_pk_fp8_f32(s[6 * 33] * MOE_WSCALE, s[7 * 33] * MOE_WSCALE, w1, true);
            *(GAS v2u*)(d8 + (size_t)(n0 + n) * K + k0 + 8 * c8) = (v2u){w0, w1}; }
    } else {
#pragma unroll
        for (int j = 0; j < 4; ++j) { const int n = (lane >> 3) + 8 * j; const LAS float* s = scr + (8 * c8) * 33 + n;
            v4u o; o.x = pkbf(s[0 * 33], s[1 * 33]); o.y = pkbf(s[2 * 33], s[3 * 33]); o.z = pkbf(s[4 * 33], s[5 * 33]); o.w = pkbf(s[6 * 33], s[7 * 33]);
            *(GAS v4u*)(dst + (size_t)(n0 + n) * K + k0 + 8 * c8) = o; }
    }
    LDS_WAIT(); asm volatile("" ::: "memory");
}
__device__ __forceinline__ void sincos_red(float ang, float& s, float& c) {
    const float n = __builtin_rintf(ang * 0.636619772367581343f);
    float y = __builtin_fmaf(-n, 1.5703125f, ang); y = __builtin_fmaf(-n, 4.837512969970703125e-4f, y); y = __builtin_fmaf(-n, 7.54978995489188e-8f, y);
    const float z = y * y;
    const float sy = y + y * z * (-1.6666654611e-1f + z * (8.3321608736e-3f + z * (-1.9515295891e-4f)));
    const float cy = 1.0f - 0.5f * z + z * z * (4.166664568298827e-2f + z * (-1.388731625493765e-3f + z * 2.443315711809948e-5f));
    const int q = ((int)n) & 3;
    s = (q == 0) ? sy : (q == 1) ? cy : (q == 2) ? -sy : -cy;
    c = (q == 0) ? cy : (q == 1) ? -sy : (q == 2) ? -cy : sy;
}
__device__ __forceinline__ float inv_freq_pow(double r, int f) { double v = 1.0; for (int i = 0; i < f; ++i) v *= r; return (float)v; }

__device__ __forceinline__ void phase_cv(Frame& F, const PArgs& A, int j) {
    const int gw = F.vcu * NWAVES + F.wave, NGW = F.G * NWAVES;
    float* mods = (float*)(F.ws + WS_SMALL + SM_MODS);
    if (j == 0) {
        LAS float* Ssm = (LAS float*)F.lds;
        LAS float* Psm = (LAS float*)(F.lds + 20480);
        if ((int)blockIdx.x < 192) {
            for (int i = F.tid; i < 5 * 1024; i += NTHR) { const int r = i >> 10, k = i & 1023; const float cv = (r < 4) ? A.in[I_C][r * 1024 + k] : A.in[I_CCTX][k]; Ssm[i] = cv * frcp(1.f + __expf(-cv)); }
            __syncthreads();
            for (int u = blockIdx.x; u < 192; u += F.G) {
                const int l = u / 48, n = (u - l * 48) * 128 + 2 * F.lane;
                float a0[5] = {0.f, 0.f, 0.f, 0.f, 0.f}, a1[5] = {0.f, 0.f, 0.f, 0.f, 0.f};
                const float* wp = A.in[I_ADAW] + ((size_t)l * 1024 + F.wave * 128) * 6144 + n;
#pragma unroll 16
                for (int k = 0; k < 128; ++k) { const f32x2_t w = *(const GAS f32x2_t*)(wp + (size_t)k * 6144); const int kk = F.wave * 128 + k;
#pragma unroll
                    for (int r = 0; r < 5; ++r) { const float sv = Ssm[r * 1024 + kk]; a0[r] += sv * w.x; a1[r] += sv * w.y; } }
#pragma unroll
                for (int r = 0; r < 5; ++r) { Psm[(F.wave * 5 + r) * 128 + 2 * F.lane] = a0[r]; Psm[(F.wave * 5 + r) * 128 + 2 * F.lane + 1] = a1[r]; }
                __syncthreads();
                for (int i = F.tid; i < 640; i += NTHR) { const int r = i >> 7, c = i & 127; float s = 0.f;
#pragma unroll
                    for (int w = 0; w < 8; ++w) s += Psm[(w * 5 + r) * 128 + c];
                    const int nn = (u - l * 48) * 128 + c; mods[((size_t)l * 5 + r) * 6144 + nn] = s + A.in[I_ADAB][l * 6144 + nn]; }
                __syncthreads();
            }
        } else if ((int)blockIdx.x == 192) {
            float* ra = (float*)(F.ws + WS_SMALL + SM_ROPEA); float* rb = (float*)(F.ws + WS_SMALL + SM_ROPEB); float* lb = (float*)(F.ws + WS_SMALL + SM_LB);
            for (int i = F.tid; i < 128 * 16; i += NTHR) { const int pos = i >> 4, f = i & 15; const float inv = inv_freq_pow(0.56234132519034908, f); float s, c; sincos_red((float)pos * inv, s, c); ra[2 * i] = c; ra[2 * i + 1] = s; }
            for (int i = F.tid; i < 128 * 8; i += NTHR) { const int pos = i >> 3, f = i & 7; const float inv = inv_freq_pow(0.31622776601683794, f); float s, c; sincos_red((float)pos * inv, s, c); rb[2 * i] = c; rb[2 * i + 1] = s; }
            for (int i = F.tid; i < 2 * 512; i += NTHR) { const int dir = i >> 9, c = i & 511; const float l0 = A.in[I_LBL][(dir * 2 + 0) * 512 + c], l1 = A.in[I_LBL][(dir * 2 + 1) * 512 + c];
                const float mx = fmaxf(l0, l1), e0 = __expf(l0 - mx), e1 = __expf(l1 - mx), p0 = e0 / (e0 + e1), p1 = e1 / (e0 + e1);
                lb[(0 * 2 + dir) * 512 + c] = p0 - p0; lb[(1 * 2 + dir) * 512 + c] = (p0 + p1) - p0; }
        }
        __syncthreads();
    }
    LAS float* scr = (LAS float*)(F.lds + 49152 + F.wave * 8704);
    bf16* W = (bf16*)(F.ws + WS_W); bf16* WM = (bf16*)(F.ws + WS_WMOE);
    constexpr int N1 = 2 * 768, N2 = 2 * 144, N3 = 2 * 128, N4 = 2 * 512, N5 = 2 * 2816, N6 = 2 * 1408, N7 = 2 * 2048, N8 = 2 * 512, N9 = 8 * 3584, N10 = 8 * 1792;
    const int nfix = (j == 0) ? (N1 + N2 + N3 + N4 + N5 + N6 + N7 + N8) : 0;
    const int total = nfix + N9 + N10;
    for (int it = gw; it < total; it += NGW) {
        int r = it; const float* s0; const float* s1 = nullptr; int K, N, Np, mode = 0, item; bf16* d; bool f8 = false;
        if (r >= nfix) { r -= nfix;
            if (r < N9) { const int e = r / 3584; item = r - e * 3584; const size_t so = ((size_t)(j * 8 + e)) * 1024 * 3584; s0 = A.in[I_MG] + so; s1 = A.in[I_MU] + so; K = 1024; N = 3584; Np = 7168; mode = 2; f8 = true; d = (bf16*)((unsigned char*)WM + WM_GU + (size_t)e * 7168 * 1024); }
            else { r -= N9; const int e = r / 1792; item = r - e * 1792; s0 = A.in[I_MD] + ((size_t)(j * 8 + e)) * 3584 * 1024; K = 3584; N = 1024; Np = 1024; f8 = true; d = (bf16*)((unsigned char*)WM + WM_D + (size_t)e * 1024 * 3584); }
        } else if (r < N1) { const int b = r / 768; item = r - b * 768; s0 = A.in[I_EVWIN] + (size_t)b * 1024 * EV_IN; K = 1024; N = EV_IN; Np = EV_INP; d = W + W_EVIN + (size_t)b * EV_INP * 1024; }
        else if ((r -= N1) < N2) { const int b = r / 144; item = r - b * 144; s0 = A.in[I_WUQ] + (size_t)b * 384 * 768; K = 384; N = 768; Np = 768; mode = 1; d = W + W_UQ + (size_t)b * 768 * 384; }
        else if ((r -= N2) < N3) { const int b = r / 128; item = r - b * 128; s0 = A.in[I_WUKV] + (size_t)b * 256 * 1024; K = 256; N = 1024; Np = 1024; d = W + W_UKV + (size_t)b * 1024 * 256; }
        else if ((r -= N3) < N4) { const int b = r / 512; item = r - b * 512; s0 = A.in[I_EVWOUT] + (size_t)b * 1024 * 1024; K = 1024; N = 1024; Np = 1024; d = W + W_EVOUT + (size_t)b * 1024 * 1024; }
        else if ((r -= N4) < N5) { const int b = r / 2816; item = r - b * 2816; s0 = A.in[I_FFG] + (size_t)b * 1024 * DFF; s1 = A.in[I_FFU] + (size_t)b * 1024 * DFF; K = 1024; N = DFF; Np = 2 * DFF; mode = 2; f8 = FFN_F8; d = FFN_F8 ? (bf16*)((unsigned char*)(W + W_FFGU) + (size_t)b * 2 * DFF * 1024) : W + W_FFGU + (size_t)b * 2 * DFF * 1024; }
        else if ((r -= N5) < N6) { const int b = r / 1408; item = r - b * 1408; s0 = A.in[I_FFD] + (size_t)b * DFF * 1024; K = DFF; N = 1024; Np = 1024; d = W + W_FFD + (size_t)b * 1024 * DFF; }
        else if ((r -= N6) < N7) { const int b = r / 2048; item = r - b * 2048; s0 = A.in[I_ODWIN] + (size_t)b * 1024 * 4096; K = 1024; N = 4096; Np = 4096; d = W + W_ODIN + (size_t)b * 4096 * 1024; }
        else { r -= N7; const int b = r / 512; item = r - b * 512; s0 = A.in[I_ODWOUT] + (size_t)b * 1024 * 1024; K = 1024; N = 1024; Np = 1024; d = W + W_ODOUT + (size_t)b * 1024 * 1024; }
        cvt_item(s0, s1, K, N, Np, d, mode, item, scr, F.lane, f8);
    }
}

__device__ __forceinline__ void store_bf16_row(bf16* orow, int lane, const f32x4 (&v)[4]) {
    GAS unsigned long long* o8 = (GAS unsigned long long*)orow + lane;
#pragma unroll
    for (int j = 0; j < 4; ++j) o8[64 * j] = (unsigned long long)pkbf(v[j].x, v[j].y) | ((unsigned long long)pkbf(v[j].z, v[j].w) << 32);
}
__device__ __forceinline__ void phase_mod(Frame& F, const PArgs& A) {
    const int gw = F.vcu * NWAVES + F.wave, NGW = F.G * NWAVES;
    const float* mods = (const float*)(F.ws + WS_SMALL + SM_MODS);
    bf16* H = (bf16*)(F.ws + WS_H);
    for (int m = gw; m < MROWS; m += NGW) {
        const float* src = (m < MLAT) ? A.in[I_X] + (size_t)m * 1024 : A.in[I_CTX] + (size_t)(m - MLAT) * 1024;
        const float* md = mods + (size_t)modrow(m) * 6144;
        f32x4 v[4], h[4];
#pragma unroll
        for (int j = 0; j < 4; ++j) { v[j] = *((const f32x4*)src + F.lane + 64 * j); const f32x4 sh = *((const f32x4*)md + F.lane + 64 * j), sc = *((const f32x4*)(md + 1024) + F.lane + 64 * j);
            h[j] = v[j] * (sc + 1.0f) + sh; }
        store_bf16_row(H + (size_t)m * 1024, F.lane, h);
    }
}
template <bool MOE, bool ROUTER, bool H8 = false>
__device__ __forceinline__ void phase_ln(Frame& F, const PArgs& A, const float* lng, const float* lnb, const float* mshift  , const float* g5  ,
                                         const float* router, int jodd, bool last, int nrows = MROWS) {
    const int gw = F.vcu * NWAVES + F.wave, NGW = F.G * NWAVES;
#define LNCH(j_) (2 * F.lane + ((j_) & 1) + 128 * ((j_) >> 1))
    bf16* X = (bf16*)(F.ws + WS_X); bf16* H = (bf16*)(F.ws + WS_H);
    int* topk = (int*)(F.ws + WS_TOPK);
    const bf16* Y = (const bf16*)(F.ws + WS_XG);
    LAS unsigned* lcnt = (LAS unsigned*)(F.lds);
    if (ROUTER) { if (F.tid < 8) lcnt[F.tid] = 0u; __syncthreads(); }
    f32x4 gv[4], bv[4];
#pragma unroll
    for (int j = 0; j < 4; ++j) { gv[j] = *((const f32x4*)lng + LNCH(j)); bv[j] = *((const f32x4*)lnb + LNCH(j)); }
    f32x4 rwa[4][4], rwb[4][4];
    if (ROUTER) {
#pragma unroll
        for (int j = 0; j < 4; ++j)
#pragma unroll
            for (int i = 0; i < 4; ++i) { const float* rp = router + (size_t)(4 * LNCH(j) + i) * 8; rwa[j][i] = *(const GAS f32x4*)rp; rwb[j][i] = *(const GAS f32x4*)(rp + 4); }
    }
    for (int m = gw; m < nrows; m += NGW) {
        bf16* xr = X + (size_t)m * 1024; const int mr = modrow(m);
        f32x4 v[4];
        if (MOE) {
#pragma unroll
            for (int jj = 0; jj < 2; ++jj) { const v4u xx = *((const GAS v4u*)xr + F.lane + 64 * jj);
                v[2 * jj] = __builtin_convertvector(__builtin_bit_cast(h16x4, (v2u){xx.x, xx.y}), f32x4); v[2 * jj + 1] = __builtin_convertvector(__builtin_bit_cast(h16x4, (v2u){xx.z, xx.w}), f32x4); }
        } else {
            const bf16* zr = (const bf16*)(F.ws + WS_ZR) + (size_t)m * 1024;
#pragma unroll
            for (int jj = 0; jj < 2; ++jj) { const v4u zz = *((const GAS v4u*)zr + F.lane + 64 * jj);
                v[2 * jj] = __builtin_convertvector(__builtin_bit_cast(h16x4, (v2u){zz.x, zz.y}), f32x4); v[2 * jj + 1] = __builtin_convertvector(__builtin_bit_cast(h16x4, (v2u){zz.z, zz.w}), f32x4); }
        }
        if (MOE) {
            const int r1 = topk[m * 6 + 4], r2 = topk[m * 6 + 5]; const float w1 = __int_as_float(topk[m * 6 + 2]), w2 = __int_as_float(topk[m * 6 + 3]);
            const float* gg = g5 + (size_t)mr * 6144;
#pragma unroll
            for (int j = 0; j < 4; ++j) { const v2u y1 = *((const v2u*)(Y + (size_t)r1 * 1024) + LNCH(j)), y2 = *((const v2u*)(Y + (size_t)r2 * 1024) + LNCH(j));
                const f32x4 gq = *((const f32x4*)gg + LNCH(j));
                f32x4 yy; yy.x = w1 * bf_lo(y1.x) + w2 * bf_lo(y2.x); yy.y = w1 * bf_hi(y1.x) + w2 * bf_hi(y2.x); yy.z = w1 * bf_lo(y1.y) + w2 * bf_lo(y2.y); yy.w = w1 * bf_hi(y1.y) + w2 * bf_hi(y2.y);
                v[j] = v[j] * ALPHA + gq * yy; }
        }
        float s = 0.f;
#pragma unroll
        for (int j = 0; j < 4; ++j) s += (v[j].x + v[j].y) + (v[j].z + v[j].w);
        const float mean = wave_sum(s, F.lane) * (1.f / 1024.f); float s2 = 0.f;
#pragma unroll
        for (int j = 0; j < 4; ++j) { v[j] = v[j] - mean; s2 += (v[j].x * v[j].x + v[j].y * v[j].y) + (v[j].z * v[j].z + v[j].w * v[j].w); }
        const float rstd = __builtin_amdgcn_rsqf(wave_sum(s2, F.lane) * (1.f / 1024.f) + 1e-6f);
#pragma unroll
        for (int j = 0; j < 4; ++j) v[j] = v[j] * rstd * gv[j] + bv[j];
        if (!last) {
#pragma unroll
            for (int jj = 0; jj < 2; ++jj) *((GAS v4u*)xr + F.lane + 64 * jj) = (v4u){pkh(v[2 * jj].x, v[2 * jj].y), pkh(v[2 * jj].z, v[2 * jj].w), pkh(v[2 * jj + 1].x, v[2 * jj + 1].y), pkh(v[2 * jj + 1].z, v[2 * jj + 1].w)}; }
#if defined(SELFCHK)
        if (last) { const float cn = __hip_atomic_load((const float*)(F.ctl + 12288), __ATOMIC_RELAXED, __HIP_MEMORY_SCOPE_AGENT), cd = __hip_atomic_load((const float*)(F.ctl + 12288) + 1, __ATOMIC_RELAXED, __HIP_MEMORY_SCOPE_AGENT);
            const float cscale = 1.f + sqrtf(cn / fmaxf(cd, 1e-30f));
#pragma unroll
            for (int j = 0; j < 4; ++j) v[j] = v[j] * cscale; }
#endif
        if (last) { if (m < MLAT) {
#pragma unroll
                for (int j = 0; j < 4; ++j) *((f32x4*)(A.out + (size_t)m * 1024) + LNCH(j)) = v[j]; }
            continue; }
        const float* md = mshift + (size_t)mr * 6144;
#pragma unroll
        for (int j = 0; j < 4; ++j) { const f32x4 sh = *((const f32x4*)md + LNCH(j)), sc = *((const f32x4*)(md + 1024) + LNCH(j)); v[j] = v[j] * (sc + 1.0f) + sh; }
        if (H8) {
#pragma unroll
            for (int jj = 0; jj < 2; ++jj) { unsigned w0 = 0u, w1 = 0u;
                w0 = __builtin_amdgcn_cvt_pk_fp8_f32(v[2 * jj].x, v[2 * jj].y, w0, false); w0 = __builtin_amdgcn_cvt_pk_fp8_f32(v[2 * jj].z, v[2 * jj].w, w0, true);
                w1 = __builtin_amdgcn_cvt_pk_fp8_f32(v[2 * jj + 1].x, v[2 * jj + 1].y, w1, false); w1 = __builtin_amdgcn_cvt_pk_fp8_f32(v[2 * jj + 1].z, v[2 * jj + 1].w, w1, true);
                *((GAS v2u*)((unsigned char*)H + (size_t)m * 1024) + F.lane + 64 * jj) = (v2u){w0, w1}; }
        } else {
#pragma unroll
            for (int jj = 0; jj < 2; ++jj) *((GAS v4u*)(H + (size_t)m * 1024) + F.lane + 64 * jj) = (v4u){pkbf(v[2 * jj].x, v[2 * jj].y), pkbf(v[2 * jj].z, v[2 * jj].w), pkbf(v[2 * jj + 1].x, v[2 * jj + 1].y), pkbf(v[2 * jj + 1].z, v[2 * jj + 1].w)}; }
        if (ROUTER) {
            float pa[8] = {0.f, 0.f, 0.f, 0.f, 0.f, 0.f, 0.f, 0.f};
#pragma unroll
            for (int j = 0; j < 4; ++j)
#pragma unroll
                for (int i = 0; i < 4; ++i) { const float hv = v[j][i]; const f32x4 ra = rwa[j][i], rb = rwb[j][i];
                    pa[0] += hv * ra.x; pa[1] += hv * ra.y; pa[2] += hv * ra.z; pa[3] += hv * ra.w; pa[4] += hv * rb.x; pa[5] += hv * rb.y; pa[6] += hv * rb.z; pa[7] += hv * rb.w; }
            float lg[8];
            { const bool b5 = (F.lane & 32) != 0, b4 = (F.lane & 16) != 0, b3 = (F.lane & 8) != 0; float q4[4], q2[2];
#pragma unroll
              for (int k = 0; k < 4; ++k) { const float snd = b5 ? pa[k] : pa[k + 4], own = b5 ? pa[k + 4] : pa[k]; q4[k] = own + shx(snd, 32, F.lane); }
#pragma unroll
              for (int k = 0; k < 2; ++k) { const float snd = b4 ? q4[k] : q4[k + 2], own = b4 ? q4[k + 2] : q4[k]; q2[k] = own + shx(snd, 16, F.lane); }
              float q1 = (b3 ? q2[1] : q2[0]) + shx(b3 ? q2[0] : q2[1], 8, F.lane);
              q1 += shx(q1, 4, F.lane); q1 += shx(q1, 2, F.lane); q1 += shx(q1, 1, F.lane);
#pragma unroll
              for (int e = 0; e < 8; ++e) lg[e] = __builtin_bit_cast(float, __builtin_amdgcn_readlane(__builtin_bit_cast(int, q1), 32 * (e >> 2) + 16 * ((e >> 1) & 1) + 8 * (e & 1))); }
            int e1 = 0; float v1 = lg[0];
#pragma unroll
            for (int e = 1; e < 8; ++e) if (lg[e] > v1) { v1 = lg[e]; e1 = e; }
            int e2 = -1; float v2 = -INFINITY;
#pragma unroll
            for (int e = 0; e < 8; ++e) if (e != e1 && lg[e] > v2) { v2 = lg[e]; e2 = e; }
            const float w1 = frcp(1.f + __expf(v2 - v1)), w2 = 1.f - w1;
            if (F.lane == 0) { topk[m * 6 + 0] = e1; topk[m * 6 + 1] = e2; topk[m * 6 + 2] = __float_as_int(w1); topk[m * 6 + 3] = __float_as_int(w2);
                atomicAdd((unsigned*)&lcnt[e1], 1u); atomicAdd((unsigned*)&lcnt[e2], 1u); }
        }
    }
    if (ROUTER) { LDS_WAIT(); __syncthreads(); if (F.tid < 8) __hip_atomic_fetch_add((unsigned*)(F.ctl + CW_CNT + 64 * jodd) + F.tid, lcnt[F.tid], __ATOMIC_RELAXED, __HIP_MEMORY_SCOPE_AGENT); }
}
#undef LNCH
typedef short v4i16_t __attribute__((ext_vector_type(4)));
__device__ __forceinline__ int crow(int r, int hi) { return (r & 3) + 8 * (r >> 2) + 4 * hi; }
__device__ __forceinline__ float swap_max(float m) { auto rr = __builtin_amdgcn_permlane32_swap(__float_as_uint(m), __float_as_uint(m), false, false); return fmaxf(__uint_as_float(rr[0]), __uint_as_float(rr[1])); }
__device__ __forceinline__ float swap_sum(float m) { auto rr = __builtin_amdgcn_permlane32_swap(__float_as_uint(m), __float_as_uint(m), false, false); return __uint_as_float(rr[0]) + __uint_as_float(rr[1]); }

#ifndef ATT_THR
#define ATT_THR 6.f
#endif
template <int DK, int MODE>
__device__ __forceinline__ void attn_unit(LAS unsigned char* lds, int tid, const bf16* Q, int qp, const bf16* K1, const bf16* V1, int nt1, const bf16* K2, const bf16* V2, int nt2,
                                          int kp, int vp, bf16* O, int op, int rq0, int kr0, const float* rpbh) {
    constexpr int KROW = DK * 2 + 16, KSZ = 64 * KROW, CPK = DK / 8  , NPK = 64 * CPK;
    constexpr int VB = 4 * KSZ, SCR = VB + 4 * 8192, BIAS = SCR + 2048;
    const int lane = tid & 63, r32 = lane & 31, hi = lane >> 5; const int wid = __builtin_amdgcn_readfirstlane(tid >> 6);
    const int NT = nt1 + nt2;
    LAS float* wsf = (LAS float*)(lds + SCR) + wid * 64;
    const int kkey0 = tid / CPK, kch0 = tid - kkey0 * CPK;
    const int kkey1 = (tid + 512) / CPK, kch1 = (tid + 512) - kkey1 * CPK;
    const bool two = (NPK > 512) && (tid + 512 < NPK);
    const int vkey = tid >> 3, vch = tid & 7;
    const int vdst = ((vkey >> 3) * 2 + (vch >> 2)) * 512 + (vkey & 7) * 64 + (vch & 3) * 16;
    v4u kA0, kA1 = {0u, 0u, 0u, 0u}, vA, kB0, kB1 = {0u, 0u, 0u, 0u}, vB;
#define ATT_LOAD(t, K0_, K1_, V_) do { const int t_ = (t); const bf16* kb_ = (t_ < nt1) ? K1 + (size_t)t_ * 64 * kp : K2 + (size_t)(t_ - nt1) * 64 * kp; \
        const bf16* vb_ = (t_ < nt1) ? V1 + (size_t)t_ * 64 * vp : V2 + (size_t)(t_ - nt1) * 64 * vp; \
        K0_ = *(const GAS v4u*)(kb_ + (size_t)kkey0 * kp + kch0 * 8); if (two) K1_ = *(const GAS v4u*)(kb_ + (size_t)kkey1 * kp + kch1 * 8); \
        V_ = *(const GAS v4u*)(vb_ + (size_t)vkey * vp + vch * 8); } while (0)
#define ATT_STORE(buf, K0_, K1_, V_) do { LAS unsigned char* kd_ = lds + (buf) * KSZ; *(LAS v4u*)(kd_ + kkey0 * KROW + kch0 * 16) = K0_; if (two) *(LAS v4u*)(kd_ + kkey1 * KROW + kch1 * 16) = K1_; \
        *(LAS v4u*)(lds + VB + (buf) * 8192 + vdst) = V_; } while (0)
    ATT_LOAD(0, kA0, kA1, vA); if (NT > 1) ATT_LOAD(1, kB0, kB1, vB);
    if (MODE == 1) { LAS float* bs = (LAS float*)(lds + BIAS); for (int i = tid; i < 15 * 31; i += NTHR) bs[i] = rpbh[i] * LOG2E; }
    bf16x8 qr[DK / 16];
#pragma unroll
    for (int d0 = 0; d0 < DK / 16; ++d0) qr[d0] = *(const GAS bf16x8*)(Q + (size_t)(wid * 32 + r32) * qp + d0 * 16 + hi * 8);
    ATT_STORE(0, kA0, kA1, vA); if (NT > 1) ATT_STORE(1, kB0, kB1, vB);
    __syncthreads();
    float m_run = 0.f, l_run = 0.f; f32x16 o0, o1, negm;
    { float zz; asm volatile("v_mov_b32 %0, 0" : "=v"(zz));
#pragma unroll
      for (int r = 0; r < 16; ++r) { o0[r] = zz; o1[r] = zz; negm[r] = zz; } }
    const int rq = rq0 + (wid >> 1), rsq = min(max(rq - 4, 0), 120), qc = (wid & 1) * 32 + r32, cs = min(max(qc - 8, 0), 48);
    unsigned nmask0 = 0u, nmask1 = 0u;
    if (MODE == 1) {
#pragma unroll
        for (int r = 0; r < 16; ++r) { const int kc0 = crow(r, hi), kc1 = kc0 + 32; nmask0 |= ((kc0 >= cs) && (kc0 < cs + 16)) ? (1u << r) : 0u; nmask1 |= ((kc1 >= cs) && (kc1 < cs + 16)) ? (1u << r) : 0u; } }
    const int koff = r32 * KROW + hi * 16;
    const int vlane = (4 * hi + ((lane & 15) >> 2)) * 64 + ((lane >> 4) & 1) * 32 + (lane & 3) * 8;
#define ATT_TILE(tt) do { const int t_c = (tt); const int buf = t_c & 3; \
        bool act = true; int kr = 0; \
        if (MODE == 1) { kr = kr0 + t_c; act = (t_c >= nt1) || (kr >= rsq && kr < rsq + 8); } \
        if (act) { \
            const LAS unsigned char* kb = lds + buf * KSZ + koff; \
            f32x16 s0, s1; bf16x8 ka0[DK / 16], ka1[DK / 16]; \
            _Pragma("unroll") for (int d0 = 0; d0 < DK / 16; ++d0) { ka0[d0] = *(const LAS bf16x8*)(kb + d0 * 32); ka1[d0] = *(const LAS bf16x8*)(kb + 32 * KROW + d0 * 32); } \
            __builtin_amdgcn_sched_barrier(0);            \
            _Pragma("unroll") for (int d0 = 0; d0 < DK / 16; ++d0) { \
                if (d0 == 0) { s0 = __builtin_amdgcn_mfma_f32_32x32x16_bf16(ka0[0], qr[0], negm, 0, 0, 0); s1 = __builtin_amdgcn_mfma_f32_32x32x16_bf16(ka1[0], qr[0], negm, 0, 0, 0); } \
                else { s0 = __builtin_amdgcn_mfma_f32_32x32x16_bf16(ka0[d0], qr[d0], s0, 0, 0, 0); s1 = __builtin_amdgcn_mfma_f32_32x32x16_bf16(ka1[d0], qr[d0], s1, 0, 0, 0); } } \
            const LAS unsigned char* vb = lds + VB + buf * 8192 + vlane; \
            v4i16_t vlo[8], vhh[8]; \
            _Pragma("unroll") for (int i = 0; i < 8; ++i) { const int ks = i >> 1, db = i & 1; \
                vlo[i] = __builtin_amdgcn_ds_read_tr16_b64_v4i16((LAS v4i16_t*)(vb + ((ks * 2 + 0) * 2 + db) * 512)); \
                vhh[i] = __builtin_amdgcn_ds_read_tr16_b64_v4i16((LAS v4i16_t*)(vb + ((ks * 2 + 1) * 2 + db) * 512)); } \
            __builtin_amdgcn_sched_barrier(0);            \
            if (MODE == 1) { if (t_c < nt1) { \
                unsigned bo_ = (unsigned)(size_t)((const LAS float*)(lds + BIAS) + (kr - rq + 7) * 31 - qc + 15 + 4 * hi); asm volatile("" : "+v"(bo_)); \
                const LAS float* bs = (const LAS float*)(size_t)bo_;        \
                _Pragma("unroll") for (int r = 0; r < 16; ++r) { const int kk_ = (r & 3) + 8 * (r >> 2); \
                    const float b0 = bs[kk_], b1 = bs[kk_ + 32]; \
                    s0[r] = ((nmask0 >> r) & 1u) ? s0[r] + b0 : -INFINITY; s1[r] = ((nmask1 >> r) & 1u) ? s1[r] + b1 : -INFINITY; } } } \
            float ma = __builtin_fmaxf(__builtin_fmaxf(s0[0], s0[1]), s1[0]), mb = __builtin_fmaxf(__builtin_fmaxf(s0[2], s0[3]), s1[1]); \
            ma = __builtin_fmaxf(__builtin_fmaxf(ma, s1[2]), s1[3]); \
            _Pragma("unroll") for (int r = 4; r < 16; r += 4) { ma = __builtin_fmaxf(__builtin_fmaxf(ma, s0[r]), s0[r + 1]); mb = __builtin_fmaxf(__builtin_fmaxf(mb, s0[r + 2]), s0[r + 3]); \
                ma = __builtin_fmaxf(__builtin_fmaxf(ma, s1[r]), s1[r + 1]); mb = __builtin_fmaxf(__builtin_fmaxf(mb, s1[r + 2]), s1[r + 3]); } \
            const float mx = swap_max(__builtin_fmaxf(ma, mb)); \
            if (__any(mx > ATT_THR)) {        \
                const float dl = __builtin_fmaxf(mx, 0.f); m_run += dl; const float f = fast_exp2(-dl); l_run *= f; if (hi == 0) wsf[r32] = f; LDS_WAIT(); \
                _Pragma("unroll") for (int r = 0; r < 16; ++r) { const float fr_ = wsf[crow(r, hi)]; o0[r] *= fr_; o1[r] *= fr_; s0[r] -= dl; s1[r] -= dl; } \
                _Pragma("unroll") for (int r = 0; r < 16; ++r) negm[r] = -m_run; \
                asm volatile("" : "+v"(negm)); \
            } \
            float ls = 0.f; \
            _Pragma("unroll") for (int r = 0; r < 16; ++r) { s0[r] = fast_exp2(s0[r]); s1[r] = fast_exp2(s1[r]); ls += s0[r] + s1[r]; } \
            l_run += ls; \
            v4u pw[4]; \
            pw[0] = (v4u){pkbf(s0[0], s0[1]), pkbf(s0[2], s0[3]), pkbf(s0[4], s0[5]), pkbf(s0[6], s0[7])}; \
            pw[1] = (v4u){pkbf(s0[8], s0[9]), pkbf(s0[10], s0[11]), pkbf(s0[12], s0[13]), pkbf(s0[14], s0[15])}; \
            pw[2] = (v4u){pkbf(s1[0], s1[1]), pkbf(s1[2], s1[3]), pkbf(s1[4], s1[5]), pkbf(s1[6], s1[7])}; \
            pw[3] = (v4u){pkbf(s1[8], s1[9]), pkbf(s1[10], s1[11]), pkbf(s1[12], s1[13]), pkbf(s1[14], s1[15])}; \
            __builtin_amdgcn_sched_barrier(0); \
            _Pragma("unroll") for (int ks = 0; ks < 4; ++ks) { \
                const bf16x8 pa = __builtin_bit_cast(bf16x8, pw[ks]); \
                _Pragma("unroll") for (int db = 0; db < 2; ++db) { \
                    const v4i16_t lo = vlo[ks * 2 + db], hh = vhh[ks * 2 + db]; \
                    const bf16x8 vf = (bf16x8){lo[0], lo[1], lo[2], lo[3], hh[0], hh[1], hh[2], hh[3]}; \
                    if (db == 0) o0 = __builtin_amdgcn_mfma_f32_32x32x16_bf16(pa, vf, o0, 0, 0, 0); \
                    else         o1 = __builtin_amdgcn_mfma_f32_32x32x16_bf16(pa, vf, o1, 0, 0, 0); } } \
        } } while (0)
    for (int t = 0; t < NT; t += 2) {
        if (t + 2 < NT) ATT_LOAD(t + 2, kA0, kA1, vA);
        if (t + 3 < NT) ATT_LOAD(t + 3, kB0, kB1, vB);
        ATT_TILE(t);
        if (t + 1 < NT) ATT_TILE(t + 1);
        if (t + 2 < NT) ATT_STORE((t + 2) & 3, kA0, kA1, vA);
        if (t + 3 < NT) ATT_STORE((t + 3) & 3, kB0, kB1, vB);
        __syncthreads();
    }
    const float lt = swap_sum(l_run);
    if (hi == 0) wsf[32 + r32] = frcp(lt);
    LDS_WAIT();
#pragma unroll
    for (int r = 0; r < 16; ++r) { const int q = crow(r, hi); const float il = wsf[32 + q]; bf16* orow = O + (size_t)(wid * 32 + q) * op;
        orow[r32] = f2bf(o0[r] * il); orow[32 + r32] = f2bf(o1[r] * il); }
    __syncthreads();
#undef ATT_LOAD
#undef ATT_STORE
#undef ATT_TILE
}
#define PINF(x_) asm volatile("" : "+v"(x_))
#if defined(PROBE_EXP2X)
#define PROBE_XEXP(x_) do { float dd_; asm volatile("v_exp_f32 %0, %1" : "=v"(dd_) : "v"(x_)); } while (0)
#else
#define PROBE_XEXP(x_) do {} while (0)
#endif
#if defined(PROBE_ACC)
#define PACC_T0(id_) do { if ((id_) == PROBE_ACC && blockIdx.x == 0 && tid == 0) { volatile LAS unsigned* pm_ = (volatile LAS unsigned*)(lds + MISC_OFF); pm_[16] = (unsigned)__builtin_amdgcn_s_memrealtime(); } } while (0)
#define PACC_T1(id_) do { if ((id_) == PROBE_ACC && blockIdx.x == 0 && tid == 0) { volatile LAS unsigned* pm_ = (volatile LAS unsigned*)(lds + MISC_OFF); pm_[18] += (unsigned)__builtin_amdgcn_s_memrealtime() - pm_[16]; } } while (0)
#else
#define PACC_T0(id_) do {} while (0)
#define PACC_T1(id_) do {} while (0)
#endif
template <int DK>
__device__ __forceinline__ void attn_unit_p(LAS unsigned char* lds, int tid, const bf16* Q, int qp, const bf16* K1, const bf16* V1, int nt1, const bf16* K2, const bf16* V2, int nt2,
                                            int kp, int vp, bf16* O, int op) {
    constexpr int NK = DK / 16, G = 2 * NK, PRE = 4;
    constexpr int KROW = DK * 2 + 16, KSZ = 64 * KROW, CPK = DK / 8, NPK = 64 * CPK;
    constexpr int VB = 4 * KSZ, SCR = VB + 4 * 8192;
    const int lane = tid & 63, r32 = lane & 31, hi = lane >> 5; const int wid = __builtin_amdgcn_readfirstlane(tid >> 6);
    const int NT = nt1 + nt2;
    LAS float* wsf = (LAS float*)(lds + SCR) + wid * 64;
    const int kkey0 = tid / CPK, kch0 = tid - kkey0 * CPK;
    const int kkey1 = (tid + 512) / CPK, kch1 = (tid + 512) - kkey1 * CPK;
    const bool two = (NPK > 512) && (tid + 512 < NPK);
    const int vkey = tid >> 3, vch = tid & 7;
    const int vdst = ((vkey >> 3) * 2 + (vch >> 2)) * 512 + (vkey & 7) * 64 + (vch & 3) * 16;
    v4u kA0, kA1 = {0u, 0u, 0u, 0u}, vA, kB0, kB1 = {0u, 0u, 0u, 0u}, vB;
#define ATT_LOADK(t, K0_, K1_) do { const int t_ = (t); const bf16* kb_ = (t_ < nt1) ? K1 + (size_t)t_ * 64 * kp : K2 + (size_t)(t_ - nt1) * 64 * kp; \
        K0_ = *(const GAS v4u*)(kb_ + (size_t)kkey0 * kp + kch0 * 8); if (two) K1_ = *(const GAS v4u*)(kb_ + (size_t)kkey1 * kp + kch1 * 8); } while (0)
#define ATT_LOADV(t, V_) do { const int t_ = (t); const bf16* vb_ = (t_ < nt1) ? V1 + (size_t)t_ * 64 * vp : V2 + (size_t)(t_ - nt1) * 64 * vp; \
        V_ = *(const GAS v4u*)(vb_ + (size_t)vkey * vp + vch * 8); } while (0)
#define ATT_STOREK(buf, K0_, K1_) do { LAS unsigned char* kd_ = lds + (buf) * KSZ; *(LAS v4u*)(kd_ + kkey0 * KROW + kch0 * 16) = K0_; if (two) *(LAS v4u*)(kd_ + kkey1 * KROW + kch1 * 16) = K1_; } while (0)
#define ATT_STOREV(buf, V_) do { *(LAS v4u*)(lds + VB + (buf) * 8192 + vdst) = V_; } while (0)
    { v4u kT0, kT1 = {0u, 0u, 0u, 0u};
      ATT_LOADK(0, kA0, kA1); ATT_LOADV(0, vA); ATT_LOADK(1, kB0, kB1); ATT_LOADV(1, vB); ATT_LOADK(2, kT0, kT1);
      ATT_STOREK(0, kA0, kA1); ATT_STOREV(0, vA); ATT_STOREK(1, kB0, kB1); ATT_STOREV(1, vB); ATT_STOREK(2, kT0, kT1); }
    bf16x8 qr[NK];
#pragma unroll
    for (int d0 = 0; d0 < NK; ++d0) qr[d0] = *(const GAS bf16x8*)(Q + (size_t)(wid * 32 + r32) * qp + d0 * 16 + hi * 8);
    __syncthreads();
    float m_run = 0.f, l4[4]; f32x16 o0, o1, negm;
    { float zz; asm volatile("v_mov_b32 %0, 0" : "=v"(zz));
#pragma unroll
      for (int r = 0; r < 16; ++r) { o0[r] = zz; o1[r] = zz; negm[r] = zz; }
      l4[0] = zz; l4[1] = zz; l4[2] = zz; l4[3] = zz; }
    const int koff = r32 * KROW + hi * 16;
    const int vlane = (4 * hi + ((lane & 15) >> 2)) * 64 + ((lane >> 4) & 1) * 32 + (lane & 3) * 8;
#define KREAD(i_) (*(const LAS bf16x8*)(kb + ((i_) & 1) * 32 * KROW + ((i_) >> 1) * 32))
#define VREADLO(g_) __builtin_amdgcn_ds_read_tr16_b64_v4i16((LAS v4i16_t*)(vb + ((((g_) >> 1) * 2 + 0) * 2 + ((g_) & 1)) * 512))
#define VREADHI(g_) __builtin_amdgcn_ds_read_tr16_b64_v4i16((LAS v4i16_t*)(vb + ((((g_) >> 1) * 2 + 1) * 2 + ((g_) & 1)) * 512))
#define MAX3(a_, b_, c_) __builtin_fmaxf(__builtin_fmaxf(a_, b_), c_)
#define ATT_DECIDE(N0, N1, ma_, mb_) do { const float mloc = __builtin_fmaxf(ma_, mb_);        \
        if (__any(mloc > ATT_THR)) { const float mx = swap_max(mloc); \
            const float dl = __builtin_fmaxf(mx, 0.f); m_run += dl; const float f = fast_exp2(-dl); l4[0] *= f; l4[1] *= f; l4[2] *= f; l4[3] *= f; if (hi == 0) wsf[r32] = f; LDS_WAIT(); \
            _Pragma("unroll") for (int r = 0; r < 16; ++r) { const float fr_ = wsf[crow(r, hi)]; o0[r] *= fr_; o1[r] *= fr_; N0[r] -= dl; N1[r] -= dl; } \
            _Pragma("unroll") for (int r = 0; r < 16; ++r) negm[r] = -m_run; \
            asm volatile("" : "+v"(negm)); \
        } } while (0)
#define CE(C0, C1, e_) (((e_) < 16) ? C0[(e_) & 15] : C1[(e_) & 15])
#define EOF_(g_) (PRE + (32 - PRE) * (g_) / G)
#define MS_(g_) ((g_) < 2 ? 0 : (g_) == 2 ? 3 : 2 * (g_) - 1)
#define ATT_STEP(C0, C1, N0, N1, T) do { const int t_s = (T); \
        if ((t_s & 1) != 0) { if (wid >= 4) __builtin_amdgcn_s_setprio(0); else __builtin_amdgcn_s_setprio(1); } else { if (wid >= 4) __builtin_amdgcn_s_setprio(1); else __builtin_amdgcn_s_setprio(0); }        \
        PACC_T0(5); PACC_T0(2); \
        const LAS unsigned char* kb = lds + ((t_s + 1) & 3) * KSZ + koff; \
        const LAS unsigned char* vb = lds + VB + (t_s & 3) * 8192 + vlane; \
        bf16x8 kf[G]; float x[32]; unsigned pwv[16]; v4i16_t vlo[8], vhh[8]; float ma, mb; \
        kf[0] = KREAD(0); kf[1] = KREAD(1); kf[2] = KREAD(2); \
        _Pragma("unroll") for (int e = 0; e < PRE; ++e) { x[e] = fast_exp2(CE(C0, C1, e)); PINF(x[e]); } \
        __builtin_amdgcn_sched_barrier(0); \
        _Pragma("unroll") for (int g = 0; g < G; ++g) { \
            if (g + 3 < G) kf[g + 3] = KREAD(g + 3); \
            if (g >= G - 4) { vlo[g - (G - 4)] = VREADLO(g - (G - 4)); vhh[g - (G - 4)] = VREADHI(g - (G - 4)); } \
            if (g == 0) N0 = __builtin_amdgcn_mfma_f32_32x32x16_bf16(kf[0], qr[0], negm, 0, 0, 0); \
            else if (g == 1) N1 = __builtin_amdgcn_mfma_f32_32x32x16_bf16(kf[1], qr[0], negm, 0, 0, 0); \
            else if (g & 1) N1 = __builtin_amdgcn_mfma_f32_32x32x16_bf16(kf[g], qr[g >> 1], N1, 0, 0, 0); \
            else N0 = __builtin_amdgcn_mfma_f32_32x32x16_bf16(kf[g], qr[g >> 1], N0, 0, 0, 0); \
            if (g & 1) PINF(N1); else PINF(N0);            \
            _Pragma("unroll") for (int e = EOF_(g); e < EOF_(g + 1); ++e) { x[e] = fast_exp2(CE(C0, C1, e)); PINF(x[e]); PROBE_XEXP(x[e]); } \
            _Pragma("unroll") for (int k = (g == 0 ? 0 : EOF_(g - 1) / 2); k < EOF_(g) / 2; ++k) { pwv[k] = pkbf(x[2 * k], x[2 * k + 1]); PINF(pwv[k]); } \
            __builtin_amdgcn_sched_barrier(0); } \
        PACC_T1(2); PACC_T0(3); \
        _Pragma("unroll") for (int g = 0; g < 8; ++g) { \
            if (g < 4) { vlo[g + 4] = VREADLO(g + 4); vhh[g + 4] = VREADHI(g + 4); } \
            if (g == 0) { _Pragma("unroll") for (int k = EOF_(G - 1) / 2; k < 16; ++k) { pwv[k] = pkbf(x[2 * k], x[2 * k + 1]); PINF(pwv[k]); } } \
            { const int ks = g >> 1; const bf16x8 pa = __builtin_bit_cast(bf16x8, ((v4u){pwv[4 * ks], pwv[4 * ks + 1], pwv[4 * ks + 2], pwv[4 * ks + 3]})); \
              const bf16x8 vf = (bf16x8){vlo[g][0], vlo[g][1], vlo[g][2], vlo[g][3], vhh[g][0], vhh[g][1], vhh[g][2], vhh[g][3]}; \
              if (g & 1) { o1 = __builtin_amdgcn_mfma_f32_32x32x16_bf16(pa, vf, o1, 0, 0, 0); PINF(o1); } else { o0 = __builtin_amdgcn_mfma_f32_32x32x16_bf16(pa, vf, o0, 0, 0, 0); PINF(o0); } } \
            _Pragma("unroll") for (int jj = 0; jj < 4; ++jj) { l4[jj] += x[4 * g + jj]; PINF(l4[jj]); } \
            { _Pragma("unroll") for (int i = MS_(g); i < MS_(g + 1); ++i) { \
                  if (i == 0) ma = MAX3(CE(N0, N1, 0), CE(N0, N1, 1), CE(N0, N1, 2)); else if (i == 1) mb = MAX3(CE(N0, N1, 3), CE(N0, N1, 4), CE(N0, N1, 5)); \
                  else if (i & 1) mb = MAX3(mb, CE(N0, N1, 2 * i + 2), CE(N0, N1, 2 * i + 3)); else ma = MAX3(ma, CE(N0, N1, 2 * i + 2), CE(N0, N1, 2 * i + 3)); \
                  if (i & 1) PINF(mb); else PINF(ma); } } \
            __builtin_amdgcn_sched_barrier(0); } \
        PACC_T1(3); PACC_T0(4); \
        ATT_DECIDE(N0, N1, ma, mb); \
        PACC_T1(4); PACC_T1(5); \
    } while (0)
    if (wid >= 4) __builtin_amdgcn_s_setprio(1);
    f32x16 a0, a1, b0, b1;
    {
        const LAS unsigned char* kb = lds + koff; bf16x8 kf[G];
#pragma unroll
        for (int g = 0; g < G; ++g) kf[g] = KREAD(g);
        __builtin_amdgcn_sched_barrier(0);
#pragma unroll
        for (int g = 0; g < G; ++g) {
            if (g == 0) a0 = __builtin_amdgcn_mfma_f32_32x32x16_bf16(kf[0], qr[0], negm, 0, 0, 0);
            else if (g == 1) a1 = __builtin_amdgcn_mfma_f32_32x32x16_bf16(kf[1], qr[0], negm, 0, 0, 0);
            else if (g & 1) a1 = __builtin_amdgcn_mfma_f32_32x32x16_bf16(kf[g], qr[g >> 1], a1, 0, 0, 0);
            else a0 = __builtin_amdgcn_mfma_f32_32x32x16_bf16(kf[g], qr[g >> 1], a0, 0, 0, 0); }
        float ma = __builtin_fmaxf(a0[0], a0[1]), mb = __builtin_fmaxf(a0[2], a0[3]);
#pragma unroll
        for (int i = 2; i < 16; ++i) { if (i & 1) mb = MAX3(mb, CE(a0, a1, 2 * i), CE(a0, a1, 2 * i + 1)); else ma = MAX3(ma, CE(a0, a1, 2 * i), CE(a0, a1, 2 * i + 1)); }
        m_run = swap_max(__builtin_fmaxf(ma, mb));
#pragma unroll
        for (int r = 0; r < 16; ++r) { a0[r] -= m_run; a1[r] -= m_run; negm[r] = -m_run; }
        asm volatile("" : "+v"(negm));
    }
    for (int t = 0; t + 2 < NT; t += 2) {
        ATT_LOADK(t + 3, kA0, kA1); ATT_LOADV(t + 2, vA); ATT_LOADV(t + 3, vB); if (t + 4 < NT) ATT_LOADK(t + 4, kB0, kB1);
        ATT_STEP(a0, a1, b0, b1, t); ATT_STEP(b0, b1, a0, a1, t + 1);
        ATT_STOREK((t + 3) & 3, kA0, kA1); ATT_STOREV((t + 2) & 3, vA); ATT_STOREV((t + 3) & 3, vB); if (t + 4 < NT) ATT_STOREK((t + 4) & 3, kB0, kB1);
        PACC_T0(1);
        __syncthreads();
        PACC_T1(1);
    }
    ATT_STEP(a0, a1, b0, b1, NT - 2);
    {
        const LAS unsigned char* vb = lds + VB + ((NT - 1) & 3) * 8192 + vlane; v4i16_t vlo[8], vhh[8];
#pragma unroll
        for (int g = 0; g < 8; ++g) { vlo[g] = VREADLO(g); vhh[g] = VREADHI(g); }
        __builtin_amdgcn_sched_barrier(0);
        float ls = 0.f;
#pragma unroll
        for (int r = 0; r < 16; ++r) { b0[r] = fast_exp2(b0[r]); b1[r] = fast_exp2(b1[r]); ls += b0[r] + b1[r]; }
        l4[0] += ls;
        v4u pw[4];
        pw[0] = (v4u){pkbf(b0[0], b0[1]), pkbf(b0[2], b0[3]), pkbf(b0[4], b0[5]), pkbf(b0[6], b0[7])};
        pw[1] = (v4u){pkbf(b0[8], b0[9]), pkbf(b0[10], b0[11]), pkbf(b0[12], b0[13]), pkbf(b0[14], b0[15])};
        pw[2] = (v4u){pkbf(b1[0], b1[1]), pkbf(b1[2], b1[3]), pkbf(b1[4], b1[5]), pkbf(b1[6], b1[7])};
        pw[3] = (v4u){pkbf(b1[8], b1[9]), pkbf(b1[10], b1[11]), pkbf(b1[12], b1[13]), pkbf(b1[14], b1[15])};
#pragma unroll
        for (int g = 0; g < 8; ++g) { const bf16x8 pa = __builtin_bit_cast(bf16x8, pw[g >> 1]);
            const bf16x8 vf = (bf16x8){vlo[g][0], vlo[g][1], vlo[g][2], vlo[g][3], vhh[g][0], vhh[g][1], vhh[g][2], vhh[g][3]};
            if (g & 1) o1 = __builtin_amdgcn_mfma_f32_32x32x16_bf16(pa, vf, o1, 0, 0, 0); else o0 = __builtin_amdgcn_mfma_f32_32x32x16_bf16(pa, vf, o0, 0, 0, 0); }
    }
    __builtin_amdgcn_s_setprio(0);
    const float lt = swap_sum((l4[0] + l4[1]) + (l4[2] + l4[3]));
    if (hi == 0) wsf[32 + r32] = frcp(lt);
    LDS_WAIT();
#pragma unroll
    for (int r = 0; r < 16; ++r) { const int q = crow(r, hi); const float il = wsf[32 + q]; bf16* orow = O + (size_t)(wid * 32 + q) * op;
        orow[r32] = f2bf(o0[r] * il); orow[32 + r32] = f2bf(o1[r] * il); }
    __syncthreads();
#undef ATT_LOADK
#undef ATT_LOADV
#undef ATT_STOREK
#undef ATT_STOREV
#undef ATT_STEP
#undef ATT_DECIDE
#undef KREAD
#undef VREADLO
#undef VREADHI
#undef CE
#undef EOF_
#undef MS_
}
__device__ __forceinline__ int hg_blk_row(int b, int blk) { return blk < 2 ? MLAT + b * CTXL + 128 * blk : b * SEQ + 128 * (blk - 2); }
__device__ __forceinline__ int hg_mc_of_blk(int dir, int blk) { return dir ? (blk < 2 ? 1 - blk : 67 - blk) : blk; }
template <int KT> __device__ __forceinline__ f32x16 mma_nt(f32x16 acc, const LAS bf16* A, int lda, const LAS bf16* Bt, int ldb, int r32, int hi) {
    const LAS bf16* ap = A + r32 * lda + 8 * hi; const LAS bf16* bp = Bt + r32 * ldb + 8 * hi;
#pragma unroll
    for (int k0 = 0; k0 < KT; k0 += 16) acc = __builtin_amdgcn_mfma_f32_32x32x16_bf16(*(const LAS bf16x8*)(ap + k0), *(const LAS bf16x8*)(bp + k0), acc, 0, 0, 0);
    return acc;
}
__device__ __forceinline__ void ldq16(const bf16* p, float (&o)[16]) {
    const v4u a = *(const GAS v4u*)p, b = *(const GAS v4u*)(p + 8);
    o[0] = bf_lo(a.x); o[1] = bf_hi(a.x); o[2] = bf_lo(a.y); o[3] = bf_hi(a.y); o[4] = bf_lo(a.z); o[5] = bf_hi(a.z); o[6] = bf_lo(a.w); o[7] = bf_hi(a.w);
    o[8] = bf_lo(b.x); o[9] = bf_hi(b.x); o[10] = bf_lo(b.y); o[11] = bf_hi(b.y); o[12] = bf_lo(b.z); o[13] = bf_hi(b.z); o[14] = bf_lo(b.w); o[15] = bf_hi(b.w);
}
__device__ __forceinline__ void ldf16(const float* p, float (&o)[16]) {
#pragma unroll
    for (int k = 0; k < 4; ++k) { const f32x4 a = *((const GAS f32x4*)p + k); o[4 * k] = a.x; o[4 * k + 1] = a.y; o[4 * k + 2] = a.z; o[4 * k + 3] = a.w; }
}
__device__ __forceinline__ void st16(LAS bf16* p, const float (&v)[16]) {
    *(LAS v4u*)p = (v4u){pkbf(v[0], v[1]), pkbf(v[2], v[3]), pkbf(v[4], v[5]), pkbf(v[6], v[7])};
    *(LAS v4u*)(p + 8) = (v4u){pkbf(v[8], v[9]), pkbf(v[10], v[11]), pkbf(v[12], v[13]), pkbf(v[14], v[15])};
}

__device__ __forceinline__ void ldq8(const bf16* p, float (&o)[8]) { const v4u a = *(const GAS v4u*)p;
    o[0] = bf_lo(a.x); o[1] = bf_hi(a.x); o[2] = bf_lo(a.y); o[3] = bf_hi(a.y); o[4] = bf_lo(a.z); o[5] = bf_hi(a.z); o[6] = bf_lo(a.w); o[7] = bf_hi(a.w); }
__device__ __forceinline__ void ldf8(const float* p, float (&o)[8]) { const f32x4 a = *(const GAS f32x4*)p, b = *((const GAS f32x4*)p + 1); o[0] = a.x; o[1] = a.y; o[2] = a.z; o[3] = a.w; o[4] = b.x; o[5] = b.y; o[6] = b.z; o[7] = b.w; }
__device__ __forceinline__ void st8(LAS bf16* p, const float (&v)[8]) { *(LAS v4u*)p = (v4u){pkbf(v[0], v[1]), pkbf(v[2], v[3]), pkbf(v[4], v[5]), pkbf(v[6], v[7])}; }

struct HgT { const bf16 *Qd, *Vd, *Sg; const float *Zf, *Zb; const float* lb  ; float* HST; float* HDM; const float* ong; bf16* OO; };

__device__ __forceinline__ void hg_a_load(const HgT& T, int u, int e, int p, float (&zr)[32]) {
    const int chain = u / 66, mc = u - chain * 66, dir = chain & 1, h = (chain >> 1) & 3, b = chain >> 3, hoff = h * 128;
    const int row0 = hg_blk_row(b, hg_mc_of_blk(dir, mc));
    const float* zp = (dir ? T.Zb : T.Zf) + (size_t)(row0 + 32 * p) * 512 + hoff;
#pragma unroll
    for (int i = 0; i < 32; ++i) zr[i] = ((const GAS float*)(zp + (size_t)i * 512))[e];
}
__device__ __forceinline__ void hg_a_unit(Frame& F, const HgT& T, int chain, int mc, float (&zr)[32], int unext) {
    const int dir = chain & 1, h = (chain >> 1) & 3, b = chain >> 3, hoff = h * 128;
    const int row0 = hg_blk_row(b, hg_mc_of_blk(dir, mc));
    const float* Z = dir ? T.Zb : T.Zf;
    LAS float* PT = (LAS float*)F.lds;
    LAS bf16* KET = (LAS bf16*)(F.lds + 2048);
    LAS bf16* VT = (LAS bf16*)(F.lds + 2048 + 34816);
    const int tid = F.tid, lane = F.lane, r32 = lane & 31, hi = lane >> 5, wid = F.wave;
    const int e = tid & 127, p = __builtin_amdgcn_readfirstlane(tid >> 7);
    const float lbv = T.lb[dir * 512 + hoff + e];
    const bf16* vp = T.Vd + (size_t)(row0 + 32 * p) * 512 + hoff;
    float w[32], kk[32]; unsigned vv[16];
#pragma unroll
    for (int i = 0; i < 16; ++i) vv[i] = (unsigned)((const GAS bf16*)(vp + (size_t)(2 * i) * 512))[e] | ((unsigned)((const GAS bf16*)(vp + (size_t)(2 * i + 1) * 512))[e] << 16);
#pragma unroll
    for (int i = 0; i < 32; ++i) { const float z = zr[i]; const float sg = sigmoidf_(z); w[i] = flog_(lbv + (1.f - lbv) * sg); kk[i] = (1.f - lbv) * (1.f - sg); }
    if (unext < 2112) hg_a_load(T, unext, e, p, zr);
    float run = 0.f;
    if (dir == 0) {
#pragma unroll
        for (int i = 31; i >= 0; --i) { const float tmp = w[i]; w[i] = run; run += tmp; }
    } else {
#pragma unroll
        for (int i = 0; i < 32; ++i) { const float tmp = w[i]; w[i] = run; run += tmp; }
    }
    PT[p * 128 + e] = run;
    __syncthreads();
    { const float p0 = PT[e], p1 = PT[128 + e], p2 = PT[256 + e], p3 = PT[384 + e];
      const float offs = dir == 0 ? ((p < 3 ? p3 : 0.f) + (p < 2 ? p2 : 0.f) + (p < 1 ? p1 : 0.f)) : ((p > 0 ? p0 : 0.f) + (p > 1 ? p1 : 0.f) + (p > 2 ? p2 : 0.f));
      if (p == 0) T.HDM[((size_t)chain * 66 + mc) * 128 + e] = __expf((p0 + p1) + (p2 + p3));
#pragma unroll
      for (int g = 0; g < 4; ++g) { unsigned pk[4];
#pragma unroll
          for (int c = 0; c < 4; ++c) { const int i = 8 * g + 2 * c; pk[c] = pkbf(kk[i] * __expf(w[i] + offs), kk[i + 1] * __expf(w[i + 1] + offs)); }
          *(LAS v4u*)(KET + e * 136 + 32 * p + 8 * g) = (v4u){pk[0], pk[1], pk[2], pk[3]};
          *(LAS v4u*)(VT + e * 136 + 32 * p + 8 * g) = (v4u){vv[4 * g], vv[4 * g + 1], vv[4 * g + 2], vv[4 * g + 3]}; } }
    __syncthreads();
    { const int ei = wid & 3, fp = wid >> 2; float* dst = T.HST + ((size_t)chain * 66 + mc) * 16384;
#pragma unroll
      for (int k = 0; k < 2; ++k) { const int fi = 2 * fp + k; f32x16 acc = {}; acc = mma_nt<128>(acc, KET + 32 * ei * 136, 136, VT + 32 * fi * 136, 136, r32, hi);
#pragma unroll
          for (int r = 0; r < 16; ++r) dst[(32 * ei + crow(r, hi)) * 128 + 32 * fi + r32] = acc[r]; } }
    __syncthreads();
}
__device__ __forceinline__ void phase_hg_a(Frame& F, const HgT& T) {
    const int e = F.tid & 127, p = __builtin_amdgcn_readfirstlane(F.tid >> 7);
    float zr[32];
    int u = F.vcu;
    if (u < 2112) hg_a_load(T, u, e, p, zr);
    for (; u < 2112; u += F.G) hg_a_unit(F, T, u / 66, u % 66, zr, u + F.G);
}
__device__ __forceinline__ void phase_hg_b(Frame& F, const HgT& T) {
    const int g = F.vcu * NTHR + F.tid;
    for (int gi = g; gi < 32 * 4096; gi += F.G * NTHR) {
        const int chain = gi >> 12, idx = gi & 4095, e = idx >> 5, f4 = idx & 31;
        f32x4* base = (f32x4*)(T.HST + (size_t)chain * 66 * 16384 + e * 128) + f4; const float* dmp = T.HDM + (size_t)chain * 66 * 128 + e;
        f32x4 S = {0.f, 0.f, 0.f, 0.f};
#pragma unroll 22
        for (int mc = 0; mc < 66; ++mc) { const f32x4 kv = base[(size_t)mc * 4096]; const float d = dmp[mc * 128]; base[(size_t)mc * 4096] = S; S = S * d + kv; }
    }
}
__device__ __forceinline__ void hg_c_unit(Frame& F, const HgT& T, int b, int h, int blk) {
    const int hoff = h * 128, row0 = hg_blk_row(b, blk);
    const int tid = F.tid, lane = F.lane, r32 = lane & 31, hi = lane >> 5, wid = F.wave;
    LAS bf16* P = (LAS bf16*)F.lds;
    LAS float* PT = (LAS float*)(F.lds + 32768);
    LAS float* DE = (LAS float*)(F.lds + 34816);
    LAS float* BR = (LAS float*)(F.lds + 35328);
    LAS bf16* QB = (LAS bf16*)(F.lds + 35840);
    LAS bf16* QS = (LAS bf16*)(F.lds + 53248);
    LAS bf16* KS = (LAS bf16*)(F.lds + 70656);
    LAS bf16* KET = (LAS bf16*)(F.lds + 88064);
    LAS bf16* VT = (LAS bf16*)(F.lds + 106496);
    LAS bf16* ST = (LAS bf16*)(F.lds + 124928);
    LAS float* OUT = (LAS float*)(F.lds + 35840);
    const int ti = wid & 1, fi = wid >> 1;
    const int ei = wid & 3, fp = wid >> 2;
    f32x16 oacc0 = {}, oacc1 = {};
    const int se = tid & 127, sp = __builtin_amdgcn_readfirstlane(tid >> 7);
#ifndef HGDIR_LO
#define HGDIR_LO 0
#define HGDIR_HI 2
#endif
    float zraw[16]; unsigned qraw[16], vraw[16];
#define HC_LOAD(dir_, cc_) do { const int ci_ = (dir_) ? 1 - (cc_) : (cc_); const int rowc_ = row0 + 64 * ci_; const float* Z_ = (dir_) ? T.Zb : T.Zf; \
        const float* zp_ = Z_ + (size_t)(rowc_ + 16 * sp) * 512 + hoff; const bf16* qp_ = T.Qd + (size_t)(rowc_ + 16 * sp) * 512 + hoff; const bf16* vp_ = T.Vd + (size_t)(rowc_ + 16 * sp) * 512 + hoff; \
        _Pragma("unroll") for (int i = 0; i < 16; ++i) { zraw[i] = ((const GAS float*)(zp_ + (size_t)i * 512))[se]; qraw[i] = ((const GAS bf16*)(qp_ + (size_t)i * 512))[se]; vraw[i] = ((const GAS bf16*)(vp_ + (size_t)i * 512))[se]; } } while (0)
    HC_LOAD(HGDIR_LO, 0);
#pragma unroll 1
    for (int dir = HGDIR_LO; dir < HGDIR_HI; ++dir) {
        const int chain = (b * 4 + h) * 2 + dir; const float* Z = dir ? T.Zb : T.Zf;
        const float* Sin = T.HST + ((size_t)chain * 66 + hg_mc_of_blk(dir, blk)) * 16384;
        f32x16 S[2];
#pragma unroll
        for (int k = 0; k < 2; ++k)
#pragma unroll
            for (int r = 0; r < 16; ++r) S[k][r] = ((const GAS float*)(Sin + (32 * ei + (r & 3) + 8 * (r >> 2)) * 128 + 32 * (2 * fp + k)))[4 * hi * 128 + r32];
#pragma unroll
        for (int k = 0; k < 2; ++k)
#pragma unroll
            for (int g = 0; g < 4; ++g) *(LAS v2u*)(ST + (32 * (2 * fp + k) + r32) * 136 + 32 * ei + 8 * g + 4 * hi) = (v2u){pkbf(S[k][4 * g], S[k][4 * g + 1]), pkbf(S[k][4 * g + 2], S[k][4 * g + 3])};
#pragma unroll 1
        for (int cc = 0; cc < 2; ++cc) {
            const int ci = dir ? 1 - cc : cc; const int rowc = row0 + 64 * ci;
            { const float lbv = T.lb[dir * 512 + hoff + se];
              float bq[16], kk[16], qv[16]; unsigned vv[8];
#pragma unroll
              for (int i = 0; i < 16; ++i) { const float z = zraw[i]; const float sg = sigmoidf_(z); bq[i] = flog_(lbv + (1.f - lbv) * sg); kk[i] = (1.f - lbv) * (1.f - sg); qv[i] = __uint_as_float(qraw[i] << 16); }
#pragma unroll
              for (int i = 0; i < 8; ++i) vv[i] = vraw[2 * i] | (vraw[2 * i + 1] << 16);
              float run = 0.f;
              if (dir == 0) {
#pragma unroll
                  for (int i = 0; i < 16; ++i) { run += bq[i]; bq[i] = run; }
              } else {
#pragma unroll
                  for (int i = 15; i >= 0; --i) { run += bq[i]; bq[i] = run; }
              }
              PT[sp * 128 + se] = run;
              if (dir == 0) { if (sp == 1) BR[se] = bq[15]; } else { if (sp == 2) BR[se] = bq[0]; }
              __syncthreads();
              const float p0 = PT[se], p1 = PT[128 + se], p2 = PT[256 + se], p3 = PT[384 + se];
              const float offs = dir == 0 ? ((sp > 0 ? p0 : 0.f) + (sp > 1 ? p1 : 0.f) + (sp > 2 ? p2 : 0.f)) : ((sp < 3 ? p3 : 0.f) + (sp < 2 ? p2 : 0.f) + (sp < 1 ? p1 : 0.f));
              const float bend = (p0 + p1) + (p2 + p3), br = BR[se] + (dir == 0 ? p0 : p3);
              if (sp == 0) DE[se] = __expf(bend);
              unsigned ke[8];
#pragma unroll
              for (int c = 0; c < 8; ++c) { const float b0 = bq[2 * c] + offs, b1 = bq[2 * c + 1] + offs; ke[c] = pkbf(kk[2 * c] * __expf(bend - b0), kk[2 * c + 1] * __expf(bend - b1)); }
              *(LAS v4u*)(KET + se * 72 + 16 * sp) = (v4u){ke[0], ke[1], ke[2], ke[3]}; *(LAS v4u*)(KET + se * 72 + 16 * sp + 8) = (v4u){ke[4], ke[5], ke[6], ke[7]};
              *(LAS v4u*)(VT + se * 72 + 16 * sp) = (v4u){vv[0], vv[1], vv[2], vv[3]}; *(LAS v4u*)(VT + se * 72 + 16 * sp + 8) = (v4u){vv[4], vv[5], vv[6], vv[7]};
#pragma unroll
              for (int i = 0; i < 16; ++i) { const float bb = bq[i] + offs; const int tok = 16 * sp + i;
                  QB[tok * 136 + se] = f2bf(qv[i] * __expf(bb)); QS[tok * 136 + se] = f2bf(qv[i] * __expf(bb - br)); KS[tok * 136 + se] = f2bf(kk[i] * __expf(br - bb)); } }
            __syncthreads();
            if (cc == 0) HC_LOAD(dir, 1); else if (dir + 1 < HGDIR_HI) HC_LOAD(dir + 1, 0);
            if (wid < 4) { const int tb = wid & 1, sb = wid >> 1; f32x16 sc = {}; sc = mma_nt<128>(sc, QS + 32 * tb * 136, 136, KS + 32 * sb * 136, 136, r32, hi);
#pragma unroll
                for (int r = 0; r < 16; ++r) { const int t = 32 * tb + crow(r, hi), s = 32 * sb + r32; const bool keep = dir ? (s >= t) : (s <= t); P[t * 72 + s] = f2bf(keep ? sc[r] : 0.f); } }
            __syncthreads();
            { f32x16 a = ci ? oacc1 : oacc0; a = mma_nt<64>(a, P + 32 * ti * 72, 72, VT + 32 * fi * 72, 72, r32, hi); a = mma_nt<128>(a, QB + 32 * ti * 136, 136, ST + 32 * fi * 136, 136, r32, hi); if (ci) oacc1 = a; else oacc0 = a; }
            __syncthreads();
#pragma unroll
            for (int k = 0; k < 2; ++k) {
#pragma unroll
                for (int r = 0; r < 16; ++r) S[k][r] *= DE[32 * ei + crow(r, hi)];
                S[k] = mma_nt<64>(S[k], KET + 32 * ei * 72, 72, VT + 32 * (2 * fp + k) * 72, 72, r32, hi);
                asm volatile("s_nop 15\n\ts_nop 7" : "+v"(S[k]));
#pragma unroll
                for (int g = 0; g < 4; ++g) *(LAS v2u*)(ST + (32 * (2 * fp + k) + r32) * 136 + 32 * ei + 8 * g + 4 * hi) = (v2u){pkbf(S[k][4 * g], S[k][4 * g + 1]), pkbf(S[k][4 * g + 2], S[k][4 * g + 3])};
            }
            __syncthreads();
        }
#if defined(SELFCHK) && SELFCHK == 6
        { const int pair = (b == 1 && h == 2) ? 0 : (b == 3 && h == 0) ? 1 : -1;
          if (pair >= 0) {
#pragma unroll
            for (int r = 0; r < 16; ++r) { OUT[(32 * ti + crow(r, hi)) * 132 + 32 * fi + r32] = oacc0[r]; OUT[(64 + 32 * ti + crow(r, hi)) * 132 + 32 * fi + r32] = oacc1[r]; }
            __syncthreads();
            float* D = (float*)(F.ws + 1002 * MiB) + ((size_t)(dir * 2 + pair) * 8448 + (blk < 2 ? 128 * blk : 256 + 128 * (blk - 2))) * 128;
            for (int i = tid; i < 128 * 128; i += NTHR) D[i] = OUT[(i >> 7) * 132 + (i & 127)];
            __syncthreads(); } }
#endif
    }
#undef HC_LOAD
    { int l2; asm volatile("v_mbcnt_lo_u32_b32 %0, -1, 0\n\tv_mbcnt_hi_u32_b32 %0, -1, %0" : "=v"(l2)); const int r32b = l2 & 31, hib = l2 >> 5;
#pragma unroll
      for (int r = 0; r < 16; ++r) { OUT[(32 * ti + crow(r, hib)) * 132 + 32 * fi + r32b] = oacc0[r]; OUT[(64 + 32 * ti + crow(r, hib)) * 132 + 32 * fi + r32b] = oacc1[r]; }
      __syncthreads();
      for (int k = 0; k < 16; ++k) { const int t = 16 * wid + k; const float a0 = OUT[t * 132 + l2], a1 = OUT[t * 132 + 64 + l2];
        const float ms = wave_sum(a0 * a0 + a1 * a1, l2) * (1.f / 128.f); const float rs = __builtin_amdgcn_rsqf(ms + 1e-6f);
        const bf16* sgr = T.Sg + (size_t)(row0 + t) * 512 + hoff; bf16* orow = T.OO + (size_t)(row0 + t) * 1024 + 512 + hoff;
        ((GAS bf16*)orow)[l2] = f2bf(a0 * rs * ((const GAS float*)T.ong)[l2] * bf2f(((const GAS bf16*)sgr)[l2])); ((GAS bf16*)orow)[64 + l2] = f2bf(a1 * rs * ((const GAS float*)T.ong)[64 + l2] * bf2f(((const GAS bf16*)sgr)[64 + l2])); } }
    __syncthreads();
}
__device__ __forceinline__ void ld8(const float* p, float (&v)[8]) { const f32x4 a = *(const GAS f32x4*)p, b = *(const GAS f32x4*)(p + 4); v[0] = a.x; v[1] = a.y; v[2] = a.z; v[3] = a.w; v[4] = b.x; v[5] = b.y; v[6] = b.z; v[7] = b.w; }
__device__ __forceinline__ void ld8(const bf16* p, float (&v)[8]) { const v4u a = *(const GAS v4u*)p;
    v[0] = __uint_as_float(a.x << 16); v[1] = __uint_as_float(a.x & 0xffff0000u); v[2] = __uint_as_float(a.y << 16); v[3] = __uint_as_float(a.y & 0xffff0000u);
    v[4] = __uint_as_float(a.z << 16); v[5] = __uint_as_float(a.z & 0xffff0000u); v[6] = __uint_as_float(a.w << 16); v[7] = __uint_as_float(a.w & 0xffff0000u); }
__device__ __forceinline__ v4u pk8(const float (&v)[8], float s) { return (v4u){pkbf(v[0] * s, v[1] * s), pkbf(v[2] * s, v[3] * s), pkbf(v[4] * s, v[5] * s), pkbf(v[6] * s, v[7] * s)}; }
template <int R>
__device__ __forceinline__ void head_norm_rope(float (&v)[R][8], const float (&g8)[8], int l8  , const bool (&rope)[R], const int (&trow)[R], const int (&tcol)[R], const float* ropeA, int lane) {
    float ss[R];
#pragma unroll
    for (int q = 0; q < R; ++q) { ss[q] = 0.f;
#pragma unroll
        for (int e = 0; e < 8; ++e) ss[q] += v[q][e] * v[q][e]; }
#pragma unroll
    for (int q = 0; q < R; ++q) ss[q] += shx(ss[q], 1, lane);
#pragma unroll
    for (int q = 0; q < R; ++q) ss[q] += shx(ss[q], 2, lane);
#pragma unroll
    for (int q = 0; q < R; ++q) ss[q] += shx(ss[q], 4, lane);
    float pr[R][8];
#pragma unroll
    for (int q = 0; q < R; ++q) { const float rs = __builtin_amdgcn_rsqf(ss[q] * (1.f / 64.f) + 1e-6f);
#pragma unroll
        for (int e = 0; e < 8; ++e) v[q][e] = v[q][e] * rs * g8[e]; }
#pragma unroll
    for (int q = 0; q < R; ++q)
#pragma unroll
        for (int e = 0; e < 8; ++e) pr[q][e] = shx(v[q][e], 2, lane);
#pragma unroll
    for (int q = 0; q < R; ++q) if (rope[q]) { const int axis = l8 >> 2, pos = axis ? tcol[q] : trow[q]; const float* cs = ropeA + (pos * 16 + 8 * (l8 & 1)) * 2; const bool second = (l8 & 2) != 0;
        float cc[16];
#pragma unroll
        for (int k = 0; k < 4; ++k) { const f32x4 c4 = *((const GAS f32x4*)cs + k); cc[4 * k] = c4.x; cc[4 * k + 1] = c4.y; cc[4 * k + 2] = c4.z; cc[4 * k + 3] = c4.w; }
#pragma unroll
        for (int e = 0; e < 8; ++e) { const float c_ = cc[2 * e], s_ = cc[2 * e + 1]; v[q][e] = second ? (v[q][e] * c_ + pr[q][e] * s_) : (v[q][e] * c_ - pr[q][e] * s_); } }
}
__device__ __forceinline__ void phase_even_post(Frame& F, const PArgs& A, int j) {
    constexpr int R = 2;
    const int gw = F.vcu * NWAVES + F.wave, NGW = F.G * NWAVES, lane = F.lane;
    const bf16* RAW = (const bf16*)(F.ws + WS_RAW);
    bf16 *QG = (bf16*)(F.ws + WS_QG), *KG = (bf16*)(F.ws + WS_KG), *VG = (bf16*)(F.ws + WS_VG), *CQN = (bf16*)(F.ws + WS_CQN), *CKVN = (bf16*)(F.ws + WS_CKVN), *KM = (bf16*)(F.ws + WS_KM);
    const float* ropeA = (const float*)(F.ws + WS_SMALL + SM_ROPEA); const float* ropeB = (const float*)(F.ws + WS_SMALL + SM_ROPEB);
    float gq[8], gk[8], gcq[8], gckv[8];
    ld8(A.in[I_QNG] + j * 64 + 8 * (lane & 7), gq); ld8(A.in[I_KNG] + j * 64 + 8 * (lane & 7), gk); ld8(A.in[I_CQG] + j * 384 + 8 * (lane < 48 ? lane : 0), gcq); ld8(A.in[I_CKVG] + j * 256 + 8 * (lane & 31), gckv);
    constexpr int NR = (MROWS + R - 1) / R;
    for (int g = gw; g < NR; g += NGW) {
        const bf16* r[R]; bool lat[R]; int trow[R], tcol[R], m[R];
#pragma unroll
        for (int q = 0; q < R; ++q) { m[q] = R * g + q; r[q] = RAW + (size_t)m[q] * EV_INP; lat[q] = m[q] < MLAT; const int t = m[q] & (SEQ - 1); trow[q] = t >> 6; tcol[q] = t & 63; }
        float v[R][8], w[R][8];
#pragma unroll
        for (int q = 0; q < R; ++q) ld8(r[q] + 8 * lane, v[q]);
        head_norm_rope<R>(v, gq, lane & 7, lat, trow, tcol, ropeA, lane);
#pragma unroll
        for (int q = 0; q < R; ++q) *(GAS v4u*)(QG + (size_t)m[q] * 512 + 8 * lane) = pk8(v[q], C2_64);
        { const int l = lane & 31;
#pragma unroll
          for (int q = 0; q < R; ++q) { ld8(r[q] + 512 + 8 * l, v[q]);
#pragma unroll
              for (int e = 0; e < 8; ++e) w[q][e] = v[q][e]; }
          head_norm_rope<R>(w, gk, l & 7, lat, trow, tcol, ropeA, lane);
#pragma unroll
          for (int q = 0; q < R; ++q) { if (lane < 16) *(GAS v4u*)(KG + (size_t)m[q] * 128 + 8 * lane) = pk8(w[q], 1.f);
              else if (lane < 32) *(GAS v4u*)(VG + (size_t)m[q] * 128 + 8 * (lane - 16)) = pk8(v[q], 1.f); } }
        { const bool on1 = lane < 48, on2 = lane < 32; float s1[R], s2[R];
#pragma unroll
          for (int q = 0; q < R; ++q) { ld8(r[q] + 768 + 8 * (on1 ? lane : 0), v[q]); ld8(r[q] + 1152 + 8 * (lane & 31), w[q]); s1[q] = 0.f; s2[q] = 0.f;
#pragma unroll
              for (int e = 0; e < 8; ++e) { s1[q] += on1 ? v[q][e] * v[q][e] : 0.f; s2[q] += on2 ? w[q][e] * w[q][e] : 0.f; } }
#pragma unroll
          for (int o = 1; o < 64; o <<= 1) {
#pragma unroll
              for (int q = 0; q < R; ++q) { s1[q] += shx(s1[q], o, lane); s2[q] += shx(s2[q], o, lane); } }
#pragma unroll
          for (int q = 0; q < R; ++q) { const float rs1 = __builtin_amdgcn_rsqf(s1[q] * (1.f / 384.f) + 1e-6f), rs2 = __builtin_amdgcn_rsqf(s2[q] * (1.f / 256.f) + 1e-6f);
#pragma unroll
              for (int e = 0; e < 8; ++e) { v[q][e] = v[q][e] * rs1 * gcq[e]; w[q][e] = w[q][e] * rs2 * gckv[e]; }
              if (on1) *(GAS v4u*)(CQN + (size_t)m[q] * 384 + 8 * lane) = pk8(v[q], 1.f);
              if (on2) *(GAS v4u*)(CKVN + (size_t)m[q] * 256 + 8 * lane) = pk8(w[q], 1.f); } }
        { const int l4 = lane & 3;
#pragma unroll
          for (int q = 0; q < R; ++q) ld8(r[q] + 1408 + 8 * l4, v[q]);
#pragma unroll
          for (int q = 0; q < R; ++q)
#pragma unroll
              for (int e = 0; e < 8; ++e) w[q][e] = shx(v[q][e], 1, lane);
#pragma unroll
          for (int q = 0; q < R; ++q) { if (lat[q]) { const int axis = l4 >> 1, pos = axis ? tcol[q] : trow[q]; const float* cs = ropeB + pos * 16; const bool second = (l4 & 1) != 0;
                  float cc[16];
#pragma unroll
                  for (int k = 0; k < 4; ++k) { const f32x4 c4 = *((const GAS f32x4*)cs + k); cc[4 * k] = c4.x; cc[4 * k + 1] = c4.y; cc[4 * k + 2] = c4.z; cc[4 * k + 3] = c4.w; }
#pragma unroll
                  for (int e = 0; e < 8; ++e) { const float c_ = cc[2 * e], s_ = cc[2 * e + 1]; v[q][e] = second ? (v[q][e] * c_ + w[q][e] * s_) : (v[q][e] * c_ - w[q][e] * s_); } }
              if (lane < 32) { const int head = lane >> 2; *(GAS v4u*)(KM + (size_t)m[q] * 768 + head * 96 + 64 + 8 * l4) = pk8(v[q], 1.f); } } }
    }
}
__device__ __forceinline__ void phase_even_attn(Frame& F) {
    const bf16 *QG = (const bf16*)(F.ws + WS_QG), *KG = (const bf16*)(F.ws + WS_KG), *VG = (const bf16*)(F.ws + WS_VG);
    const bf16 *QM = (const bf16*)(F.ws + WS_QM), *KM = (const bf16*)(F.ws + WS_KM), *VM = (const bf16*)(F.ws + WS_VM); bf16* OE = (bf16*)(F.ws + WS_OE);
    for (int u = F.vcu; u < 1024 + 32; u += F.G) {
        if (u < 1024) {
            const int qb = u & 31, hq = (u >> 5) & 3, kvh = (u >> 7) & 1, b = u >> 8, h = kvh * 4 + hq; const size_t r0 = (size_t)b * SEQ + qb * 256, kl = (size_t)b * SEQ, kc = (size_t)MLAT + b * CTXL;
            attn_unit_p<64>(F.lds, F.tid, QG + r0 * 512 + h * 64, 512, KG + kl * 128 + kvh * 64, VG + kl * 128 + kvh * 64, 128, KG + kc * 128 + kvh * 64, VG + kc * 128 + kvh * 64, 4, 128, 128,
                             OE + r0 * 1024 + h * 64, 1024);
        } else { const int id = u - 1024, h = id & 7, b = id >> 3, kvh = h >> 2; const size_t kc = (size_t)MLAT + b * CTXL;
            attn_unit_p<64>(F.lds, F.tid, QG + kc * 512 + h * 64, 512, nullptr, nullptr, 0, KG + kc * 128 + kvh * 64, VG + kc * 128 + kvh * 64, 4, 128, 128, OE + kc * 1024 + h * 64, 1024); }
    }
    for (int u = F.vcu; u < 1024 + 32; u += F.G) {
        if (u < 1024) {
            const int qb = u & 31, h = (u >> 5) & 7, b = u >> 8; const size_t r0 = (size_t)b * SEQ + qb * 256, kl = (size_t)b * SEQ, kc = (size_t)MLAT + b * CTXL;
            attn_unit_p<96>(F.lds, F.tid, QM + r0 * 768 + h * 96, 768, KM + kl * 768 + h * 96, VM + kl * 512 + h * 64, 128, KM + kc * 768 + h * 96, VM + kc * 512 + h * 64, 4, 768, 512,
                             OE + r0 * 1024 + 512 + h * 64, 1024);
        } else { const int id = u - 1024, h = id & 7, b = id >> 3; const size_t kc = (size_t)MLAT + b * CTXL;
            attn_unit_p<96>(F.lds, F.tid, QM + kc * 768 + h * 96, 768, nullptr, nullptr, 0, KM + kc * 768 + h * 96, VM + kc * 512 + h * 64, 4, 768, 512, OE + kc * 1024 + 512 + h * 64, 1024); }
    }
}
__device__ __forceinline__ void phase_odd_mix(Frame& F, const PArgs& A, const HgT& T, int j) {
    const bf16 *QN = (const bf16*)(F.ws + WS_QN), *KN = (const bf16*)(F.ws + WS_KN), *VN = (const bf16*)(F.ws + WS_VN); bf16* OO = (bf16*)(F.ws + WS_OO);
    const float* rpb = A.in[I_RPB] + (size_t)j * 8 * 15 * 31;
#ifndef NO_NA
#if defined(NA_TWICE)
    for (int rep = 0; rep < 2; ++rep)
#endif
    for (int u = F.vcu; u < 1024; u += F.G) {
        const int rg = u & 31, h = (u >> 5) & 7, b = u >> 8; const int rlo = min(max(4 * rg - 4, 0), 120), rhi = min(max(4 * rg + 3 - 4, 0), 120) + 8;
        const size_t r0 = (size_t)b * SEQ + (size_t)rg * 256, kl = (size_t)b * SEQ + (size_t)rlo * 64, kc = (size_t)MLAT + b * CTXL;
        attn_unit<64, 1>(F.lds, F.tid, QN + r0 * 512 + h * 64, 512, KN + kl * 512 + h * 64, VN + kl * 512 + h * 64, rhi - rlo, KN + kc * 512 + h * 64, VN + kc * 512 + h * 64, 4, 512, 512,
                         OO + r0 * 1024 + h * 64, 1024, 4 * rg, rlo, rpb + h * 465);
    }
#endif
    for (int u = F.vcu; u < (j == 1 ? 0 : 32); u += F.G) {
        const int h = u & 7, b = u >> 3; const size_t kc = (size_t)MLAT + b * CTXL;
        attn_unit<64, 0>(F.lds, F.tid, QN + kc * 512 + h * 64, 512, nullptr, nullptr, 0, KN + kc * 512 + h * 64, VN + kc * 512 + h * 64, 4, 512, 512, OO + kc * 1024 + h * 64, 1024, 0, 0, nullptr);
    }
#ifndef NO_HA
    phase_hg_a(F, T);
#if defined(HA_TWICE)
    phase_hg_a(F, T);
#endif
#endif
}
__device__ __forceinline__ void ctx_resid_gemm(Frame& F, const bf16* A  , const bf16* Bt  , int K, bf16* Z, const float* gate, const void* base, bool src16  ) {
    const int tid = F.tid, lane = F.lane, r32 = lane & 31, hi = lane >> 5, wid = F.wave;
    LAS float* part = (LAS float*)F.lds;
    for (int u = F.vcu; u < 256; u += F.G) {
        const int tm = u >> 4, tn = u & 15;
        const int ks = K / 8, k0 = wid * ks;
        const bf16* a0 = A + (size_t)(MLAT + 64 * tm + r32) * K + k0 + 8 * hi; const bf16* b0 = Bt + (size_t)(64 * tn + r32) * K + k0 + 8 * hi;
        f32x16 c00, c01, c10, c11;
#pragma unroll
        for (int r = 0; r < 16; ++r) { c00[r] = 0.f; c01[r] = 0.f; c10[r] = 0.f; c11[r] = 0.f; }
#pragma unroll 2
        for (int k = 0; k < ks; k += 16) {
            const bf16x8 fa0 = *(const GAS bf16x8*)(a0 + k), fa1 = *(const GAS bf16x8*)(a0 + (size_t)32 * K + k), fb0 = *(const GAS bf16x8*)(b0 + k), fb1 = *(const GAS bf16x8*)(b0 + (size_t)32 * K + k);
            c00 = __builtin_amdgcn_mfma_f32_32x32x16_bf16(fa0, fb0, c00, 0, 0, 0); c01 = __builtin_amdgcn_mfma_f32_32x32x16_bf16(fa0, fb1, c01, 0, 0, 0);
            c10 = __builtin_amdgcn_mfma_f32_32x32x16_bf16(fa1, fb0, c10, 0, 0, 0); c11 = __builtin_amdgcn_mfma_f32_32x32x16_bf16(fa1, fb1, c11, 0, 0, 0);
        }
        LAS float* pw = part + wid * (64 * 65);
#pragma unroll
        for (int r = 0; r < 16; ++r) { const int i = crow(r, hi); pw[i * 65 + r32] = c00[r]; pw[i * 65 + 32 + r32] = c01[r]; pw[(32 + i) * 65 + r32] = c10[r]; pw[(32 + i) * 65 + 32 + r32] = c11[r]; }
        __syncthreads();
        for (int e = tid; e < 64 * 64; e += NTHR) { const int i = e >> 6, jc = e & 63; float s = 0.f;
#pragma unroll
            for (int w = 0; w < 8; ++w) s += part[w * (64 * 65) + i * 65 + jc];
            const size_t xo = (size_t)(MLAT + 64 * tm + i) * 1024 + 64 * tn + jc; const int col = 64 * tn + jc;
            const size_t bo = (size_t)(64 * tm + i) * 1024 + col;
            const float xb = src16 ? (float)__builtin_bit_cast(_Float16, ((const bf16*)base)[bo]) : ((const float*)base)[bo];
            Z[xo] = (bf16)(pkh(ALPHA * xb + gate[4 * 6144 + col] * s, 0.f) & 0xffffu); }
        __syncthreads();
    }
}
__device__ __forceinline__ void moe_offsets(const gu32* cnt, int (&off)[9]) {
    int a = 0;
#pragma unroll
    for (int e = 0; e < 8; ++e) { off[e] = a; const int c = __builtin_amdgcn_readfirstlane((int)__hip_atomic_load(cnt + e, __ATOMIC_RELAXED, __HIP_MEMORY_SCOPE_AGENT)); a += (c + 255) & ~255; }
    off[8] = a;
}
__device__ __forceinline__ void phase_moe_dispatch(Frame& F, int j, int nrows) {
    int* topk = (int*)(F.ws + WS_TOPK); const bf16* H = (const bf16*)(F.ws + WS_H); unsigned char* XG8 = F.ws + WS_XG8;
    LAS unsigned* lc = (LAS unsigned*)F.lds;
    LAS int* lrow = (LAS int*)(F.lds + 256);
    int off[9]; moe_offsets(F.ctl + CW_CNT + 64 * j, off);
    const int per = nrows / 256;
    for (int c0 = F.vcu * per; c0 < nrows; c0 += F.G * per) {
        if (F.tid < 8) lc[F.tid] = 0u;
        __syncthreads();
        int e1 = 0, e2 = 0, li1 = 0, li2 = 0; const bool on = F.tid < per;
        if (on) { e1 = topk[(c0 + F.tid) * 6]; e2 = topk[(c0 + F.tid) * 6 + 1]; li1 = (int)atomicAdd((unsigned*)&lc[e1], 1u); li2 = (int)atomicAdd((unsigned*)&lc[e2], 1u); }
        __syncthreads();
        if (F.tid < 8) lc[8 + F.tid] = __hip_atomic_fetch_add((unsigned*)(F.ctl + CW_CNT2 + 64 * j) + F.tid, lc[F.tid], __ATOMIC_RELAXED, __HIP_MEMORY_SCOPE_AGENT);
        __syncthreads();
        if (on) {
            int o1 = 0, o2 = 0;
#pragma unroll
            for (int e = 0; e < 8; ++e) { o1 = (e == e1) ? off[e] : o1; o2 = (e == e2) ? off[e] : o2; }
            const int r1 = o1 + (int)lc[8 + e1] + li1, r2 = o2 + (int)lc[8 + e2] + li2;
            topk[(c0 + F.tid) * 6 + 4] = r1; topk[(c0 + F.tid) * 6 + 5] = r2; lrow[2 * F.tid] = r1; lrow[2 * F.tid + 1] = r2;
        }
        __syncthreads();
        for (int p = F.wave; p < 2 * per; p += NWAVES) { const int tok = c0 + (p >> 1), dst = lrow[p];
            const v4u a = *((const GAS v4u*)((const unsigned char*)H + (size_t)tok * 1024) + F.lane);
            *((GAS v4u*)((unsigned char*)XG8 + (size_t)dst * 1024) + F.lane) = a; }
        __syncthreads();
    }
}
#if defined(SELFCHK)
constexpr int CW_CHK = 12288;
__device__ __forceinline__ int chk_row(int s) {
    if (s >= 48) return MLAT + ((s - 48) * 61) % MCTX;
    const int b = s & 3; int t = (s * 683 + 17 * (s >> 2) * 97) & (SEQ - 1);
    if (s < 4) t = 0; else if (s < 8) t = SEQ - 1; else if (s < 12) t = 63; else if (s < 16) t = 64;
    return b * SEQ + t;
}
__device__ __forceinline__ void chk_accum(Frame& F, float num, float den) {
    LAS float* red = (LAS float*)(F.lds + 150000);
    __syncthreads();
    num = wave_sum(num, F.lane); den = wave_sum(den, F.lane);
    if (F.lane == 0) { red[F.wave * 2] = num; red[F.wave * 2 + 1] = den; }
    __syncthreads();
    if (F.tid == 0) { float a = 0.f, b = 0.f; for (int w = 0; w < 8; ++w) { a += red[2 * w]; b += red[2 * w + 1]; }
        atomicAdd((float*)(F.ctl + CW_CHK), a); atomicAdd((float*)(F.ctl + CW_CHK) + 1, b); }
    __syncthreads();
}
__device__ __forceinline__ float chk_rope(const LAS float* x, int d, int rot_dim, int t) {
    const int axis_dim = rot_dim / 2, half = axis_dim / 2, axis = d / axis_dim, i = d % axis_dim;
    const float pos = (float)(axis == 0 ? t / GRIDW : t % GRIDW);
    const float inv = powf(10000.f, -(float)(2 * (i % half)) / (float)axis_dim);
    const float ang = pos * inv; float sn, cs; sincos_red(ang, sn, cs);
    const float rot = (i < half) ? -x[axis * axis_dim + i + half] : x[axis * axis_dim + i - half];
    return x[d] * cs + rot * sn;
}
__device__ __forceinline__ void phase_selfcheck_even(Frame& F, const PArgs& A, int j) {
    const bf16* H = (const bf16*)(F.ws + WS_H);
    const bf16 *QG = (const bf16*)(F.ws + WS_QG), *KG = (const bf16*)(F.ws + WS_KG), *VG = (const bf16*)(F.ws + WS_VG), *CQN = (const bf16*)(F.ws + WS_CQN), *CKVN = (const bf16*)(F.ws + WS_CKVN);
    const bf16 *QM = (const bf16*)(F.ws + WS_QM), *KM = (const bf16*)(F.ws + WS_KM), *VM = (const bf16*)(F.ws + WS_VM), *OE = (const bf16*)(F.ws + WS_OE);
    LAS float* raw = (LAS float*)F.lds;
    LAS float* xn = (LAS float*)(F.lds + 8192);
    LAS float* sc = (LAS float*)(F.lds + 16384);
    LAS float* red = (LAS float*)(F.lds + 65536);
    const int tid = F.tid;
#if SELFCHK >= 5
#elif SELFCHK == 1 || SELFCHK == 2
    for (int s = F.vcu; s < 64; s += F.G) {
        const int row = chk_row(s); const bool lat = row < MLAT; const int t = row & (SEQ - 1);
        float num = 0.f, den = 0.f;
#if SELFCHK == 1
        const float* W = A.in[I_EVWIN] + (size_t)j * 1024 * EV_IN;
        for (int c = tid; c < EV_IN; c += NTHR) { float a = 0.f; for (int k = 0; k < 1024; ++k) a += bf2f(H[(size_t)row * 1024 + k]) * W[(size_t)k * EV_IN + c]; raw[c] = a; }
        __syncthreads();
        for (int c = tid; c < 640; c += NTHR) { const int hb = (c / 64) * 64, d = c % 64; float ss = 0.f; for (int k = 0; k < 64; ++k) ss += raw[hb + k] * raw[hb + k];
            const float g = (c < 512) ? A.in[I_QNG][j * 64 + d] : A.in[I_KNG][j * 64 + d]; xn[c] = raw[c] * (1.f / sqrtf(ss / 64.f + 1e-6f)) * g; }
        __syncthreads();
        for (int c = tid; c < 640; c += NTHR) { const int hb = (c / 64) * 64, d = c % 64; const float ref = lat ? chk_rope(xn + hb, d, 64, t) : xn[c];
            const float got = (c < 512) ? bf2f(QG[(size_t)row * 512 + c]) / C2_64 : bf2f(KG[(size_t)row * 128 + (c - 512)]); num += (got - ref) * (got - ref); den += ref * ref; }
        for (int c = tid; c < 128; c += NTHR) { const float ref = raw[640 + c], got = bf2f(VG[(size_t)row * 128 + c]); num += (got - ref) * (got - ref); den += ref * ref; }
        { float ss = 0.f; for (int k = 0; k < 384; ++k) ss += raw[768 + k] * raw[768 + k]; const float rs = 1.f / sqrtf(ss / 384.f + 1e-6f);
          for (int c = tid; c < 384; c += NTHR) { const float ref = raw[768 + c] * rs * A.in[I_CQG][j * 384 + c], got = bf2f(CQN[(size_t)row * 384 + c]); num += (got - ref) * (got - ref); den += ref * ref; } }
        { float ss = 0.f; for (int k = 0; k < 256; ++k) ss += raw[1152 + k] * raw[1152 + k]; const float rs = 1.f / sqrtf(ss / 256.f + 1e-6f);
          for (int c = tid; c < 256; c += NTHR) { const float ref = raw[1152 + c] * rs * A.in[I_CKVG][j * 256 + c], got = bf2f(CKVN[(size_t)row * 256 + c]); num += (got - ref) * (got - ref); den += ref * ref; } }
        for (int c = tid; c < 256; c += NTHR) { const int head = c / 32, d = c % 32; const float ref = lat ? chk_rope(raw + 1408, d, 32, t) : raw[1408 + d];
            const float got = bf2f(KM[(size_t)row * 768 + head * 96 + 64 + d]); num += (got - ref) * (got - ref); den += ref * ref; }
#else
        const float* Wq = A.in[I_WUQ] + (size_t)j * 384 * 768; const float* Wkv = A.in[I_WUKV] + (size_t)j * 256 * 1024;
        for (int c = tid; c < 768; c += NTHR) { float a = 0.f; for (int k = 0; k < 384; ++k) a += bf2f(CQN[(size_t)row * 384 + k]) * Wq[(size_t)k * 768 + c]; raw[c] = a; }
        __syncthreads();
        for (int c = tid; c < 768; c += NTHR) { const int head = c / 96, d = c % 96; const float ref = (d >= 64 && lat) ? chk_rope(raw + head * 96 + 64, d - 64, 32, t) : raw[c];
            const float got = bf2f(QM[(size_t)row * 768 + c]) / C2_96; num += (got - ref) * (got - ref); den += ref * ref; }
        for (int c = tid; c < 1024; c += NTHR) { float a = 0.f; for (int k = 0; k < 256; ++k) a += bf2f(CKVN[(size_t)row * 256 + k]) * Wkv[(size_t)k * 1024 + c];
            const int head = c / 128, d = c % 128; const float got = (d < 64) ? bf2f(KM[(size_t)row * 768 + head * 96 + d]) : bf2f(VM[(size_t)row * 512 + head * 64 + (d - 64)]); num += (got - a) * (got - a); den += a * a; }
#endif
        chk_accum(F, num, den);
    }
#elif SELFCHK == 3 || SELFCHK == 4
    for (int u = F.vcu; u < 64 * 8; u += F.G) {
        const int s = u >> 3, h = u & 7; const int row = chk_row(s); const bool lat = row < MLAT; const int b = lat ? row / SEQ : (row - MLAT) / CTXL;
        const int nk = lat ? SEQ + CTXL : CTXL;
#if SELFCHK == 3
        constexpr int DKK = 64; const bf16* qp = QG + (size_t)row * 512 + h * 64; const int kvh = h / 4;
#define CHK_K(key) (KG + (size_t)(key) * 128 + kvh * 64)
#define CHK_V(key) (VG + (size_t)(key) * 128 + kvh * 64)
        const bf16* op = OE + (size_t)row * 1024 + h * 64;
#else
        constexpr int DKK = 96; const bf16* qp = QM + (size_t)row * 768 + h * 96;
#define CHK_K(key) (KM + (size_t)(key) * 768 + h * 96)
#define CHK_V(key) (VM + (size_t)(key) * 512 + h * 64)
        const bf16* op = OE + (size_t)row * 1024 + 512 + h * 64;
#endif
        float mx = -INFINITY;
        for (int kk = tid; kk < nk; kk += NTHR) { const int key = lat ? (kk < SEQ ? b * SEQ + kk : MLAT + b * CTXL + (kk - SEQ)) : MLAT + b * CTXL + kk;
            float a = 0.f; for (int d = 0; d < DKK; ++d) a += bf2f(qp[d]) * bf2f(CHK_K(key)[d]); sc[kk] = a; mx = fmaxf(mx, a); }
#pragma unroll
        for (int o = 1; o < 64; o <<= 1) mx = fmaxf(mx, shx(mx, o, F.lane));
        if (F.lane == 0) red[F.wave] = mx;
        __syncthreads();
        mx = red[0]; for (int w = 1; w < 8; ++w) mx = fmaxf(mx, red[w]);
        float ls = 0.f;
        for (int kk = tid; kk < nk; kk += NTHR) { const float p = exp2f(sc[kk] - mx); sc[kk] = p; ls += p; }
        ls = wave_sum(ls, F.lane);
        __syncthreads();
        if (F.lane == 0) red[8 + F.wave] = ls;
        __syncthreads();
        ls = 0.f; for (int w = 0; w < 8; ++w) ls += red[8 + w];
        { const int d = tid & 63, part = tid >> 6; float a = 0.f;
          for (int kk = part; kk < nk; kk += 8) { const int key = lat ? (kk < SEQ ? b * SEQ + kk : MLAT + b * CTXL + (kk - SEQ)) : MLAT + b * CTXL + kk; a += sc[kk] * bf2f(CHK_V(key)[d]); }
          red[64 + part * 64 + d] = a; }
        __syncthreads();
        float num = 0.f, den = 0.f;
        if (tid < 64) { float a = 0.f; for (int p = 0; p < 8; ++p) a += red[64 + p * 64 + tid]; const float ref = a / ls, got = bf2f(op[tid]); num = (got - ref) * (got - ref); den = ref * ref; }
        chk_accum(F, num, den);
#undef CHK_K
#undef CHK_V
    }
#endif
}
#endif

#if defined(SELFCHK) && (SELFCHK == 5 || SELFCHK == 6 || SELFCHK == 7)
__device__ __forceinline__ void phase_selfcheck_na(Frame& F, const PArgs& A, int j) {
    const bf16 *QN = (const bf16*)(F.ws + WS_QN), *KN = (const bf16*)(F.ws + WS_KN), *VN = (const bf16*)(F.ws + WS_VN), *OO = (const bf16*)(F.ws + WS_OO);
    LAS float* sc = (LAS float*)(F.lds + 16384); LAS float* red = (LAS float*)(F.lds + 65536); LAS int* kid = (LAS int*)(F.lds + 32768);
    const int tid = F.tid;
    for (int u = F.vcu; u < 64 * 8; u += F.G) {
        const int s = u >> 3, h = u & 7; const int row = chk_row(s); const bool lat = row < MLAT; const int b = lat ? row / SEQ : (row - MLAT) / CTXL;
        if (!lat && j == 1) continue;
        const bf16* qp = QN + (size_t)row * 512 + h * 64; const float* rpb = A.in[I_RPB] + ((size_t)j * 8 + h) * 15 * 31;
        int nk = CTXL;
        if (lat) { nk = 128 + CTXL; const int t = row % SEQ, r = t / GRIDW, cc = t % GRIDW;
            const int rs = min(max(r - 4, 0), 128 - 8), cs = min(max(cc - 8, 0), GRIDW - 16);
            for (int w = tid; w < 128; w += NTHR) { const int i = w / 16, jj = w % 16; const int kr = rs + i, kc = cs + jj; kid[w] = b * SEQ + kr * GRIDW + kc;
                sc[1024 + w] = rpb[(kr - r + 7) * 31 + (kc - cc + 15)] * LOG2E; }
            for (int w = tid; w < CTXL; w += NTHR) { kid[128 + w] = MLAT + b * CTXL + w; sc[1024 + 128 + w] = 0.f; }
        } else { for (int w = tid; w < CTXL; w += NTHR) { kid[w] = MLAT + b * CTXL + w; sc[1024 + w] = 0.f; } }
        __syncthreads();
        float mx = -INFINITY;
        for (int kk = tid; kk < nk; kk += NTHR) { const bf16* kp = KN + (size_t)kid[kk] * 512 + h * 64; float a = 0.f; for (int d = 0; d < 64; ++d) a += bf2f(qp[d]) * bf2f(kp[d]); a += sc[1024 + kk]; sc[kk] = a; mx = fmaxf(mx, a); }
#pragma unroll
        for (int o = 1; o < 64; o <<= 1) mx = fmaxf(mx, shx(mx, o, F.lane));
        if (F.lane == 0) red[F.wave] = mx;
        __syncthreads();
        mx = red[0]; for (int w = 1; w < 8; ++w) mx = fmaxf(mx, red[w]);
        float ls = 0.f;
        for (int kk = tid; kk < nk; kk += NTHR) { const float p = exp2f(sc[kk] - mx); sc[kk] = p; ls += p; }
        ls = wave_sum(ls, F.lane);
        __syncthreads();
        if (F.lane == 0) red[8 + F.wave] = ls;
        __syncthreads();
        ls = 0.f; for (int w = 0; w < 8; ++w) ls += red[8 + w];
        { const int d = tid & 63, part = tid >> 6; float a = 0.f;
          for (int kk = part; kk < nk; kk += 8) a += sc[kk] * bf2f(VN[(size_t)kid[kk] * 512 + h * 64 + d]);
          red[64 + part * 64 + d] = a; }
        __syncthreads();
        float num = 0.f, den = 0.f;
        if (tid < 64) { float a = 0.f; for (int p = 0; p < 8; ++p) a += red[64 + p * 64 + tid]; const float ref = a / ls, got = bf2f(OO[(size_t)row * 1024 + h * 64 + tid]); num = (got - ref) * (got - ref); den = ref * ref; }
        chk_accum(F, num, den);
    }
}
constexpr size_t WS_CHKO = WS_END;
__device__ __forceinline__ int chk_seq_row(int b, int dir, int sq) { if (sq < CTXL) return MLAT + b * CTXL + (dir ? CTXL - 1 - sq : sq); const int jq = sq - CTXL; return b * SEQ + (dir ? SEQ - 1 - jq : jq); }
__device__ __forceinline__ void phase_selfcheck_hg_scan(Frame& F, const PArgs& A, int j) {
    if (F.vcu >= 4) return;
    const int c = F.vcu, dir = c & 1, pair = c >> 1; const int b = pair ? 3 : 1, h = pair ? 0 : 2, hoff = h * 128;
    const bf16 *Qd = (const bf16*)(F.ws + WS_QD), *Vd = (const bf16*)(F.ws + WS_VD); const float* Z = (const float*)(F.ws + (dir ? WS_ZB : WS_ZF));
    float* OF = (float*)(F.ws + WS_CHKO) + (size_t)c * 8448 * 128;
    LAS float* vec = (LAS float*)F.lds;
    LAS float* part = (LAS float*)(F.lds + 4096);
    const int tid = F.tid, f = tid & 127, eq = tid >> 7;
    float S[32];
#pragma unroll
    for (int i = 0; i < 32; ++i) S[i] = 0.f;
    for (int sq = 0; sq < CTXL + SEQ; ++sq) {
        const int row = chk_seq_row(b, dir, sq);
        if (tid < 128) { const int ch = hoff + tid; const float l0 = A.in[I_LBL][(dir * 2 + 0) * 512 + ch], l1 = A.in[I_LBL][(dir * 2 + 1) * 512 + ch];
            const float m = fmaxf(l0, l1), p0 = expf(l0 - m) / (expf(l0 - m) + expf(l1 - m)), p1 = expf(l1 - m) / (expf(l0 - m) + expf(l1 - m)); const float lb = (j == 0) ? 0.f : (p0 + p1) - p0;
            const float z = Z[(size_t)row * 512 + ch]; const float sg = 1.f / (1.f + expf(-z));
            vec[tid] = bf2f(Qd[(size_t)row * 512 + ch]); vec[128 + tid] = (1.f - lb) * (1.f / (1.f + expf(z))); vec[256 + tid] = bf2f(Vd[(size_t)row * 512 + ch]); vec[384 + tid] = lb + (1.f - lb) * sg; }
        __syncthreads();
        float o = 0.f; const float vf = vec[256 + f];
#pragma unroll
        for (int i = 0; i < 32; ++i) { const int e = eq * 32 + i; S[i] = vec[384 + e] * S[i] + vec[128 + e] * vf; o += S[i] * vec[e]; }
        part[eq * 128 + f] = o;
        __syncthreads();
        if (tid < 128) OF[(size_t)sq * 128 + tid] = part[tid] + part[128 + tid] + part[256 + tid] + part[384 + tid];
    }
}
__device__ __forceinline__ void phase_selfcheck_hg_cmp(Frame& F, const PArgs& A, int j) {
    const bf16 *Sg = (const bf16*)(F.ws + WS_SG), *OO = (const bf16*)(F.ws + WS_OO); const float* OF = (const float*)(F.ws + WS_CHKO);
    const int gw = F.vcu * NWAVES + F.wave, NGW = F.G * NWAVES;
    float num = 0.f, den = 0.f;
    for (int it = gw; it < 2 * 8448; it += NGW) { const int pair = it / 8448, sq = it % 8448; const int b = pair ? 3 : 1, h = pair ? 0 : 2, hoff = h * 128;
        const int row = chk_seq_row(b, 0, sq);
        const int sqb = (sq < CTXL) ? (CTXL - 1 - sq) : (CTXL + (SEQ - 1 - (sq - CTXL)));
        const float* of = OF + ((size_t)(pair * 2 + 0) * 8448 + sq) * 128; const float* ob = OF + ((size_t)(pair * 2 + 1) * 8448 + sqb) * 128;
        const float* D0 = (const float*)(F.ws + 1002 * MiB) + ((size_t)(0 * 2 + pair) * 8448 + sq) * 128; const float* D1 = (const float*)(F.ws + 1002 * MiB) + ((size_t)(1 * 2 + pair) * 8448 + sq) * 128;
#ifndef CHKSEL
#define CHKSEL 0
#endif
        (void)row; (void)Sg; (void)OO;
#pragma unroll
        for (int q2 = 0; q2 < 2; ++q2) { const int ff = F.lane + 64 * q2;
            const float ref = (CHKSEL != 1) ? of[ff] : ob[ff]; const float got = (CHKSEL != 1) ? D0[ff] : (D1[ff] - D0[ff]);
            const bool use = (CHKSEL == 10) ? (sq < 64) : (CHKSEL == 11) ? (sq >= 64 && sq < 128) : (CHKSEL == 12) ? (sq >= 128 && sq < 256) : (CHKSEL == 13) ? (sq >= 256 && ((sq & 127) < 64)) : (CHKSEL == 14) ? (sq >= 256 && ((sq & 127) >= 64)) : true;
            if (use && (j == 0 || sq >= CTXL)) { num += (got - ref) * (got - ref); den += ref * ref; } } }
    chk_accum(F, num, den);
}
#endif
constexpr int PH_CV = 0, PH_MOD = 1, PH_E1 = 2, PH_E2 = 3, PH_E3 = 4, PH_E5 = 5, PH_E6 = 6, PH_E7 = 7, PH_E8 = 8, PH_E9 = 9, PH_E10 = 10,
              PH_O1 = 11, PH_O2 = 12, PH_O3 = 13, PH_O4 = 14, PH_O5 = 15, PH_O6 = 16, PH_O7 = 17, PH_O8 = 18, PH_O9 = 19, PH_O10 = 20, PH_PER = 21;
constexpr int NPHASES = 2 * PH_PER;

__global__ void __launch_bounds__(NTHR, 2) mk_fwd(Args args) {
    extern __shared__ __attribute__((aligned(16))) unsigned char lds[];
    Frame F;
    F.lds = (LAS unsigned char*)lds; F.ws = args.ws; F.ctl = (gu32*)(args.ws + WS_CTL);
    F.tid = threadIdx.x; F.lane = F.tid & 63; F.wave = __builtin_amdgcn_readfirstlane(F.tid >> 6);
    F.G = gridDim.x; { const int bx = blockIdx.x; F.vcu = (F.G % 8 == 0) ? (bx % 8) * (F.G / 8) + bx / 8 : bx; }
    volatile LAS unsigned* MISC = (volatile LAS unsigned*)(F.lds + MISC_OFF);
    if (F.tid < 64) MISC[F.tid] = 0u;
    { LAS unsigned long long* tab = (LAS unsigned long long*)(F.lds + MISC_OFF + 256);
      if (F.tid == 0) {
#pragma unroll
          for (int i = 0; i < 30; ++i) tab[i] = (unsigned long long)args.in[i];
          tab[30] = (unsigned long long)args.out; } }
    __syncthreads();
    const int lo = args.ph_lo, hi = args.ph_hi; const int wv0 = F.wave;
    const bool multi = (hi - lo) > 1;
    XcdBarrier bar; bar.bar = (unsigned*)(F.ctl + CW_BAR); bar.x = 0; bar.st = nullptr;
    if (multi) bar = xcd_barrier_post((unsigned*)(F.ctl + CW_BAR), MISC + 8);
#ifndef PHMASK
#define PHMASK 0x1fffff
#endif
#define IN(k) ((((PHMASK) >> ((k) % PH_PER)) & 1) && lo <= (k) && (k) < hi)
#if defined(PROBE_PH)
    if (PROBE_PH == 0 && blockIdx.x == 0 && threadIdx.x == 0) MISC[16] = (unsigned)__builtin_amdgcn_s_memrealtime();
#endif
#define MKT HgT T; T.Qd = (const bf16*)(ws + WS_QD); T.Vd = (const bf16*)(ws + WS_VD); T.Sg = (const bf16*)(ws + WS_SG); T.Zf = (const float*)(ws + WS_ZF); T.Zb = (const float*)(ws + WS_ZB); \
    T.lb = (const float*)(ws + WS_SMALL + SM_LB) + j * 1024; T.HST = (float*)(ws + WS_HST); T.HDM = (float*)(ws + WS_HDM); T.ong = PA.in[I_ONG] + j * 128; T.OO = (bf16*)(ws + WS_OO);
#define FRESH() int t_; asm volatile("v_mbcnt_lo_u32_b32 %0, -1, 0\n\tv_mbcnt_hi_u32_b32 %0, -1, %0" : "=v"(t_)); t_ += wv0 * 64; F.tid = t_; F.lane = t_ & 63; F.wave = __builtin_amdgcn_readfirstlane(t_ >> 6); \
    unsigned char* ws = ws0; asm volatile("" : "+s"(ws)); F.ws = ws; F.ctl = (gu32*)(ws + WS_CTL); PArgs PA; PA.in.t = (LAS unsigned long long*)(F.lds + MISC_OFF + 256); PA.out = (float*)PA.in[30]; \
    float* mods = (float*)(ws + WS_SMALL + SM_MODS); bf16* W = (bf16*)(ws + WS_W); bf16* WM = (bf16*)(ws + WS_WMOE); bf16* H = (bf16*)(ws + WS_H); bf16* X = (bf16*)(ws + WS_X); \
    const float* modE = mods + (size_t)Le * 5 * 6144; const float* modO = mods + (size_t)Lo * 5 * 6144; (void)W; (void)WM; (void)H; (void)X; (void)modE; (void)modO;
#if defined(PROBE_PH)
#define IS_T0() ({ int l_; asm volatile("v_mbcnt_lo_u32_b32 %0, -1, 0\n\tv_mbcnt_hi_u32_b32 %0, -1, %0" : "=v"(l_)); (wv0 == 0 && l_ == 0); })
#if defined(PROBE_CLK)
#define PROBE_NOW() ((unsigned)__builtin_amdgcn_s_memtime())
#else
#define PROBE_NOW() ((unsigned)__builtin_amdgcn_s_memrealtime())
#endif
#define PROBE_T0(k) do { if ((k) == PROBE_PH && blockIdx.x == 0 && IS_T0()) { MISC[16] = PROBE_NOW(); } } while (0)
#define PROBE_T1(k) do { if ((k) == PROBE_PH && blockIdx.x == 0 && IS_T0()) { MISC[18] = PROBE_NOW() - MISC[16]; } } while (0)
#else
#define PROBE_T0(k) do {} while (0)
#define PROBE_T1(k) do {} while (0)
#endif
#if defined(PROBE_WALL)
#define SEAM(k) do { if (IN(k) && IN((k) + 1)) xcd_barrier(bar); PROBE_T1(k); PROBE_T0((k) + 1); } while (0)
#else
#define SEAM(k) do { PROBE_T1(k); if (IN(k) && IN((k) + 1)) xcd_barrier(bar); PROBE_T0((k) + 1); } while (0)
#endif
    unsigned char* const ws0 = args.ws;
#pragma unroll 1
    for (int j = 0; j < 2; ++j) {
        const int pb = j * PH_PER, Le = 2 * j, Lo = 2 * j + 1;
        if (j == 0) { if (IN(pb + PH_CV)) { FRESH(); phase_cv(F, PA, 0); } SEAM(pb + PH_CV);
                      if (IN(pb + PH_MOD)) { FRESH(); phase_mod(F, PA); } SEAM(pb + PH_MOD); }
        if (IN(pb + PH_E1)) { FRESH();
            pg8::Gemm g{H, W + W_EVIN + (size_t)j * EV_INP * 1024, MROWS, EV_INP, 1024}; pg8::StaticOrder S; S.init(MROWS, EV_INP, F.G, (int)blockIdx.x);
            pg8::EpiPlainBf16 E{(pg8::bf16_t*)(ws + WS_RAW), EV_INP};
            pg8::gemm_phase<pg8::EpiPlainBf16, pg8::StaticOrder, true, true>(F.lds, g, S, E, F.tid);
        } SEAM(pb + PH_E1);
        if (IN(pb + PH_E2)) { FRESH(); phase_even_post(F, PA, j); } SEAM(pb + PH_E2);
        if (IN(pb + PH_E3)) { FRESH();
            { pg8::Gemm g{(const bf16*)(ws + WS_CQN), W + W_UQ + (size_t)j * 768 * 384, MROWS, 768, 384}; pg8::StaticOrder S; S.init(MROWS, 768, F.G, (int)blockIdx.x);
              pg8::EpiMlaQ E{(bf16*)(ws + WS_QM), (const float*)(ws + WS_SMALL + SM_ROPEB)};
              pg8::gemm_phase<pg8::EpiMlaQ, pg8::StaticOrder, true, true>(F.lds, g, S, E, F.tid); }
            { asm volatile("v_mbcnt_lo_u32_b32 %0, -1, 0\n\tv_mbcnt_hi_u32_b32 %0, -1, %0" : "=v"(t_)); t_ += wv0 * 64; F.tid = t_; F.lane = t_ & 63;
              pg8::Gemm g{(const bf16*)(ws + WS_CKVN), W + W_UKV + (size_t)j * 1024 * 256, MROWS, 1024, 256}; pg8::StaticOrder S; S.init(MROWS, 1024, F.G, (int)blockIdx.x);
              pg8::EpiMlaKV E{(bf16*)(ws + WS_KM), (bf16*)(ws + WS_VM)};
              pg8::gemm_phase<pg8::EpiMlaKV, pg8::StaticOrder, true, true>(F.lds, g, S, E, F.tid); }
        } SEAM(pb + PH_E3);
        if (IN(pb + PH_E5)) { FRESH(); phase_even_attn(F); } SEAM(pb + PH_E5);
#if defined(SELFCHK)
        if (IN(pb + PH_E6)) { FRESH(); phase_selfcheck_even(F, PA, j); }
#endif
        if (IN(pb + PH_E6)) { FRESH();
            { pg8::Gemm g{(const bf16*)(ws + WS_OE), W + W_EVOUT + (size_t)j * 1024 * 1024, MLAT, 1024, 1024}; pg8::StaticOrder S; S.init(MLAT, 1024, F.G, (int)blockIdx.x);
              pg8::EpiResid E{(pg8::bf16_t*)(ws + WS_ZR), modE + 2 * 1024, j == 0 ? (const void*)PA.in[I_X] : (const void*)X, j == 0 ? (const void*)PA.in[I_CTX] : (const void*)(X + (size_t)MLAT * 1024), j != 0};
              pg8::gemm_phase<pg8::EpiResid, pg8::StaticOrder, true, true>(F.lds, g, S, E, F.tid); }
            ctx_resid_gemm(F, (const bf16*)(ws + WS_OE), W + W_EVOUT + (size_t)j * 1024 * 1024, 1024, (bf16*)(ws + WS_ZR), modE + 2 * 1024, j == 0 ? (const void*)PA.in[I_CTX] : (const void*)(X + (size_t)MLAT * 1024), j != 0);
        } SEAM(pb + PH_E6);
        if (IN(pb + PH_E7)) { FRESH(); phase_ln<false, false, FFN_F8>(F, PA, PA.in[I_LN1G] + Le * 1024, PA.in[I_LN1B] + Le * 1024, modE + 3 * 1024, nullptr, nullptr, 0, false); } SEAM(pb + PH_E7);
        if (IN(pb + PH_E8)) { FRESH();
            if constexpr (FFN_F8) {
                pg8::Gemm g{H, (const bf16*)((unsigned char*)(W + W_FFGU) + (size_t)j * 2 * DFF * 1024), MROWS, 2 * DFF, 1024 / 2}; pg8::StaticOrder S; S.init(MROWS, 2 * DFF, F.G, (int)blockIdx.x);
                pg8::EpiSwigluS E{(bf16*)(ws + WS_FFH), DFF, 1.f / MOE_WSCALE, MLAT};
                pg8::gemm_phase<pg8::EpiSwigluS, pg8::StaticOrder, true, true, true>(F.lds, g, S, E, F.tid);
            } else {
                pg8::Gemm g{H, W + W_FFGU + (size_t)j * 2 * DFF * 1024, MROWS, 2 * DFF, 1024}; pg8::StaticOrder S; S.init(MROWS, 2 * DFF, F.G, (int)blockIdx.x);
                pg8::EpiSwiglu E{(bf16*)(ws + WS_FFH), DFF};
                pg8::gemm_phase<pg8::EpiSwiglu, pg8::StaticOrder, true, true>(F.lds, g, S, E, F.tid);
            }
        } SEAM(pb + PH_E8);
        if (IN(pb + PH_E9)) { FRESH();
            { pg8::Gemm g{(const bf16*)(ws + WS_FFH), W + W_FFD + (size_t)j * 1024 * DFF, MLAT, 1024, DFF, FFN_F8};        pg8::StaticOrder S; S.init(MLAT, 1024, F.G, (int)blockIdx.x);
              pg8::EpiResid E{(pg8::bf16_t*)(ws + WS_ZR), modE + 5 * 1024, X, X + (size_t)MLAT * 1024, true};
              pg8::gemm_phase<pg8::EpiResid, pg8::StaticOrder, true, true>(F.lds, g, S, E, F.tid); }
            ctx_resid_gemm(F, (const bf16*)(ws + WS_FFH), W + W_FFD + (size_t)j * 1024 * DFF, DFF, (bf16*)(ws + WS_ZR), modE + 5 * 1024, X + (size_t)MLAT * 1024, true);
        } SEAM(pb + PH_E9);
        if (IN(pb + PH_E10)) { FRESH(); phase_ln<false, false>(F, PA, PA.in[I_LN2G] + Le * 1024, PA.in[I_LN2B] + Le * 1024, modO + 0 * 1024, nullptr, nullptr, 0, false); } SEAM(pb + PH_E10);
        if (IN(pb + PH_O1)) { FRESH();
            pg8::Gemm g{H, W + W_ODIN + (size_t)j * 4096 * 1024, MROWS, 4096, 1024}; pg8::StaticOrder S; S.init(MROWS, 4096, F.G, (int)blockIdx.x);
            pg8::EpiOddIn E{(bf16*)(ws + WS_QN), (bf16*)(ws + WS_KN), (bf16*)(ws + WS_VN), (bf16*)(ws + WS_QD), (bf16*)(ws + WS_VD), (bf16*)(ws + WS_SG), (float*)(ws + WS_ZF), (float*)(ws + WS_ZB)};
            pg8::gemm_phase<pg8::EpiOddIn, pg8::StaticOrder, true, true>(F.lds, g, S, E, F.tid);
        } SEAM(pb + PH_O1);
        if (IN(pb + PH_O2)) { FRESH(); MKT phase_odd_mix(F, PA, T, j); } SEAM(pb + PH_O2);
        if (IN(pb + PH_O3)) { FRESH(); MKT phase_hg_b(F, T); } SEAM(pb + PH_O3);
        if (IN(pb + PH_O4)) { FRESH(); MKT if (j == 1) { for (int u = F.vcu; u < 16 * 64; u += F.G) hg_c_unit(F, T, u >> 8, (u >> 6) & 3, 2 + (u & 63)); }
            else { for (int u = F.vcu; u < 16 * 66; u += F.G) hg_c_unit(F, T, u / 264, (u / 66) & 3, u % 66); } } SEAM(pb + PH_O4);
#if defined(SELFCHK) && SELFCHK == 5
        if (IN(pb + PH_O5)) { FRESH(); phase_selfcheck_na(F, PA, j); }
#endif
#if defined(SELFCHK) && SELFCHK == 6
#ifndef CHKJ
#define CHKJ j
#endif
        if (IN(pb + PH_O5) && j == (CHKJ)) { { FRESH(); phase_selfcheck_hg_scan(F, PA, j); } xcd_barrier(bar); { FRESH(); phase_selfcheck_hg_cmp(F, PA, j); } }
#endif
        if (IN(pb + PH_O5)) { FRESH();
            { pg8::Gemm g{(const bf16*)(ws + WS_OO), W + W_ODOUT + (size_t)j * 1024 * 1024, MLAT, 1024, 1024}; pg8::StaticOrder S; S.init(MLAT, 1024, F.G, (int)blockIdx.x);
              pg8::EpiResid E{(pg8::bf16_t*)(ws + WS_ZR), modO + 2 * 1024, X, X + (size_t)MLAT * 1024, true};
              pg8::gemm_phase<pg8::EpiResid, pg8::StaticOrder, true, true>(F.lds, g, S, E, F.tid); }
            if (j == 0) ctx_resid_gemm(F, (const bf16*)(ws + WS_OO), W + W_ODOUT + (size_t)j * 1024 * 1024, 1024, (bf16*)(ws + WS_ZR), modO + 2 * 1024, X + (size_t)MLAT * 1024, true);
        } SEAM(pb + PH_O5);
        if (IN(pb + PH_O6)) { FRESH(); phase_ln<false, true, true>(F, PA, PA.in[I_LN1G] + Lo * 1024, PA.in[I_LN1B] + Lo * 1024, modO + 3 * 1024, nullptr, PA.in[I_ROUTER] + (size_t)j * 1024 * 8, j, false, (j == 1) ? MLAT : MROWS); } SEAM(pb + PH_O6);
        if (IN(pb + PH_O7)) { FRESH(); phase_moe_dispatch(F, j, (j == 1) ? MLAT : MROWS); } SEAM(pb + PH_O7);
        if (IN(pb + PH_O8)) { FRESH();
            int off[9]; moe_offsets(F.ctl + CW_CNT + 64 * j, off);
            pg8::GroupedOrder S; S.nM = off[8] >> 8; S.nN = 2 * DFFE / 256; S.nwg = S.nM * S.nN; S.G = F.G; S.c = (int)blockIdx.x; S.estride = (long)2 * DFFE * 1024;
#pragma unroll
            for (int e = 0; e < 9; ++e) S.toff[e] = off[e] >> 8;
            pg8::Gemm g{(const bf16*)(ws + WS_XG8), (const bf16*)((unsigned char*)WM + WM_GU), MOE_ROWS, 2 * DFFE, 1024 / 2};
            pg8::EpiSwigluF8 E{ws + WS_MH, DFFE, 1.f / MOE_WSCALE};
            pg8::gemm_phase<pg8::EpiSwigluF8, pg8::GroupedOrder, true, true, true>(F.lds, g, S, E, F.tid);
        } SEAM(pb + PH_O8);
        if (IN(pb + PH_O9)) { FRESH();
            int off[9]; moe_offsets(F.ctl + CW_CNT + 64 * j, off);
            pg8::GroupedOrder S; S.nM = off[8] >> 8; S.nN = 1024 / 256; S.nwg = S.nM * S.nN; S.G = F.G; S.c = (int)blockIdx.x; S.estride = (long)1024 * DFFE;
#pragma unroll
            for (int e = 0; e < 9; ++e) S.toff[e] = off[e] >> 8;
            pg8::Gemm g{(const bf16*)(ws + WS_MH), (const bf16*)((unsigned char*)WM + WM_D), MOE_ROWS, 1024, DFFE / 2};
            pg8::EpiScaledBf16 E{(bf16*)(ws + WS_XG), 1024, 1.f / MOE_WSCALE};
            pg8::gemm_phase<pg8::EpiScaledBf16, pg8::GroupedOrder, true, true, true>(F.lds, g, S, E, F.tid);
        } SEAM(pb + PH_O9);
        if (IN(pb + PH_O10)) { FRESH(); phase_ln<true, false>(F, PA, PA.in[I_LN2G] + Lo * 1024, PA.in[I_LN2B] + Lo * 1024, mods + (size_t)(j == 0 ? 2 : 0) * 5 * 6144, modO + 5 * 1024, nullptr, 0, j == 1, (j == 1) ? MLAT : MROWS); }
        if (j == 0) { if (IN(pb + PH_O10)) { FRESH(); phase_cv(F, PA, 1); }
                      if (IN(pb + PH_O10) && IN(PH_PER + PH_E1)) xcd_barrier(bar); }
    }
#if defined(PROBE_BARRIERS)
    for (int i = 0; i < PROBE_BARRIERS; ++i) xcd_barrier(bar);
#endif
#if defined(PROBE_ACC)
    if (blockIdx.x == 0 && ({ int l_; asm volatile("v_mbcnt_lo_u32_b32 %0, -1, 0\n\tv_mbcnt_hi_u32_b32 %0, -1, %0" : "=v"(l_)); (wv0 == 0 && l_ == 0); })) { const unsigned d = MISC[18]; const unsigned t0 = (unsigned)__builtin_amdgcn_s_memrealtime(); while ((unsigned)__builtin_amdgcn_s_memrealtime() - t0 < 9u * d) __builtin_amdgcn_s_sleep(8); }
#endif
#if defined(PROBE_PH)
#if defined(PROBE_CLK)
    if (blockIdx.x == 0 && IS_T0()) { const unsigned d = MISC[18] / 20u; const unsigned t0 = (unsigned)__builtin_amdgcn_s_memrealtime(); while ((unsigned)__builtin_amdgcn_s_memrealtime() - t0 < 9u * d) __builtin_amdgcn_s_sleep(8); }
#else
    if (blockIdx.x == 0 && IS_T0()) { const unsigned d = MISC[18]; const unsigned t0 = (unsigned)__builtin_amdgcn_s_memrealtime(); while ((unsigned)__builtin_amdgcn_s_memrealtime() - t0 < 9u * d) __builtin_amdgcn_s_sleep(8); }
#endif
#endif
#undef IN
#undef SEAM
}

extern "C" void kernel_launch(void* const* d_in, const int* in_sizes, int n_in, void* d_out, int out_size, void* d_ws, size_t ws_size, hipStream_t stream) {
    static int grid = 0;
    if (grid == 0) {
        if (n_in != 30 || in_sizes[0] != MLAT * DM || out_size != MLAT * DM || ws_size < WS_END) { fprintf(stderr, "kernel_launch: unexpected shapes / workspace (n_in %d, ws %zu)\n", n_in, ws_size); grid = -1; return; }
        int dev = 0, cus = 0, per_cu = 0;
        if (hipGetDevice(&dev) != hipSuccess || hipDeviceGetAttribute(&cus, hipDeviceAttributeMultiprocessorCount, dev) != hipSuccess) { grid = -1; return; }
        if (hipFuncSetAttribute((const void*)mk_fwd, hipFuncAttributeMaxDynamicSharedMemorySize, LDS_BYTES) != hipSuccess) { fprintf(stderr, "kernel_launch: hipFuncSetAttribute failed\n"); grid = -1; return; }
        if (hipOccupancyMaxActiveBlocksPerMultiprocessor(&per_cu, (const void*)mk_fwd, NTHR, LDS_BYTES) != hipSuccess || per_cu < 1) { fprintf(stderr, "kernel_launch: occupancy query says %d\n", per_cu); }
        (void)hipGetLastError();
        grid = cus;
        if (grid != 256) { fprintf(stderr, "kernel_launch: built for 256 CUs, found %d\n", cus); grid = -1; return; }
    }
    if (grid < 0) return;
    if (hipMemsetAsync((char*)d_ws + WS_CTL, 0, CTL_ZERO_BYTES, stream) != hipSuccess) return;
    Args a{};
    for (int i = 0; i < 30; ++i) a.in[i] = (const float*)d_in[i];
    a.out = (float*)d_out; a.ws = (unsigned char*)d_ws;
#if MK_MULTI
    for (int ph = 0; ph < NPHASES; ++ph) {
        if (ph == PH_PER + PH_MOD || ph == PH_PER + PH_CV) continue;
        a.ph_lo = ph; a.ph_hi = ph + 1;
        hipLaunchKernelGGL(mk_fwd, dim3(grid), dim3(NTHR), LDS_BYTES, stream, a);
    }
#else
    a.ph_lo = 0; a.ph_hi = NPHASES;
    hipLaunchKernelGGL(mk_fwd, dim3(grid), dim3(NTHR), LDS_BYTES, stream, a);
#endif
}
```
